# Optimizing an MI355X kernel written in HIP

```python
import jax, jax.numpy as jnp
from jax import lax
import numpy as np

D_MODEL = 1024
BATCH = 4
SEQ = 8192
DEPTH = 4

MEM_LEN = 256
N_MIXERS = 2
CHUNK = 64
NORM_EPS = 1e-6
GLA_HEADS = 4
GLA_DK = (D_MODEL // 2) // GLA_HEADS
GLA_DV = D_MODEL // GLA_HEADS
GLA_GATE_RANK = 16
GLA_TAU = 16.0
HGRN_EXPAND = 128
HGRN_HEADS = D_MODEL // HGRN_EXPAND
HGRN_DF = HGRN_EXPAND
HGRN_FDIM = HGRN_HEADS * HGRN_DF
HGRN_DI = D_MODEL // HGRN_HEADS
XA_HEADS = 4
XA_DH = 128
XA_DIM = XA_HEADS * XA_DH
MLP_HIDDEN = 4 * D_MODEL
MIX_OUT_DIM = D_MODEL + XA_DIM
GLA_SPLITS = (GLA_HEADS * GLA_DK, GLA_HEADS * GLA_DK, GLA_HEADS * GLA_DV, GLA_GATE_RANK, D_MODEL, XA_DIM)
HGRN_SPLITS = (HGRN_FDIM, HGRN_FDIM, D_MODEL, D_MODEL, XA_DIM)
GLA_IN_DIM = sum(GLA_SPLITS)
HGRN_IN_DIM = sum(HGRN_SPLITS)

kernel_name = "hybrid_gla_hgrn2_memxattn_sqrelu"


def rms_norm(x, gain):
    x32 = x.astype(jnp.float32)
    y = x32 * lax.rsqrt(jnp.mean(x32 * x32, axis=-1, keepdims=True) + NORM_EPS)
    return (y * gain.astype(jnp.float32)).astype(x.dtype)


def split_cols(a, sizes):
    idx = [int(v) for v in np.cumsum(sizes)[:-1]]
    return jnp.split(a, idx, axis=-1)


def chunked_gated_linear_attention(q, k, v, log_decay):
    B, T, H, dk = q.shape
    dv = v.shape[-1]
    n = T // CHUNK

    def to_chunks(a):
        return a.astype(jnp.float32).reshape(B, n, CHUNK, H, a.shape[-1]).transpose(1, 0, 3, 2, 4)

    causal = jnp.tril(jnp.ones((CHUNK, CHUNK), dtype=bool))[None, None, :, :, None]

    def step(S, inp):
        qb, kb, vb, gb = inp
        b = jnp.cumsum(gb, axis=2)
        rel = jnp.exp(jnp.where(causal, b[:, :, :, None, :] - b[:, :, None, :, :], -jnp.inf))
        attn = jnp.einsum('bhtd,bhsd,bhtsd->bhts', qb, kb, rel)
        o = (jnp.einsum('bhtd,bhdv->bhtv', qb * jnp.exp(b), S)
             + jnp.einsum('bhts,bhsv->bhtv', attn, vb))
        b_last = b[:, :, -1, :]
        S = (jnp.exp(b_last)[..., None] * S
             + jnp.einsum('bhsd,bhsv->bhdv', kb * jnp.exp(b_last[:, :, None, :] - b), vb))
        return S, o

    S0 = jnp.zeros((B, H, dk, dv), jnp.float32)
    _, o = lax.scan(step, S0, (to_chunks(q), to_chunks(k), to_chunks(v), to_chunks(log_decay)))
    return o.transpose(1, 0, 3, 2, 4).reshape(B, T, H, dv)


def gla_branch(h, w_in, w_gate2, b_gate, out_gain):
    B, T, _ = h.shape
    q, k, v, g_lr, r, xq = split_cols(h @ w_in, GLA_SPLITS)
    q = q.reshape(B, T, GLA_HEADS, GLA_DK) * (GLA_DK ** -0.5)
    k = k.reshape(B, T, GLA_HEADS, GLA_DK)
    v = v.reshape(B, T, GLA_HEADS, GLA_DV)
    z = (g_lr @ w_gate2 + b_gate).astype(jnp.float32)
    log_alpha = (jax.nn.log_sigmoid(z) / GLA_TAU).reshape(B, T, GLA_HEADS, GLA_DK)
    o = chunked_gated_linear_attention(q, k, v, log_alpha)
    o = rms_norm(o, out_gain) * jax.nn.silu(r.astype(jnp.float32)).reshape(B, T, GLA_HEADS, GLA_DV)
    return o.reshape(B, T, D_MODEL).astype(h.dtype), xq


def hgrn2_branch(h, w_in, lower_bound, out_gain):
    B, T, _ = h.shape
    q, f, i, g, xq = split_cols(h @ w_in, HGRN_SPLITS)
    q = jax.nn.silu(q).reshape(B, T, HGRN_HEADS, HGRN_DF) * (HGRN_DF ** -0.5)
    lb = lower_bound.astype(jnp.float32)
    forget = lb + (1.0 - lb) * jax.nn.sigmoid(f.astype(jnp.float32))
    k = (1.0 - forget).reshape(B, T, HGRN_HEADS, HGRN_DF)
    log_f = jnp.log(forget).reshape(B, T, HGRN_HEADS, HGRN_DF)
    i = i.reshape(B, T, HGRN_HEADS, HGRN_DI)
    o = chunked_gated_linear_attention(q, k, i, log_f)
    o = rms_norm(o, out_gain) * jax.nn.silu(g.astype(jnp.float32)).reshape(B, T, HGRN_HEADS, HGRN_DI)
    return o.reshape(B, T, D_MODEL).astype(h.dtype), xq


def memory_cross_attention(xq, m, w_kv):
    B, T, _ = xq.shape
    km, vm = split_cols(m @ w_kv, (XA_DIM, XA_DIM))
    qh = xq.reshape(B, T, XA_HEADS, XA_DH)
    km = km.reshape(B, -1, XA_HEADS, XA_DH)
    vm = vm.reshape(B, -1, XA_HEADS, XA_DH)
    scores = jnp.einsum('bthd,bmhd->bhtm', qh, km).astype(jnp.float32) * (XA_DH ** -0.5)
    p = jax.nn.softmax(scores, axis=-1).astype(vm.dtype)
    out = jnp.einsum('bhtm,bmhd->bthd', p, vm)
    return out.reshape(B, T, XA_DIM)


def sq_relu_mlp(h, w_up, w_down):
    u = jax.nn.relu(h @ w_up)
    return (u * u) @ w_down


def setup_inputs(seed: int = 0) -> dict:
    key = jax.random.key(seed)
    ks = jax.random.split(key, 20)
    n_gla = len(range(0, DEPTH, N_MIXERS))
    n_hgrn = len(range(1, DEPTH, N_MIXERS))
    f32 = jnp.float32

    def w(k, shape, fan_in):
        return jax.random.normal(k, shape, f32) * (fan_in ** -0.5)

    def gain(k, shape):
        return 1.0 + 0.02 * jax.random.normal(k, shape, f32)

    return {
        "x": jax.random.normal(ks[0], (BATCH, SEQ, D_MODEL), f32),
        "mem": jax.random.normal(ks[1], (BATCH, MEM_LEN, D_MODEL), f32),
        "norm_mix": gain(ks[2], (DEPTH, D_MODEL)),
        "norm_mem": gain(ks[3], (DEPTH, D_MODEL)),
        "w_kv": w(ks[4], (DEPTH, D_MODEL, 2 * XA_DIM), D_MODEL),
        "w_out": w(ks[5], (DEPTH, MIX_OUT_DIM, D_MODEL), MIX_OUT_DIM),
        "norm_mlp": gain(ks[6], (DEPTH, D_MODEL)),
        "w_up": w(ks[7], (DEPTH, D_MODEL, MLP_HIDDEN), D_MODEL),
        "w_down": w(ks[8], (DEPTH, MLP_HIDDEN, D_MODEL), MLP_HIDDEN),
        "gla_w_in": w(ks[9], (n_gla, D_MODEL, GLA_IN_DIM), D_MODEL),
        "gla_w_gate2": w(ks[10], (n_gla, GLA_GATE_RANK, GLA_HEADS * GLA_DK), GLA_GATE_RANK),
        "gla_b_gate": 0.1 * jax.random.normal(ks[11], (n_gla, GLA_HEADS * GLA_DK), f32),
        "gla_out_gain": gain(ks[12], (n_gla, GLA_DV)),
        "hgrn_w_in": w(ks[13], (n_hgrn, D_MODEL, HGRN_IN_DIM), D_MODEL),
        "hgrn_lower_bounds": 0.1 * jax.random.normal(ks[14], (DEPTH, HGRN_FDIM), f32),
        "hgrn_out_gain": gain(ks[15], (n_hgrn, HGRN_DI)),
        "final_norm": gain(ks[16], (D_MODEL,)),
    }


def reference(x, mem, norm_mix, norm_mem, w_kv, w_out, norm_mlp, w_up, w_down,
              gla_w_in, gla_w_gate2, gla_b_gate, gla_out_gain,
              hgrn_w_in, hgrn_lower_bounds, hgrn_out_gain, final_norm):
    p = jax.nn.softmax(hgrn_lower_bounds.astype(jnp.float32), axis=0)
    lower_bounds = jnp.cumsum(p, axis=0) - p[0]

    for i in range(DEPTH):
        j = i // N_MIXERS
        h = rms_norm(x, norm_mix[i])
        m = rms_norm(mem, norm_mem[i])
        if i % N_MIXERS == 0:
            y_mix, xq = gla_branch(h, gla_w_in[j], gla_w_gate2[j], gla_b_gate[j], gla_out_gain[j])
        else:
            y_mix, xq = hgrn2_branch(h, hgrn_w_in[j], lower_bounds[i], hgrn_out_gain[j])
        y_mem = memory_cross_attention(xq, m, w_kv[i])
        x = x + jnp.concatenate([y_mix, y_mem.astype(y_mix.dtype)], axis=-1) @ w_out[i]
        x = x + sq_relu_mlp(rms_norm(x, norm_mlp[i]), w_up[i], w_down[i])
    return rms_norm(x, final_norm)
```

```cpp
#include <hip/hip_runtime.h>
#include <hip/hip_cooperative_groups.h>
#include <cstdio>
#include <cstdint>
namespace cg = cooperative_groups;

#ifndef ONE_LAUNCH
#define ONE_LAUNCH 1
#endif

namespace pg8 {
#define PG8_LAS __attribute__((address_space(3)))
typedef unsigned short bf16_t;
typedef short bf16x8 __attribute__((ext_vector_type(8)));
typedef float f32x4 __attribute__((ext_vector_type(4)));
typedef unsigned u32x4 __attribute__((ext_vector_type(4)));
typedef unsigned u32x2 __attribute__((ext_vector_type(2)));
constexpr int BM = 256, BK = 64, HALF = 128, HTB = HALF * BK * 2, STAGE_BYTES = 8 * HTB, NXCD = 8, WGM = 8;

__host__ __device__ __forceinline__ int lds_byte(int r, int c) { const int st = (r >> 4) * 2 + (c >> 5), rr = r & 15, cc = c & 31, ob = rr * 64 + cc * 2; return st * 1024 + (ob ^ (((ob >> 9) & 1) << 5)); }
__host__ __device__ __forceinline__ void stage_rc(int b, int& R, int& C) { const int st = b / 1024, sb = b % 1024, swz = sb ^ (((sb >> 9) & 1) << 5); R = (st >> 1) * 16 + swz / 64; C = (st & 1) * 32 + (swz % 64) / 2; }
__host__ __device__ __forceinline__ int perm32(int rho) { const int n = rho >> 4, i = rho & 15; return 8 * (i >> 2) + 4 * n + (i & 3); }

struct Unit { int pm, pn; };
struct Gemm { const bf16_t* A; const bf16_t* Bt; int M, N, K, lda, perm; };

struct StaticOrder {
    int nM, nN, nwg, G, c;
    __host__ __device__ void init(int M, int N, int G_, int c_) { nM = M / BM; nN = N / BM; nwg = nM * nN; G = G_; c = c_; }
    __host__ __device__ bool next(int i, Unit& u) const {
        const long L = (long)i * G + c; if (L >= nwg) return false;
        int wgid = (int)L; { const int q = nwg / NXCD, r = nwg % NXCD, xcd = wgid % NXCD, off = wgid / NXCD; wgid = (xcd < r ? xcd * (q + 1) : r * (q + 1) + (xcd - r) * q) + off; }
        const int nig = WGM * nN, gid = wgid / nig, fm = gid * WGM, gsz = (nM - fm) < WGM ? (nM - fm) : WGM;
        u.pm = fm + ((wgid % nig) % gsz); u.pn = (wgid % nig) / gsz; return true;
    }
    __device__ __forceinline__ void a_ready(const Unit&) const {}
    __device__ __forceinline__ void done(const Unit&) const {}
};

__device__ __forceinline__ float shx(float v, int mask, int lane) { return __int_as_float(__builtin_amdgcn_ds_bpermute((lane ^ mask) << 2, __float_as_int(v))); }
typedef float f32x2_t __attribute__((ext_vector_type(2)));
typedef __bf16 bf16x2_t __attribute__((ext_vector_type(2)));
__device__ __forceinline__ unsigned cvt_pk_native(float lo, float hi) { const f32x2_t f = {lo, hi}; const bf16x2_t b = __builtin_convertvector(f, bf16x2_t); return __builtin_bit_cast(unsigned, b); }
__device__ __forceinline__ unsigned cvt_pk_bf16(float lo, float hi) { unsigned r; asm volatile("v_cvt_pk_bf16_f32 %0, %1, %2" : "=v"(r) : "v"(lo), "v"(hi)); return r; }

__device__ __forceinline__ float fsigmoid(float v) { return __builtin_amdgcn_rcpf(1.0f + __expf(-v)); }
__device__ __forceinline__ float fsilu(float v) { return v * fsigmoid(v); }
__device__ __forceinline__ float row_rstd(const float* ss, int M, int row, int fq, int lane) {
    const float* p = ss + (size_t)(4 * fq) * M + row;
    float s = (p[0] + p[M]) + (p[2 * (size_t)M] + p[3 * (size_t)M]);
    s += shx(s, 16, lane); s += shx(s, 32, lane);
    return rsqrtf(s * (1.0f / 1024.0f) + 1e-6f);
}
template <int MODE> __device__ __forceinline__ float proj_act(float v, float a) {
    if (MODE == 1) return fsilu(v);
    if (MODE == 2) { const float z = v + a; const float ls = fminf(z, 0.f) - __logf(1.0f + __expf(-fabsf(z))); return ls * 0.0625f; }
    if (MODE == 3) { const float sg = fsigmoid(v); return __logf(a + (1.0f - a) * sg); }
    if (MODE == 4) return fsilu(v) * 0.08838834764831845f;
    if (MODE == 5) { const float r = fmaxf(v, 0.f); return r * r; }
    return v;
}
struct EpiAll {
    static constexpr bool AFTER_DRAIN = false;
    int kind, ldc, hgrn, M;
    bf16_t* O;
    const float* ss;
    const float* aux;
    const float* xin;
    float* xout;
    template <int MODE> __device__ __forceinline__ void body_proj(const f32x4 (&acc)[2][2][4][2], const Unit& u, int wr, int wc, int fr, int fq) const {
        const int row0 = u.pm * BM + wr * 64 + fr, col0 = u.pn * BM + wc * 32 + 8 * fq;
        f32x4 av[2][2];
#pragma unroll
        for (int bj = 0; bj < 2; ++bj)
#pragma unroll
            for (int n = 0; n < 2; ++n) av[bj][n] = (MODE == 2 || MODE == 3) ? *(const f32x4*)(aux + (col0 - 1024) + bj * HALF + 4 * n) : (f32x4){0.f, 0.f, 0.f, 0.f};
#pragma unroll
        for (int ai = 0; ai < 2; ++ai)
#pragma unroll
            for (int m = 0; m < 4; ++m) { const int row = row0 + ai * HALF + m * 16; const float rstd = row_rstd(ss, M, row, fq, fq * 16 + fr); bf16_t* rowp = O + (size_t)row * ldc + col0;
#pragma unroll
                for (int bj = 0; bj < 2; ++bj) { f32x4 v0 = acc[ai][bj][m][0] * rstd, v1 = acc[ai][bj][m][1] * rstd;
#pragma unroll
                    for (int j = 0; j < 4; ++j) { v0[j] = proj_act<MODE>(v0[j], av[bj][0][j]); v1[j] = proj_act<MODE>(v1[j], av[bj][1][j]); }
                    u32x4 w; w.x = cvt_pk_bf16(v0[0], v0[1]); w.y = cvt_pk_bf16(v0[2], v0[3]); w.z = cvt_pk_bf16(v1[0], v1[1]); w.w = cvt_pk_bf16(v1[2], v1[3]);
                    *(u32x4*)(rowp + bj * HALF) = w; } }
    }
    __device__ __forceinline__ void body_res(const f32x4 (&acc)[2][2][4][2], const Unit& u, int wr, int wc, int fr, int fq) const {
        const int row0 = u.pm * BM + wr * 64 + fr, col0 = u.pn * BM + wc * 32 + 4 * fq; float* ssw = (float*)ss;
#pragma unroll
        for (int ai = 0; ai < 2; ++ai)
#pragma unroll
            for (int m = 0; m < 4; ++m) { const int row = row0 + ai * HALF + m * 16; const size_t off = (size_t)row * 1024 + col0; float s = 0.f;
#pragma unroll
                for (int bj = 0; bj < 2; ++bj)
#pragma unroll
                    for (int n = 0; n < 2; ++n) { const f32x4 o = *(const f32x4*)(xin + off + bj * HALF + n * 16) + acc[ai][bj][m][n];
                        *(f32x4*)(xout + off + bj * HALF + n * 16) = o; s += (o[0] * o[0] + o[1] * o[1]) + (o[2] * o[2] + o[3] * o[3]);
                        u32x2 w; w.x = cvt_pk_bf16(o[0], o[1]); w.y = cvt_pk_bf16(o[2], o[3]); *(u32x2*)(O + off + bj * HALF + n * 16) = w; }
                s += shx(s, 16, fq * 16 + fr); s += shx(s, 32, fq * 16 + fr);
                if (fq == 0) ssw[(size_t)(u.pn * 4 + wc) * M + row] = s; }
    }
    __device__ __forceinline__ void body_kv(const f32x4 (&acc)[2][2][4][2], const Unit& u, int wr, int wc, int fr, int fq) const {
        const int row0 = u.pm * BM + wr * 64 + fr, layer = u.pn >> 2, cl0 = (u.pn & 3) * BM + wc * 32 + 4 * fq; bf16_t* VMT = (bf16_t*)xout;
#pragma unroll
        for (int ai = 0; ai < 2; ++ai)
#pragma unroll
            for (int m = 0; m < 4; ++m) { const int row = row0 + ai * HALF + m * 16; const float rstd = rsqrtf(ss[row] * (1.0f / 1024.0f) + 1e-6f);
#pragma unroll
                for (int bj = 0; bj < 2; ++bj)
#pragma unroll
                    for (int n = 0; n < 2; ++n) { const f32x4 o = acc[ai][bj][m][n] * rstd; const int cl = cl0 + bj * HALF + n * 16;
                        if (cl < 512) { u32x2 w; w.x = cvt_pk_bf16(o[0], o[1]); w.y = cvt_pk_bf16(o[2], o[3]); *(u32x2*)(O + ((size_t)layer * 1024 + row) * 512 + cl) = w; }
                        else { const unsigned lo = cvt_pk_bf16(o[0], o[1]), hi = cvt_pk_bf16(o[2], o[3]); bf16_t* d = VMT + ((size_t)(layer * 4 + (row >> 8)) * 512 + (cl - 512)) * 256 + (row & 255);
                            d[0] = (bf16_t)(lo & 0xffff); d[256] = (bf16_t)(lo >> 16); d[512] = (bf16_t)(hi & 0xffff); d[768] = (bf16_t)(hi >> 16); } } }
    }
    __device__ __forceinline__ void operator()(const f32x4 (&acc)[2][2][4][2], const Unit& u, int wr, int wc, int fr, int fq) const {
        if (kind == 0) {
            int mode;
            if (!hgrn) mode = (u.pn >= 4 && u.pn < 6) ? 2 : ((u.pn >= 6 && u.pn < 10) ? 1 : 0);
            else mode = u.pn < 4 ? 4 : (u.pn < 8 ? 3 : (u.pn < 12 ? 1 : 0));
            if (mode == 0) body_proj<0>(acc, u, wr, wc, fr, fq); else if (mode == 1) body_proj<1>(acc, u, wr, wc, fr, fq); else if (mode == 2) body_proj<2>(acc, u, wr, wc, fr, fq);
            else if (mode == 3) body_proj<3>(acc, u, wr, wc, fr, fq); else body_proj<4>(acc, u, wr, wc, fr, fq);
        } else if (kind == 1) body_proj<5>(acc, u, wr, wc, fr, fq);
        else if (kind == 2) body_res(acc, u, wr, wc, fr, fq);
        else body_kv(acc, u, wr, wc, fr, fq);
    }
};

template <class Epi, class Sched, bool ALIGN_EPI = false, bool SP2 = false>
__device__ __forceinline__ void gemm_phase(PG8_LAS unsigned char* lds, const Gemm g, const Sched& S, const Epi& E, const int tid) {
    const int wid = __builtin_amdgcn_readfirstlane(tid >> 6), lane = tid & 63, wr = wid >> 2, wc = wid & 3, fr = lane & 15, fq = lane >> 4;
    const int K = g.K, nt = K / BK;
    unsigned voffA[2], voffB[2];
#pragma unroll
    for (int i = 0; i < 2; ++i) { int R, C; stage_rc(tid * 16 + i * 8192, R, C); const int Rb = g.perm ? ((R & ~31) + perm32(R & 31)) : R;
        voffA[i] = (unsigned)(R * g.lda + C) * 2u; voffB[i] = (unsigned)(Rb * K + C) * 2u; }
    const size_t kstep = (size_t)(BK * 2);
    const size_t hstepA = (size_t)HALF * g.lda * 2, hstepB = (size_t)HALF * K * 2;
    const size_t tstepA = 2 * hstepA, tstepB = 2 * hstepB;
    const unsigned ldsw = (unsigned)wid * 1024u;
    const int aoff = lds_byte(wr * 64 + fr, fq * 8), boff = lds_byte(wc * 32 + fr, fq * 8);
#define PG8_SA(b, h) (((b) * 2 + (h)) * HTB)
#define PG8_SB(b, h) ((4 + (b) * 2 + (h)) * HTB)
#define PG8_STAGE(bufoff, gbase, voff) do { _Pragma("unroll") for (int _i = 0; _i < 2; ++_i) \
        __builtin_amdgcn_global_load_lds((const unsigned*)((const char*)(gbase) + (voff)[_i]), (PG8_LAS unsigned*)(lds + (bufoff) + ldsw + _i * 8192), 16, 0, 0); } while (0)
#define PG8_LDA(dst, b, h) do { _Pragma("unroll") for (int m = 0; m < 4; ++m) _Pragma("unroll") for (int k = 0; k < 2; ++k) dst[m][k] = *(const PG8_LAS bf16x8*)(lds + PG8_SA(b, h) + aoff + m * 2048 + k * 1024); } while (0)
#define PG8_LDB(dst, b, h) do { _Pragma("unroll") for (int n = 0; n < 2; ++n) _Pragma("unroll") for (int k = 0; k < 2; ++k) dst[n][k] = *(const PG8_LAS bf16x8*)(lds + PG8_SB(b, h) + boff + n * 2048 + k * 1024); } while (0)
#define PG8_MMA(ai, bj, At, Bt) do { __builtin_amdgcn_s_setprio(1); _Pragma("unroll") for (int m = 0; m < 4; ++m) _Pragma("unroll") for (int n = 0; n < 2; ++n) _Pragma("unroll") for (int k = 0; k < 2; ++k) \
        acc[ai][bj][m][n] = __builtin_amdgcn_mfma_f32_16x16x32_bf16(Bt[n][k], At[m][k], acc[ai][bj][m][n], 0, 0, 0); __builtin_amdgcn_s_setprio(0); } while (0)
#define PG8_WAIT_V(n) asm volatile("s_waitcnt vmcnt(" #n ")" ::: "memory")
#define PG8_WAIT_L(n) asm volatile("s_waitcnt lgkmcnt(" #n ")" ::: "memory")
#define PG8_BAR __builtin_amdgcn_s_barrier()
#define PG8_SCHED __builtin_amdgcn_sched_barrier(0)
    Unit cur, nxt; int ui = 0;
    if (!S.next(0, cur)) return;
    f32x4 acc[2][2][4][2];
#pragma unroll
    for (int a = 0; a < 2; ++a)
#pragma unroll
        for (int b = 0; b < 2; ++b)
#pragma unroll
            for (int m = 0; m < 4; ++m)
#pragma unroll
                for (int n = 0; n < 2; ++n) acc[a][b][m][n] = (f32x4){0.f, 0.f, 0.f, 0.f};
    bf16x8 At[4][2], B0[2][2], B1[2][2];
    const char* cA = (const char*)g.A + (size_t)cur.pm * tstepA; const char* cB = (const char*)g.Bt + (size_t)cur.pn * tstepB;
    S.a_ready(cur);
    if constexpr (SP2) {
        PG8_STAGE(PG8_SB(0, 0), cB, voffB); PG8_STAGE(PG8_SB(0, 1), cB + hstepB, voffB); PG8_STAGE(PG8_SA(0, 0), cA, voffA); PG8_STAGE(PG8_SA(0, 1), cA + hstepA, voffA);
        if (wr == 1) PG8_BAR;
        PG8_WAIT_V(2); PG8_BAR;
        PG8_STAGE(PG8_SB(1, 0), cB + kstep, voffB); PG8_STAGE(PG8_SA(1, 0), cA + kstep, voffA); PG8_STAGE(PG8_SB(1, 1), cB + hstepB + kstep, voffB);
        PG8_WAIT_V(6); PG8_BAR;
    } else {
        PG8_STAGE(PG8_SB(0, 0), cB, voffB); PG8_STAGE(PG8_SA(0, 0), cA, voffA); PG8_STAGE(PG8_SB(0, 1), cB + hstepB, voffB); PG8_STAGE(PG8_SA(0, 1), cA + hstepA, voffA);
        if (wr == 1) PG8_BAR;
        PG8_WAIT_V(4); PG8_BAR;
        PG8_STAGE(PG8_SB(1, 0), cB + kstep, voffB); PG8_STAGE(PG8_SA(1, 0), cA + kstep, voffA); PG8_STAGE(PG8_SB(1, 1), cB + hstepB + kstep, voffB);
        PG8_WAIT_V(6); PG8_BAR;
    }
    for (;;) {
        const bool has_next = S.next(ui + 1, nxt);
        const char* nA = has_next ? (const char*)g.A + (size_t)nxt.pm * tstepA : cA; const char* nB = has_next ? (const char*)g.Bt + (size_t)nxt.pn * tstepB : cB;
        for (int t = 0; t < nt; t += 2) {
            const bool last = (t == nt - 2);
            const char* a1 = cA + (size_t)(t + 1) * kstep;
            const char* a2 = last ? nA : cA + (size_t)(t + 2) * kstep; const char* b2 = last ? nB : cB + (size_t)(t + 2) * kstep;
            const char* a3 = a2 + kstep; const char* b3 = b2 + kstep;
            if (last && has_next) S.a_ready(nxt);
            if constexpr (SP2) {
            PG8_LDB(B0, 0, 0); PG8_LDB(B1, 0, 1); PG8_SCHED; PG8_LDA(At, 0, 0); PG8_STAGE(PG8_SA(1, 1), a1 + hstepA, voffA);
            PG8_WAIT_V(8); PG8_WAIT_L(0); PG8_BAR; PG8_MMA(0, 0, At, B0); PG8_MMA(0, 1, At, B1); PG8_BAR; PG8_SCHED;
            PG8_LDA(At, 0, 1); PG8_STAGE(PG8_SB(0, 0), b2, voffB); PG8_STAGE(PG8_SB(0, 1), b2 + hstepB, voffB); PG8_STAGE(PG8_SA(0, 0), a2, voffA);
            PG8_WAIT_V(8); PG8_WAIT_L(0); PG8_BAR; PG8_MMA(1, 0, At, B0); PG8_MMA(1, 1, At, B1); PG8_BAR; PG8_SCHED;
            PG8_LDB(B0, 1, 0); PG8_LDB(B1, 1, 1); PG8_SCHED; PG8_LDA(At, 1, 0); PG8_STAGE(PG8_SA(0, 1), a2 + hstepA, voffA);
            PG8_WAIT_V(8); PG8_WAIT_L(0); PG8_BAR; PG8_MMA(0, 0, At, B0); PG8_MMA(0, 1, At, B1); PG8_BAR; PG8_SCHED;
            PG8_LDA(At, 1, 1); PG8_STAGE(PG8_SB(1, 0), b3, voffB); PG8_STAGE(PG8_SB(1, 1), b3 + hstepB, voffB); PG8_STAGE(PG8_SA(1, 0), a3, voffA);
            PG8_WAIT_V(8); PG8_WAIT_L(0); PG8_BAR; PG8_MMA(1, 0, At, B0); PG8_MMA(1, 1, At, B1); PG8_BAR; PG8_SCHED;
            } else {
            PG8_LDB(B0, 0, 0); PG8_SCHED; PG8_LDA(At, 0, 0); PG8_STAGE(PG8_SA(1, 1), a1 + hstepA, voffA);
            PG8_WAIT_L(8); PG8_BAR; PG8_WAIT_L(0); PG8_MMA(0, 0, At, B0); PG8_BAR; PG8_SCHED;
            PG8_LDB(B1, 0, 1); PG8_STAGE(PG8_SB(0, 0), b2, voffB);
            PG8_BAR; PG8_WAIT_L(0); PG8_MMA(0, 1, At, B1); PG8_BAR;
            PG8_LDA(At, 0, 1); PG8_STAGE(PG8_SA(0, 0), a2, voffA);
            PG8_BAR; PG8_WAIT_L(0); PG8_MMA(1, 0, At, B0); PG8_BAR; PG8_SCHED;
            PG8_STAGE(PG8_SB(0, 1), b2 + hstepB, voffB);
            PG8_WAIT_V(6); PG8_BAR; PG8_MMA(1, 1, At, B1); PG8_BAR;
            PG8_LDB(B0, 1, 0); PG8_SCHED; PG8_LDA(At, 1, 0); PG8_STAGE(PG8_SA(0, 1), a2 + hstepA, voffA);
            PG8_WAIT_L(8); PG8_BAR; PG8_WAIT_L(0); PG8_MMA(0, 0, At, B0); PG8_BAR; PG8_SCHED;
            PG8_LDB(B1, 1, 1); PG8_STAGE(PG8_SB(1, 0), b3, voffB);
            PG8_BAR; PG8_WAIT_L(0); PG8_MMA(0, 1, At, B1); PG8_BAR;
            PG8_LDA(At, 1, 1); PG8_STAGE(PG8_SA(1, 0), a3, voffA);
            PG8_BAR; PG8_WAIT_L(0); PG8_MMA(1, 0, At, B0); PG8_BAR; PG8_SCHED;
            PG8_STAGE(PG8_SB(1, 1), b3 + hstepB, voffB);
            PG8_WAIT_V(6); PG8_BAR; PG8_MMA(1, 1, At, B1); PG8_BAR;
            }
        }
        if constexpr (ALIGN_EPI) { if (wr == 0) PG8_BAR; }
        if constexpr (!Epi::AFTER_DRAIN) { E(acc, cur, wr, wc, fr, fq); S.done(cur); }
        if (!has_next) break;
#pragma unroll
        for (int a = 0; a < 2; ++a)
#pragma unroll
            for (int b = 0; b < 2; ++b)
#pragma unroll
                for (int m = 0; m < 4; ++m)
#pragma unroll
                    for (int n = 0; n < 2; ++n) acc[a][b][m][n] = (f32x4){0.f, 0.f, 0.f, 0.f};
        cur = nxt; cA = nA; cB = nB; ++ui;
        if constexpr (ALIGN_EPI) { if (wr == 1) PG8_BAR; }
    }
    PG8_WAIT_V(0);
    if constexpr (!ALIGN_EPI) { if (wr == 0) PG8_BAR; }
    PG8_BAR;
    if constexpr (Epi::AFTER_DRAIN) { E.fused(acc, cur, wr, wc, fr, fq, lds, wid, lane); S.done(cur); }
#undef PG8_SA
#undef PG8_SB
#undef PG8_STAGE
#undef PG8_LDA
#undef PG8_LDB
#undef PG8_MMA
#undef PG8_WAIT_V
#undef PG8_WAIT_L
#undef PG8_BAR
#undef PG8_SCHED
}
}

constexpr int NWAVES = 8, NT = 512;
constexpr int D = 1024, BATCH = 4, T = 8192, M = BATCH * T, DEPTH = 4, MEM = 256, MROWS = BATCH * MEM;
constexpr int DK = 128, CH = 64, NCH = T / CH;
constexpr int GLA_N = 4096, HGRN_N = 4608, FF = 4096, KOUT = 1536;
constexpr float EPS = 1e-6f;
constexpr size_t MiB = 1u << 20;
constexpr size_t WS_SS = 0;
constexpr size_t WS_DEC = 2 * MiB;
constexpr size_t WS_MEMB = 4 * MiB;
constexpr size_t WS_SSM = 6 * MiB;
constexpr size_t WS_LB = 6 * MiB + 65536;
constexpr size_t WS_KM = 8 * MiB;
constexpr size_t WS_VMT = 12 * MiB;
constexpr size_t WS_WKV = 16 * MiB;
constexpr size_t WS_WT = 24 * MiB, WT_BUF = 30 * MiB;
constexpr size_t WT_IN = 0, WT_OUT = 10 * MiB, WT_UP = 14 * MiB, WT_DOWN = 22 * MiB;
constexpr size_t WS_PROJ = 84 * MiB;
constexpr size_t WS_XB = 372 * MiB;
constexpr size_t WS_END = 500 * MiB;
constexpr int LDS_BYTES = 147456;

#define LAS __attribute__((address_space(3)))
typedef unsigned short bf16;
typedef float f32x4 __attribute__((ext_vector_type(4)));
typedef short bf16x8 __attribute__((ext_vector_type(8)));
typedef short bf16x4 __attribute__((ext_vector_type(4)));
typedef unsigned u32x4 __attribute__((ext_vector_type(4)));
typedef unsigned u32x2 __attribute__((ext_vector_type(2)));
__device__ __forceinline__ float bf2f(bf16 b) { return __uint_as_float(((unsigned)b) << 16); }
__device__ __forceinline__ unsigned f2bf(float f) { unsigned u = __float_as_uint(f); return (u + 0x7fffu + ((u >> 16) & 1u)) >> 16; }
__device__ __forceinline__ unsigned pk2(float lo, float hi) { return pg8::cvt_pk_bf16(lo, hi); }
__device__ __forceinline__ float wave_sum(float v, int lane) {
#pragma unroll
    for (int o = 1; o < 64; o <<= 1) v += pg8::shx(v, o, lane);
    return v;
}
#define MFMA16(a, b, c) __builtin_amdgcn_mfma_f32_16x16x32_bf16((a), (b), (c), 0, 0, 0)

constexpr size_t WS_CTL = 7 * MiB, CTL_BYTES = 16384;
constexpr int LDS_BARST = LDS_BYTES - 64;
#define XB_TMO      128
#define XB_XCNT(j)  (256  + 64 * (j))
#define XB_XSUB(j)  (1280 + 64 * (j))
#define XB_XGEN(j)  (2304 + 64 * (j))
#define XB_TOP      3328
#define XB_TOPGEN   3392
#define XCD_BAR_WORDS 3456
#define XB_SPIN_CAP (1u << 18)

__device__ __forceinline__ unsigned xb_ld(unsigned* p)              { return __hip_atomic_load(p, __ATOMIC_RELAXED, __HIP_MEMORY_SCOPE_AGENT); }
__device__ __forceinline__ unsigned xb_add(unsigned* p, unsigned v) { return __hip_atomic_fetch_add(p, v, __ATOMIC_RELAXED, __HIP_MEMORY_SCOPE_AGENT); }
__device__ __forceinline__ unsigned xb_xcc_id() { return (unsigned)__builtin_amdgcn_s_getreg((3 << 11) | 20) & 0xFu; }
#define XB_SPIN(cond, bar) do { unsigned _sp = 0; while (cond) { __builtin_amdgcn_s_sleep(1); \
    if ((++_sp & 255u) == 0u) { if (xb_ld(&(bar)[XB_TMO])) break; if (_sp > XB_SPIN_CAP) { atomicAdd(&(bar)[XB_TMO], 1u); break; } } } } while (0)

struct XcdBarrier {
    unsigned* bar; unsigned x;
    volatile LAS unsigned* st;
};

__device__ __forceinline__ XcdBarrier xcd_barrier_post(unsigned* bar, volatile LAS unsigned* st, int tid) {
    XcdBarrier b; b.bar = bar; b.x = xb_xcc_id(); b.st = st;
    if (tid == 0) (void)xb_add(&bar[XB_XCNT(b.x)], 1u);
    return b;
}
__device__ __forceinline__ void xcd_barrier_complete(unsigned* bar, unsigned x, unsigned& nloc, unsigned& nx) {
    const unsigned G = gridDim.x * gridDim.y * gridDim.z;
    unsigned sum, cnt, mine, sp = 0u;
    for (;;) {
        sum = 0u; cnt = 0u; mine = 0u;
#pragma unroll
        for (unsigned j = 0; j < 16; ++j) { const unsigned c = xb_ld(&bar[XB_XCNT(j)]); sum += c; cnt += (c > 0u) ? 1u : 0u; mine = (j == x) ? c : mine; }
        if (sum == G) break;
        __builtin_amdgcn_s_sleep(1);
        if ((++sp & 255u) == 0u) { if (xb_ld(&bar[XB_TMO])) break; if (sp > XB_SPIN_CAP) { atomicAdd(&bar[XB_TMO], 1u); break; } }
    }
    nloc = mine > 0u ? mine : 1u; nx = cnt > 0u ? cnt : 1u;
}

__device__ __forceinline__ void xcd_barrier(const XcdBarrier& b, int tid) {
    asm volatile("s_waitcnt vmcnt(0)" ::: "memory");
    __syncthreads();
    if (tid == 0) {
        unsigned* bar = b.bar;
        __builtin_amdgcn_s_waitcnt(0);
        unsigned nloc = b.st[0], nx = b.st[1];
        if (nloc == 0u) { xcd_barrier_complete(bar, b.x, nloc, nx); b.st[0] = nloc; b.st[1] = nx; }
        const unsigned old = xb_add(&bar[XB_XSUB(b.x)], 1u);
        const unsigned gen = old / nloc;
        if (old + 1u == (gen + 1u) * nloc) {
            __builtin_amdgcn_fence(__ATOMIC_RELEASE, "agent");
            asm volatile("s_waitcnt vmcnt(0)" ::: "memory");
            const unsigned og = xb_add(&bar[XB_TOP], 1u);
            const unsigned tg = og / nx;
            if (og + 1u == (tg + 1u) * nx) xb_add(&bar[XB_TOPGEN], 1u);
            else XB_SPIN(xb_ld(&bar[XB_TOPGEN]) == tg, bar);
            __builtin_amdgcn_fence(__ATOMIC_ACQUIRE, "agent");
            xb_add(&bar[XB_XGEN(b.x)], 1u);
            asm volatile("s_waitcnt vmcnt(0)" ::: "memory");
        } else {
            XB_SPIN(xb_ld(&bar[XB_XGEN(b.x)]) == gen, bar);
            __builtin_amdgcn_fence(__ATOMIC_ACQUIRE, "agent");
            asm volatile("s_waitcnt vmcnt(0)" ::: "memory");
        }
    }
    __syncthreads();
}

__device__ __forceinline__ void transpose_item(const float* W, int ldw, int K, int sc, bf16* WT, int dr, const float* gain, int gmask, int glimit, float scale, LAS float* scr, int item, int nblk, int lane) {
    const int kb = item / nblk, nb = item % nblk, k0 = 64 * kb, n0 = 32 * nb;
#pragma unroll 8
    for (int i = 0; i < 32; ++i) { const int kk = 2 * i + (lane >> 5); const int k = k0 + kk; float g = scale; if (gain && k < glimit) g *= gain[k & gmask];
        scr[kk * 33 + (lane & 31)] = W[(size_t)k * ldw + sc + n0 + (lane & 31)] * g; }
    asm volatile("s_waitcnt lgkmcnt(0)" ::: "memory");
    const int c = lane & 7;
#pragma unroll
    for (int j = 0; j < 4; ++j) { const int n = (lane >> 3) + 8 * j; const LAS float* s = scr + (8 * c) * 33 + n;
        u32x4 o; o.x = pk2(s[0 * 33], s[1 * 33]); o.y = pk2(s[2 * 33], s[3 * 33]); o.z = pk2(s[4 * 33], s[5 * 33]); o.w = pk2(s[6 * 33], s[7 * 33]);
        *(u32x4*)(WT + (size_t)(dr + n0 + n) * K + k0 + 8 * c) = o; }
    asm volatile("s_waitcnt lgkmcnt(0)" ::: "memory");
}
struct Ptrs {
    const float *x, *mem, *norm_mix, *norm_mem, *w_kv, *w_out, *norm_mlp, *w_up, *w_down, *gla_w_in, *gla_w_gate2, *gla_b_gate, *gla_out_gain, *hgrn_w_in, *hgrn_lb, *hgrn_out_gain, *final_norm;
    float* out; unsigned char* ws;
};
#define SEG(Wp, ldw, K, sc, ncols, WTp, dr, gain, gmask, glimit, scale) { const int nblk_ = (ncols) / 32, nit_ = ((K) / 64) * nblk_; \
    if (r < nit_) { transpose_item(Wp, ldw, K, sc, WTp, dr, gain, gmask, glimit, scale, scr, r, nblk_, lane); continue; } r -= nit_; }
template <class PT> __device__ __forceinline__ void convert_layer(PT Pp, int L, LAS unsigned char* lds, int gw, int ngw, int wave, int lane) {
    LAS float* scr = (LAS float*)(lds + wave * 16384);
    unsigned char* wb = Pp->ws + WS_WT + (size_t)(L & 1) * WT_BUF;
    bf16* Win = (bf16*)(wb + WT_IN); bf16* Wout = (bf16*)(wb + WT_OUT); bf16* Wup = (bf16*)(wb + WT_UP); bf16* Wdn = (bf16*)(wb + WT_DOWN);
    const int j = L >> 1; const bool hg = (L & 1);
    const float* gmix = Pp->norm_mix + (size_t)L * D; const float* gmlp = Pp->norm_mlp + (size_t)L * D;
    const float* wo = Pp->w_out + (size_t)L * KOUT * D; const float* wu = Pp->w_up + (size_t)L * D * FF; const float* wd = Pp->w_down + (size_t)L * FF * D;
    const float QS = 0.08838834764831845f;
    if (!hg) {
        const float* wi = Pp->gla_w_in + (size_t)j * D * 3600; const float* og = Pp->gla_out_gain + (size_t)j * 256;
        const int total = 16 * (16 + 16 + 32 + 32 + 16) + 24 * 32 + 16 * 128 + 64 * 32 + 128;
        for (int it = gw; it < total; it += ngw) { int r = it;
            SEG(wi, 3600, D, 0, 512, Win, 0, gmix, 1023, D, QS)
            SEG(wi, 3600, D, 512, 512, Win, 512, gmix, 1023, D, 1.f)
            SEG(wi, 3600, D, 1024, 1024, Win, 2560, gmix, 1023, D, 1.f)
            SEG(wi, 3600, D, 2064, 1024, Win, 1536, gmix, 1023, D, 1.f)
            SEG(wi, 3600, D, 3088, 512, Win, 3584, gmix, 1023, D, QS)
            SEG(wo, D, KOUT, 0, 1024, Wout, 0, og, 255, 1024, 1.f)
            SEG(wu, FF, D, 0, 4096, Wup, 0, gmlp, 1023, D, 1.f)
            SEG(wd, D, FF, 0, 1024, Wdn, 0, (const float*)nullptr, 0, 0, 1.f)
            { const int kb = r >> 3, cb = r & 7, k = kb * 64 + lane; const float* g2 = Pp->gla_w_gate2 + (size_t)j * 16 * 512 + cb * 64;
              const f32x4* wr4 = (const f32x4*)(wi + (size_t)k * 3600 + 2048); const f32x4 w0 = wr4[0], w1 = wr4[1], w2 = wr4[2], w3 = wr4[3]; const float gk = gmix[k];
              for (int c = 0; c < 64; ++c) { float s = 0.f;
#pragma unroll
                  for (int q = 0; q < 4; ++q) { s += w0[q] * g2[q * 512 + c]; s += w1[q] * g2[(4 + q) * 512 + c]; s += w2[q] * g2[(8 + q) * 512 + c]; s += w3[q] * g2[(12 + q) * 512 + c]; }
                  Win[(size_t)(1024 + cb * 64 + c) * D + k] = (bf16)f2bf(s * gk); } }
        }
    } else {
        const float* wi = Pp->hgrn_w_in + (size_t)j * D * 4608; const float* og = Pp->hgrn_out_gain + (size_t)j * 128;
        const int total = 16 * (32 + 32 + 32 + 32 + 16) + 24 * 32 + 16 * 128 + 64 * 32;
        for (int it = gw; it < total; it += ngw) { int r = it;
            SEG(wi, 4608, D, 0, 1024, Win, 0, gmix, 1023, D, 1.f)
            SEG(wi, 4608, D, 1024, 1024, Win, 1024, gmix, 1023, D, 1.f)
            SEG(wi, 4608, D, 2048, 1024, Win, 3072, gmix, 1023, D, 1.f)
            SEG(wi, 4608, D, 3072, 1024, Win, 2048, gmix, 1023, D, 1.f)
            SEG(wi, 4608, D, 4096, 512, Win, 4096, gmix, 1023, D, QS)
            SEG(wo, D, KOUT, 0, 1024, Wout, 0, og, 127, 1024, 1.f)
            SEG(wu, FF, D, 0, 4096, Wup, 0, gmlp, 1023, D, 1.f)
            { const int nblk_ = 32; transpose_item(wd, D, FF, 0, Wdn, 0, (const float*)nullptr, 0, 0, 1.f, scr, r, nblk_, lane); }
        }
    }
}
template <class PT> __device__ __forceinline__ void prologue(PT Pp, LAS unsigned char* lds, int gw, int ngw, int wave, int lane) {
    convert_layer(Pp, 0, lds, gw, ngw, wave, lane);
    { LAS float* scr = (LAS float*)(lds + wave * 16384); bf16* Wkv = (bf16*)(Pp->ws + WS_WKV);
      const int per = 16 * 32, total = 4 * per;
      for (int it = gw; it < total; it += ngw) { const int L = it / per, r = it % per;
          transpose_item(Pp->w_kv + (size_t)L * D * 1024, 1024, D, 0, Wkv + (size_t)L * 1024 * D, 0, Pp->norm_mem + (size_t)L * D, 1023, D, 1.f, scr, r, 32, lane); } }
    { float* LB = (float*)(Pp->ws + WS_LB);
      for (int c = gw * 64 + lane; c < 1024; c += ngw * 64) { const float v0 = Pp->hgrn_lb[c], v1 = Pp->hgrn_lb[1024 + c], v2 = Pp->hgrn_lb[2048 + c], v3 = Pp->hgrn_lb[3072 + c];
          const float mx = fmaxf(fmaxf(v0, v1), fmaxf(v2, v3)); const float e0 = expf(v0 - mx), e1 = expf(v1 - mx), e2 = expf(v2 - mx), e3 = expf(v3 - mx); const float inv = 1.0f / (e0 + e1 + e2 + e3);
          LB[c] = 0.f; LB[1024 + c] = e1 * inv; LB[2048 + c] = (e1 + e2) * inv; LB[3072 + c] = (e1 + e2 + e3) * inv; } }
    bf16* XB = (bf16*)(Pp->ws + WS_XB); float* SS = (float*)(Pp->ws + WS_SS); bf16* MB = (bf16*)(Pp->ws + WS_MEMB); float* SSM = (float*)(Pp->ws + WS_SSM);
    for (int m = gw; m < M + MROWS; m += ngw) {
        const bool ism = m >= M; const int row = ism ? m - M : m;
        const f32x4* xr = (const f32x4*)((ism ? Pp->mem : Pp->x) + (size_t)row * D) + lane; unsigned long long* o8 = (unsigned long long*)((ism ? MB : XB) + (size_t)row * D) + lane;
        float s = 0.f;
#pragma unroll
        for (int j = 0; j < 4; ++j) { const f32x4 v = xr[64 * j]; s += (v.x * v.x + v.y * v.y) + (v.z * v.z + v.w * v.w); o8[64 * j] = (unsigned long long)pk2(v.x, v.y) | ((unsigned long long)pk2(v.z, v.w) << 32); }
        s = wave_sum(s, lane);
        if (ism) { if (lane == 0) SSM[row] = s; }
        else if (lane < 16) SS[(size_t)lane * M + row] = lane == 0 ? s : 0.f;
    }
}
constexpr int KT_STR = 144;
constexpr int QS_STR = 272;
constexpr int L_TOT = 0;
constexpr int L_KT = 2048;
constexpr int L_VT = L_KT + 128 * KT_STR;
constexpr int L_QS = L_VT + 256 * KT_STR;
constexpr int L_KS = L_QS + 64 * QS_STR;
constexpr int L_AT = L_KS + 64 * QS_STR;
constexpr int L_RED = L_AT + 64 * KT_STR;
static_assert(L_RED + 2048 <= LDS_BYTES, "mixer LDS map");

template <bool HGRN>
__device__ __forceinline__ void chunk_cumsum(LAS unsigned char* lds, const bf16* base, int ld, int lacol, int kcol, int d, int rg, float (&bb)[16], float (&kv)[16], float& blast) {
#pragma unroll
    for (int i = 0; i < 16; ++i) { const bf16* rp = base + (size_t)(rg * 16 + i) * ld; const float la = bf2f(rp[lacol + d]); bb[i] = la; kv[i] = HGRN ? (1.0f - __expf(la)) : bf2f(rp[kcol + d]); }
#pragma unroll
    for (int i = 1; i < 16; ++i) bb[i] += bb[i - 1];
    LAS float* tot = (LAS float*)(lds + L_TOT);
    tot[rg * 128 + d] = bb[15];
    __syncthreads();
    const float t0 = tot[d], t1 = tot[128 + d], t2 = tot[256 + d], t3 = tot[384 + d];
    const float off = rg == 0 ? 0.f : (rg == 1 ? t0 : (rg == 2 ? t0 + t1 : t0 + t1 + t2));
    blast = (t0 + t1) + (t2 + t3);
#pragma unroll
    for (int i = 0; i < 16; ++i) bb[i] += off;
}
template <int DV>
__device__ __forceinline__ void load_vt(LAS unsigned char* lds, const bf16* base, int ld, int vcol, int tid) {
    constexpr int RPT = DV / 8;
    const int v = tid % DV, part = tid / DV;
    unsigned w[RPT / 2];
#pragma unroll
    for (int i = 0; i < RPT / 2; ++i) { const unsigned lo = base[(size_t)(part * RPT + 2 * i) * ld + vcol + v], hi = base[(size_t)(part * RPT + 2 * i + 1) * ld + vcol + v]; w[i] = lo | (hi << 16); }
    LAS u32x4* dst = (LAS u32x4*)(lds + L_VT + v * KT_STR + part * RPT * 2);
#pragma unroll
    for (int i = 0; i < RPT / 8; ++i) dst[i] = (u32x4){w[4 * i], w[4 * i + 1], w[4 * i + 2], w[4 * i + 3]};
}
template <int DV, bool HGRN>
__device__ __forceinline__ void pass_a(LAS unsigned char* lds, const bf16* proj, bf16* GS, float* DEC, int G, int bid, const int tid) {
    constexpr int H = HGRN ? 8 : 4, LD = HGRN ? HGRN_N : GLA_N, NTW = DV / 128;
    const int lane = tid & 63, wave = tid >> 6, g = lane >> 4, l15 = lane & 15, d = tid & 127, rg = tid >> 7;
    for (int u = bid; u < BATCH * H * NCH; u += G) {
        const int b = u / (H * NCH), h = (u / NCH) % H, n = u % NCH;
        const bf16* base = proj + (size_t)(b * T + n * CH) * LD;
        const int lacol = 1024 + h * 128, kcol = 512 + h * 128, vcol = (HGRN ? 3072 : 2560) + h * DV;
        float bb[16], kv[16], blast;
        chunk_cumsum<HGRN>(lds, base, LD, lacol, kcol, d, rg, bb, kv, blast);
        { unsigned w[8];
#pragma unroll
          for (int i = 0; i < 8; ++i) w[i] = pk2(kv[2 * i] * __expf(-bb[2 * i]), kv[2 * i + 1] * __expf(-bb[2 * i + 1]));
          LAS u32x4* dst = (LAS u32x4*)(lds + L_KT + d * KT_STR + rg * 32);
          dst[0] = (u32x4){w[0], w[1], w[2], w[3]}; dst[1] = (u32x4){w[4], w[5], w[6], w[7]}; }
        if (rg == 0) DEC[(size_t)u * 128 + d] = __expf(blast);
        load_vt<DV>(lds, base, LD, vcol, tid);
        __syncthreads();
        f32x4 acc[8][NTW];
#pragma unroll
        for (int mt = 0; mt < 8; ++mt)
#pragma unroll
            for (int nt = 0; nt < NTW; ++nt) acc[mt][nt] = (f32x4){0.f, 0.f, 0.f, 0.f};
#pragma unroll
        for (int kk = 0; kk < 2; ++kk) {
            bf16x8 bfr[NTW];
#pragma unroll
            for (int nt = 0; nt < NTW; ++nt) bfr[nt] = *(const LAS bf16x8*)(lds + L_VT + ((wave * NTW + nt) * 16 + l15) * KT_STR + (kk * 32 + 8 * g) * 2);
#pragma unroll
            for (int mt = 0; mt < 8; ++mt) { const bf16x8 afr = *(const LAS bf16x8*)(lds + L_KT + (mt * 16 + l15) * KT_STR + (kk * 32 + 8 * g) * 2);
#pragma unroll
                for (int nt = 0; nt < NTW; ++nt) acc[mt][nt] = MFMA16(afr, bfr[nt], acc[mt][nt]); }
        }
#pragma unroll
        for (int mt = 0; mt < 8; ++mt)
#pragma unroll
            for (int nt = 0; nt < NTW; ++nt) asm volatile("s_nop 7\n\ts_nop 7" : "+v"(acc[mt][nt]));
#pragma unroll
        for (int nt = 0; nt < NTW; ++nt) { bf16* gp = GS + ((size_t)u * DV + (wave * NTW + nt) * 16 + l15) * 128 + 4 * g;
#pragma unroll
            for (int mt = 0; mt < 8; ++mt) { u32x2 w; w.x = pk2(acc[mt][nt][0], acc[mt][nt][1]); w.y = pk2(acc[mt][nt][2], acc[mt][nt][3]); *(u32x2*)(gp + mt * 16) = w; } }
        __syncthreads();
    }
}
template <int DV, bool HGRN>
__device__ __forceinline__ void pass_b(bf16* GS, const float* DEC, int G, int bid, const int tid) {
    constexpr int H = HGRN ? 8 : 4, E = DV * 128, E4 = E / 4;
    const int nthreads = G * NT;
    for (int i = bid * NT + tid; i < BATCH * H * E4; i += nthreads) {
        const int bh = i / E4, e = (i % E4) * 4, d = e & 127;
        float S0 = 0.f, S1 = 0.f, S2 = 0.f, S3 = 0.f;
        u32x2* gp = (u32x2*)(GS + (size_t)bh * NCH * E + e); const f32x4* dp = (const f32x4*)(DEC + (size_t)bh * NCH * 128 + d);
        for (int n0 = 0; n0 < NCH; n0 += 8) {
            u32x2 gv[8]; f32x4 dv[8];
#pragma unroll
            for (int q = 0; q < 8; ++q) { gv[q] = gp[(size_t)(n0 + q) * (E / 4)]; dv[q] = dp[(size_t)(n0 + q) * 32]; }
#pragma unroll
            for (int q = 0; q < 8; ++q) {
                u32x2 o; o.x = pk2(S0, S1); o.y = pk2(S2, S3); gp[(size_t)(n0 + q) * (E / 4)] = o;
                S0 = dv[q].x * (S0 + __uint_as_float(gv[q].x << 16)); S1 = dv[q].y * (S1 + __uint_as_float(gv[q].x & 0xffff0000u));
                S2 = dv[q].z * (S2 + __uint_as_float(gv[q].y << 16)); S3 = dv[q].w * (S3 + __uint_as_float(gv[q].y & 0xffff0000u)); }
        }
    }
}
template <int DV, bool HGRN>
__device__ __forceinline__ void pass_c(LAS unsigned char* lds, bf16* proj, const bf16* GS, int G, int bid, const int tid) {
    constexpr int H = HGRN ? 8 : 4, LD = HGRN ? HGRN_N : GLA_N, MTW = DV / 128;
    const int lane = tid & 63, wave = tid >> 6, g = lane >> 4, l15 = lane & 15, d = tid & 127, rg = tid >> 7;
    for (int u = bid; u < BATCH * H * NCH; u += G) {
        const int b = u / (H * NCH), h = (u / NCH) % H, n = u % NCH;
        bf16* base = proj + (size_t)(b * T + n * CH) * LD;
        const int qcol = h * 128, lacol = 1024 + h * 128, kcol = 512 + h * 128, vcol = (HGRN ? 3072 : 2560) + h * DV, gcol = (HGRN ? 2048 : 1536) + h * DV;
        float bb[16], kv[16], blast;
        chunk_cumsum<HGRN>(lds, base, LD, lacol, kcol, d, rg, bb, kv, blast);
#pragma unroll
        for (int i = 0; i < 16; ++i) { const int s = rg * 16 + i; const float q = bf2f(base[(size_t)s * LD + qcol + d]);
            *(LAS bf16*)(lds + L_QS + s * QS_STR + d * 2) = (bf16)f2bf(q * __expf(bb[i]));
            *(LAS bf16*)(lds + L_KS + s * QS_STR + d * 2) = (bf16)f2bf(kv[i] * __expf(-bb[i])); }
        load_vt<DV>(lds, base, LD, vcol, tid);
        __syncthreads();
        { const int tt = wave >> 1;
#pragma unroll
          for (int si = 0; si < 2; ++si) { const int st = (wave & 1) * 2 + si; f32x4 c = (f32x4){0.f, 0.f, 0.f, 0.f};
#pragma unroll
              for (int kk = 0; kk < 4; ++kk) { const bf16x8 afr = *(const LAS bf16x8*)(lds + L_KS + (st * 16 + l15) * QS_STR + (kk * 32 + 8 * g) * 2);
                  const bf16x8 bfr = *(const LAS bf16x8*)(lds + L_QS + (tt * 16 + l15) * QS_STR + (kk * 32 + 8 * g) * 2); c = MFMA16(afr, bfr, c); }
              const int t = tt * 16 + l15, s0 = st * 16 + 4 * g;
              u32x2 w; w.x = pk2(s0 <= t ? c[0] : 0.f, s0 + 1 <= t ? c[1] : 0.f); w.y = pk2(s0 + 2 <= t ? c[2] : 0.f, s0 + 3 <= t ? c[3] : 0.f);
              *(LAS u32x2*)(lds + L_AT + t * KT_STR + s0 * 2) = w; } }
        __syncthreads();
        f32x4 acc[MTW][4];
#pragma unroll
        for (int mt = 0; mt < MTW; ++mt)
#pragma unroll
            for (int nt = 0; nt < 4; ++nt) acc[mt][nt] = (f32x4){0.f, 0.f, 0.f, 0.f};
        const int v0 = wave * MTW * 16;
#pragma unroll
        for (int kk = 0; kk < 4; ++kk) {
            bf16x8 afr[MTW];
#pragma unroll
            for (int mt = 0; mt < MTW; ++mt) afr[mt] = *(const bf16x8*)(GS + ((size_t)u * DV + v0 + mt * 16 + l15) * 128 + kk * 32 + 8 * g);
#pragma unroll
            for (int nt = 0; nt < 4; ++nt) { const bf16x8 bfr = *(const LAS bf16x8*)(lds + L_QS + (nt * 16 + l15) * QS_STR + (kk * 32 + 8 * g) * 2);
#pragma unroll
                for (int mt = 0; mt < MTW; ++mt) acc[mt][nt] = MFMA16(afr[mt], bfr, acc[mt][nt]); }
        }
#pragma unroll
        for (int kk = 0; kk < 2; ++kk) {
            bf16x8 afr[MTW];
#pragma unroll
            for (int mt = 0; mt < MTW; ++mt) afr[mt] = *(const LAS bf16x8*)(lds + L_VT + (v0 + mt * 16 + l15) * KT_STR + (kk * 32 + 8 * g) * 2);
#pragma unroll
            for (int nt = 0; nt < 4; ++nt) { const bf16x8 bfr = *(const LAS bf16x8*)(lds + L_AT + (nt * 16 + l15) * KT_STR + (kk * 32 + 8 * g) * 2);
#pragma unroll
                for (int mt = 0; mt < MTW; ++mt) acc[mt][nt] = MFMA16(afr[mt], bfr, acc[mt][nt]); }
        }
        LAS float* red = (LAS float*)(lds + L_RED);
#pragma unroll
        for (int nt = 0; nt < 4; ++nt) { float p = 0.f;
#pragma unroll
            for (int mt = 0; mt < MTW; ++mt) p += (acc[mt][nt][0] * acc[mt][nt][0] + acc[mt][nt][1] * acc[mt][nt][1]) + (acc[mt][nt][2] * acc[mt][nt][2] + acc[mt][nt][3] * acc[mt][nt][3]);
            p += pg8::shx(p, 16, lane); p += pg8::shx(p, 32, lane);
            if (g == 0) red[wave * 64 + nt * 16 + l15] = p; }
        __syncthreads();
#pragma unroll
        for (int nt = 0; nt < 4; ++nt) { const int t = nt * 16 + l15; float s = 0.f;
#pragma unroll
            for (int w = 0; w < 8; ++w) s += red[w * 64 + t];
            const float rstd = rsqrtf(s * (1.0f / DV) + EPS);
            bf16* rowp = base + (size_t)t * LD;
#pragma unroll
            for (int mt = 0; mt < MTW; ++mt) { const int v = v0 + mt * 16 + 4 * g; const u32x2 gt = *(const u32x2*)(rowp + gcol + v);
                u32x2 w; w.x = pk2(acc[mt][nt][0] * rstd * __uint_as_float(gt.x << 16), acc[mt][nt][1] * rstd * __uint_as_float(gt.x & 0xffff0000u));
                w.y = pk2(acc[mt][nt][2] * rstd * __uint_as_float(gt.y << 16), acc[mt][nt][3] * rstd * __uint_as_float(gt.y & 0xffff0000u));
                *(u32x2*)(rowp + vcol + v) = w; } }
        __syncthreads();
    }
}
constexpr int KL_STR = 272, VL_STR = 528, L_KL = 0, L_VL = 256 * KL_STR;
static_assert(L_VL + 128 * VL_STR <= LDS_BYTES, "xattn LDS map");
__device__ __forceinline__ void xattn(LAS unsigned char* lds, bf16* proj, int LD, int xcol, const bf16* KM, const bf16* VMT, int G, int bid, const int tid) {
    const int lane = tid & 63, wave = tid >> 6, g = lane >> 4, l15 = lane & 15;
    for (int w = bid; w < 256; w += G) {
        const int pair = w >> 4, sub = w & 15, b = pair >> 2, h = pair & 3;
        __syncthreads();
#pragma unroll
        for (int i = 0; i < 8; ++i) { const int c = tid + i * NT, m = c >> 4, part = c & 15;
            *(LAS u32x4*)(lds + L_KL + m * KL_STR + part * 16) = *(const u32x4*)(KM + (size_t)(b * 256 + m) * 512 + h * 128 + part * 8); }
#pragma unroll
        for (int i = 0; i < 8; ++i) { const int c = tid + i * NT, dd = c >> 5, part = c & 31;
            *(LAS u32x4*)(lds + L_VL + dd * VL_STR + part * 16) = *(const u32x4*)(VMT + ((size_t)b * 512 + h * 128 + dd) * 256 + part * 8); }
        __syncthreads();
        for (int tile = 0; tile < 4; ++tile) {
            const int r0 = b * T + (sub * 4 + tile) * 128 + wave * 16;
            bf16* qp = proj + (size_t)(r0 + l15) * LD + xcol + h * 128;
            bf16x8 qf[4];
#pragma unroll
            for (int kk = 0; kk < 4; ++kk) qf[kk] = *(const bf16x8*)(qp + kk * 32 + 8 * g);
            f32x4 sc[16];
#pragma unroll
            for (int mt = 0; mt < 16; ++mt) { f32x4 c = (f32x4){0.f, 0.f, 0.f, 0.f};
#pragma unroll
                for (int kk = 0; kk < 4; ++kk) { const bf16x8 afr = *(const LAS bf16x8*)(lds + L_KL + (mt * 16 + l15) * KL_STR + (kk * 32 + 8 * g) * 2); c = MFMA16(afr, qf[kk], c); }
                sc[mt] = c; }
            float mx = -1e30f;
#pragma unroll
            for (int mt = 0; mt < 16; ++mt) mx = fmaxf(mx, fmaxf(fmaxf(sc[mt][0], sc[mt][1]), fmaxf(sc[mt][2], sc[mt][3])));
            mx = fmaxf(mx, pg8::shx(mx, 16, lane)); mx = fmaxf(mx, pg8::shx(mx, 32, lane));
            float sum = 0.f;
#pragma unroll
            for (int mt = 0; mt < 16; ++mt) {
#pragma unroll
                for (int j = 0; j < 4; ++j) { const float p = __expf(sc[mt][j] - mx); sc[mt][j] = p; sum += p; } }
            sum += pg8::shx(sum, 16, lane); sum += pg8::shx(sum, 32, lane);
            const float inv = 1.0f / sum;
            f32x4 oa[8];
#pragma unroll
            for (int dt = 0; dt < 8; ++dt) oa[dt] = (f32x4){0.f, 0.f, 0.f, 0.f};
#pragma unroll
            for (int kb = 0; kb < 8; ++kb) {
                union { bf16x8 v; unsigned u[4]; } pb;
                pb.u[0] = pk2(sc[2 * kb][0], sc[2 * kb][1]); pb.u[1] = pk2(sc[2 * kb][2], sc[2 * kb][3]); pb.u[2] = pk2(sc[2 * kb + 1][0], sc[2 * kb + 1][1]); pb.u[3] = pk2(sc[2 * kb + 1][2], sc[2 * kb + 1][3]);
#pragma unroll
                for (int dt = 0; dt < 8; ++dt) { union { bf16x8 v; u32x2 h[2]; } pa; const LAS unsigned char* vp = lds + L_VL + (dt * 16 + l15) * VL_STR + (kb * 32 + 4 * g) * 2;
                    pa.h[0] = *(const LAS u32x2*)vp; pa.h[1] = *(const LAS u32x2*)(vp + 32); oa[dt] = MFMA16(pa.v, pb.v, oa[dt]); }
            }
#pragma unroll
            for (int dt = 0; dt < 8; ++dt) { u32x2 o; o.x = pk2(oa[dt][0] * inv, oa[dt][1] * inv); o.y = pk2(oa[dt][2] * inv, oa[dt][3] * inv); *(u32x2*)(qp + dt * 16 + 4 * g) = o; }
        }
    }
    __syncthreads();
}
__device__ __forceinline__ void final_norm(float* out, const float* SS, const float* gain, int gw, int ngw, int lane) {
    f32x4 gv[4];
#pragma unroll
    for (int j = 0; j < 4; ++j) gv[j] = ((const f32x4*)gain)[lane + 64 * j];
    for (int m = gw; m < M; m += ngw) {
        float s = lane < 16 ? SS[(size_t)lane * M + m] : 0.f; s = wave_sum(s, lane);
        const float rstd = rsqrtf(s * (1.0f / D) + EPS);
        f32x4* xr = (f32x4*)(out + (size_t)m * D) + lane;
#pragma unroll
        for (int j = 0; j < 4; ++j) { f32x4 v = xr[64 * j]; v = v * rstd * gv[j]; xr[64 * j] = v; }
    }
}

struct Args { Ptrs P; int ph_lo, ph_hi; };
constexpr int N_PHASES = 2 + 7 * DEPTH;
__global__ void __launch_bounds__(NT, 2) fwd_kernel(Args a) {
    extern __shared__ __attribute__((aligned(16))) unsigned char lds_raw[];
#if ONE_LAUNCH
    cg::grid_group grid = cg::this_grid();
    { volatile LAS unsigned* st = (volatile LAS unsigned*)((LAS unsigned char*)lds_raw + LDS_BARST); int t0_ = threadIdx.x; if (t0_ == 0) { st[0] = 0u; st[1] = 0u; } __syncthreads();
      (void)xcd_barrier_post((unsigned*)(a.P.ws + WS_CTL), st, t0_); }
#define SEAM() do { XcdBarrier xb_; xb_.bar = (unsigned*)(ws + WS_CTL); xb_.x = xb_xcc_id(); xb_.st = (volatile LAS unsigned*)(lds + LDS_BARST); xcd_barrier(xb_, tid); if (ph == 0) grid.sync(); } while (0)
#else
#define SEAM() do {} while (0)
#endif
    const int ph_lo = a.ph_lo, ph_hi = a.ph_hi;
    const int wave0 = __builtin_amdgcn_readfirstlane(threadIdx.x >> 6);
    for (int ph = ph_lo; ph < ph_hi; ++ph) {
        const __attribute__((address_space(4))) Args* ap = (const __attribute__((address_space(4))) Args*)__builtin_amdgcn_kernarg_segment_ptr();
        asm volatile("" : "+s"(ap));
        int zero_ = 0; asm volatile("" : "+v"(zero_));
        int tid = wave0 * 64 + (int)__builtin_amdgcn_mbcnt_hi(~0u, __builtin_amdgcn_mbcnt_lo(~0u, (unsigned)zero_)); asm volatile("" : "+v"(tid));
        LAS unsigned char* lds = (LAS unsigned char*)lds_raw;
        const int lane = tid & 63, wave = __builtin_amdgcn_readfirstlane(tid >> 6);
        int G = gridDim.x, bid = blockIdx.x; asm volatile("" : "+s"(G), "+s"(bid));
        const int gw = bid * NWAVES + wave, ngw = G * NWAVES;
        unsigned char* ws = ap->P.ws;
        float* SS = (float*)(ws + WS_SS); bf16* XB = (bf16*)(ws + WS_XB); bf16* GS = (bf16*)(ws + WS_XB); bf16* PROJ = (bf16*)(ws + WS_PROJ);
        int ngemm = 0;
        int L = 0, sp = 0; bool hg = false;
        if (ph == 0) { prologue(&ap->P, lds, gw, ngw, wave, lane); }
        else if (ph == N_PHASES - 1) { final_norm(ap->P.out, SS, ap->P.final_norm, gw, ngw, lane); }
        else {
            L = (ph - 1) / 7; sp = (ph - 1) % 7; hg = (L & 1);
            const int LD = hg ? HGRN_N : GLA_N;
            if (sp == 0) ngemm = (L == 0) ? 2 : 1;
            else if (sp == 1) {
                float* DEC = (float*)(ws + WS_DEC);
                if (hg) pass_a<128, true>(lds, PROJ, GS, DEC, G, bid, tid); else pass_a<256, false>(lds, PROJ, GS, DEC, G, bid, tid);
                xattn(lds, PROJ, LD, hg ? 4096 : 3584, (const bf16*)(ws + WS_KM) + (size_t)L * 1024 * 512, (const bf16*)(ws + WS_VMT) + (size_t)L * 4 * 512 * 256, G, bid, tid);
                if (L + 1 < DEPTH) { convert_layer(&ap->P, L + 1, lds, gw, ngw, wave, lane); }
            } else if (sp == 2) {
                const float* DEC = (const float*)(ws + WS_DEC);
                if (hg) pass_b<128, true>(GS, DEC, G, bid, tid); else pass_b<256, false>(GS, DEC, G, bid, tid);
            } else if (sp == 3) {
                if (hg) pass_c<128, true>(lds, PROJ, GS, G, bid, tid); else pass_c<256, false>(lds, PROJ, GS, G, bid, tid);
            } else ngemm = 1;
        }
        for (int rep = 0; rep < ngemm; ++rep) {
            unsigned char* wb = ws + WS_WT + (size_t)(L & 1) * WT_BUF;
            const int LD = hg ? HGRN_N : GLA_N;
            pg8::Gemm g; pg8::EpiAll E; E.hgrn = hg ? 1 : 0; E.M = M; E.aux = nullptr; E.xin = nullptr; E.xout = nullptr;
            if (sp == 0 && ngemm == 2 && rep == 0) {
                g.A = (const bf16*)(ws + WS_MEMB); g.Bt = (const bf16*)(ws + WS_WKV); g.M = MROWS; g.N = 4096; g.K = D; g.lda = D; g.perm = 0;
                E.kind = 3; E.ldc = 0; E.O = (bf16*)(ws + WS_KM); E.ss = (const float*)(ws + WS_SSM); E.xout = (float*)(ws + WS_VMT);
            } else if (sp == 0) {
                g.A = XB; g.Bt = (const bf16*)(wb + WT_IN); g.M = M; g.N = LD; g.K = D; g.lda = D; g.perm = 1;
                E.kind = 0; E.ldc = LD; E.O = PROJ; E.ss = SS; E.aux = hg ? (const float*)(ws + WS_LB) + (size_t)L * 1024 : ap->P.gla_b_gate + (size_t)(L >> 1) * 512;
            } else if (sp == 4) {
                g.A = PROJ + (hg ? 3072 : 2560); g.Bt = (const bf16*)(wb + WT_OUT); g.M = M; g.N = D; g.K = KOUT; g.lda = LD; g.perm = 0;
                E.kind = 2; E.ldc = D; E.O = XB; E.ss = SS; E.xin = (L == 0) ? ap->P.x : ap->P.out; E.xout = ap->P.out;
            } else if (sp == 5) {
                g.A = XB; g.Bt = (const bf16*)(wb + WT_UP); g.M = M; g.N = FF; g.K = D; g.lda = D; g.perm = 1;
                E.kind = 1; E.ldc = FF; E.O = PROJ; E.ss = SS;
            } else {
                g.A = PROJ; g.Bt = (const bf16*)(wb + WT_DOWN); g.M = M; g.N = D; g.K = FF; g.lda = FF; g.perm = 0;
                E.kind = 2; E.ldc = D; E.O = XB; E.ss = SS; E.xin = ap->P.out; E.xout = ap->P.out;
            }
            pg8::StaticOrder S; S.init(g.M, g.N, G, bid);
            pg8::gemm_phase<pg8::EpiAll, pg8::StaticOrder, true, true>(lds, g, S, E, tid);
        }
        if (ph + 1 < ph_hi) { SEAM(); }
    }
}

extern "C" void kernel_launch(void* const* d_in, const int* in_sizes, int n_in, void* d_out, int out_size, void* d_ws, size_t ws_size, hipStream_t stream) {
    static int grid = 0;
    if (grid == 0) {
        if (n_in != 17 || out_size != M * D || ws_size < WS_END) { fprintf(stderr, "kernel_launch: unexpected shapes (n_in %d out %d ws %zu)\n", n_in, out_size, ws_size); grid = -1; return; }
        int dev = 0, cus = 0, per_cu = 0;
        hipGetDevice(&dev); hipDeviceGetAttribute(&cus, hipDeviceAttributeMultiprocessorCount, dev);
        if (hipFuncSetAttribute((const void*)fwd_kernel, hipFuncAttributeMaxDynamicSharedMemorySize, LDS_BYTES) != hipSuccess) { fprintf(stderr, "kernel_launch: hipFuncSetAttribute failed\n"); grid = -1; return; }
        if (hipOccupancyMaxActiveBlocksPerMultiprocessor(&per_cu, (const void*)fwd_kernel, NT, LDS_BYTES) != hipSuccess || per_cu < 1) { fprintf(stderr, "kernel_launch: occupancy query says %d\n", per_cu); per_cu = 1; }
        (void)hipGetLastError();
        grid = cus * per_cu;
        if (grid > 256) grid = 256;
        grid = (grid / 16) * 16;
        fprintf(stderr, "kernel_launch: grid %d (cus %d per_cu %d)\n", grid, cus, per_cu);
    }
    if (grid <= 0) return;
#if ONE_LAUNCH
    if (hipMemsetAsync((char*)d_ws + WS_CTL, 0, CTL_BYTES, stream) != hipSuccess) { fprintf(stderr, "kernel_launch: memset failed\n"); return; }
#endif
    Args a{};
    const float** pp = (const float**)&a.P;
    for (int i = 0; i < 17; ++i) pp[i] = (const float*)d_in[i];
    a.P.out = (float*)d_out; a.P.ws = (unsigned char*)d_ws;
#if ONE_LAUNCH
    a.ph_lo = 0; a.ph_hi = N_PHASES;
    void* args[] = {&a};
    hipError_t e = hipLaunchCooperativeKernel((const void*)fwd_kernel, dim3(grid), dim3(NT), args, LDS_BYTES, stream);
    if (e != hipSuccess) fprintf(stderr, "kernel_launch: cooperative launch failed: %s (grid %d)\n", hipGetErrorString(e), grid);
#else
    for (int ph = 0; ph < N_PHASES; ++ph) { a.ph_lo = ph; a.ph_hi = ph + 1; hipLaunchKernelGGL(fwd_kernel, dim3(grid), dim3(NT), LDS_BYTES, stream, a); }
#endif
}
```

```cpp
#include <hip/hip_runtime.h>
#include <hip/hip_cooperative_groups.h>
#include <cstdio>
#include <cstdint>
namespace cg = cooperative_groups;

#ifndef EXP
#define EXP 0
#endif
#ifndef ONE_LAUNCH
#define ONE_LAUNCH 1
#endif

namespace pg8 {
#define PG8_LAS __attribute__((address_space(3)))
typedef unsigned short bf16_t;
typedef short bf16x8 __attribute__((ext_vector_type(8)));
typedef float f32x4 __attribute__((ext_vector_type(4)));
typedef unsigned u32x4 __attribute__((ext_vector_type(4)));
typedef unsigned u32x2 __attribute__((ext_vector_type(2)));
constexpr int BM = 256, BK = 64, HALF = 128, HTB = HALF * BK * 2, STAGE_BYTES = 8 * HTB, NXCD = 8, WGM = 8;

__host__ __device__ __forceinline__ int lds_byte(int r, int c) { const int st = (r >> 4) * 2 + (c >> 5), rr = r & 15, cc = c & 31, ob = rr * 64 + cc * 2; return st * 1024 + (ob ^ (((ob >> 9) & 1) << 5)); }
__host__ __device__ __forceinline__ void stage_rc(int b, int& R, int& C) { const int st = b / 1024, sb = b % 1024, swz = sb ^ (((sb >> 9) & 1) << 5); R = (st >> 1) * 16 + swz / 64; C = (st & 1) * 32 + (swz % 64) / 2; }
__host__ __device__ __forceinline__ int perm32(int rho) { const int n = rho >> 4, i = rho & 15; return 8 * (i >> 2) + 4 * n + (i & 3); }

struct Unit { int pm, pn; };
struct Gemm { const bf16_t* A; const bf16_t* Bt; int M, N, K, lda, perm; };

struct StaticOrder {
    int nM, nN, nwg, G, c;
    __host__ __device__ void init(int M, int N, int G_, int c_) { nM = M / BM; nN = N / BM; nwg = nM * nN; G = G_; c = c_; }
    __host__ __device__ bool next(int i, Unit& u) const {
        const long L = (long)i * G + c; if (L >= nwg) return false;
        int wgid = (int)L; { const int q = nwg / NXCD, r = nwg % NXCD, xcd = wgid % NXCD, off = wgid / NXCD; wgid = (xcd < r ? xcd * (q + 1) : r * (q + 1) + (xcd - r) * q) + off; }
        const int nig = WGM * nN, gid = wgid / nig, fm = gid * WGM, gsz = (nM - fm) < WGM ? (nM - fm) : WGM;
        u.pm = fm + ((wgid % nig) % gsz); u.pn = (wgid % nig) / gsz; return true;
    }
    __device__ __forceinline__ void a_ready(const Unit&) const {}
    __device__ __forceinline__ void done(const Unit&) const {}
};

__device__ __forceinline__ float shx(float v, int mask, int lane) { return __int_as_float(__builtin_amdgcn_ds_bpermute((lane ^ mask) << 2, __float_as_int(v))); }
typedef float f32x2_t __attribute__((ext_vector_type(2)));
typedef __bf16 bf16x2_t __attribute__((ext_vector_type(2)));
__device__ __forceinline__ unsigned cvt_pk_native(float lo, float hi) { const f32x2_t f = {lo, hi}; const bf16x2_t b = __builtin_convertvector(f, bf16x2_t); return __builtin_bit_cast(unsigned, b); }
__device__ __forceinline__ unsigned cvt_pk_bf16(float lo, float hi) { unsigned r; asm volatile("v_cvt_pk_bf16_f32 %0, %1, %2" : "=v"(r) : "v"(lo), "v"(hi)); return r; }

__device__ __forceinline__ float fsigmoid(float v) { return __builtin_amdgcn_rcpf(1.0f + __expf(-v)); }
__device__ __forceinline__ float fsilu(float v) { return v * fsigmoid(v); }
__device__ __forceinline__ float row_rstd(const float* ss, int M, int row, int fq, int lane) {
    const float* p = ss + (size_t)(4 * fq) * M + row;
    float s = (p[0] + p[M]) + (p[2 * (size_t)M] + p[3 * (size_t)M]);
    s += shx(s, 16, lane); s += shx(s, 32, lane);
    return rsqrtf(s * (1.0f / 1024.0f) + 1e-6f);
}
template <int MODE> __device__ __forceinline__ float proj_act(float v, float a) {
    if (MODE == 1) return fsilu(v);
    if (MODE == 2) { const float z = v + a; const float ls = fminf(z, 0.f) - __logf(1.0f + __expf(-fabsf(z))); return ls * 0.0625f; }
    if (MODE == 3) { const float sg = fsigmoid(v); return __logf(a + (1.0f - a) * sg); }
    if (MODE == 4) return fsilu(v) * 0.08838834764831845f;
    if (MODE == 5) { const float r = fmaxf(v, 0.f); return r * r; }
    return v;
}
struct EpiAll {
    static constexpr bool AFTER_DRAIN = false;
    int kind, ldc, hgrn, M;
    bf16_t* O;
    const float* ss;
    const float* aux;
    const float* xin;
    float* xout;
    template <int MODE> __device__ __forceinline__ void body_proj(const f32x4 (&acc)[2][2][4][2], const Unit& u, int wr, int wc, int fr, int fq) const {
        const int row0 = u.pm * BM + wr * 64 + fr, col0 = u.pn * BM + wc * 32 + 8 * fq;
        f32x4 av[2][2];
#pragma unroll
        for (int bj = 0; bj < 2; ++bj)
#pragma unroll
            for (int n = 0; n < 2; ++n) av[bj][n] = (MODE == 2 || MODE == 3) ? *(const f32x4*)(aux + (col0 - 1024) + bj * HALF + 4 * n) : (f32x4){0.f, 0.f, 0.f, 0.f};
#pragma unroll
        for (int ai = 0; ai < 2; ++ai)
#pragma unroll
            for (int m = 0; m < 4; ++m) { const int row = row0 + ai * HALF + m * 16; const float rstd = row_rstd(ss, M, row, fq, fq * 16 + fr); bf16_t* rowp = O + (size_t)row * ldc + col0;
#pragma unroll
                for (int bj = 0; bj < 2; ++bj) { f32x4 v0 = acc[ai][bj][m][0] * rstd, v1 = acc[ai][bj][m][1] * rstd;
#pragma unroll
                    for (int j = 0; j < 4; ++j) { v0[j] = proj_act<MODE>(v0[j], av[bj][0][j]); v1[j] = proj_act<MODE>(v1[j], av[bj][1][j]); }
                    u32x4 w; w.x = cvt_pk_bf16(v0[0], v0[1]); w.y = cvt_pk_bf16(v0[2], v0[3]); w.z = cvt_pk_bf16(v1[0], v1[1]); w.w = cvt_pk_bf16(v1[2], v1[3]);
                    *(u32x4*)(rowp + bj * HALF) = w; } }
    }
    __device__ __forceinline__ void body_res(const f32x4 (&acc)[2][2][4][2], const Unit& u, int wr, int wc, int fr, int fq) const {
        const int row0 = u.pm * BM + wr * 64 + fr, col0 = u.pn * BM + wc * 32 + 4 * fq; float* ssw = (float*)ss;
#pragma unroll
        for (int ai = 0; ai < 2; ++ai)
#pragma unroll
            for (int m = 0; m < 4; ++m) { const int row = row0 + ai * HALF + m * 16; const size_t off = (size_t)row * 1024 + col0; float s = 0.f;
#pragma unroll
                for (int bj = 0; bj < 2; ++bj)
#pragma unroll
                    for (int n = 0; n < 2; ++n) { const f32x4 o = *(const f32x4*)(xin + off + bj * HALF + n * 16) + acc[ai][bj][m][n];
                        *(f32x4*)(xout + off + bj * HALF + n * 16) = o; s += (o[0] * o[0] + o[1] * o[1]) + (o[2] * o[2] + o[3] * o[3]);
                        u32x2 w; w.x = cvt_pk_bf16(o[0], o[1]); w.y = cvt_pk_bf16(o[2], o[3]); *(u32x2*)(O + off + bj * HALF + n * 16) = w; }
                s += shx(s, 16, fq * 16 + fr); s += shx(s, 32, fq * 16 + fr);
                if (fq == 0) ssw[(size_t)(u.pn * 4 + wc) * M + row] = s; }
    }
    __device__ __forceinline__ void body_kv(const f32x4 (&acc)[2][2][4][2], const Unit& u, int wr, int wc, int fr, int fq) const {
        const int row0 = u.pm * BM + wr * 64 + fr, layer = u.pn >> 2, cl0 = (u.pn & 3) * BM + wc * 32 + 4 * fq; bf16_t* VMT = (bf16_t*)xout;
#pragma unroll
        for (int ai = 0; ai < 2; ++ai)
#pragma unroll
            for (int m = 0; m < 4; ++m) { const int row = row0 + ai * HALF + m * 16; const float rstd = rsqrtf(ss[row] * (1.0f / 1024.0f) + 1e-6f);
#pragma unroll
                for (int bj = 0; bj < 2; ++bj)
#pragma unroll
                    for (int n = 0; n < 2; ++n) { const f32x4 o = acc[ai][bj][m][n] * rstd; const int cl = cl0 + bj * HALF + n * 16;
                        if (cl < 512) { u32x2 w; w.x = cvt_pk_bf16(o[0], o[1]); w.y = cvt_pk_bf16(o[2], o[3]); *(u32x2*)(O + ((size_t)layer * 1024 + row) * 512 + cl) = w; }
                        else { const unsigned lo = cvt_pk_bf16(o[0], o[1]), hi = cvt_pk_bf16(o[2], o[3]); bf16_t* d = VMT + ((size_t)(layer * 4 + (row >> 8)) * 512 + (cl - 512)) * 256 + (row & 255);
                            d[0] = (bf16_t)(lo & 0xffff); d[256] = (bf16_t)(lo >> 16); d[512] = (bf16_t)(hi & 0xffff); d[768] = (bf16_t)(hi >> 16); } } }
    }
    __device__ __forceinline__ void operator()(const f32x4 (&acc)[2][2][4][2], const Unit& u, int wr, int wc, int fr, int fq) const {
        if (kind == 0) {
            int mode;
            if (!hgrn) mode = (u.pn >= 4 && u.pn < 6) ? 2 : ((u.pn >= 6 && u.pn < 10) ? 1 : 0);
            else mode = u.pn < 4 ? 4 : (u.pn < 8 ? 3 : (u.pn < 12 ? 1 : 0));
            if (mode == 0) body_proj<0>(acc, u, wr, wc, fr, fq); else if (mode == 1) body_proj<1>(acc, u, wr, wc, fr, fq); else if (mode == 2) body_proj<2>(acc, u, wr, wc, fr, fq);
            else if (mode == 3) body_proj<3>(acc, u, wr, wc, fr, fq); else body_proj<4>(acc, u, wr, wc, fr, fq);
        } else if (kind == 1) body_proj<5>(acc, u, wr, wc, fr, fq);
        else if (kind == 2) body_res(acc, u, wr, wc, fr, fq);
        else body_kv(acc, u, wr, wc, fr, fq);
    }
};

template <class Epi, class Sched, bool ALIGN_EPI = false, bool SP2 = false>
__device__ __forceinline__ void gemm_phase(PG8_LAS unsigned char* lds, const Gemm g, const Sched& S, const Epi& E, const int tid) {
    const int wid = __builtin_amdgcn_readfirstlane(tid >> 6), lane = tid & 63, wr = wid >> 2, wc = wid & 3, fr = lane & 15, fq = lane >> 4;
    const int K = g.K, nt = K / BK;
    unsigned voffA[2], voffB[2];
#pragma unroll
    for (int i = 0; i < 2; ++i) { int R, C; stage_rc(tid * 16 + i * 8192, R, C); const int Rb = g.perm ? ((R & ~31) + perm32(R & 31)) : R;
        voffA[i] = (unsigned)(R * g.lda + C) * 2u; voffB[i] = (unsigned)(Rb * K + C) * 2u; }
    const size_t kstep = (size_t)(BK * 2);
    const size_t hstepA = (size_t)HALF * g.lda * 2, hstepB = (size_t)HALF * K * 2;
    const size_t tstepA = 2 * hstepA, tstepB = 2 * hstepB;
    const unsigned ldsw = (unsigned)wid * 1024u;
    const int aoff = lds_byte(wr * 64 + fr, fq * 8), boff = lds_byte(wc * 32 + fr, fq * 8);
#define PG8_SA(b, h) (((b) * 2 + (h)) * HTB)
#define PG8_SB(b, h) ((4 + (b) * 2 + (h)) * HTB)
#define PG8_STAGE(bufoff, gbase, voff) do { _Pragma("unroll") for (int _i = 0; _i < 2; ++_i) \
        __builtin_amdgcn_global_load_lds((const unsigned*)((const char*)(gbase) + (voff)[_i]), (PG8_LAS unsigned*)(lds + (bufoff) + ldsw + _i * 8192), 16, 0, 0); } while (0)
#define PG8_LDA(dst, b, h) do { _Pragma("unroll") for (int m = 0; m < 4; ++m) _Pragma("unroll") for (int k = 0; k < 2; ++k) dst[m][k] = *(const PG8_LAS bf16x8*)(lds + PG8_SA(b, h) + aoff + m * 2048 + k * 1024); } while (0)
#define PG8_LDB(dst, b, h) do { _Pragma("unroll") for (int n = 0; n < 2; ++n) _Pragma("unroll") for (int k = 0; k < 2; ++k) dst[n][k] = *(const PG8_LAS bf16x8*)(lds + PG8_SB(b, h) + boff + n * 2048 + k * 1024); } while (0)
#define PG8_MMA(ai, bj, At, Bt) do { __builtin_amdgcn_s_setprio(1); _Pragma("unroll") for (int m = 0; m < 4; ++m) _Pragma("unroll") for (int n = 0; n < 2; ++n) _Pragma("unroll") for (int k = 0; k < 2; ++k) \
        acc[ai][bj][m][n] = __builtin_amdgcn_mfma_f32_16x16x32_bf16(Bt[n][k], At[m][k], acc[ai][bj][m][n], 0, 0, 0); __builtin_amdgcn_s_setprio(0); } while (0)
#define PG8_WAIT_V(n) asm volatile("s_waitcnt vmcnt(" #n ")" ::: "memory")
#define PG8_WAIT_L(n) asm volatile("s_waitcnt lgkmcnt(" #n ")" ::: "memory")
#define PG8_BAR __builtin_amdgcn_s_barrier()
#define PG8_SCHED __builtin_amdgcn_sched_barrier(0)
    Unit cur, nxt; int ui = 0;
    if (!S.next(0, cur)) return;
    f32x4 acc[2][2][4][2];
#pragma unroll
    for (int a = 0; a < 2; ++a)
#pragma unroll
        for (int b = 0; b < 2; ++b)
#pragma unroll
            for (int m = 0; m < 4; ++m)
#pragma unroll
                for (int n = 0; n < 2; ++n) acc[a][b][m][n] = (f32x4){0.f, 0.f, 0.f, 0.f};
    bf16x8 At[4][2], B0[2][2], B1[2][2];
    const char* cA = (const char*)g.A + (size_t)cur.pm * tstepA; const char* cB = (const char*)g.Bt + (size_t)cur.pn * tstepB;
    S.a_ready(cur);
    if constexpr (SP2) {
        PG8_STAGE(PG8_SB(0, 0), cB, voffB); PG8_STAGE(PG8_SB(0, 1), cB + hstepB, voffB); PG8_STAGE(PG8_SA(0, 0), cA, voffA); PG8_STAGE(PG8_SA(0, 1), cA + hstepA, voffA);
        if (wr == 1) PG8_BAR;
        PG8_WAIT_V(2); PG8_BAR;
        PG8_STAGE(PG8_SB(1, 0), cB + kstep, voffB); PG8_STAGE(PG8_SA(1, 0), cA + kstep, voffA); PG8_STAGE(PG8_SB(1, 1), cB + hstepB + kstep, voffB);
        PG8_WAIT_V(6); PG8_BAR;
    } else {
        PG8_STAGE(PG8_SB(0, 0), cB, voffB); PG8_STAGE(PG8_SA(0, 0), cA, voffA); PG8_STAGE(PG8_SB(0, 1), cB + hstepB, voffB); PG8_STAGE(PG8_SA(0, 1), cA + hstepA, voffA);
        if (wr == 1) PG8_BAR;
        PG8_WAIT_V(4); PG8_BAR;
        PG8_STAGE(PG8_SB(1, 0), cB + kstep, voffB); PG8_STAGE(PG8_SA(1, 0), cA + kstep, voffA); PG8_STAGE(PG8_SB(1, 1), cB + hstepB + kstep, voffB);
        PG8_WAIT_V(6); PG8_BAR;
    }
    for (;;) {
        const bool has_next = S.next(ui + 1, nxt);
        const char* nA = has_next ? (const char*)g.A + (size_t)nxt.pm * tstepA : cA; const char* nB = has_next ? (const char*)g.Bt + (size_t)nxt.pn * tstepB : cB;
        for (int t = 0; t < nt; t += 2) {
            const bool last = (t == nt - 2);
            const char* a1 = cA + (size_t)(t + 1) * kstep;
            const char* a2 = last ? nA : cA + (size_t)(t + 2) * kstep; const char* b2 = last ? nB : cB + (size_t)(t + 2) * kstep;
            const char* a3 = a2 + kstep; const char* b3 = b2 + kstep;
            if (last && has_next) S.a_ready(nxt);
            if constexpr (SP2) {
            PG8_LDB(B0, 0, 0); PG8_LDB(B1, 0, 1); PG8_SCHED; PG8_LDA(At, 0, 0); PG8_STAGE(PG8_SA(1, 1), a1 + hstepA, voffA);
            PG8_WAIT_V(8); PG8_WAIT_L(0); PG8_BAR; PG8_MMA(0, 0, At, B0); PG8_MMA(0, 1, At, B1); PG8_BAR; PG8_SCHED;
            PG8_LDA(At, 0, 1); PG8_STAGE(PG8_SB(0, 0), b2, voffB); PG8_STAGE(PG8_SB(0, 1), b2 + hstepB, voffB); PG8_STAGE(PG8_SA(0, 0), a2, voffA);
            PG8_WAIT_V(8); PG8_WAIT_L(0); PG8_BAR; PG8_MMA(1, 0, At, B0); PG8_MMA(1, 1, At, B1); PG8_BAR; PG8_SCHED;
            PG8_LDB(B0, 1, 0); PG8_LDB(B1, 1, 1); PG8_SCHED; PG8_LDA(At, 1, 0); PG8_STAGE(PG8_SA(0, 1), a2 + hstepA, voffA);
            PG8_WAIT_V(8); PG8_WAIT_L(0); PG8_BAR; PG8_MMA(0, 0, At, B0); PG8_MMA(0, 1, At, B1); PG8_BAR; PG8_SCHED;
            PG8_LDA(At, 1, 1); PG8_STAGE(PG8_SB(1, 0), b3, voffB); PG8_STAGE(PG8_SB(1, 1), b3 + hstepB, voffB); PG8_STAGE(PG8_SA(1, 0), a3, voffA);
            PG8_WAIT_V(8); PG8_WAIT_L(0); PG8_BAR; PG8_MMA(1, 0, At, B0); PG8_MMA(1, 1, At, B1); PG8_BAR; PG8_SCHED;
            } else {
            PG8_LDB(B0, 0, 0); PG8_SCHED; PG8_LDA(At, 0, 0); PG8_STAGE(PG8_SA(1, 1), a1 + hstepA, voffA);
            PG8_WAIT_L(8); PG8_BAR; PG8_WAIT_L(0); PG8_MMA(0, 0, At, B0); PG8_BAR; PG8_SCHED;
            PG8_LDB(B1, 0, 1); PG8_STAGE(PG8_SB(0, 0), b2, voffB);
            PG8_BAR; PG8_WAIT_L(0); PG8_MMA(0, 1, At, B1); PG8_BAR;
            PG8_LDA(At, 0, 1); PG8_STAGE(PG8_SA(0, 0), a2, voffA);
            PG8_BAR; PG8_WAIT_L(0); PG8_MMA(1, 0, At, B0); PG8_BAR; PG8_SCHED;
            PG8_STAGE(PG8_SB(0, 1), b2 + hstepB, voffB);
            PG8_WAIT_V(6); PG8_BAR; PG8_MMA(1, 1, At, B1); PG8_BAR;
            PG8_LDB(B0, 1, 0); PG8_SCHED; PG8_LDA(At, 1, 0); PG8_STAGE(PG8_SA(0, 1), a2 + hstepA, voffA);
            PG8_WAIT_L(8); PG8_BAR; PG8_WAIT_L(0); PG8_MMA(0, 0, At, B0); PG8_BAR; PG8_SCHED;
            PG8_LDB(B1, 1, 1); PG8_STAGE(PG8_SB(1, 0), b3, voffB);
            PG8_BAR; PG8_WAIT_L(0); PG8_MMA(0, 1, At, B1); PG8_BAR;
            PG8_LDA(At, 1, 1); PG8_STAGE(PG8_SA(1, 0), a3, voffA);
            PG8_BAR; PG8_WAIT_L(0); PG8_MMA(1, 0, At, B0); PG8_BAR; PG8_SCHED;
            PG8_STAGE(PG8_SB(1, 1), b3 + hstepB, voffB);
            PG8_WAIT_V(6); PG8_BAR; PG8_MMA(1, 1, At, B1); PG8_BAR;
            }
        }
        if constexpr (ALIGN_EPI) { if (wr == 0) PG8_BAR; }
        if constexpr (!Epi::AFTER_DRAIN) { E(acc, cur, wr, wc, fr, fq); S.done(cur); }
        if (!has_next) break;
#pragma unroll
        for (int a = 0; a < 2; ++a)
#pragma unroll
            for (int b = 0; b < 2; ++b)
#pragma unroll
                for (int m = 0; m < 4; ++m)
#pragma unroll
                    for (int n = 0; n < 2; ++n) acc[a][b][m][n] = (f32x4){0.f, 0.f, 0.f, 0.f};
        cur = nxt; cA = nA; cB = nB; ++ui;
        if constexpr (ALIGN_EPI) { if (wr == 1) PG8_BAR; }
    }
    PG8_WAIT_V(0);
    if constexpr (!ALIGN_EPI) { if (wr == 0) PG8_BAR; }
    PG8_BAR;
    if constexpr (Epi::AFTER_DRAIN) { E.fused(acc, cur, wr, wc, fr, fq, lds, wid, lane); S.done(cur); }
#undef PG8_SA
#undef PG8_SB
#undef PG8_STAGE
#undef PG8_LDA
#undef PG8_LDB
#undef PG8_MMA
#undef PG8_WAIT_V
#undef PG8_WAIT_L
#undef PG8_BAR
#undef PG8_SCHED
}
}

constexpr int NWAVES = 8, NT = 512;
constexpr int D = 1024, BATCH = 4, T = 8192, M = BATCH * T, DEPTH = 4, MEM = 256, MROWS = BATCH * MEM;
constexpr int DK = 128, CH = 64, NCH = T / CH;
constexpr int GLA_N = 4096, HGRN_N = 4608, FF = 4096, KOUT = 1536;
constexpr float EPS = 1e-6f;
constexpr size_t MiB = 1u << 20;
constexpr size_t WS_SS = 0;
constexpr size_t WS_DEC = 2 * MiB;
constexpr size_t WS_MEMB = 4 * MiB;
constexpr size_t WS_SSM = 6 * MiB;
constexpr size_t WS_LB = 6 * MiB + 65536;
constexpr size_t WS_KM = 8 * MiB;
constexpr size_t WS_VMT = 12 * MiB;
constexpr size_t WS_WKV = 16 * MiB;
constexpr size_t WS_WT = 24 * MiB, WT_BUF = 30 * MiB;
constexpr size_t WT_IN = 0, WT_OUT = 10 * MiB, WT_UP = 14 * MiB, WT_DOWN = 22 * MiB;
constexpr size_t WS_PROJ = 84 * MiB;
constexpr size_t WS_XB = 372 * MiB;
constexpr size_t WS_END = 500 * MiB;
constexpr int LDS_BYTES = 147456;

#define LAS __attribute__((address_space(3)))
typedef unsigned short bf16;
typedef float f32x4 __attribute__((ext_vector_type(4)));
typedef short bf16x8 __attribute__((ext_vector_type(8)));
typedef short bf16x4 __attribute__((ext_vector_type(4)));
typedef unsigned u32x4 __attribute__((ext_vector_type(4)));
typedef unsigned u32x2 __attribute__((ext_vector_type(2)));
__device__ __forceinline__ float bf2f(bf16 b) { return __uint_as_float(((unsigned)b) << 16); }
__device__ __forceinline__ unsigned f2bf(float f) { unsigned u = __float_as_uint(f); return (u + 0x7fffu + ((u >> 16) & 1u)) >> 16; }
__device__ __forceinline__ unsigned pk2(float lo, float hi) { return pg8::cvt_pk_bf16(lo, hi); }
__device__ __forceinline__ float wave_sum(float v, int lane) {
#pragma unroll
    for (int o = 1; o < 64; o <<= 1) v += pg8::shx(v, o, lane);
    return v;
}
#define MFMA16(a, b, c) __builtin_amdgcn_mfma_f32_16x16x32_bf16((a), (b), (c), 0, 0, 0)

constexpr size_t WS_CTL = 7 * MiB, CTL_BYTES = 16384;
constexpr int LDS_BARST = LDS_BYTES - 64;
#define XB_TMO      128
#define XB_XCNT(j)  (256  + 64 * (j))
#define XB_XSUB(j)  (1280 + 64 * (j))
#define XB_XGEN(j)  (2304 + 64 * (j))
#define XB_TOP      3328
#define XB_TOPGEN   3392
#define XCD_BAR_WORDS 3456
#define XB_SPIN_CAP (1u << 18)

__device__ __forceinline__ unsigned xb_ld(unsigned* p)              { return __hip_atomic_load(p, __ATOMIC_RELAXED, __HIP_MEMORY_SCOPE_AGENT); }
__device__ __forceinline__ unsigned xb_add(unsigned* p, unsigned v) { return __hip_atomic_fetch_add(p, v, __ATOMIC_RELAXED, __HIP_MEMORY_SCOPE_AGENT); }
__device__ __forceinline__ unsigned xb_xcc_id() { return (unsigned)__builtin_amdgcn_s_getreg((3 << 11) | 20) & 0xFu; }
#define XB_SPIN(cond, bar) do { unsigned _sp = 0; while (cond) { __builtin_amdgcn_s_sleep(1); \
    if ((++_sp & 255u) == 0u) { if (xb_ld(&(bar)[XB_TMO])) break; if (_sp > XB_SPIN_CAP) { atomicAdd(&(bar)[XB_TMO], 1u); break; } } } } while (0)

struct XcdBarrier {
    unsigned* bar; unsigned x;
    volatile LAS unsigned* st;
};

__device__ __forceinline__ XcdBarrier xcd_barrier_post(unsigned* bar, volatile LAS unsigned* st, int tid) {
    XcdBarrier b; b.bar = bar; b.x = xb_xcc_id(); b.st = st;
    if (tid == 0) (void)xb_add(&bar[XB_XCNT(b.x)], 1u);
    return b;
}
__device__ __forceinline__ void xcd_barrier_complete(unsigned* bar, unsigned x, unsigned& nloc, unsigned& nx) {
    const unsigned G = gridDim.x * gridDim.y * gridDim.z;
    unsigned sum, cnt, mine, sp = 0u;
    for (;;) {
        sum = 0u; cnt = 0u; mine = 0u;
#pragma unroll
        for (unsigned j = 0; j < 16; ++j) { const unsigned c = xb_ld(&bar[XB_XCNT(j)]); sum += c; cnt += (c > 0u) ? 1u : 0u; mine = (j == x) ? c : mine; }
        if (sum == G) break;
        __builtin_amdgcn_s_sleep(1);
        if ((++sp & 255u) == 0u) { if (xb_ld(&bar[XB_TMO])) break; if (sp > XB_SPIN_CAP) { atomicAdd(&bar[XB_TMO], 1u); break; } }
    }
    nloc = mine > 0u ? mine : 1u; nx = cnt > 0u ? cnt : 1u;
}

__device__ __forceinline__ void xcd_barrier(const XcdBarrier& b, int tid) {
    asm volatile("s_waitcnt vmcnt(0)" ::: "memory");
    __syncthreads();
    if (tid == 0) {
        unsigned* bar = b.bar;
        __builtin_amdgcn_s_waitcnt(0);
        unsigned nloc = b.st[0], nx = b.st[1];
        if (nloc == 0u) { xcd_barrier_complete(bar, b.x, nloc, nx); b.st[0] = nloc; b.st[1] = nx; }
        const unsigned old = xb_add(&bar[XB_XSUB(b.x)], 1u);
        const unsigned gen = old / nloc;
        if (old + 1u == (gen + 1u) * nloc) {
            __builtin_amdgcn_fence(__ATOMIC_RELEASE, "agent");
            asm volatile("s_waitcnt vmcnt(0)" ::: "memory");
            const unsigned og = xb_add(&bar[XB_TOP], 1u);
            const unsigned tg = og / nx;
            if (og + 1u == (tg + 1u) * nx) xb_add(&bar[XB_TOPGEN], 1u);
            else XB_SPIN(xb_ld(&bar[XB_TOPGEN]) == tg, bar);
            __builtin_amdgcn_fence(__ATOMIC_ACQUIRE, "agent");
            xb_add(&bar[XB_XGEN(b.x)], 1u);
            asm volatile("s_waitcnt vmcnt(0)" ::: "memory");
        } else {
            XB_SPIN(xb_ld(&bar[XB_XGEN(b.x)]) == gen, bar);
            __builtin_amdgcn_fence(__ATOMIC_ACQUIRE, "agent");
            asm volatile("s_waitcnt vmcnt(0)" ::: "memory");
        }
    }
    __syncthreads();
}

__device__ __forceinline__ void transpose_item(const float* W, int ldw, int K, int sc, bf16* WT, int dr, const float* gain, int gmask, int glimit, float scale, LAS float* scr, int item, int nblk, int lane) {
    const int kb = item / nblk, nb = item % nblk, k0 = 64 * kb, n0 = 32 * nb;
#pragma unroll 8
    for (int i = 0; i < 32; ++i) { const int kk = 2 * i + (lane >> 5); const int k = k0 + kk; float g = scale; if (gain && k < glimit) g *= gain[k & gmask];
        scr[kk * 33 + (lane & 31)] = W[(size_t)k * ldw + sc + n0 + (lane & 31)] * g; }
    asm volatile("s_waitcnt lgkmcnt(0)" ::: "memory");
    const int c = lane & 7;
#pragma unroll
    for (int j = 0; j < 4; ++j) { const int n = (lane >> 3) + 8 * j; const LAS float* s = scr + (8 * c) * 33 + n;
        u32x4 o; o.x = pk2(s[0 * 33], s[1 * 33]); o.y = pk2(s[2 * 33], s[3 * 33]); o.z = pk2(s[4 * 33], s[5 * 33]); o.w = pk2(s[6 * 33], s[7 * 33]);
        *(u32x4*)(WT + (size_t)(dr + n0 + n) * K + k0 + 8 * c) = o; }
    asm volatile("s_waitcnt lgkmcnt(0)" ::: "memory");
}
struct Ptrs {
    const float *x, *mem, *norm_mix, *norm_mem, *w_kv, *w_out, *norm_mlp, *w_up, *w_down, *gla_w_in, *gla_w_gate2, *gla_b_gate, *gla_out_gain, *hgrn_w_in, *hgrn_lb, *hgrn_out_gain, *final_norm;
    float* out; unsigned char* ws;
};
#define SEG(Wp, ldw, K, sc, ncols, WTp, dr, gain, gmask, glimit, scale) { const int nblk_ = (ncols) / 32, nit_ = ((K) / 64) * nblk_; \
    if (r < nit_) { transpose_item(Wp, ldw, K, sc, WTp, dr, gain, gmask, glimit, scale, scr, r, nblk_, lane); continue; } r -= nit_; }
template <class PT> __device__ __forceinline__ void convert_layer(PT Pp, int L, LAS unsigned char* lds, int gw, int ngw, int wave, int lane) {
    LAS float* scr = (LAS float*)(lds + wave * 16384);
    unsigned char* wb = Pp->ws + WS_WT + (size_t)(L & 1) * WT_BUF;
    bf16* Win = (bf16*)(wb + WT_IN); bf16* Wout = (bf16*)(wb + WT_OUT); bf16* Wup = (bf16*)(wb + WT_UP); bf16* Wdn = (bf16*)(wb + WT_DOWN);
    const int j = L >> 1; const bool hg = (L & 1);
    const float* gmix = Pp->norm_mix + (size_t)L * D; const float* gmlp = Pp->norm_mlp + (size_t)L * D;
    const float* wo = Pp->w_out + (size_t)L * KOUT * D; const float* wu = Pp->w_up + (size_t)L * D * FF; const float* wd = Pp->w_down + (size_t)L * FF * D;
    const float QS = 0.08838834764831845f;
    if (!hg) {
        const float* wi = Pp->gla_w_in + (size_t)j * D * 3600; const float* og = Pp->gla_out_gain + (size_t)j * 256;
        const int total = 16 * (16 + 16 + 32 + 32 + 16) + 24 * 32 + 16 * 128 + 64 * 32 + 128;
        for (int it = gw; it < total; it += ngw) { int r = it;
            SEG(wi, 3600, D, 0, 512, Win, 0, gmix, 1023, D, QS)
            SEG(wi, 3600, D, 512, 512, Win, 512, gmix, 1023, D, 1.f)
            SEG(wi, 3600, D, 1024, 1024, Win, 2560, gmix, 1023, D, 1.f)
            SEG(wi, 3600, D, 2064, 1024, Win, 1536, gmix, 1023, D, 1.f)
            SEG(wi, 3600, D, 3088, 512, Win, 3584, gmix, 1023, D, QS)
            SEG(wo, D, KOUT, 0, 1024, Wout, 0, og, 255, 1024, 1.f)
            SEG(wu, FF, D, 0, 4096, Wup, 0, gmlp, 1023, D, 1.f)
            SEG(wd, D, FF, 0, 1024, Wdn, 0, (const float*)nullptr, 0, 0, 1.f)
            { const int kb = r >> 3, cb = r & 7, k = kb * 64 + lane; const float* g2 = Pp->gla_w_gate2 + (size_t)j * 16 * 512 + cb * 64;
              const f32x4* wr4 = (const f32x4*)(wi + (size_t)k * 3600 + 2048); const f32x4 w0 = wr4[0], w1 = wr4[1], w2 = wr4[2], w3 = wr4[3]; const float gk = gmix[k];
              for (int c = 0; c < 64; ++c) { float s = 0.f;
#pragma unroll
                  for (int q = 0; q < 4; ++q) { s += w0[q] * g2[q * 512 + c]; s += w1[q] * g2[(4 + q) * 512 + c]; s += w2[q] * g2[(8 + q) * 512 + c]; s += w3[q] * g2[(12 + q) * 512 + c]; }
                  Win[(size_t)(1024 + cb * 64 + c) * D + k] = (bf16)f2bf(s * gk); } }
        }
    } else {
        const float* wi = Pp->hgrn_w_in + (size_t)j * D * 4608; const float* og = Pp->hgrn_out_gain + (size_t)j * 128;
        const int total = 16 * (32 + 32 + 32 + 32 + 16) + 24 * 32 + 16 * 128 + 64 * 32;
        for (int it = gw; it < total; it += ngw) { int r = it;
            SEG(wi, 4608, D, 0, 1024, Win, 0, gmix, 1023, D, 1.f)
            SEG(wi, 4608, D, 1024, 1024, Win, 1024, gmix, 1023, D, 1.f)
            SEG(wi, 4608, D, 2048, 1024, Win, 3072, gmix, 1023, D, 1.f)
            SEG(wi, 4608, D, 3072, 1024, Win, 2048, gmix, 1023, D, 1.f)
            SEG(wi, 4608, D, 4096, 512, Win, 4096, gmix, 1023, D, QS)
            SEG(wo, D, KOUT, 0, 1024, Wout, 0, og, 127, 1024, 1.f)
            SEG(wu, FF, D, 0, 4096, Wup, 0, gmlp, 1023, D, 1.f)
            { const int nblk_ = 32; transpose_item(wd, D, FF, 0, Wdn, 0, (const float*)nullptr, 0, 0, 1.f, scr, r, nblk_, lane); }
        }
    }
}
template <class PT> __device__ __forceinline__ void prologue(PT Pp, LAS unsigned char* lds, int gw, int ngw, int wave, int lane) {
    convert_layer(Pp, 0, lds, gw, ngw, wave, lane);
    { LAS float* scr = (LAS float*)(lds + wave * 16384); bf16* Wkv = (bf16*)(Pp->ws + WS_WKV);
      const int per = 16 * 32, total = 4 * per;
      for (int it = gw; it < total; it += ngw) { const int L = it / per, r = it % per;
          transpose_item(Pp->w_kv + (size_t)L * D * 1024, 1024, D, 0, Wkv + (size_t)L * 1024 * D, 0, Pp->norm_mem + (size_t)L * D, 1023, D, 1.f, scr, r, 32, lane); } }
    { float* LB = (float*)(Pp->ws + WS_LB);
      for (int c = gw * 64 + lane; c < 1024; c += ngw * 64) { const float v0 = Pp->hgrn_lb[c], v1 = Pp->hgrn_lb[1024 + c], v2 = Pp->hgrn_lb[2048 + c], v3 = Pp->hgrn_lb[3072 + c];
          const float mx = fmaxf(fmaxf(v0, v1), fmaxf(v2, v3)); const float e0 = expf(v0 - mx), e1 = expf(v1 - mx), e2 = expf(v2 - mx), e3 = expf(v3 - mx); const float inv = 1.0f / (e0 + e1 + e2 + e3);
          LB[c] = 0.f; LB[1024 + c] = e1 * inv; LB[2048 + c] = (e1 + e2) * inv; LB[3072 + c] = (e1 + e2 + e3) * inv; } }
    bf16* XB = (bf16*)(Pp->ws + WS_XB); float* SS = (float*)(Pp->ws + WS_SS); bf16* MB = (bf16*)(Pp->ws + WS_MEMB); float* SSM = (float*)(Pp->ws + WS_SSM);
    for (int m = gw; m < M + MROWS; m += ngw) {
        const bool ism = m >= M; const int row = ism ? m - M : m;
        const f32x4* xr = (const f32x4*)((ism ? Pp->mem : Pp->x) + (size_t)row * D) + lane; unsigned long long* o8 = (unsigned long long*)((ism ? MB : XB) + (size_t)row * D) + lane;
        float s = 0.f;
#pragma unroll
        for (int j = 0; j < 4; ++j) { const f32x4 v = xr[64 * j]; s += (v.x * v.x + v.y * v.y) + (v.z * v.z + v.w * v.w); o8[64 * j] = (unsigned long long)pk2(v.x, v.y) | ((unsigned long long)pk2(v.z, v.w) << 32); }
        s = wave_sum(s, lane);
        if (ism) { if (lane == 0) SSM[row] = s; }
        else if (lane < 16) SS[(size_t)lane * M + row] = lane == 0 ? s : 0.f;
    }
}
constexpr int KT_STR = 144;
constexpr int QS_STR = 272;
constexpr int VS_STR = 528;
constexpr int L_TOT = 0;
constexpr int L_LA = 2048;
constexpr int L_QS = L_LA + 64 * QS_STR;
constexpr int L_KS = L_QS + 64 * QS_STR;
constexpr int L_VS = L_KS + 64 * QS_STR;
constexpr int L_VT = L_VS + 64 * VS_STR;
constexpr int L_KT = L_VT + 256 * KT_STR;
constexpr int L_AT = L_KT;
constexpr int L_RED = L_KT + 128 * KT_STR;
static_assert(L_RED + 2048 <= LDS_BYTES - 64, "mixer LDS map");

template <int DV>
__device__ __forceinline__ void load_raw_v(const bf16* base, int ld, int vcol, int tid, u32x4 (&rv)[DV / 64]) {
#pragma unroll
    for (int i = 0; i < DV / 64; ++i) { const int c = tid + i * NT, row = c / (DV / 8), part = c % (DV / 8); rv[i] = *(const u32x4*)(base + (size_t)row * ld + vcol + part * 8); }
}
template <int DV>
__device__ __forceinline__ void store_raw_v(LAS unsigned char* lds, int tid, const u32x4 (&rv)[DV / 64]) {
#pragma unroll
    for (int i = 0; i < DV / 64; ++i) { const int c = tid + i * NT, row = c / (DV / 8), part = c % (DV / 8); *(LAS u32x4*)(lds + L_VS + row * VS_STR + part * 16) = rv[i]; }
}
__device__ __forceinline__ void load_raw128(const bf16* base, int ld, int col, int tid, u32x4 (&r)[2]) {
#pragma unroll
    for (int i = 0; i < 2; ++i) { const int c = tid + i * NT; r[i] = *(const u32x4*)(base + (size_t)(c >> 4) * ld + col + (c & 15) * 8); }
}
__device__ __forceinline__ void store_raw128(LAS unsigned char* lds, int off, int tid, const u32x4 (&r)[2]) {
#pragma unroll
    for (int i = 0; i < 2; ++i) { const int c = tid + i * NT; *(LAS u32x4*)(lds + off + (c >> 4) * QS_STR + (c & 15) * 16) = r[i]; }
}
template <int DV>
__device__ __forceinline__ void transpose_v(LAS unsigned char* lds, int tid) {
    constexpr int RPT = DV / 8;
    const int v = tid % DV, part = tid / DV;
    unsigned w[RPT / 2];
#pragma unroll
    for (int i = 0; i < RPT / 2; ++i) { const unsigned lo = *(const LAS bf16*)(lds + L_VS + (part * RPT + 2 * i) * VS_STR + v * 2), hi = *(const LAS bf16*)(lds + L_VS + (part * RPT + 2 * i + 1) * VS_STR + v * 2); w[i] = lo | (hi << 16); }
    LAS u32x4* dst = (LAS u32x4*)(lds + L_VT + v * KT_STR + part * RPT * 2);
#pragma unroll
    for (int i = 0; i < RPT / 8; ++i) dst[i] = (u32x4){w[4 * i], w[4 * i + 1], w[4 * i + 2], w[4 * i + 3]};
}
__device__ __forceinline__ void cumsum_local(LAS unsigned char* lds, int d, int rg, float (&bb)[16]) {
#pragma unroll
    for (int i = 0; i < 16; ++i) bb[i] = bf2f(*(const LAS bf16*)(lds + L_LA + (rg * 16 + i) * QS_STR + d * 2));
}
__device__ __forceinline__ void cumsum_scan(LAS unsigned char* lds, int d, int rg, float (&bb)[16]) {
#pragma unroll
    for (int i = 1; i < 16; ++i) bb[i] += bb[i - 1];
    ((LAS float*)(lds + L_TOT))[rg * 128 + d] = bb[15];
}
__device__ __forceinline__ void cumsum_finish(LAS unsigned char* lds, int d, int rg, float (&bb)[16], float& blast) {
    const LAS float* tot = (const LAS float*)(lds + L_TOT);
    const float t0 = tot[d], t1 = tot[128 + d], t2 = tot[256 + d], t3 = tot[384 + d];
    const float off = rg == 0 ? 0.f : (rg == 1 ? t0 : (rg == 2 ? t0 + t1 : t0 + t1 + t2));
    blast = (t0 + t1) + (t2 + t3);
#pragma unroll
    for (int i = 0; i < 16; ++i) bb[i] += off;
}
template <int DV, bool HGRN>
__device__ __forceinline__ void pass_a(LAS unsigned char* lds, const bf16* proj, bf16* GS, float* DEC, int G, int bid, const int tid) {
    constexpr int H = HGRN ? 8 : 4, LD = HGRN ? HGRN_N : GLA_N, NTW = DV / 128, NU = BATCH * H * NCH;
    const int lane = tid & 63, wave = tid >> 6, g = lane >> 4, l15 = lane & 15, d = tid & 127, rg = tid >> 7;
    u32x4 rla[2], rk[2], rv[DV / 64];
    int u = bid;
    if (u < NU) { const int b = u / (H * NCH), h = (u / NCH) % H, n = u % NCH; const bf16* base = proj + (size_t)(b * T + n * CH) * LD;
        load_raw128(base, LD, 1024 + h * 128, tid, rla); if (!HGRN) load_raw128(base, LD, 512 + h * 128, tid, rk); load_raw_v<DV>(base, LD, (HGRN ? 3072 : 2560) + h * DV, tid, rv); }
    for (; u < NU; u += G) {
        store_raw128(lds, L_LA, tid, rla); if (!HGRN) store_raw128(lds, L_KS, tid, rk); store_raw_v<DV>(lds, tid, rv);
        __syncthreads();
        { const int un = u + G; if (un < NU) { const int b = un / (H * NCH), h = (un / NCH) % H, n = un % NCH; const bf16* base = proj + (size_t)(b * T + n * CH) * LD;
            load_raw128(base, LD, 1024 + h * 128, tid, rla); if (!HGRN) load_raw128(base, LD, 512 + h * 128, tid, rk); load_raw_v<DV>(base, LD, (HGRN ? 3072 : 2560) + h * DV, tid, rv); } }
        float bb[16], kv[16], blast;
        cumsum_local(lds, d, rg, bb);
#pragma unroll
        for (int i = 0; i < 16; ++i) kv[i] = HGRN ? (1.0f - __expf(bb[i])) : bf2f(*(const LAS bf16*)(lds + L_KS + (rg * 16 + i) * QS_STR + d * 2));
        cumsum_scan(lds, d, rg, bb);
        transpose_v<DV>(lds, tid);
        __syncthreads();
        cumsum_finish(lds, d, rg, bb, blast);
        { unsigned w[8];
#pragma unroll
          for (int i = 0; i < 8; ++i) w[i] = pk2(kv[2 * i] * __expf(-bb[2 * i]), kv[2 * i + 1] * __expf(-bb[2 * i + 1]));
          LAS u32x4* dst = (LAS u32x4*)(lds + L_KT + d * KT_STR + rg * 32);
          dst[0] = (u32x4){w[0], w[1], w[2], w[3]}; dst[1] = (u32x4){w[4], w[5], w[6], w[7]}; }
        if (rg == 0) DEC[(size_t)u * 128 + d] = __expf(blast);
        __syncthreads();
        f32x4 acc[8][NTW];
#pragma unroll
        for (int mt = 0; mt < 8; ++mt)
#pragma unroll
            for (int nt = 0; nt < NTW; ++nt) acc[mt][nt] = (f32x4){0.f, 0.f, 0.f, 0.f};
#pragma unroll
        for (int kk = 0; kk < 2; ++kk) {
            bf16x8 bfr[NTW];
#pragma unroll
            for (int nt = 0; nt < NTW; ++nt) bfr[nt] = *(const LAS bf16x8*)(lds + L_VT + ((wave * NTW + nt) * 16 + l15) * KT_STR + (kk * 32 + 8 * g) * 2);
#pragma unroll
            for (int mt = 0; mt < 8; ++mt) { const bf16x8 afr = *(const LAS bf16x8*)(lds + L_KT + (mt * 16 + l15) * KT_STR + (kk * 32 + 8 * g) * 2);
#pragma unroll
                for (int nt = 0; nt < NTW; ++nt) acc[mt][nt] = MFMA16(afr, bfr[nt], acc[mt][nt]); }
        }
#pragma unroll
        for (int mt = 0; mt < 8; ++mt)
#pragma unroll
            for (int nt = 0; nt < NTW; ++nt) asm volatile("s_nop 7\n\ts_nop 7" : "+v"(acc[mt][nt]));
#pragma unroll
        for (int nt = 0; nt < NTW; ++nt) { bf16* gp = GS + ((size_t)u * DV + (wave * NTW + nt) * 16 + l15) * 128 + 4 * g;
#pragma unroll
            for (int mt = 0; mt < 8; ++mt) { u32x2 w; w.x = pk2(acc[mt][nt][0], acc[mt][nt][1]); w.y = pk2(acc[mt][nt][2], acc[mt][nt][3]); *(u32x2*)(gp + mt * 16) = w; } }
    }
    __syncthreads();
}
template <int DV, bool HGRN>
__device__ __forceinline__ void pass_b(bf16* GS, const float* DEC, int G, int bid, const int tid) {
    constexpr int H = HGRN ? 8 : 4, E = DV * 128, E4 = E / 4;
    const int nthreads = G * NT;
    for (int i = bid * NT + tid; i < BATCH * H * E4; i += nthreads) {
        const int bh = i / E4, e = (i % E4) * 4, d = e & 127;
        float S0 = 0.f, S1 = 0.f, S2 = 0.f, S3 = 0.f;
        u32x2* gp = (u32x2*)(GS + (size_t)bh * NCH * E + e); const f32x4* dp = (const f32x4*)(DEC + (size_t)bh * NCH * 128 + d);
        for (int n0 = 0; n0 < NCH; n0 += 8) {
            u32x2 gv[8]; f32x4 dv[8];
#pragma unroll
            for (int q = 0; q < 8; ++q) { gv[q] = gp[(size_t)(n0 + q) * (E / 4)]; dv[q] = dp[(size_t)(n0 + q) * 32]; }
#pragma unroll
            for (int q = 0; q < 8; ++q) {
                u32x2 o; o.x = pk2(S0, S1); o.y = pk2(S2, S3); gp[(size_t)(n0 + q) * (E / 4)] = o;
                S0 = dv[q].x * (S0 + __uint_as_float(gv[q].x << 16)); S1 = dv[q].y * (S1 + __uint_as_float(gv[q].x & 0xffff0000u));
                S2 = dv[q].z * (S2 + __uint_as_float(gv[q].y << 16)); S3 = dv[q].w * (S3 + __uint_as_float(gv[q].y & 0xffff0000u)); }
        }
    }
}
template <int DV, bool HGRN>
__device__ __forceinline__ void pass_c(LAS unsigned char* lds, bf16* proj, const bf16* GS, int G, int bid, const int tid) {
    constexpr int H = HGRN ? 8 : 4, LD = HGRN ? HGRN_N : GLA_N, MTW = DV / 128, NU = BATCH * H * NCH;
    const int lane = tid & 63, wave = tid >> 6, g = lane >> 4, l15 = lane & 15, d = tid & 127, rg = tid >> 7;
    const int v0 = wave * MTW * 16;
    u32x4 rla[2], rq[2], rk[2], rv[DV / 64];
    int u = bid;
    if (u < NU) { const int b = u / (H * NCH), h = (u / NCH) % H, n = u % NCH; const bf16* base = proj + (size_t)(b * T + n * CH) * LD;
        load_raw128(base, LD, 1024 + h * 128, tid, rla); load_raw128(base, LD, h * 128, tid, rq); if (!HGRN) load_raw128(base, LD, 512 + h * 128, tid, rk); load_raw_v<DV>(base, LD, (HGRN ? 3072 : 2560) + h * DV, tid, rv); }
    for (; u < NU; u += G) {
        const int b = u / (H * NCH), h = (u / NCH) % H, n = u % NCH;
        bf16* base = proj + (size_t)(b * T + n * CH) * LD;
        const int vcol = (HGRN ? 3072 : 2560) + h * DV, gcol = (HGRN ? 2048 : 1536) + h * DV;
        store_raw128(lds, L_LA, tid, rla); store_raw128(lds, L_QS, tid, rq); if (!HGRN) store_raw128(lds, L_KS, tid, rk); store_raw_v<DV>(lds, tid, rv);
        __syncthreads();
        bf16x8 sfr[4][MTW];
#pragma unroll
        for (int kk = 0; kk < 4; ++kk)
#pragma unroll
            for (int mt = 0; mt < MTW; ++mt) sfr[kk][mt] = *(const bf16x8*)(GS + ((size_t)u * DV + v0 + mt * 16 + l15) * 128 + kk * 32 + 8 * g);
        { const int un = u + G; if (un < NU) { const int b2 = un / (H * NCH), h2 = (un / NCH) % H, n2 = un % NCH; const bf16* nb = proj + (size_t)(b2 * T + n2 * CH) * LD;
            load_raw128(nb, LD, 1024 + h2 * 128, tid, rla); load_raw128(nb, LD, h2 * 128, tid, rq); if (!HGRN) load_raw128(nb, LD, 512 + h2 * 128, tid, rk); load_raw_v<DV>(nb, LD, (HGRN ? 3072 : 2560) + h2 * DV, tid, rv); } }
        float bb[16], kv[16], blast;
        cumsum_local(lds, d, rg, bb);
#pragma unroll
        for (int i = 0; i < 16; ++i) kv[i] = HGRN ? (1.0f - __expf(bb[i])) : bf2f(*(const LAS bf16*)(lds + L_KS + (rg * 16 + i) * QS_STR + d * 2));
        cumsum_scan(lds, d, rg, bb);
        transpose_v<DV>(lds, tid);
        __syncthreads();
        cumsum_finish(lds, d, rg, bb, blast);
#pragma unroll
        for (int i = 0; i < 16; ++i) { const int s = rg * 16 + i; LAS bf16* qa = (LAS bf16*)(lds + L_QS + s * QS_STR + d * 2); LAS bf16* ka = (LAS bf16*)(lds + L_KS + s * QS_STR + d * 2);
            const float q = bf2f(*qa); *qa = (bf16)f2bf(q * __expf(bb[i])); *ka = (bf16)f2bf(kv[i] * __expf(-bb[i])); }
        __syncthreads();
        { const int tt = wave >> 1;
#pragma unroll
          for (int si = 0; si < 2; ++si) { const int st = (wave & 1) * 2 + si; f32x4 c = (f32x4){0.f, 0.f, 0.f, 0.f};
#pragma unroll
              for (int kk = 0; kk < 4; ++kk) { const bf16x8 afr = *(const LAS bf16x8*)(lds + L_KS + (st * 16 + l15) * QS_STR + (kk * 32 + 8 * g) * 2);
                  const bf16x8 bfr = *(const LAS bf16x8*)(lds + L_QS + (tt * 16 + l15) * QS_STR + (kk * 32 + 8 * g) * 2); c = MFMA16(afr, bfr, c); }
              const int t = tt * 16 + l15, s0 = st * 16 + 4 * g;
              u32x2 w; w.x = pk2(s0 <= t ? c[0] : 0.f, s0 + 1 <= t ? c[1] : 0.f); w.y = pk2(s0 + 2 <= t ? c[2] : 0.f, s0 + 3 <= t ? c[3] : 0.f);
              *(LAS u32x2*)(lds + L_AT + t * KT_STR + s0 * 2) = w; } }
        u32x2 gt[4][MTW];
#pragma unroll
        for (int nt = 0; nt < 4; ++nt)
#pragma unroll
            for (int mt = 0; mt < MTW; ++mt) gt[nt][mt] = *(const u32x2*)(base + (size_t)(nt * 16 + l15) * LD + gcol + v0 + mt * 16 + 4 * g);
        __syncthreads();
        f32x4 acc[MTW][4];
#pragma unroll
        for (int mt = 0; mt < MTW; ++mt)
#pragma unroll
            for (int nt = 0; nt < 4; ++nt) acc[mt][nt] = (f32x4){0.f, 0.f, 0.f, 0.f};
#pragma unroll
        for (int kk = 0; kk < 4; ++kk) {
#pragma unroll
            for (int nt = 0; nt < 4; ++nt) { const bf16x8 bfr = *(const LAS bf16x8*)(lds + L_QS + (nt * 16 + l15) * QS_STR + (kk * 32 + 8 * g) * 2);
#pragma unroll
                for (int mt = 0; mt < MTW; ++mt) acc[mt][nt] = MFMA16(sfr[kk][mt], bfr, acc[mt][nt]); }
        }
#pragma unroll
        for (int kk = 0; kk < 2; ++kk) {
            bf16x8 afr[MTW];
#pragma unroll
            for (int mt = 0; mt < MTW; ++mt) afr[mt] = *(const LAS bf16x8*)(lds + L_VT + (v0 + mt * 16 + l15) * KT_STR + (kk * 32 + 8 * g) * 2);
#pragma unroll
            for (int nt = 0; nt < 4; ++nt) { const bf16x8 bfr = *(const LAS bf16x8*)(lds + L_AT + (nt * 16 + l15) * KT_STR + (kk * 32 + 8 * g) * 2);
#pragma unroll
                for (int mt = 0; mt < MTW; ++mt) acc[mt][nt] = MFMA16(afr[mt], bfr, acc[mt][nt]); }
        }
        LAS float* red = (LAS float*)(lds + L_RED);
#pragma unroll
        for (int nt = 0; nt < 4; ++nt) { float p = 0.f;
#pragma unroll
            for (int mt = 0; mt < MTW; ++mt) p += (acc[mt][nt][0] * acc[mt][nt][0] + acc[mt][nt][1] * acc[mt][nt][1]) + (acc[mt][nt][2] * acc[mt][nt][2] + acc[mt][nt][3] * acc[mt][nt][3]);
            p += pg8::shx(p, 16, lane); p += pg8::shx(p, 32, lane);
            if (g == 0) red[wave * 64 + nt * 16 + l15] = p; }
        __syncthreads();
#pragma unroll
        for (int nt = 0; nt < 4; ++nt) { const int t = nt * 16 + l15; float s = 0.f;
#pragma unroll
            for (int w = 0; w < 8; ++w) s += red[w * 64 + t];
            const float rstd = rsqrtf(s * (1.0f / DV) + EPS);
            bf16* rowp = base + (size_t)t * LD;
#pragma unroll
            for (int mt = 0; mt < MTW; ++mt) { const int v = v0 + mt * 16 + 4 * g; const u32x2 gg = gt[nt][mt];
                u32x2 w; w.x = pk2(acc[mt][nt][0] * rstd * __uint_as_float(gg.x << 16), acc[mt][nt][1] * rstd * __uint_as_float(gg.x & 0xffff0000u));
                w.y = pk2(acc[mt][nt][2] * rstd * __uint_as_float(gg.y << 16), acc[mt][nt][3] * rstd * __uint_as_float(gg.y & 0xffff0000u));
                *(u32x2*)(rowp + vcol + v) = w; } }
    }
    __syncthreads();
}
constexpr int KL_STR = 272, VL_STR = 528, L_KL = 0, L_VL = 256 * KL_STR;
static_assert(L_VL + 128 * VL_STR <= LDS_BYTES, "xattn LDS map");
template <bool DRY = false>
__device__ __forceinline__ void xattn(LAS unsigned char* lds, bf16* proj, int LD, int xcol, const bf16* KM, const bf16* VMT, int G, int bid, const int tid) {
    const int lane = tid & 63, wave = tid >> 6, g = lane >> 4, l15 = lane & 15;
    for (int w = bid; w < 256; w += G) {
        const int pair = w >> 4, sub = w & 15, b = pair >> 2, h = pair & 3;
        __syncthreads();
#pragma unroll
        for (int i = 0; i < 8; ++i) { const int c = tid + i * NT, m = c >> 4, part = c & 15;
            *(LAS u32x4*)(lds + L_KL + m * KL_STR + part * 16) = *(const u32x4*)(KM + (size_t)(b * 256 + m) * 512 + h * 128 + part * 8); }
#pragma unroll
        for (int i = 0; i < 8; ++i) { const int c = tid + i * NT, dd = c >> 5, part = c & 31;
            *(LAS u32x4*)(lds + L_VL + dd * VL_STR + part * 16) = *(const u32x4*)(VMT + ((size_t)b * 512 + h * 128 + dd) * 256 + part * 8); }
        __syncthreads();
        for (int tile = 0; tile < 4; ++tile) {
            const int r0 = b * T + (sub * 4 + tile) * 128 + wave * 16;
            bf16* qp = proj + (size_t)(r0 + l15) * LD + xcol + h * 128;
            bf16x8 qf[4];
#pragma unroll
            for (int kk = 0; kk < 4; ++kk) qf[kk] = *(const bf16x8*)(qp + kk * 32 + 8 * g);
            f32x4 sc[16];
#pragma unroll
            for (int mt = 0; mt < 16; ++mt) { f32x4 c = (f32x4){0.f, 0.f, 0.f, 0.f};
#pragma unroll
                for (int kk = 0; kk < 4; ++kk) { const bf16x8 afr = *(const LAS bf16x8*)(lds + L_KL + (mt * 16 + l15) * KL_STR + (kk * 32 + 8 * g) * 2); c = MFMA16(afr, qf[kk], c); }
                sc[mt] = c; }
            float mx = -1e30f;
#pragma unroll
            for (int mt = 0; mt < 16; ++mt) mx = fmaxf(mx, fmaxf(fmaxf(sc[mt][0], sc[mt][1]), fmaxf(sc[mt][2], sc[mt][3])));
            mx = fmaxf(mx, pg8::shx(mx, 16, lane)); mx = fmaxf(mx, pg8::shx(mx, 32, lane));
            float sum = 0.f;
#pragma unroll
            for (int mt = 0; mt < 16; ++mt) {
#pragma unroll
                for (int j = 0; j < 4; ++j) { const float p = __expf(sc[mt][j] - mx); sc[mt][j] = p; sum += p; } }
            sum += pg8::shx(sum, 16, lane); sum += pg8::shx(sum, 32, lane);
            const float inv = 1.0f / sum;
            f32x4 oa[8];
#pragma unroll
            for (int dt = 0; dt < 8; ++dt) oa[dt] = (f32x4){0.f, 0.f, 0.f, 0.f};
#pragma unroll
            for (int kb = 0; kb < 8; ++kb) {
                union { bf16x8 v; unsigned u[4]; } pb;
                pb.u[0] = pk2(sc[2 * kb][0], sc[2 * kb][1]); pb.u[1] = pk2(sc[2 * kb][2], sc[2 * kb][3]); pb.u[2] = pk2(sc[2 * kb + 1][0], sc[2 * kb + 1][1]); pb.u[3] = pk2(sc[2 * kb + 1][2], sc[2 * kb + 1][3]);
#pragma unroll
                for (int dt = 0; dt < 8; ++dt) { union { bf16x8 v; u32x2 h[2]; } pa; const LAS unsigned char* vp = lds + L_VL + (dt * 16 + l15) * VL_STR + (kb * 32 + 4 * g) * 2;
                    pa.h[0] = *(const LAS u32x2*)vp; pa.h[1] = *(const LAS u32x2*)(vp + 32); oa[dt] = MFMA16(pa.v, pb.v, oa[dt]); }
            }
#pragma unroll
            for (int dt = 0; dt < 8; ++dt) { u32x2 o; o.x = pk2(oa[dt][0] * inv, oa[dt][1] * inv); o.y = pk2(oa[dt][2] * inv, oa[dt][3] * inv); if (!DRY || o.x == 0x12345678u) *(u32x2*)(qp + dt * 16 + 4 * g) = o; }
        }
    }
    __syncthreads();
}
__device__ __forceinline__ void final_norm(float* out, const float* SS, const float* gain, int gw, int ngw, int lane) {
    f32x4 gv[4];
#pragma unroll
    for (int j = 0; j < 4; ++j) gv[j] = ((const f32x4*)gain)[lane + 64 * j];
    for (int m = gw; m < M; m += ngw) {
        float s = lane < 16 ? SS[(size_t)lane * M + m] : 0.f; s = wave_sum(s, lane);
        const float rstd = rsqrtf(s * (1.0f / D) + EPS);
        f32x4* xr = (f32x4*)(out + (size_t)m * D) + lane;
#pragma unroll
        for (int j = 0; j < 4; ++j) { f32x4 v = xr[64 * j]; v = v * rstd * gv[j]; xr[64 * j] = v; }
    }
}

struct Args { Ptrs P; int ph_lo, ph_hi; };
constexpr int N_PHASES = 2 + 7 * DEPTH;
__global__ void __launch_bounds__(NT, 2) fwd_kernel(Args a) {
    extern __shared__ __attribute__((aligned(16))) unsigned char lds_raw[];
#if ONE_LAUNCH
    cg::grid_group grid = cg::this_grid();
    { volatile LAS unsigned* st = (volatile LAS unsigned*)((LAS unsigned char*)lds_raw + LDS_BARST); int t0_ = threadIdx.x; if (t0_ == 0) { st[0] = 0u; st[1] = 0u; } __syncthreads();
      (void)xcd_barrier_post((unsigned*)(a.P.ws + WS_CTL), st, t0_); }
#define SEAM() do { XcdBarrier xb_; xb_.bar = (unsigned*)(ws + WS_CTL); xb_.x = xb_xcc_id(); xb_.st = (volatile LAS unsigned*)(lds + LDS_BARST); xcd_barrier(xb_, tid); if (ph == 0) grid.sync(); } while (0)
#else
#define SEAM() do {} while (0)
#endif
    const int ph_lo = a.ph_lo, ph_hi = a.ph_hi;
    const int wave0 = __builtin_amdgcn_readfirstlane(threadIdx.x >> 6);
    for (int ph = ph_lo; ph < ph_hi; ++ph) {
        const __attribute__((address_space(4))) Args* ap = (const __attribute__((address_space(4))) Args*)__builtin_amdgcn_kernarg_segment_ptr();
        asm volatile("" : "+s"(ap));
        int zero_ = 0; asm volatile("" : "+v"(zero_));
        int tid = wave0 * 64 + (int)__builtin_amdgcn_mbcnt_hi(~0u, __builtin_amdgcn_mbcnt_lo(~0u, (unsigned)zero_)); asm volatile("" : "+v"(tid));
        LAS unsigned char* lds = (LAS unsigned char*)lds_raw;
        const int lane = tid & 63, wave = __builtin_amdgcn_readfirstlane(tid >> 6);
        int G = gridDim.x, bid = blockIdx.x; asm volatile("" : "+s"(G), "+s"(bid));
        const int gw = bid * NWAVES + wave, ngw = G * NWAVES;
        unsigned char* ws = ap->P.ws;
        float* SS = (float*)(ws + WS_SS); bf16* XB = (bf16*)(ws + WS_XB); bf16* GS = (bf16*)(ws + WS_XB); bf16* PROJ = (bf16*)(ws + WS_PROJ);
        int ngemm = 0;
        int L = 0, sp = 0; bool hg = false;
        if (ph == 0) { prologue(&ap->P, lds, gw, ngw, wave, lane); }
        else if (ph == N_PHASES - 1) { final_norm(ap->P.out, SS, ap->P.final_norm, gw, ngw, lane); }
        else {
            L = (ph - 1) / 7; sp = (ph - 1) % 7; hg = (L & 1);
            const int LD = hg ? HGRN_N : GLA_N;
            if (sp == 0) ngemm = (L == 0) ? 2 : 1;
            else if (sp == 1) {
                float* DEC = (float*)(ws + WS_DEC);
                if (hg) pass_a<128, true>(lds, PROJ, GS, DEC, G, bid, tid); else pass_a<256, false>(lds, PROJ, GS, DEC, G, bid, tid);
                xattn(lds, PROJ, LD, hg ? 4096 : 3584, (const bf16*)(ws + WS_KM) + (size_t)L * 1024 * 512, (const bf16*)(ws + WS_VMT) + (size_t)L * 4 * 512 * 256, G, bid, tid);
                if (L + 1 < DEPTH) { convert_layer(&ap->P, L + 1, lds, gw, ngw, wave, lane); }
            } else if (sp == 2) {
                const float* DEC = (const float*)(ws + WS_DEC);
                if (hg) pass_b<128, true>(GS, DEC, G, bid, tid); else pass_b<256, false>(GS, DEC, G, bid, tid);
            } else if (sp == 3) {
                if (hg) pass_c<128, true>(lds, PROJ, GS, G, bid, tid); else pass_c<256, false>(lds, PROJ, GS, G, bid, tid);
            } else ngemm = 1;
            if (EXP == 2 && (sp == 0 || sp == 5)) ngemm += 8;
        }
        for (int rep = 0; rep < (ngemm & 7) * (ngemm >= 8 ? 2 : 1); ++rep) {
            unsigned char* wb = ws + WS_WT + (size_t)(L & 1) * WT_BUF;
            const int LD = hg ? HGRN_N : GLA_N;
            pg8::Gemm g; pg8::EpiAll E; E.hgrn = hg ? 1 : 0; E.M = M; E.aux = nullptr; E.xin = nullptr; E.xout = nullptr;
            if (sp == 0 && (ngemm & 7) == 2 && (rep & 7) == 0 && rep < 8) {
                g.A = (const bf16*)(ws + WS_MEMB); g.Bt = (const bf16*)(ws + WS_WKV); g.M = MROWS; g.N = 4096; g.K = D; g.lda = D; g.perm = 0;
                E.kind = 3; E.ldc = 0; E.O = (bf16*)(ws + WS_KM); E.ss = (const float*)(ws + WS_SSM); E.xout = (float*)(ws + WS_VMT);
            } else if (sp == 0) {
                g.A = XB; g.Bt = (const bf16*)(wb + WT_IN); g.M = M; g.N = LD; g.K = D; g.lda = D; g.perm = 1;
                E.kind = 0; E.ldc = LD; E.O = PROJ; E.ss = SS; E.aux = hg ? (const float*)(ws + WS_LB) + (size_t)L * 1024 : ap->P.gla_b_gate + (size_t)(L >> 1) * 512;
            } else if (sp == 4) {
                g.A = PROJ + (hg ? 3072 : 2560); g.Bt = (const bf16*)(wb + WT_OUT); g.M = M; g.N = D; g.K = KOUT; g.lda = LD; g.perm = 0;
                E.kind = 2; E.ldc = D; E.O = XB; E.ss = SS; E.xin = (L == 0) ? ap->P.x : ap->P.out; E.xout = ap->P.out;
            } else if (sp == 5) {
                g.A = XB; g.Bt = (const bf16*)(wb + WT_UP); g.M = M; g.N = FF; g.K = D; g.lda = D; g.perm = 1;
                E.kind = 1; E.ldc = FF; E.O = PROJ; E.ss = SS;
            } else {
                g.A = PROJ; g.Bt = (const bf16*)(wb + WT_DOWN); g.M = M; g.N = D; g.K = FF; g.lda = FF; g.perm = 0;
                E.kind = 2; E.ldc = D; E.O = XB; E.ss = SS; E.xin = ap->P.out; E.xout = ap->P.out;
            }
            pg8::StaticOrder S; S.init(g.M, g.N, G, bid);
            pg8::gemm_phase<pg8::EpiAll, pg8::StaticOrder, true, true>(lds, g, S, E, tid);
        }
        if (ph + 1 < ph_hi) { SEAM(); }
    }
}

extern "C" void kernel_launch(void* const* d_in, const int* in_sizes, int n_in, void* d_out, int out_size, void* d_ws, size_t ws_size, hipStream_t stream) {
    static int grid = 0;
    if (grid == 0) {
        if (n_in != 17 || out_size != M * D || ws_size < WS_END) { fprintf(stderr, "kernel_launch: unexpected shapes (n_in %d out %d ws %zu)\n", n_in, out_size, ws_size); grid = -1; return; }
        int dev = 0, cus = 0, per_cu = 0;
        hipGetDevice(&dev); hipDeviceGetAttribute(&cus, hipDeviceAttributeMultiprocessorCount, dev);
        if (hipFuncSetAttribute((const void*)fwd_kernel, hipFuncAttributeMaxDynamicSharedMemorySize, LDS_BYTES) != hipSuccess) { fprintf(stderr, "kernel_launch: hipFuncSetAttribute failed\n"); grid = -1; return; }
        if (hipOccupancyMaxActiveBlocksPerMultiprocessor(&per_cu, (const void*)fwd_kernel, NT, LDS_BYTES) != hipSuccess || per_cu < 1) { fprintf(stderr, "kernel_launch: occupancy query says %d\n", per_cu); per_cu = 1; }
        (void)hipGetLastError();
        grid = cus * per_cu;
        if (grid > 256) grid = 256;
        grid = (grid / 16) * 16;
        fprintf(stderr, "kernel_launch: grid %d (cus %d per_cu %d)\n", grid, cus, per_cu);
    }
    if (grid <= 0) return;
#if ONE_LAUNCH
    if (hipMemsetAsync((char*)d_ws + WS_CTL, 0, CTL_BYTES, stream) != hipSuccess) { fprintf(stderr, "kernel_launch: memset failed\n"); return; }
#endif
    Args a{};
    const float** pp = (const float**)&a.P;
    for (int i = 0; i < 17; ++i) pp[i] = (const float*)d_in[i];
    a.P.out = (float*)d_out; a.P.ws = (unsigned char*)d_ws;
#if ONE_LAUNCH
    a.ph_lo = 0; a.ph_hi = N_PHASES;
    void* args[] = {&a};
    hipError_t e = hipLaunchCooperativeKernel((const void*)fwd_kernel, dim3(grid), dim3(NT), args, LDS_BYTES, stream);
    if (e != hipSuccess) fprintf(stderr, "kernel_launch: cooperative launch failed: %s (grid %d)\n", hipGetErrorString(e), grid);
#else
    for (int ph = 0; ph < N_PHASES; ++ph) { a.ph_lo = ph; a.ph_hi = ph + 1; hipLaunchKernelGGL(fwd_kernel, dim3(grid), dim3(NT), LDS_BYTES, stream, a); }
#endif
}
```

```cpp
#include <hip/hip_runtime.h>
#include <hip/hip_cooperative_groups.h>
#include <cstdio>
#include <cstdint>
namespace cg = cooperative_groups;

#ifndef EXP
#define EXP 0
#endif
#ifndef ONE_LAUNCH
#define ONE_LAUNCH 1
#endif

namespace pg8 {
#define PG8_LAS __attribute__((address_space(3)))
typedef unsigned short bf16_t;
typedef short bf16x8 __attribute__((ext_vector_type(8)));
typedef float f32x4 __attribute__((ext_vector_type(4)));
typedef unsigned u32x4 __attribute__((ext_vector_type(4)));
typedef unsigned u32x2 __attribute__((ext_vector_type(2)));
constexpr int BM = 256, BK = 64, HALF = 128, HTB = HALF * BK * 2, STAGE_BYTES = 8 * HTB, NXCD = 8, WGM = 8;

__host__ __device__ __forceinline__ int lds_byte(int r, int c) { const int st = (r >> 4) * 2 + (c >> 5), rr = r & 15, cc = c & 31, ob = rr * 64 + cc * 2; return st * 1024 + (ob ^ (((ob >> 9) & 1) << 5)); }
__host__ __device__ __forceinline__ void stage_rc(int b, int& R, int& C) { const int st = b / 1024, sb = b % 1024, swz = sb ^ (((sb >> 9) & 1) << 5); R = (st >> 1) * 16 + swz / 64; C = (st & 1) * 32 + (swz % 64) / 2; }
__host__ __device__ __forceinline__ int perm32(int rho) { const int n = rho >> 4, i = rho & 15; return 8 * (i >> 2) + 4 * n + (i & 3); }

struct Unit { int pm, pn; };
struct Gemm { const bf16_t* A; const bf16_t* Bt; int M, N, K, lda, perm; };

struct StaticOrder {
    int nM, nN, nwg, G, c;
    __host__ __device__ void init(int M, int N, int G_, int c_) { nM = M / BM; nN = N / BM; nwg = nM * nN; G = G_; c = c_; }
    __host__ __device__ bool next(int i, Unit& u) const {
        const long L = (long)i * G + c; if (L >= nwg) return false;
        int wgid = (int)L; { const int q = nwg / NXCD, r = nwg % NXCD, xcd = wgid % NXCD, off = wgid / NXCD; wgid = (xcd < r ? xcd * (q + 1) : r * (q + 1) + (xcd - r) * q) + off; }
        const int nig = WGM * nN, gid = wgid / nig, fm = gid * WGM, gsz = (nM - fm) < WGM ? (nM - fm) : WGM;
        u.pm = fm + ((wgid % nig) % gsz); u.pn = (wgid % nig) / gsz; return true;
    }
    __device__ __forceinline__ void a_ready(const Unit&) const {}
    __device__ __forceinline__ void done(const Unit&) const {}
};

__device__ __forceinline__ float shx(float v, int mask, int lane) { return __int_as_float(__builtin_amdgcn_ds_bpermute((lane ^ mask) << 2, __float_as_int(v))); }
typedef float f32x2_t __attribute__((ext_vector_type(2)));
typedef __bf16 bf16x2_t __attribute__((ext_vector_type(2)));
__device__ __forceinline__ unsigned cvt_pk_native(float lo, float hi) { const f32x2_t f = {lo, hi}; const bf16x2_t b = __builtin_convertvector(f, bf16x2_t); return __builtin_bit_cast(unsigned, b); }
__device__ __forceinline__ unsigned cvt_pk_bf16(float lo, float hi) { unsigned r; asm volatile("v_cvt_pk_bf16_f32 %0, %1, %2" : "=v"(r) : "v"(lo), "v"(hi)); return r; }

__device__ __forceinline__ float fsigmoid(float v) { return __builtin_amdgcn_rcpf(1.0f + __expf(-v)); }
__device__ __forceinline__ float fsilu(float v) { return v * fsigmoid(v); }
__device__ __forceinline__ float row_rstd(const float* ss, int M, int row, int fq, int lane) {
    const float* p = ss + (size_t)(4 * fq) * M + row;
    float s = (p[0] + p[M]) + (p[2 * (size_t)M] + p[3 * (size_t)M]);
    s += shx(s, 16, lane); s += shx(s, 32, lane);
    return rsqrtf(s * (1.0f / 1024.0f) + 1e-6f);
}
template <int MODE> __device__ __forceinline__ float proj_act(float v, float a) {
    if (MODE == 1) return fsilu(v);
    if (MODE == 2) { const float z = v + a; const float ls = fminf(z, 0.f) - __logf(1.0f + __expf(-fabsf(z))); return ls * 0.0625f; }
    if (MODE == 3) { const float sg = fsigmoid(v); return __logf(a + (1.0f - a) * sg); }
    if (MODE == 4) return fsilu(v) * 0.08838834764831845f;
    if (MODE == 5) { const float r = fmaxf(v, 0.f); return r * r; }
    return v;
}
struct EpiAll {
    static constexpr bool AFTER_DRAIN = false;
    int kind, ldc, hgrn, M;
    bf16_t* O;
    const float* ss;
    const float* aux;
    const float* xin;
    float* xout;
    template <int MODE> __device__ __forceinline__ void body_proj(const f32x4 (&acc)[2][2][4][2], const Unit& u, int wr, int wc, int fr, int fq) const {
        const int row0 = u.pm * BM + wr * 64 + fr, col0 = u.pn * BM + wc * 32 + 8 * fq;
        f32x4 av[2][2];
#pragma unroll
        for (int bj = 0; bj < 2; ++bj)
#pragma unroll
            for (int n = 0; n < 2; ++n) av[bj][n] = (MODE == 2 || MODE == 3) ? *(const f32x4*)(aux + (col0 - 1024) + bj * HALF + 4 * n) : (f32x4){0.f, 0.f, 0.f, 0.f};
#pragma unroll
        for (int ai = 0; ai < 2; ++ai)
#pragma unroll
            for (int m = 0; m < 4; ++m) { const int row = row0 + ai * HALF + m * 16; const float rstd = row_rstd(ss, M, row, fq, fq * 16 + fr); bf16_t* rowp = O + (size_t)row * ldc + col0;
#pragma unroll
                for (int bj = 0; bj < 2; ++bj) { f32x4 v0 = acc[ai][bj][m][0] * rstd, v1 = acc[ai][bj][m][1] * rstd;
#pragma unroll
                    for (int j = 0; j < 4; ++j) { v0[j] = proj_act<MODE>(v0[j], av[bj][0][j]); v1[j] = proj_act<MODE>(v1[j], av[bj][1][j]); }
                    u32x4 w; w.x = cvt_pk_bf16(v0[0], v0[1]); w.y = cvt_pk_bf16(v0[2], v0[3]); w.z = cvt_pk_bf16(v1[0], v1[1]); w.w = cvt_pk_bf16(v1[2], v1[3]);
                    *(u32x4*)(rowp + bj * HALF) = w; } }
    }
    template <bool F32IN> __device__ __forceinline__ void body_res(const f32x4 (&acc)[2][2][4][2], const Unit& u, int wr, int wc, int fr, int fq) const {
        const int row0 = u.pm * BM + wr * 64 + fr, col0 = u.pn * BM + wc * 32 + 4 * fq; float* ssw = (float*)ss; bf16_t* XO = (bf16_t*)xout;
#pragma unroll
        for (int ai = 0; ai < 2; ++ai)
#pragma unroll
            for (int m = 0; m < 4; ++m) { const int row = row0 + ai * HALF + m * 16; const size_t off = (size_t)row * 1024 + col0; float s = 0.f;
#pragma unroll
                for (int bj = 0; bj < 2; ++bj)
#pragma unroll
                    for (int n = 0; n < 2; ++n) { f32x4 o;
                        if (F32IN) o = *(const f32x4*)(xin + off + bj * HALF + n * 16);
                        else { const u32x2 xw = *(const u32x2*)(O + off + bj * HALF + n * 16); o = (f32x4){__uint_as_float(xw.x << 16), __uint_as_float(xw.x & 0xffff0000u), __uint_as_float(xw.y << 16), __uint_as_float(xw.y & 0xffff0000u)}; }
                        o = o + acc[ai][bj][m][n];
                        u32x2 w; w.x = cvt_pk_bf16(o[0], o[1]); w.y = cvt_pk_bf16(o[2], o[3]); *(u32x2*)(XO + off + bj * HALF + n * 16) = w;
                        const float r0 = __uint_as_float(w.x << 16), r1 = __uint_as_float(w.x & 0xffff0000u), r2 = __uint_as_float(w.y << 16), r3 = __uint_as_float(w.y & 0xffff0000u);
                        s += (r0 * r0 + r1 * r1) + (r2 * r2 + r3 * r3); }
                s += shx(s, 16, fq * 16 + fr); s += shx(s, 32, fq * 16 + fr);
                if (fq == 0) ssw[(size_t)(u.pn * 4 + wc) * M + row] = s; }
    }
    __device__ __forceinline__ void body_kv(const f32x4 (&acc)[2][2][4][2], const Unit& u, int wr, int wc, int fr, int fq) const {
        const int row0 = u.pm * BM + wr * 64 + fr, layer = u.pn >> 2, cl0 = (u.pn & 3) * BM + wc * 32 + 4 * fq; bf16_t* VMT = (bf16_t*)xout;
#pragma unroll
        for (int ai = 0; ai < 2; ++ai)
#pragma unroll
            for (int m = 0; m < 4; ++m) { const int row = row0 + ai * HALF + m * 16; const float rstd = rsqrtf(ss[row] * (1.0f / 1024.0f) + 1e-6f);
#pragma unroll
                for (int bj = 0; bj < 2; ++bj)
#pragma unroll
                    for (int n = 0; n < 2; ++n) { const f32x4 o = acc[ai][bj][m][n] * rstd; const int cl = cl0 + bj * HALF + n * 16;
                        if (cl < 512) { u32x2 w; w.x = cvt_pk_bf16(o[0], o[1]); w.y = cvt_pk_bf16(o[2], o[3]); *(u32x2*)(O + ((size_t)layer * 1024 + row) * 512 + cl) = w; }
                        else { const unsigned lo = cvt_pk_bf16(o[0], o[1]), hi = cvt_pk_bf16(o[2], o[3]); bf16_t* d = VMT + ((size_t)(layer * 4 + (row >> 8)) * 512 + (cl - 512)) * 256 + (row & 255);
                            d[0] = (bf16_t)(lo & 0xffff); d[256] = (bf16_t)(lo >> 16); d[512] = (bf16_t)(hi & 0xffff); d[768] = (bf16_t)(hi >> 16); } } }
    }
    __device__ __forceinline__ void operator()(const f32x4 (&acc)[2][2][4][2], const Unit& u, int wr, int wc, int fr, int fq) const {
        if (kind == 0) {
            int mode;
            if (!hgrn) mode = (u.pn >= 4 && u.pn < 6) ? 2 : ((u.pn >= 6 && u.pn < 10) ? 1 : 0);
            else mode = u.pn < 4 ? 4 : (u.pn < 8 ? 3 : (u.pn < 12 ? 1 : 0));
            if (mode == 0) body_proj<0>(acc, u, wr, wc, fr, fq); else if (mode == 1) body_proj<1>(acc, u, wr, wc, fr, fq); else if (mode == 2) body_proj<2>(acc, u, wr, wc, fr, fq);
            else if (mode == 3) body_proj<3>(acc, u, wr, wc, fr, fq); else body_proj<4>(acc, u, wr, wc, fr, fq);
        } else if (kind == 1) body_proj<5>(acc, u, wr, wc, fr, fq);
        else if (kind == 2) { if (xin) body_res<true>(acc, u, wr, wc, fr, fq); else body_res<false>(acc, u, wr, wc, fr, fq); }
        else body_kv(acc, u, wr, wc, fr, fq);
    }
};

template <class Epi, class Sched, bool ALIGN_EPI = false, bool SP2 = false>
__device__ __forceinline__ void gemm_phase(PG8_LAS unsigned char* lds, const Gemm g, const Sched& S, const Epi& E, const int tid) {
    const int wid = __builtin_amdgcn_readfirstlane(tid >> 6), lane = tid & 63, wr = wid >> 2, wc = wid & 3, fr = lane & 15, fq = lane >> 4;
    const int K = g.K, nt = K / BK;
    unsigned voffA[2], voffB[2];
#pragma unroll
    for (int i = 0; i < 2; ++i) { int R, C; stage_rc(tid * 16 + i * 8192, R, C); const int Rb = g.perm ? ((R & ~31) + perm32(R & 31)) : R;
        voffA[i] = (unsigned)(R * g.lda + C) * 2u; voffB[i] = (unsigned)(Rb * K + C) * 2u; }
    const size_t kstep = (size_t)(BK * 2);
    const size_t hstepA = (size_t)HALF * g.lda * 2, hstepB = (size_t)HALF * K * 2;
    const size_t tstepA = 2 * hstepA, tstepB = 2 * hstepB;
    const unsigned ldsw = (unsigned)wid * 1024u;
    const int aoff = lds_byte(wr * 64 + fr, fq * 8), boff = lds_byte(wc * 32 + fr, fq * 8);
#define PG8_SA(b, h) (((b) * 2 + (h)) * HTB)
#define PG8_SB(b, h) ((4 + (b) * 2 + (h)) * HTB)
#define PG8_STAGE(bufoff, gbase, voff) do { _Pragma("unroll") for (int _i = 0; _i < 2; ++_i) \
        __builtin_amdgcn_global_load_lds((const unsigned*)((const char*)(gbase) + (voff)[_i]), (PG8_LAS unsigned*)(lds + (bufoff) + ldsw + _i * 8192), 16, 0, 0); } while (0)
#define PG8_LDA(dst, b, h) do { _Pragma("unroll") for (int m = 0; m < 4; ++m) _Pragma("unroll") for (int k = 0; k < 2; ++k) dst[m][k] = *(const PG8_LAS bf16x8*)(lds + PG8_SA(b, h) + aoff + m * 2048 + k * 1024); } while (0)
#define PG8_LDB(dst, b, h) do { _Pragma("unroll") for (int n = 0; n < 2; ++n) _Pragma("unroll") for (int k = 0; k < 2; ++k) dst[n][k] = *(const PG8_LAS bf16x8*)(lds + PG8_SB(b, h) + boff + n * 2048 + k * 1024); } while (0)
#define PG8_MMA(ai, bj, At, Bt) do { __builtin_amdgcn_s_setprio(1); _Pragma("unroll") for (int m = 0; m < 4; ++m) _Pragma("unroll") for (int n = 0; n < 2; ++n) _Pragma("unroll") for (int k = 0; k < 2; ++k) \
        acc[ai][bj][m][n] = __builtin_amdgcn_mfma_f32_16x16x32_bf16(Bt[n][k], At[m][k], acc[ai][bj][m][n], 0, 0, 0); __builtin_amdgcn_s_setprio(0); } while (0)
#define PG8_WAIT_V(n) asm volatile("s_waitcnt vmcnt(" #n ")" ::: "memory")
#define PG8_WAIT_L(n) asm volatile("s_waitcnt lgkmcnt(" #n ")" ::: "memory")
#define PG8_BAR __builtin_amdgcn_s_barrier()
#define PG8_SCHED __builtin_amdgcn_sched_barrier(0)
    Unit cur, nxt; int ui = 0;
    if (!S.next(0, cur)) return;
    f32x4 acc[2][2][4][2];
#pragma unroll
    for (int a = 0; a < 2; ++a)
#pragma unroll
        for (int b = 0; b < 2; ++b)
#pragma unroll
            for (int m = 0; m < 4; ++m)
#pragma unroll
                for (int n = 0; n < 2; ++n) acc[a][b][m][n] = (f32x4){0.f, 0.f, 0.f, 0.f};
    bf16x8 At[4][2], B0[2][2], B1[2][2];
    const char* cA = (const char*)g.A + (size_t)cur.pm * tstepA; const char* cB = (const char*)g.Bt + (size_t)cur.pn * tstepB;
    S.a_ready(cur);
    if constexpr (SP2) {
        PG8_STAGE(PG8_SB(0, 0), cB, voffB); PG8_STAGE(PG8_SB(0, 1), cB + hstepB, voffB); PG8_STAGE(PG8_SA(0, 0), cA, voffA); PG8_STAGE(PG8_SA(0, 1), cA + hstepA, voffA);
        if (wr == 1) PG8_BAR;
        PG8_WAIT_V(2); PG8_BAR;
        PG8_STAGE(PG8_SB(1, 0), cB + kstep, voffB); PG8_STAGE(PG8_SA(1, 0), cA + kstep, voffA); PG8_STAGE(PG8_SB(1, 1), cB + hstepB + kstep, voffB);
        PG8_WAIT_V(6); PG8_BAR;
    } else {
        PG8_STAGE(PG8_SB(0, 0), cB, voffB); PG8_STAGE(PG8_SA(0, 0), cA, voffA); PG8_STAGE(PG8_SB(0, 1), cB + hstepB, voffB); PG8_STAGE(PG8_SA(0, 1), cA + hstepA, voffA);
        if (wr == 1) PG8_BAR;
        PG8_WAIT_V(4); PG8_BAR;
        PG8_STAGE(PG8_SB(1, 0), cB + kstep, voffB); PG8_STAGE(PG8_SA(1, 0), cA + kstep, voffA); PG8_STAGE(PG8_SB(1, 1), cB + hstepB + kstep, voffB);
        PG8_WAIT_V(6); PG8_BAR;
    }
    for (;;) {
        const bool has_next = S.next(ui + 1, nxt);
        const char* nA = has_next ? (const char*)g.A + (size_t)nxt.pm * tstepA : cA; const char* nB = has_next ? (const char*)g.Bt + (size_t)nxt.pn * tstepB : cB;
        for (int t = 0; t < nt; t += 2) {
            const bool last = (t == nt - 2);
            const char* a1 = cA + (size_t)(t + 1) * kstep;
            const char* a2 = last ? nA : cA + (size_t)(t + 2) * kstep; const char* b2 = last ? nB : cB + (size_t)(t + 2) * kstep;
            const char* a3 = a2 + kstep; const char* b3 = b2 + kstep;
            if (last && has_next) S.a_ready(nxt);
            if constexpr (SP2) {
            PG8_LDB(B0, 0, 0); PG8_LDB(B1, 0, 1); PG8_SCHED; PG8_LDA(At, 0, 0); PG8_STAGE(PG8_SA(1, 1), a1 + hstepA, voffA);
            PG8_WAIT_V(8); PG8_WAIT_L(0); PG8_BAR; PG8_MMA(0, 0, At, B0); PG8_MMA(0, 1, At, B1); PG8_BAR; PG8_SCHED;
            PG8_LDA(At, 0, 1); PG8_STAGE(PG8_SB(0, 0), b2, voffB); PG8_STAGE(PG8_SB(0, 1), b2 + hstepB, voffB); PG8_STAGE(PG8_SA(0, 0), a2, voffA);
            PG8_WAIT_V(8); PG8_WAIT_L(0); PG8_BAR; PG8_MMA(1, 0, At, B0); PG8_MMA(1, 1, At, B1); PG8_BAR; PG8_SCHED;
            PG8_LDB(B0, 1, 0); PG8_LDB(B1, 1, 1); PG8_SCHED; PG8_LDA(At, 1, 0); PG8_STAGE(PG8_SA(0, 1), a2 + hstepA, voffA);
            PG8_WAIT_V(8); PG8_WAIT_L(0); PG8_BAR; PG8_MMA(0, 0, At, B0); PG8_MMA(0, 1, At, B1); PG8_BAR; PG8_SCHED;
            PG8_LDA(At, 1, 1); PG8_STAGE(PG8_SB(1, 0), b3, voffB); PG8_STAGE(PG8_SB(1, 1), b3 + hstepB, voffB); PG8_STAGE(PG8_SA(1, 0), a3, voffA);
            PG8_WAIT_V(8); PG8_WAIT_L(0); PG8_BAR; PG8_MMA(1, 0, At, B0); PG8_MMA(1, 1, At, B1); PG8_BAR; PG8_SCHED;
            } else {
            PG8_LDB(B0, 0, 0); PG8_SCHED; PG8_LDA(At, 0, 0); PG8_STAGE(PG8_SA(1, 1), a1 + hstepA, voffA);
            PG8_WAIT_L(8); PG8_BAR; PG8_WAIT_L(0); PG8_MMA(0, 0, At, B0); PG8_BAR; PG8_SCHED;
            PG8_LDB(B1, 0, 1); PG8_STAGE(PG8_SB(0, 0), b2, voffB);
            PG8_BAR; PG8_WAIT_L(0); PG8_MMA(0, 1, At, B1); PG8_BAR;
            PG8_LDA(At, 0, 1); PG8_STAGE(PG8_SA(0, 0), a2, voffA);
            PG8_BAR; PG8_WAIT_L(0); PG8_MMA(1, 0, At, B0); PG8_BAR; PG8_SCHED;
            PG8_STAGE(PG8_SB(0, 1), b2 + hstepB, voffB);
            PG8_WAIT_V(6); PG8_BAR; PG8_MMA(1, 1, At, B1); PG8_BAR;
            PG8_LDB(B0, 1, 0); PG8_SCHED; PG8_LDA(At, 1, 0); PG8_STAGE(PG8_SA(0, 1), a2 + hstepA, voffA);
            PG8_WAIT_L(8); PG8_BAR; PG8_WAIT_L(0); PG8_MMA(0, 0, At, B0); PG8_BAR; PG8_SCHED;
            PG8_LDB(B1, 1, 1); PG8_STAGE(PG8_SB(1, 0), b3, voffB);
            PG8_BAR; PG8_WAIT_L(0); PG8_MMA(0, 1, At, B1); PG8_BAR;
            PG8_LDA(At, 1, 1); PG8_STAGE(PG8_SA(1, 0), a3, voffA);
            PG8_BAR; PG8_WAIT_L(0); PG8_MMA(1, 0, At, B0); PG8_BAR; PG8_SCHED;
            PG8_STAGE(PG8_SB(1, 1), b3 + hstepB, voffB);
            PG8_WAIT_V(6); PG8_BAR; PG8_MMA(1, 1, At, B1); PG8_BAR;
            }
        }
        if constexpr (ALIGN_EPI) { if (wr == 0) PG8_BAR; }
        if constexpr (!Epi::AFTER_DRAIN) { E(acc, cur, wr, wc, fr, fq); S.done(cur); }
        if (!has_next) break;
#pragma unroll
        for (int a = 0; a < 2; ++a)
#pragma unroll
            for (int b = 0; b < 2; ++b)
#pragma unroll
                for (int m = 0; m < 4; ++m)
#pragma unroll
                    for (int n = 0; n < 2; ++n) acc[a][b][m][n] = (f32x4){0.f, 0.f, 0.f, 0.f};
        cur = nxt; cA = nA; cB = nB; ++ui;
        if constexpr (ALIGN_EPI) { if (wr == 1) PG8_BAR; }
    }
    PG8_WAIT_V(0);
    if constexpr (!ALIGN_EPI) { if (wr == 0) PG8_BAR; }
    PG8_BAR;
    if constexpr (Epi::AFTER_DRAIN) { E.fused(acc, cur, wr, wc, fr, fq, lds, wid, lane); S.done(cur); }
#undef PG8_SA
#undef PG8_SB
#undef PG8_STAGE
#undef PG8_LDA
#undef PG8_LDB
#undef PG8_MMA
#undef PG8_WAIT_V
#undef PG8_WAIT_L
#undef PG8_BAR
#undef PG8_SCHED
}
}

constexpr int NWAVES = 8, NT = 512;
constexpr int D = 1024, BATCH = 4, T = 8192, M = BATCH * T, DEPTH = 4, MEM = 256, MROWS = BATCH * MEM;
constexpr int DK = 128, CH = 64, NCH = T / CH;
constexpr int GLA_N = 4096, HGRN_N = 4608, FF = 4096, KOUT = 1536;
constexpr float EPS = 1e-6f;
constexpr size_t MiB = 1u << 20;
constexpr size_t WS_SS = 0;
constexpr size_t WS_DEC = 2 * MiB;
constexpr size_t WS_MEMB = 4 * MiB;
constexpr size_t WS_SSM = 6 * MiB;
constexpr size_t WS_LB = 6 * MiB + 65536;
constexpr size_t WS_KM = 8 * MiB;
constexpr size_t WS_VMT = 12 * MiB;
constexpr size_t WS_WKV = 16 * MiB;
constexpr size_t WS_WT = 24 * MiB, WT_BUF = 30 * MiB;
constexpr size_t WT_IN = 0, WT_OUT = 10 * MiB, WT_UP = 14 * MiB, WT_DOWN = 22 * MiB;
constexpr size_t WS_PROJ = 84 * MiB;
constexpr size_t WS_XB = 372 * MiB;
constexpr size_t WS_END = 500 * MiB;
constexpr int LDS_BYTES = 147456;

#define LAS __attribute__((address_space(3)))
typedef unsigned short bf16;
typedef float f32x4 __attribute__((ext_vector_type(4)));
typedef short bf16x8 __attribute__((ext_vector_type(8)));
typedef short bf16x4 __attribute__((ext_vector_type(4)));
typedef unsigned u32x4 __attribute__((ext_vector_type(4)));
typedef unsigned u32x2 __attribute__((ext_vector_type(2)));
__device__ __forceinline__ float bf2f(bf16 b) { return __uint_as_float(((unsigned)b) << 16); }
__device__ __forceinline__ unsigned f2bf(float f) { unsigned u = __float_as_uint(f); return (u + 0x7fffu + ((u >> 16) & 1u)) >> 16; }
__device__ __forceinline__ unsigned pk2(float lo, float hi) { return pg8::cvt_pk_bf16(lo, hi); }
__device__ __forceinline__ float wave_sum(float v, int lane) {
#pragma unroll
    for (int o = 1; o < 64; o <<= 1) v += pg8::shx(v, o, lane);
    return v;
}
#define MFMA16(a, b, c) __builtin_amdgcn_mfma_f32_16x16x32_bf16((a), (b), (c), 0, 0, 0)

constexpr size_t WS_CTL = 7 * MiB, CTL_BYTES = 16384;
constexpr int LDS_BARST = LDS_BYTES - 64;
#define XB_TMO      128
#define XB_XCNT(j)  (256  + 64 * (j))
#define XB_XSUB(j)  (1280 + 64 * (j))
#define XB_XGEN(j)  (2304 + 64 * (j))
#define XB_TOP      3328
#define XB_TOPGEN   3392
#define XCD_BAR_WORDS 3456
#define XB_SPIN_CAP (1u << 18)

__device__ __forceinline__ unsigned xb_ld(unsigned* p)              { return __hip_atomic_load(p, __ATOMIC_RELAXED, __HIP_MEMORY_SCOPE_AGENT); }
__device__ __forceinline__ unsigned xb_add(unsigned* p, unsigned v) { return __hip_atomic_fetch_add(p, v, __ATOMIC_RELAXED, __HIP_MEMORY_SCOPE_AGENT); }
__device__ __forceinline__ unsigned xb_xcc_id() { return (unsigned)__builtin_amdgcn_s_getreg((3 << 11) | 20) & 0xFu; }
#define XB_SPIN(cond, bar) do { unsigned _sp = 0; while (cond) { __builtin_amdgcn_s_sleep(1); \
    if ((++_sp & 255u) == 0u) { if (xb_ld(&(bar)[XB_TMO])) break; if (_sp > XB_SPIN_CAP) { atomicAdd(&(bar)[XB_TMO], 1u); break; } } } } while (0)

struct XcdBarrier {
    unsigned* bar; unsigned x;
    volatile LAS unsigned* st;
};

__device__ __forceinline__ XcdBarrier xcd_barrier_post(unsigned* bar, volatile LAS unsigned* st, int tid) {
    XcdBarrier b; b.bar = bar; b.x = xb_xcc_id(); b.st = st;
    if (tid == 0) (void)xb_add(&bar[XB_XCNT(b.x)], 1u);
    return b;
}
__device__ __forceinline__ void xcd_barrier_complete(unsigned* bar, unsigned x, unsigned& nloc, unsigned& nx) {
    const unsigned G = gridDim.x * gridDim.y * gridDim.z;
    unsigned sum, cnt, mine, sp = 0u;
    for (;;) {
        sum = 0u; cnt = 0u; mine = 0u;
#pragma unroll
        for (unsigned j = 0; j < 16; ++j) { const unsigned c = xb_ld(&bar[XB_XCNT(j)]); sum += c; cnt += (c > 0u) ? 1u : 0u; mine = (j == x) ? c : mine; }
        if (sum == G) break;
        __builtin_amdgcn_s_sleep(1);
        if ((++sp & 255u) == 0u) { if (xb_ld(&bar[XB_TMO])) break; if (sp > XB_SPIN_CAP) { atomicAdd(&bar[XB_TMO], 1u); break; } }
    }
    nloc = mine > 0u ? mine : 1u; nx = cnt > 0u ? cnt : 1u;
}

__device__ __forceinline__ void xcd_barrier(const XcdBarrier& b, int tid) {
    asm volatile("s_waitcnt vmcnt(0)" ::: "memory");
    __syncthreads();
    if (tid == 0) {
        unsigned* bar = b.bar;
        __builtin_amdgcn_s_waitcnt(0);
        unsigned nloc = b.st[0], nx = b.st[1];
        if (nloc == 0u) { xcd_barrier_complete(bar, b.x, nloc, nx); b.st[0] = nloc; b.st[1] = nx; }
        const unsigned old = xb_add(&bar[XB_XSUB(b.x)], 1u);
        const unsigned gen = old / nloc;
        if (old + 1u == (gen + 1u) * nloc) {
            __builtin_amdgcn_fence(__ATOMIC_RELEASE, "agent");
            asm volatile("s_waitcnt vmcnt(0)" ::: "memory");
            const unsigned og = xb_add(&bar[XB_TOP], 1u);
            const unsigned tg = og / nx;
            if (og + 1u == (tg + 1u) * nx) xb_add(&bar[XB_TOPGEN], 1u);
            else XB_SPIN(xb_ld(&bar[XB_TOPGEN]) == tg, bar);
            __builtin_amdgcn_fence(__ATOMIC_ACQUIRE, "agent");
            xb_add(&bar[XB_XGEN(b.x)], 1u);
            asm volatile("s_waitcnt vmcnt(0)" ::: "memory");
        } else {
            XB_SPIN(xb_ld(&bar[XB_XGEN(b.x)]) == gen, bar);
            __builtin_amdgcn_fence(__ATOMIC_ACQUIRE, "agent");
            asm volatile("s_waitcnt vmcnt(0)" ::: "memory");
        }
    }
    __syncthreads();
}

__device__ __forceinline__ void transpose_item(const float* W, int ldw, int K, int sc, bf16* WT, int dr, const float* gain, int gmask, int glimit, float scale, LAS float* scr, int item, int nblk, int lane) {
    const int kb = item / nblk, nb = item % nblk, k0 = 64 * kb, n0 = 32 * nb;
#pragma unroll 8
    for (int i = 0; i < 32; ++i) { const int kk = 2 * i + (lane >> 5); const int k = k0 + kk; float g = scale; if (gain && k < glimit) g *= gain[k & gmask];
        scr[kk * 33 + (lane & 31)] = W[(size_t)k * ldw + sc + n0 + (lane & 31)] * g; }
    asm volatile("s_waitcnt lgkmcnt(0)" ::: "memory");
    const int c = lane & 7;
#pragma unroll
    for (int j = 0; j < 4; ++j) { const int n = (lane >> 3) + 8 * j; const LAS float* s = scr + (8 * c) * 33 + n;
        u32x4 o; o.x = pk2(s[0 * 33], s[1 * 33]); o.y = pk2(s[2 * 33], s[3 * 33]); o.z = pk2(s[4 * 33], s[5 * 33]); o.w = pk2(s[6 * 33], s[7 * 33]);
        *(u32x4*)(WT + (size_t)(dr + n0 + n) * K + k0 + 8 * c) = o; }
    asm volatile("s_waitcnt lgkmcnt(0)" ::: "memory");
}
struct Ptrs {
    const float *x, *mem, *norm_mix, *norm_mem, *w_kv, *w_out, *norm_mlp, *w_up, *w_down, *gla_w_in, *gla_w_gate2, *gla_b_gate, *gla_out_gain, *hgrn_w_in, *hgrn_lb, *hgrn_out_gain, *final_norm;
    float* out; unsigned char* ws;
};
#define SEG(Wp, ldw, K, sc, ncols, WTp, dr, gain, gmask, glimit, scale) { const int nblk_ = (ncols) / 32, nit_ = ((K) / 64) * nblk_; \
    if (r < nit_) { transpose_item(Wp, ldw, K, sc, WTp, dr, gain, gmask, glimit, scale, scr, r, nblk_, lane); continue; } r -= nit_; }
template <class PT> __device__ __forceinline__ void convert_layer(PT Pp, int L, LAS unsigned char* lds, int gw, int ngw, int wave, int lane) {
    LAS float* scr = (LAS float*)(lds + wave * 16384);
    unsigned char* wb = Pp->ws + WS_WT + (size_t)(L & 1) * WT_BUF;
    bf16* Win = (bf16*)(wb + WT_IN); bf16* Wout = (bf16*)(wb + WT_OUT); bf16* Wup = (bf16*)(wb + WT_UP); bf16* Wdn = (bf16*)(wb + WT_DOWN);
    const int j = L >> 1; const bool hg = (L & 1);
    const float* gmix = Pp->norm_mix + (size_t)L * D; const float* gmlp = Pp->norm_mlp + (size_t)L * D;
    const float* wo = Pp->w_out + (size_t)L * KOUT * D; const float* wu = Pp->w_up + (size_t)L * D * FF; const float* wd = Pp->w_down + (size_t)L * FF * D;
    const float QS = 0.08838834764831845f;
    if (!hg) {
        const float* wi = Pp->gla_w_in + (size_t)j * D * 3600; const float* og = Pp->gla_out_gain + (size_t)j * 256;
        const int total = 16 * (16 + 16 + 32 + 32 + 16) + 24 * 32 + 16 * 128 + 64 * 32 + 128;
        for (int it = gw; it < total; it += ngw) { int r = it;
            SEG(wi, 3600, D, 0, 512, Win, 0, gmix, 1023, D, QS)
            SEG(wi, 3600, D, 512, 512, Win, 512, gmix, 1023, D, 1.f)
            SEG(wi, 3600, D, 1024, 1024, Win, 2560, gmix, 1023, D, 1.f)
            SEG(wi, 3600, D, 2064, 1024, Win, 1536, gmix, 1023, D, 1.f)
            SEG(wi, 3600, D, 3088, 512, Win, 3584, gmix, 1023, D, QS)
            SEG(wo, D, KOUT, 0, 1024, Wout, 0, og, 255, 1024, 1.f)
            SEG(wu, FF, D, 0, 4096, Wup, 0, gmlp, 1023, D, 1.f)
            SEG(wd, D, FF, 0, 1024, Wdn, 0, (const float*)nullptr, 0, 0, 1.f)
            { const int kb = r >> 3, cb = r & 7, k = kb * 64 + lane; const float* g2 = Pp->gla_w_gate2 + (size_t)j * 16 * 512 + cb * 64;
              const f32x4* wr4 = (const f32x4*)(wi + (size_t)k * 3600 + 2048); const f32x4 w0 = wr4[0], w1 = wr4[1], w2 = wr4[2], w3 = wr4[3]; const float gk = gmix[k];
              for (int c = 0; c < 64; ++c) { float s = 0.f;
#pragma unroll
                  for (int q = 0; q < 4; ++q) { s += w0[q] * g2[q * 512 + c]; s += w1[q] * g2[(4 + q) * 512 + c]; s += w2[q] * g2[(8 + q) * 512 + c]; s += w3[q] * g2[(12 + q) * 512 + c]; }
                  Win[(size_t)(1024 + cb * 64 + c) * D + k] = (bf16)f2bf(s * gk); } }
        }
    } else {
        const float* wi = Pp->hgrn_w_in + (size_t)j * D * 4608; const float* og = Pp->hgrn_out_gain + (size_t)j * 128;
        const int total = 16 * (32 + 32 + 32 + 32 + 16) + 24 * 32 + 16 * 128 + 64 * 32;
        for (int it = gw; it < total; it += ngw) { int r = it;
            SEG(wi, 4608, D, 0, 1024, Win, 0, gmix, 1023, D, 1.f)
            SEG(wi, 4608, D, 1024, 1024, Win, 1024, gmix, 1023, D, 1.f)
            SEG(wi, 4608, D, 2048, 1024, Win, 3072, gmix, 1023, D, 1.f)
            SEG(wi, 4608, D, 3072, 1024, Win, 2048, gmix, 1023, D, 1.f)
            SEG(wi, 4608, D, 4096, 512, Win, 4096, gmix, 1023, D, QS)
            SEG(wo, D, KOUT, 0, 1024, Wout, 0, og, 127, 1024, 1.f)
            SEG(wu, FF, D, 0, 4096, Wup, 0, gmlp, 1023, D, 1.f)
            { const int nblk_ = 32; transpose_item(wd, D, FF, 0, Wdn, 0, (const float*)nullptr, 0, 0, 1.f, scr, r, nblk_, lane); }
        }
    }
}
template <class PT> __device__ __forceinline__ void prologue(PT Pp, LAS unsigned char* lds, int gw, int ngw, int wave, int lane) {
    convert_layer(Pp, 0, lds, gw, ngw, wave, lane);
    { LAS float* scr = (LAS float*)(lds + wave * 16384); bf16* Wkv = (bf16*)(Pp->ws + WS_WKV);
      const int per = 16 * 32, total = 4 * per;
      for (int it = gw; it < total; it += ngw) { const int L = it / per, r = it % per;
          transpose_item(Pp->w_kv + (size_t)L * D * 1024, 1024, D, 0, Wkv + (size_t)L * 1024 * D, 0, Pp->norm_mem + (size_t)L * D, 1023, D, 1.f, scr, r, 32, lane); } }
    { float* LB = (float*)(Pp->ws + WS_LB);
      for (int c = gw * 64 + lane; c < 1024; c += ngw * 64) { const float v0 = Pp->hgrn_lb[c], v1 = Pp->hgrn_lb[1024 + c], v2 = Pp->hgrn_lb[2048 + c], v3 = Pp->hgrn_lb[3072 + c];
          const float mx = fmaxf(fmaxf(v0, v1), fmaxf(v2, v3)); const float e0 = expf(v0 - mx), e1 = expf(v1 - mx), e2 = expf(v2 - mx), e3 = expf(v3 - mx); const float inv = 1.0f / (e0 + e1 + e2 + e3);
          LB[c] = 0.f; LB[1024 + c] = e1 * inv; LB[2048 + c] = (e1 + e2) * inv; LB[3072 + c] = (e1 + e2 + e3) * inv; } }
    bf16* XB = (bf16*)Pp->out; float* SS = (float*)(Pp->ws + WS_SS);     bf16* MB = (bf16*)(Pp->ws + WS_MEMB); float* SSM = (float*)(Pp->ws + WS_SSM);
    for (int m = gw; m < M + MROWS; m += ngw) {
        const bool ism = m >= M; const int row = ism ? m - M : m;
        const f32x4* xr = (const f32x4*)((ism ? Pp->mem : Pp->x) + (size_t)row * D) + lane; unsigned long long* o8 = (unsigned long long*)((ism ? MB : XB) + (size_t)row * D) + lane;
        float s = 0.f;
#pragma unroll
        for (int j = 0; j < 4; ++j) { const f32x4 v = xr[64 * j]; s += (v.x * v.x + v.y * v.y) + (v.z * v.z + v.w * v.w); o8[64 * j] = (unsigned long long)pk2(v.x, v.y) | ((unsigned long long)pk2(v.z, v.w) << 32); }
        s = wave_sum(s, lane);
        if (ism) { if (lane == 0) SSM[row] = s; }
        else if (lane < 16) SS[(size_t)lane * M + row] = lane == 0 ? s : 0.f;
    }
}
constexpr int KT_STR = 144;
constexpr int QS_STR = 272;
constexpr int VS_STR = 528;
constexpr int L_TOT = 0;
constexpr int L_LA = 2048;
constexpr int L_QS = L_LA + 64 * QS_STR;
constexpr int L_KS = L_QS + 64 * QS_STR;
constexpr int L_VS = L_KS + 64 * QS_STR;
constexpr int L_VT = L_VS + 64 * VS_STR;
constexpr int L_KT = L_VT + 256 * KT_STR;
constexpr int L_AT = L_KT;
constexpr int L_RED = L_KT + 128 * KT_STR;
static_assert(L_RED + 2048 <= LDS_BYTES - 64, "mixer LDS map");

template <int DV>
__device__ __forceinline__ void load_raw_v(const bf16* base, int ld, int vcol, int tid, u32x4 (&rv)[DV / 64]) {
#pragma unroll
    for (int i = 0; i < DV / 64; ++i) { const int c = tid + i * NT, row = c / (DV / 8), part = c % (DV / 8); rv[i] = *(const u32x4*)(base + (size_t)row * ld + vcol + part * 8); }
}
template <int DV>
__device__ __forceinline__ void store_raw_v(LAS unsigned char* lds, int tid, const u32x4 (&rv)[DV / 64]) {
#pragma unroll
    for (int i = 0; i < DV / 64; ++i) { const int c = tid + i * NT, row = c / (DV / 8), part = c % (DV / 8); *(LAS u32x4*)(lds + L_VS + row * VS_STR + part * 16) = rv[i]; }
}
__device__ __forceinline__ void load_raw128(const bf16* base, int ld, int col, int tid, u32x4 (&r)[2]) {
#pragma unroll
    for (int i = 0; i < 2; ++i) { const int c = tid + i * NT; r[i] = *(const u32x4*)(base + (size_t)(c >> 4) * ld + col + (c & 15) * 8); }
}
__device__ __forceinline__ void store_raw128(LAS unsigned char* lds, int off, int tid, const u32x4 (&r)[2]) {
#pragma unroll
    for (int i = 0; i < 2; ++i) { const int c = tid + i * NT; *(LAS u32x4*)(lds + off + (c >> 4) * QS_STR + (c & 15) * 16) = r[i]; }
}
template <int DV>
__device__ __forceinline__ void transpose_v(LAS unsigned char* lds, int tid) {
    constexpr int RPT = DV / 8;
    const int v = tid % DV, part = tid / DV;
    unsigned w[RPT / 2];
#pragma unroll
    for (int i = 0; i < RPT / 2; ++i) { const unsigned lo = *(const LAS bf16*)(lds + L_VS + (part * RPT + 2 * i) * VS_STR + v * 2), hi = *(const LAS bf16*)(lds + L_VS + (part * RPT + 2 * i + 1) * VS_STR + v * 2); w[i] = lo | (hi << 16); }
    LAS u32x4* dst = (LAS u32x4*)(lds + L_VT + v * KT_STR + part * RPT * 2);
#pragma unroll
    for (int i = 0; i < RPT / 8; ++i) dst[i] = (u32x4){w[4 * i], w[4 * i + 1], w[4 * i + 2], w[4 * i + 3]};
}
__device__ __forceinline__ void cumsum_local(LAS unsigned char* lds, int d, int rg, float (&bb)[16]) {
#pragma unroll
    for (int i = 0; i < 16; ++i) bb[i] = bf2f(*(const LAS bf16*)(lds + L_LA + (rg * 16 + i) * QS_STR + d * 2));
}
__device__ __forceinline__ void cumsum_scan(LAS unsigned char* lds, int d, int rg, float (&bb)[16]) {
#pragma unroll
    for (int i = 1; i < 16; ++i) bb[i] += bb[i - 1];
    ((LAS float*)(lds + L_TOT))[rg * 128 + d] = bb[15];
}
__device__ __forceinline__ void cumsum_finish(LAS unsigned char* lds, int d, int rg, float (&bb)[16], float& blast) {
    const LAS float* tot = (const LAS float*)(lds + L_TOT);
    const float t0 = tot[d], t1 = tot[128 + d], t2 = tot[256 + d], t3 = tot[384 + d];
    const float off = rg == 0 ? 0.f : (rg == 1 ? t0 : (rg == 2 ? t0 + t1 : t0 + t1 + t2));
    blast = (t0 + t1) + (t2 + t3);
#pragma unroll
    for (int i = 0; i < 16; ++i) bb[i] += off;
}
template <int DV, bool HGRN>
__device__ __forceinline__ void pass_a(LAS unsigned char* lds, const bf16* proj, bf16* GS, float* DEC, int G, int bid, const int tid) {
    constexpr int H = HGRN ? 8 : 4, LD = HGRN ? HGRN_N : GLA_N, NTW = DV / 128, NU = BATCH * H * NCH;
    const int lane = tid & 63, wave = tid >> 6, g = lane >> 4, l15 = lane & 15, d = tid & 127, rg = tid >> 7;
    u32x4 rla[2], rk[2], rv[DV / 64];
    int u = bid;
    if (u < NU) { const int b = u / (H * NCH), h = (u / NCH) % H, n = u % NCH; const bf16* base = proj + (size_t)(b * T + n * CH) * LD;
        load_raw128(base, LD, 1024 + h * 128, tid, rla); if (!HGRN) load_raw128(base, LD, 512 + h * 128, tid, rk); load_raw_v<DV>(base, LD, (HGRN ? 3072 : 2560) + h * DV, tid, rv); }
    for (; u < NU; u += G) {
        store_raw128(lds, L_LA, tid, rla); if (!HGRN) store_raw128(lds, L_KS, tid, rk); store_raw_v<DV>(lds, tid, rv);
        __syncthreads();
        { const int un = u + G; if (un < NU) { const int b = un / (H * NCH), h = (un / NCH) % H, n = un % NCH; const bf16* base = proj + (size_t)(b * T + n * CH) * LD;
            load_raw128(base, LD, 1024 + h * 128, tid, rla); if (!HGRN) load_raw128(base, LD, 512 + h * 128, tid, rk); load_raw_v<DV>(base, LD, (HGRN ? 3072 : 2560) + h * DV, tid, rv); } }
        float bb[16], kv[16], blast;
        cumsum_local(lds, d, rg, bb);
#pragma unroll
        for (int i = 0; i < 16; ++i) kv[i] = HGRN ? (1.0f - __expf(bb[i])) : bf2f(*(const LAS bf16*)(lds + L_KS + (rg * 16 + i) * QS_STR + d * 2));
        cumsum_scan(lds, d, rg, bb);
        transpose_v<DV>(lds, tid);
        __syncthreads();
        cumsum_finish(lds, d, rg, bb, blast);
        { unsigned w[8];
#pragma unroll
          for (int i = 0; i < 8; ++i) w[i] = pk2(kv[2 * i] * __expf(-bb[2 * i]), kv[2 * i + 1] * __expf(-bb[2 * i + 1]));
          LAS u32x4* dst = (LAS u32x4*)(lds + L_KT + d * KT_STR + rg * 32);
          dst[0] = (u32x4){w[0], w[1], w[2], w[3]}; dst[1] = (u32x4){w[4], w[5], w[6], w[7]}; }
        if (rg == 0) DEC[(size_t)u * 128 + d] = __expf(blast);
        __syncthreads();
        f32x4 acc[8][NTW];
#pragma unroll
        for (int mt = 0; mt < 8; ++mt)
#pragma unroll
            for (int nt = 0; nt < NTW; ++nt) acc[mt][nt] = (f32x4){0.f, 0.f, 0.f, 0.f};
#pragma unroll
        for (int kk = 0; kk < 2; ++kk) {
            bf16x8 bfr[NTW];
#pragma unroll
            for (int nt = 0; nt < NTW; ++nt) bfr[nt] = *(const LAS bf16x8*)(lds + L_VT + ((wave * NTW + nt) * 16 + l15) * KT_STR + (kk * 32 + 8 * g) * 2);
#pragma unroll
            for (int mt = 0; mt < 8; ++mt) { const bf16x8 afr = *(const LAS bf16x8*)(lds + L_KT + (mt * 16 + l15) * KT_STR + (kk * 32 + 8 * g) * 2);
#pragma unroll
                for (int nt = 0; nt < NTW; ++nt) acc[mt][nt] = MFMA16(afr, bfr[nt], acc[mt][nt]); }
        }
#pragma unroll
        for (int mt = 0; mt < 8; ++mt)
#pragma unroll
            for (int nt = 0; nt < NTW; ++nt) asm volatile("s_nop 7\n\ts_nop 7" : "+v"(acc[mt][nt]));
#pragma unroll
        for (int nt = 0; nt < NTW; ++nt) { bf16* gp = GS + ((size_t)u * DV + (wave * NTW + nt) * 16 + l15) * 128 + 4 * g;
#pragma unroll
            for (int mt = 0; mt < 8; ++mt) { u32x2 w; w.x = pk2(acc[mt][nt][0], acc[mt][nt][1]); w.y = pk2(acc[mt][nt][2], acc[mt][nt][3]); *(u32x2*)(gp + mt * 16) = w; } }
    }
    __syncthreads();
}
template <int DV, bool HGRN, bool DRY = false>
__device__ __forceinline__ void pass_b(bf16* GS, const float* DEC, int G, int bid, const int tid) {
    constexpr int H = HGRN ? 8 : 4, E = DV * 128, E4 = E / 4;
    const int nthreads = G * NT;
    for (int i = bid * NT + tid; i < BATCH * H * E4; i += nthreads) {
        const int bh = i / E4, e = (i % E4) * 4, d = e & 127;
        float S0 = 0.f, S1 = 0.f, S2 = 0.f, S3 = 0.f;
        u32x2* gp = (u32x2*)(GS + (size_t)bh * NCH * E + e); const f32x4* dp = (const f32x4*)(DEC + (size_t)bh * NCH * 128 + d);
        for (int n0 = 0; n0 < NCH; n0 += 8) {
            u32x2 gv[8]; f32x4 dv[8];
#pragma unroll
            for (int q = 0; q < 8; ++q) { gv[q] = gp[(size_t)(n0 + q) * (E / 4)]; dv[q] = dp[(size_t)(n0 + q) * 32]; }
#pragma unroll
            for (int q = 0; q < 8; ++q) {
                u32x2 o; o.x = pk2(S0, S1); o.y = pk2(S2, S3); if (!DRY || o.x == 0x12345678u) gp[(size_t)(n0 + q) * (E / 4)] = o;
                S0 = dv[q].x * (S0 + __uint_as_float(gv[q].x << 16)); S1 = dv[q].y * (S1 + __uint_as_float(gv[q].x & 0xffff0000u));
                S2 = dv[q].z * (S2 + __uint_as_float(gv[q].y << 16)); S3 = dv[q].w * (S3 + __uint_as_float(gv[q].y & 0xffff0000u)); }
        }
    }
}
template <int DV, bool HGRN, bool DRY = false>
__device__ __forceinline__ void pass_c(LAS unsigned char* lds, bf16* proj, const bf16* GS, int G, int bid, const int tid) {
    constexpr int H = HGRN ? 8 : 4, LD = HGRN ? HGRN_N : GLA_N, MTW = DV / 128, NU = BATCH * H * NCH;
    const int lane = tid & 63, wave = tid >> 6, g = lane >> 4, l15 = lane & 15, d = tid & 127, rg = tid >> 7;
    const int v0 = wave * MTW * 16;
    u32x4 rla[2], rq[2], rk[2], rv[DV / 64];
    int u = bid;
    if (u < NU) { const int b = u / (H * NCH), h = (u / NCH) % H, n = u % NCH; const bf16* base = proj + (size_t)(b * T + n * CH) * LD;
        load_raw128(base, LD, 1024 + h * 128, tid, rla); load_raw128(base, LD, h * 128, tid, rq); if (!HGRN) load_raw128(base, LD, 512 + h * 128, tid, rk); load_raw_v<DV>(base, LD, (HGRN ? 3072 : 2560) + h * DV, tid, rv); }
    for (; u < NU; u += G) {
        const int b = u / (H * NCH), h = (u / NCH) % H, n = u % NCH;
        bf16* base = proj + (size_t)(b * T + n * CH) * LD;
        const int vcol = (HGRN ? 3072 : 2560) + h * DV, gcol = (HGRN ? 2048 : 1536) + h * DV;
        store_raw128(lds, L_LA, tid, rla); store_raw128(lds, L_QS, tid, rq); if (!HGRN) store_raw128(lds, L_KS, tid, rk); store_raw_v<DV>(lds, tid, rv);
        __syncthreads();
        bf16x8 sfr[4][MTW];
#pragma unroll
        for (int kk = 0; kk < 4; ++kk)
#pragma unroll
            for (int mt = 0; mt < MTW; ++mt) sfr[kk][mt] = *(const bf16x8*)(GS + ((size_t)u * DV + v0 + mt * 16 + l15) * 128 + kk * 32 + 8 * g);
        { const int un = u + G; if (un < NU) { const int b2 = un / (H * NCH), h2 = (un / NCH) % H, n2 = un % NCH; const bf16* nb = proj + (size_t)(b2 * T + n2 * CH) * LD;
            load_raw128(nb, LD, 1024 + h2 * 128, tid, rla); load_raw128(nb, LD, h2 * 128, tid, rq); if (!HGRN) load_raw128(nb, LD, 512 + h2 * 128, tid, rk); load_raw_v<DV>(nb, LD, (HGRN ? 3072 : 2560) + h2 * DV, tid, rv); } }
        float bb[16], kv[16], blast;
        cumsum_local(lds, d, rg, bb);
#pragma unroll
        for (int i = 0; i < 16; ++i) kv[i] = HGRN ? (1.0f - __expf(bb[i])) : bf2f(*(const LAS bf16*)(lds + L_KS + (rg * 16 + i) * QS_STR + d * 2));
        cumsum_scan(lds, d, rg, bb);
        transpose_v<DV>(lds, tid);
        __syncthreads();
        cumsum_finish(lds, d, rg, bb, blast);
#pragma unroll
        for (int i = 0; i < 16; ++i) { const int s = rg * 16 + i; LAS bf16* qa = (LAS bf16*)(lds + L_QS + s * QS_STR + d * 2); LAS bf16* ka = (LAS bf16*)(lds + L_KS + s * QS_STR + d * 2);
            const float q = bf2f(*qa); *qa = (bf16)f2bf(q * __expf(bb[i])); *ka = (bf16)f2bf(kv[i] * __expf(-bb[i])); }
        __syncthreads();
        { const int tt = wave >> 1;
#pragma unroll
          for (int si = 0; si < 2; ++si) { const int st = (wave & 1) * 2 + si; f32x4 c = (f32x4){0.f, 0.f, 0.f, 0.f};
#pragma unroll
              for (int kk = 0; kk < 4; ++kk) { const bf16x8 afr = *(const LAS bf16x8*)(lds + L_KS + (st * 16 + l15) * QS_STR + (kk * 32 + 8 * g) * 2);
                  const bf16x8 bfr = *(const LAS bf16x8*)(lds + L_QS + (tt * 16 + l15) * QS_STR + (kk * 32 + 8 * g) * 2); c = MFMA16(afr, bfr, c); }
              const int t = tt * 16 + l15, s0 = st * 16 + 4 * g;
              u32x2 w; w.x = pk2(s0 <= t ? c[0] : 0.f, s0 + 1 <= t ? c[1] : 0.f); w.y = pk2(s0 + 2 <= t ? c[2] : 0.f, s0 + 3 <= t ? c[3] : 0.f);
              *(LAS u32x2*)(lds + L_AT + t * KT_STR + s0 * 2) = w; } }
        u32x2 gt[4][MTW];
#pragma unroll
        for (int nt = 0; nt < 4; ++nt)
#pragma unroll
            for (int mt = 0; mt < MTW; ++mt) gt[nt][mt] = *(const u32x2*)(base + (size_t)(nt * 16 + l15) * LD + gcol + v0 + mt * 16 + 4 * g);
        __syncthreads();
        f32x4 acc[MTW][4];
#pragma unroll
        for (int mt = 0; mt < MTW; ++mt)
#pragma unroll
            for (int nt = 0; nt < 4; ++nt) acc[mt][nt] = (f32x4){0.f, 0.f, 0.f, 0.f};
#pragma unroll
        for (int kk = 0; kk < 4; ++kk) {
#pragma unroll
            for (int nt = 0; nt < 4; ++nt) { const bf16x8 bfr = *(const LAS bf16x8*)(lds + L_QS + (nt * 16 + l15) * QS_STR + (kk * 32 + 8 * g) * 2);
#pragma unroll
                for (int mt = 0; mt < MTW; ++mt) acc[mt][nt] = MFMA16(sfr[kk][mt], bfr, acc[mt][nt]); }
        }
#pragma unroll
        for (int kk = 0; kk < 2; ++kk) {
            bf16x8 afr[MTW];
#pragma unroll
            for (int mt = 0; mt < MTW; ++mt) afr[mt] = *(const LAS bf16x8*)(lds + L_VT + (v0 + mt * 16 + l15) * KT_STR + (kk * 32 + 8 * g) * 2);
#pragma unroll
            for (int nt = 0; nt < 4; ++nt) { const bf16x8 bfr = *(const LAS bf16x8*)(lds + L_AT + (nt * 16 + l15) * KT_STR + (kk * 32 + 8 * g) * 2);
#pragma unroll
                for (int mt = 0; mt < MTW; ++mt) acc[mt][nt] = MFMA16(afr[mt], bfr, acc[mt][nt]); }
        }
        LAS float* red = (LAS float*)(lds + L_RED);
#pragma unroll
        for (int nt = 0; nt < 4; ++nt) { float p = 0.f;
#pragma unroll
            for (int mt = 0; mt < MTW; ++mt) p += (acc[mt][nt][0] * acc[mt][nt][0] + acc[mt][nt][1] * acc[mt][nt][1]) + (acc[mt][nt][2] * acc[mt][nt][2] + acc[mt][nt][3] * acc[mt][nt][3]);
            p += pg8::shx(p, 16, lane); p += pg8::shx(p, 32, lane);
            if (g == 0) red[wave * 64 + nt * 16 + l15] = p; }
        __syncthreads();
#pragma unroll
        for (int nt = 0; nt < 4; ++nt) { const int t = nt * 16 + l15; float s = 0.f;
#pragma unroll
            for (int w = 0; w < 8; ++w) s += red[w * 64 + t];
            const float rstd = rsqrtf(s * (1.0f / DV) + EPS);
            bf16* rowp = base + (size_t)t * LD;
#pragma unroll
            for (int mt = 0; mt < MTW; ++mt) { const int v = v0 + mt * 16 + 4 * g; const u32x2 gg = gt[nt][mt];
                u32x2 w; w.x = pk2(acc[mt][nt][0] * rstd * __uint_as_float(gg.x << 16), acc[mt][nt][1] * rstd * __uint_as_float(gg.x & 0xffff0000u));
                w.y = pk2(acc[mt][nt][2] * rstd * __uint_as_float(gg.y << 16), acc[mt][nt][3] * rstd * __uint_as_float(gg.y & 0xffff0000u));
                if (!DRY || w.x == 0x12345678u) *(u32x2*)(rowp + vcol + v) = w; } }
    }
    __syncthreads();
}
constexpr int KL_STR = 272, VL_STR = 528, L_KL = 0, L_VL = 256 * KL_STR;
static_assert(L_VL + 128 * VL_STR <= LDS_BYTES, "xattn LDS map");
template <bool DRY = false>
__device__ __forceinline__ void xattn(LAS unsigned char* lds, bf16* proj, int LD, int xcol, const bf16* KM, const bf16* VMT, int G, int bid, const int tid) {
    const int lane = tid & 63, wave = tid >> 6, g = lane >> 4, l15 = lane & 15;
    for (int w = bid; w < 256; w += G) {
        const int pair = w >> 4, sub = w & 15, b = pair >> 2, h = pair & 3;
        __syncthreads();
#pragma unroll
        for (int i = 0; i < 8; ++i) { const int c = tid + i * NT, m = c >> 4, part = c & 15;
            *(LAS u32x4*)(lds + L_KL + m * KL_STR + part * 16) = *(const u32x4*)(KM + (size_t)(b * 256 + m) * 512 + h * 128 + part * 8); }
#pragma unroll
        for (int i = 0; i < 8; ++i) { const int c = tid + i * NT, dd = c >> 5, part = c & 31;
            *(LAS u32x4*)(lds + L_VL + dd * VL_STR + part * 16) = *(const u32x4*)(VMT + ((size_t)b * 512 + h * 128 + dd) * 256 + part * 8); }
        __syncthreads();
        for (int tile = 0; tile < 4; ++tile) {
            const int r0 = b * T + (sub * 4 + tile) * 128 + wave * 16;
            bf16* qp = proj + (size_t)(r0 + l15) * LD + xcol + h * 128;
            bf16x8 qf[4];
#pragma unroll
            for (int kk = 0; kk < 4; ++kk) qf[kk] = *(const bf16x8*)(qp + kk * 32 + 8 * g);
            f32x4 sc[16];
#pragma unroll
            for (int mt = 0; mt < 16; ++mt) { f32x4 c = (f32x4){0.f, 0.f, 0.f, 0.f};
#pragma unroll
                for (int kk = 0; kk < 4; ++kk) { const bf16x8 afr = *(const LAS bf16x8*)(lds + L_KL + (mt * 16 + l15) * KL_STR + (kk * 32 + 8 * g) * 2); c = MFMA16(afr, qf[kk], c); }
                sc[mt] = c; }
            float mx = -1e30f;
#pragma unroll
            for (int mt = 0; mt < 16; ++mt) mx = fmaxf(mx, fmaxf(fmaxf(sc[mt][0], sc[mt][1]), fmaxf(sc[mt][2], sc[mt][3])));
            mx = fmaxf(mx, pg8::shx(mx, 16, lane)); mx = fmaxf(mx, pg8::shx(mx, 32, lane));
            float sum = 0.f;
#pragma unroll
            for (int mt = 0; mt < 16; ++mt) {
#pragma unroll
                for (int j = 0; j < 4; ++j) { const float p = __expf(sc[mt][j] - mx); sc[mt][j] = p; sum += p; } }
            sum += pg8::shx(sum, 16, lane); sum += pg8::shx(sum, 32, lane);
            const float inv = 1.0f / sum;
            f32x4 oa[8];
#pragma unroll
            for (int dt = 0; dt < 8; ++dt) oa[dt] = (f32x4){0.f, 0.f, 0.f, 0.f};
#pragma unroll
            for (int kb = 0; kb < 8; ++kb) {
                union { bf16x8 v; unsigned u[4]; } pb;
                pb.u[0] = pk2(sc[2 * kb][0], sc[2 * kb][1]); pb.u[1] = pk2(sc[2 * kb][2], sc[2 * kb][3]); pb.u[2] = pk2(sc[2 * kb + 1][0], sc[2 * kb + 1][1]); pb.u[3] = pk2(sc[2 * kb + 1][2], sc[2 * kb + 1][3]);
#pragma unroll
                for (int dt = 0; dt < 8; ++dt) { union { bf16x8 v; u32x2 h[2]; } pa; const LAS unsigned char* vp = lds + L_VL + (dt * 16 + l15) * VL_STR + (kb * 32 + 4 * g) * 2;
                    pa.h[0] = *(const LAS u32x2*)vp; pa.h[1] = *(const LAS u32x2*)(vp + 32); oa[dt] = MFMA16(pa.v, pb.v, oa[dt]); }
            }
#pragma unroll
            for (int dt = 0; dt < 8; ++dt) { u32x2 o; o.x = pk2(oa[dt][0] * inv, oa[dt][1] * inv); o.y = pk2(oa[dt][2] * inv, oa[dt][3] * inv); if (!DRY || o.x == 0x12345678u) *(u32x2*)(qp + dt * 16 + 4 * g) = o; }
        }
    }
    __syncthreads();
}
__device__ __forceinline__ void final_norm(float* out, const bf16* XB, const float* SS, const float* gain, int gw, int ngw, int lane) {
    f32x4 gv[4];
#pragma unroll
    for (int j = 0; j < 4; ++j) gv[j] = ((const f32x4*)gain)[lane + 64 * j];
    for (int m = gw; m < M; m += ngw) {
        float s = lane < 16 ? SS[(size_t)lane * M + m] : 0.f; s = wave_sum(s, lane);
        const float rstd = rsqrtf(s * (1.0f / D) + EPS);
        const u32x2* xr = (const u32x2*)(XB + (size_t)m * D) + lane; f32x4* orow = (f32x4*)(out + (size_t)m * D) + lane;
#pragma unroll
        for (int j = 0; j < 4; ++j) { const u32x2 xw = xr[64 * j]; f32x4 v = (f32x4){__uint_as_float(xw.x << 16), __uint_as_float(xw.x & 0xffff0000u), __uint_as_float(xw.y << 16), __uint_as_float(xw.y & 0xffff0000u)};
            orow[64 * j] = v * rstd * gv[j]; }
    }
}

struct Args { Ptrs P; int ph_lo, ph_hi; };
constexpr int N_PHASES = 2 + 7 * DEPTH;
__global__ void __launch_bounds__(NT, 2) fwd_kernel(Args a) {
    extern __shared__ __attribute__((aligned(16))) unsigned char lds_raw[];
#if ONE_LAUNCH
    cg::grid_group grid = cg::this_grid();
    { volatile LAS unsigned* st = (volatile LAS unsigned*)((LAS unsigned char*)lds_raw + LDS_BARST); int t0_ = threadIdx.x; if (t0_ == 0) { st[0] = 0u; st[1] = 0u; } __syncthreads();
      (void)xcd_barrier_post((unsigned*)(a.P.ws + WS_CTL), st, t0_); }
#define SEAM() do { XcdBarrier xb_; xb_.bar = (unsigned*)(ws + WS_CTL); xb_.x = xb_xcc_id(); xb_.st = (volatile LAS unsigned*)(lds + LDS_BARST); xcd_barrier(xb_, tid); if (ph == 0) grid.sync(); } while (0)
#else
#define SEAM() do {} while (0)
#endif
    const int ph_lo = a.ph_lo, ph_hi = a.ph_hi;
    const int wave0 = __builtin_amdgcn_readfirstlane(threadIdx.x >> 6);
    for (int ph = ph_lo; ph < ph_hi; ++ph) {
        const __attribute__((address_space(4))) Args* ap = (const __attribute__((address_space(4))) Args*)__builtin_amdgcn_kernarg_segment_ptr();
        asm volatile("" : "+s"(ap));
        int zero_ = 0; asm volatile("" : "+v"(zero_));
        int tid = wave0 * 64 + (int)__builtin_amdgcn_mbcnt_hi(~0u, __builtin_amdgcn_mbcnt_lo(~0u, (unsigned)zero_)); asm volatile("" : "+v"(tid));
        LAS unsigned char* lds = (LAS unsigned char*)lds_raw;
        const int lane = tid & 63, wave = __builtin_amdgcn_readfirstlane(tid >> 6);
        int G = gridDim.x, bid = blockIdx.x; asm volatile("" : "+s"(G), "+s"(bid));
        const int gw = bid * NWAVES + wave, ngw = G * NWAVES;
        unsigned char* ws = ap->P.ws;
        float* SS = (float*)(ws + WS_SS); bf16* XB = (bf16*)ap->P.out; bf16* GS = (bf16*)(ws + WS_XB); bf16* X2 = (bf16*)(ws + WS_XB); bf16* PROJ = (bf16*)(ws + WS_PROJ);
        int ngemm = 0;
        int L = 0, sp = 0; bool hg = false;
        if (ph == 0) { prologue(&ap->P, lds, gw, ngw, wave, lane); }
        else if (ph == N_PHASES - 1) { final_norm(ap->P.out, X2, SS, ap->P.final_norm, gw, ngw, lane); }
        else {
            L = (ph - 1) / 7; sp = (ph - 1) % 7; hg = (L & 1);
            const int LD = hg ? HGRN_N : GLA_N;
            if (sp == 0) ngemm = (L == 0) ? 2 : 1;
            else if (sp == 1) {
                float* DEC = (float*)(ws + WS_DEC);
#if EXP == 3
                if (hg) pass_a<128, true>(lds, PROJ, GS, DEC, G, bid, tid); else pass_a<256, false>(lds, PROJ, GS, DEC, G, bid, tid);
#endif
                if (hg) pass_a<128, true>(lds, PROJ, GS, DEC, G, bid, tid); else pass_a<256, false>(lds, PROJ, GS, DEC, G, bid, tid);
#if EXP == 5
                xattn<true>(lds, PROJ, LD, hg ? 4096 : 3584, (const bf16*)(ws + WS_KM) + (size_t)L * 1024 * 512, (const bf16*)(ws + WS_VMT) + (size_t)L * 4 * 512 * 256, G, bid, tid);
#endif
#if EXP == 6
                if (L + 1 < DEPTH) { convert_layer(&ap->P, L + 1, lds, gw, ngw, wave, lane); } __syncthreads();
#endif
                xattn(lds, PROJ, LD, hg ? 4096 : 3584, (const bf16*)(ws + WS_KM) + (size_t)L * 1024 * 512, (const bf16*)(ws + WS_VMT) + (size_t)L * 4 * 512 * 256, G, bid, tid);
                if (L + 1 < DEPTH) { convert_layer(&ap->P, L + 1, lds, gw, ngw, wave, lane); }
            } else if (sp == 2) {
                const float* DEC = (const float*)(ws + WS_DEC);
#if EXP == 3
                if (hg) pass_b<128, true, true>(GS, DEC, G, bid, tid); else pass_b<256, false, true>(GS, DEC, G, bid, tid);
#endif
                if (hg) pass_b<128, true>(GS, DEC, G, bid, tid); else pass_b<256, false>(GS, DEC, G, bid, tid);
            } else if (sp == 3) {
#if EXP == 4
                if (hg) pass_c<128, true, true>(lds, PROJ, GS, G, bid, tid); else pass_c<256, false, true>(lds, PROJ, GS, G, bid, tid);
#endif
                if (hg) pass_c<128, true>(lds, PROJ, GS, G, bid, tid); else pass_c<256, false>(lds, PROJ, GS, G, bid, tid);
            } else ngemm = 1;
            if (EXP == 2 && (sp == 0 || sp == 5)) ngemm += 8;
        }
        for (int rep = 0; rep < (ngemm & 7) * (ngemm >= 8 ? 2 : 1); ++rep) {
            unsigned char* wb = ws + WS_WT + (size_t)(L & 1) * WT_BUF;
            const int LD = hg ? HGRN_N : GLA_N;
            pg8::Gemm g; pg8::EpiAll E; E.hgrn = hg ? 1 : 0; E.M = M; E.aux = nullptr; E.xin = nullptr; E.xout = nullptr;
            if (sp == 0 && (ngemm & 7) == 2 && (rep & 7) == 0 && rep < 8) {
                g.A = (const bf16*)(ws + WS_MEMB); g.Bt = (const bf16*)(ws + WS_WKV); g.M = MROWS; g.N = 4096; g.K = D; g.lda = D; g.perm = 0;
                E.kind = 3; E.ldc = 0; E.O = (bf16*)(ws + WS_KM); E.ss = (const float*)(ws + WS_SSM); E.xout = (float*)(ws + WS_VMT);
            } else if (sp == 0) {
                g.A = XB; g.Bt = (const bf16*)(wb + WT_IN); g.M = M; g.N = LD; g.K = D; g.lda = D; g.perm = 1;
                E.kind = 0; E.ldc = LD; E.O = PROJ; E.ss = SS; E.aux = hg ? (const float*)(ws + WS_LB) + (size_t)L * 1024 : ap->P.gla_b_gate + (size_t)(L >> 1) * 512;
            } else if (sp == 4) {
                g.A = PROJ + (hg ? 3072 : 2560); g.Bt = (const bf16*)(wb + WT_OUT); g.M = M; g.N = D; g.K = KOUT; g.lda = LD; g.perm = 0;
                E.kind = 2; E.ldc = D; E.O = XB; E.ss = SS; E.xin = (L == 0) ? ap->P.x : nullptr; E.xout = (float*)XB;
            } else if (sp == 5) {
                g.A = XB; g.Bt = (const bf16*)(wb + WT_UP); g.M = M; g.N = FF; g.K = D; g.lda = D; g.perm = 1;
                E.kind = 1; E.ldc = FF; E.O = PROJ; E.ss = SS;
            } else {
                g.A = PROJ; g.Bt = (const bf16*)(wb + WT_DOWN); g.M = M; g.N = D; g.K = FF; g.lda = FF; g.perm = 0;
                E.kind = 2; E.ldc = D; E.O = XB; E.ss = SS; E.xout = (float*)((L == DEPTH - 1) ? X2 : XB);
            }
            pg8::StaticOrder S; S.init(g.M, g.N, G, bid);
            pg8::gemm_phase<pg8::EpiAll, pg8::StaticOrder, true, true>(lds, g, S, E, tid);
        }
        if (ph + 1 < ph_hi) { SEAM(); }
#if EXP == 7
        if (ph + 1 < ph_hi) { SEAM(); }
#endif
    }
}

extern "C" void kernel_launch(void* const* d_in, const int* in_sizes, int n_in, void* d_out, int out_size, void* d_ws, size_t ws_size, hipStream_t stream) {
    static int grid = 0;
    if (grid == 0) {
        if (n_in != 17 || out_size != M * D || ws_size < WS_END) { fprintf(stderr, "kernel_launch: unexpected shapes (n_in %d out %d ws %zu)\n", n_in, out_size, ws_size); grid = -1; return; }
        int dev = 0, cus = 0, per_cu = 0;
        hipGetDevice(&dev); hipDeviceGetAttribute(&cus, hipDeviceAttributeMultiprocessorCount, dev);
        if (hipFuncSetAttribute((const void*)fwd_kernel, hipFuncAttributeMaxDynamicSharedMemorySize, LDS_BYTES) != hipSuccess) { fprintf(stderr, "kernel_launch: hipFuncSetAttribute failed\n"); grid = -1; return; }
        if (hipOccupancyMaxActiveBlocksPerMultiprocessor(&per_cu, (const void*)fwd_kernel, NT, LDS_BYTES) != hipSuccess || per_cu < 1) { fprintf(stderr, "kernel_launch: occupancy query says %d\n", per_cu); per_cu = 1; }
        (void)hipGetLastError();
        grid = cus * per_cu;
        if (grid > 256) grid = 256;
        grid = (grid / 16) * 16;
        fprintf(stderr, "kernel_launch: grid %d (cus %d per_cu %d)\n", grid, cus, per_cu);
    }
    if (grid <= 0) return;
#if ONE_LAUNCH
    if (hipMemsetAsync((char*)d_ws + WS_CTL, 0, CTL_BYTES, stream) != hipSuccess) { fprintf(stderr, "kernel_launch: memset failed\n"); return; }
#endif
    Args a{};
    const float** pp = (const float**)&a.P;
    for (int i = 0; i < 17; ++i) pp[i] = (const float*)d_in[i];
    a.P.out = (float*)d_out; a.P.ws = (unsigned char*)d_ws;
#if ONE_LAUNCH
    a.ph_lo = 0; a.ph_hi = N_PHASES;
    void* args[] = {&a};
    hipError_t e = hipLaunchCooperativeKernel((const void*)fwd_kernel, dim3(grid), dim3(NT), args, LDS_BYTES, stream);
    if (e != hipSuccess) fprintf(stderr, "kernel_launch: cooperative launch failed: %s (grid %d)\n", hipGetErrorString(e), grid);
#else
    for (int ph = 0; ph < N_PHASES; ++ph) { a.ph_lo = ph; a.ph_hi = ph + 1; hipLaunchKernelGGL(fwd_kernel, dim3(grid), dim3(NT), LDS_BYTES, stream, a); }
#endif
}
```

```cpp
#include <hip/hip_runtime.h>
#include <hip/hip_cooperative_groups.h>
#include <cstdio>
#include <cstdint>
namespace cg = cooperative_groups;

#ifndef EXP
#define EXP 0
#endif
#ifndef SKEW_TICKS
#define SKEW_TICKS 0
#endif
#ifndef ONE_LAUNCH
#define ONE_LAUNCH 1
#endif

namespace pg8 {
#define PG8_LAS __attribute__((address_space(3)))
typedef unsigned short bf16_t;
typedef short bf16x8 __attribute__((ext_vector_type(8)));
typedef float f32x4 __attribute__((ext_vector_type(4)));
typedef unsigned u32x4 __attribute__((ext_vector_type(4)));
typedef unsigned u32x2 __attribute__((ext_vector_type(2)));
constexpr int BM = 256, BK = 64, HALF = 128, HTB = HALF * BK * 2, STAGE_BYTES = 8 * HTB, NXCD = 8, WGM = 8;

__host__ __device__ __forceinline__ int lds_byte(int r, int c) { const int st = (r >> 4) * 2 + (c >> 5), rr = r & 15, cc = c & 31, ob = rr * 64 + cc * 2; return st * 1024 + (ob ^ (((ob >> 9) & 1) << 5)); }
__host__ __device__ __forceinline__ void stage_rc(int b, int& R, int& C) { const int st = b / 1024, sb = b % 1024, swz = sb ^ (((sb >> 9) & 1) << 5); R = (st >> 1) * 16 + swz / 64; C = (st & 1) * 32 + (swz % 64) / 2; }
__host__ __device__ __forceinline__ int perm32(int rho) { const int n = rho >> 4, i = rho & 15; return 8 * (i >> 2) + 4 * n + (i & 3); }

struct Unit { int pm, pn; };
struct Gemm { const bf16_t* A; const bf16_t* Bt; int M, N, K, lda, perm; };

struct StaticOrder {
    int nM, nN, nwg, G, c;
    __host__ __device__ void init(int M, int N, int G_, int c_) { nM = M / BM; nN = N / BM; nwg = nM * nN; G = G_; c = c_; }
    __host__ __device__ bool next(int i, Unit& u) const {
        const long L = (long)i * G + c; if (L >= nwg) return false;
        int wgid = (int)L; { const int q = nwg / NXCD, r = nwg % NXCD, xcd = wgid % NXCD, off = wgid / NXCD; wgid = (xcd < r ? xcd * (q + 1) : r * (q + 1) + (xcd - r) * q) + off; }
        const int nig = WGM * nN, gid = wgid / nig, fm = gid * WGM, gsz = (nM - fm) < WGM ? (nM - fm) : WGM;
        u.pm = fm + ((wgid % nig) % gsz); u.pn = (wgid % nig) / gsz; return true;
    }
    __device__ __forceinline__ void a_ready(const Unit&) const {}
    __device__ __forceinline__ void done(const Unit&) const {}
};

__device__ __forceinline__ float shx(float v, int mask, int lane) { return __int_as_float(__builtin_amdgcn_ds_bpermute((lane ^ mask) << 2, __float_as_int(v))); }
typedef float f32x2_t __attribute__((ext_vector_type(2)));
typedef __bf16 bf16x2_t __attribute__((ext_vector_type(2)));
__device__ __forceinline__ unsigned cvt_pk_native(float lo, float hi) { const f32x2_t f = {lo, hi}; const bf16x2_t b = __builtin_convertvector(f, bf16x2_t); return __builtin_bit_cast(unsigned, b); }
__device__ __forceinline__ unsigned cvt_pk_bf16(float lo, float hi) { unsigned r; asm volatile("v_cvt_pk_bf16_f32 %0, %1, %2" : "=v"(r) : "v"(lo), "v"(hi)); return r; }

__device__ __forceinline__ float fsigmoid(float v) { return __builtin_amdgcn_rcpf(1.0f + __expf(-v)); }
__device__ __forceinline__ float fsilu(float v) { return v * fsigmoid(v); }
__device__ __forceinline__ float row_rstd(const float* ss, int M, int row, int fq, int lane) {
    const float* p = ss + (size_t)(4 * fq) * M + row;
    float s = (p[0] + p[M]) + (p[2 * (size_t)M] + p[3 * (size_t)M]);
    s += shx(s, 16, lane); s += shx(s, 32, lane);
    return rsqrtf(s * (1.0f / 1024.0f) + 1e-6f);
}
template <int MODE> __device__ __forceinline__ float proj_act(float v, float a) {
    if (MODE == 1) return fsilu(v);
    if (MODE == 2) { const float z = v + a; const float ls = fminf(z, 0.f) - __logf(1.0f + __expf(-fabsf(z))); return ls * 0.0625f; }
    if (MODE == 3) { const float sg = fsigmoid(v); return __logf(a + (1.0f - a) * sg); }
    if (MODE == 4) return fsilu(v) * 0.08838834764831845f;
    if (MODE == 5) { const float r = fmaxf(v, 0.f); return r * r; }
    return v;
}
struct EpiAll {
    static constexpr bool AFTER_DRAIN = false;
    int kind, ldc, hgrn, M;
    bf16_t* O;
    const float* ss;
    const float* aux;
    const float* xin;
    float* xout;
    template <int MODE> __device__ __forceinline__ void body_proj(const f32x4 (&acc)[2][2][4][2], const Unit& u, int wr, int wc, int fr, int fq) const {
        const int row0 = u.pm * BM + wr * 64 + fr, col0 = u.pn * BM + wc * 32 + 8 * fq;
        f32x4 av[2][2];
#pragma unroll
        for (int bj = 0; bj < 2; ++bj)
#pragma unroll
            for (int n = 0; n < 2; ++n) av[bj][n] = (MODE == 2 || MODE == 3) ? *(const f32x4*)(aux + (col0 - 1024) + bj * HALF + 4 * n) : (f32x4){0.f, 0.f, 0.f, 0.f};
        float ps[2][4];
#pragma unroll
        for (int ai = 0; ai < 2; ++ai)
#pragma unroll
            for (int m = 0; m < 4; ++m) { const float* p = ss + (size_t)(4 * fq) * M + (row0 + ai * HALF + m * 16); ps[ai][m] = (p[0] + p[M]) + (p[2 * (size_t)M] + p[3 * (size_t)M]); }
        float rs[2][4];
#pragma unroll
        for (int ai = 0; ai < 2; ++ai)
#pragma unroll
            for (int m = 0; m < 4; ++m) { float s = ps[ai][m]; s += shx(s, 16, fq * 16 + fr); s += shx(s, 32, fq * 16 + fr); rs[ai][m] = rsqrtf(s * (1.0f / 1024.0f) + 1e-6f); }
#pragma unroll
        for (int ai = 0; ai < 2; ++ai)
#pragma unroll
            for (int m = 0; m < 4; ++m) { const int row = row0 + ai * HALF + m * 16; const float rstd = rs[ai][m]; bf16_t* rowp = O + (size_t)row * ldc + col0;
#pragma unroll
                for (int bj = 0; bj < 2; ++bj) { f32x4 v0 = acc[ai][bj][m][0] * rstd, v1 = acc[ai][bj][m][1] * rstd;
#pragma unroll
                    for (int j = 0; j < 4; ++j) { v0[j] = proj_act<MODE>(v0[j], av[bj][0][j]); v1[j] = proj_act<MODE>(v1[j], av[bj][1][j]); }
                    u32x4 w; w.x = cvt_pk_bf16(v0[0], v0[1]); w.y = cvt_pk_bf16(v0[2], v0[3]); w.z = cvt_pk_bf16(v1[0], v1[1]); w.w = cvt_pk_bf16(v1[2], v1[3]);
                    *(u32x4*)(rowp + bj * HALF) = w; } }
    }
    template <bool F32IN> __device__ __forceinline__ void body_res(const f32x4 (&acc)[2][2][4][2], const Unit& u, int wr, int wc, int fr, int fq) const {
        const int row0 = u.pm * BM + wr * 64 + fr, col0 = u.pn * BM + wc * 32 + 8 * fq; float* ssw = (float*)ss; bf16_t* XO = (bf16_t*)xout;
#pragma unroll
        for (int ai = 0; ai < 2; ++ai) {
            u32x4 xi[4][2];
            if (!F32IN) {
#pragma unroll
                for (int m = 0; m < 4; ++m) { const size_t off = (size_t)(row0 + ai * HALF + m * 16) * 1024 + col0;
#pragma unroll
                    for (int bj = 0; bj < 2; ++bj) xi[m][bj] = *(const u32x4*)(O + off + bj * HALF); } }
#pragma unroll
            for (int m = 0; m < 4; ++m) { const int row = row0 + ai * HALF + m * 16; const size_t off = (size_t)row * 1024 + col0; float s = 0.f;
#pragma unroll
                for (int bj = 0; bj < 2; ++bj) { f32x4 o0, o1;
                    if (F32IN) { o0 = *(const f32x4*)(xin + off + bj * HALF); o1 = *(const f32x4*)(xin + off + bj * HALF + 4); }
                    else { const u32x4 xw = xi[m][bj]; o0 = (f32x4){__uint_as_float(xw.x << 16), __uint_as_float(xw.x & 0xffff0000u), __uint_as_float(xw.y << 16), __uint_as_float(xw.y & 0xffff0000u)};
                        o1 = (f32x4){__uint_as_float(xw.z << 16), __uint_as_float(xw.z & 0xffff0000u), __uint_as_float(xw.w << 16), __uint_as_float(xw.w & 0xffff0000u)}; }
                    o0 = o0 + acc[ai][bj][m][0]; o1 = o1 + acc[ai][bj][m][1];
                    u32x4 w; w.x = cvt_pk_bf16(o0[0], o0[1]); w.y = cvt_pk_bf16(o0[2], o0[3]); w.z = cvt_pk_bf16(o1[0], o1[1]); w.w = cvt_pk_bf16(o1[2], o1[3]);
                    *(u32x4*)(XO + off + bj * HALF) = w;
#pragma unroll
                    for (int q = 0; q < 4; ++q) { const unsigned wq = q == 0 ? w.x : (q == 1 ? w.y : (q == 2 ? w.z : w.w)); const float r0 = __uint_as_float(wq << 16), r1 = __uint_as_float(wq & 0xffff0000u); s += r0 * r0 + r1 * r1; } }
                s += shx(s, 16, fq * 16 + fr); s += shx(s, 32, fq * 16 + fr);
                if (fq == 0) ssw[(size_t)(u.pn * 4 + wc) * M + row] = s; }
        }
    }
    __device__ __forceinline__ void body_kv(const f32x4 (&acc)[2][2][4][2], const Unit& u, int wr, int wc, int fr, int fq) const {
        const int row0 = u.pm * BM + wr * 64 + fr, layer = u.pn >> 2, cl0 = (u.pn & 3) * BM + wc * 32 + 4 * fq; bf16_t* VMT = (bf16_t*)xout;
#pragma unroll
        for (int ai = 0; ai < 2; ++ai)
#pragma unroll
            for (int m = 0; m < 4; ++m) { const int row = row0 + ai * HALF + m * 16; const float rstd = rsqrtf(ss[row] * (1.0f / 1024.0f) + 1e-6f);
#pragma unroll
                for (int bj = 0; bj < 2; ++bj)
#pragma unroll
                    for (int n = 0; n < 2; ++n) { const f32x4 o = acc[ai][bj][m][n] * rstd; const int cl = cl0 + bj * HALF + n * 16;
                        if (cl < 512) { u32x2 w; w.x = cvt_pk_bf16(o[0], o[1]); w.y = cvt_pk_bf16(o[2], o[3]); *(u32x2*)(O + ((size_t)layer * 1024 + row) * 512 + cl) = w; }
                        else { const unsigned lo = cvt_pk_bf16(o[0], o[1]), hi = cvt_pk_bf16(o[2], o[3]); bf16_t* d = VMT + ((size_t)(layer * 4 + (row >> 8)) * 512 + (cl - 512)) * 256 + (row & 255);
                            d[0] = (bf16_t)(lo & 0xffff); d[256] = (bf16_t)(lo >> 16); d[512] = (bf16_t)(hi & 0xffff); d[768] = (bf16_t)(hi >> 16); } } }
    }
    __device__ __forceinline__ void operator()(const f32x4 (&acc)[2][2][4][2], const Unit& u, int wr, int wc, int fr, int fq) const {
        if (kind == 0) {
            int mode;
            if (!hgrn) mode = (u.pn >= 4 && u.pn < 6) ? 2 : ((u.pn >= 6 && u.pn < 10) ? 1 : 0);
            else mode = u.pn < 4 ? 4 : (u.pn < 8 ? 3 : (u.pn < 12 ? 1 : 0));
            if (mode == 0) body_proj<0>(acc, u, wr, wc, fr, fq); else if (mode == 1) body_proj<1>(acc, u, wr, wc, fr, fq); else if (mode == 2) body_proj<2>(acc, u, wr, wc, fr, fq);
            else if (mode == 3) body_proj<3>(acc, u, wr, wc, fr, fq); else body_proj<4>(acc, u, wr, wc, fr, fq);
        } else if (kind == 1) body_proj<5>(acc, u, wr, wc, fr, fq);
        else if (kind == 2) { if (xin) body_res<true>(acc, u, wr, wc, fr, fq); else body_res<false>(acc, u, wr, wc, fr, fq); }
        else body_kv(acc, u, wr, wc, fr, fq);
    }
};

template <class Epi, class Sched, bool ALIGN_EPI = false, bool SP2 = false>
__device__ __forceinline__ void gemm_phase(PG8_LAS unsigned char* lds, const Gemm g, const Sched& S, const Epi& E, const int tid) {
    const int wid = __builtin_amdgcn_readfirstlane(tid >> 6), lane = tid & 63, wr = wid >> 2, wc = wid & 3, fr = lane & 15, fq = lane >> 4;
    const int K = g.K, nt = K / BK;
    unsigned voffA[2], voffB[2];
#pragma unroll
    for (int i = 0; i < 2; ++i) { int R, C; stage_rc(tid * 16 + i * 8192, R, C); const int Rb = g.perm ? ((R & ~31) + perm32(R & 31)) : R;
        voffA[i] = (unsigned)(R * g.lda + C) * 2u; voffB[i] = (unsigned)(Rb * K + C) * 2u; }
    const size_t kstep = (size_t)(BK * 2);
    const size_t hstepA = (size_t)HALF * g.lda * 2, hstepB = (size_t)HALF * K * 2;
    const size_t tstepA = 2 * hstepA, tstepB = 2 * hstepB;
    const unsigned ldsw = (unsigned)wid * 1024u;
    const int aoff = lds_byte(wr * 64 + fr, fq * 8), boff = lds_byte(wc * 32 + fr, fq * 8);
#define PG8_SA(b, h) (((b) * 2 + (h)) * HTB)
#define PG8_SB(b, h) ((4 + (b) * 2 + (h)) * HTB)
#define PG8_STAGE(bufoff, gbase, voff) do { _Pragma("unroll") for (int _i = 0; _i < 2; ++_i) \
        __builtin_amdgcn_global_load_lds((const unsigned*)((const char*)(gbase) + (voff)[_i]), (PG8_LAS unsigned*)(lds + (bufoff) + ldsw + _i * 8192), 16, 0, 0); } while (0)
#define PG8_LDA(dst, b, h) do { _Pragma("unroll") for (int m = 0; m < 4; ++m) _Pragma("unroll") for (int k = 0; k < 2; ++k) dst[m][k] = *(const PG8_LAS bf16x8*)(lds + PG8_SA(b, h) + aoff + m * 2048 + k * 1024); } while (0)
#define PG8_LDB(dst, b, h) do { _Pragma("unroll") for (int n = 0; n < 2; ++n) _Pragma("unroll") for (int k = 0; k < 2; ++k) dst[n][k] = *(const PG8_LAS bf16x8*)(lds + PG8_SB(b, h) + boff + n * 2048 + k * 1024); } while (0)
#define PG8_MMA(ai, bj, At, Bt) do { __builtin_amdgcn_s_setprio(1); _Pragma("unroll") for (int m = 0; m < 4; ++m) _Pragma("unroll") for (int n = 0; n < 2; ++n) _Pragma("unroll") for (int k = 0; k < 2; ++k) \
        acc[ai][bj][m][n] = __builtin_amdgcn_mfma_f32_16x16x32_bf16(Bt[n][k], At[m][k], acc[ai][bj][m][n], 0, 0, 0); __builtin_amdgcn_s_setprio(0); } while (0)
#define PG8_WAIT_V(n) asm volatile("s_waitcnt vmcnt(" #n ")" ::: "memory")
#define PG8_WAIT_L(n) asm volatile("s_waitcnt lgkmcnt(" #n ")" ::: "memory")
#define PG8_BAR __builtin_amdgcn_s_barrier()
#define PG8_SCHED __builtin_amdgcn_sched_barrier(0)
    Unit cur, nxt; int ui = 0;
    if (!S.next(0, cur)) return;
    f32x4 acc[2][2][4][2];
#pragma unroll
    for (int a = 0; a < 2; ++a)
#pragma unroll
        for (int b = 0; b < 2; ++b)
#pragma unroll
            for (int m = 0; m < 4; ++m)
#pragma unroll
                for (int n = 0; n < 2; ++n) acc[a][b][m][n] = (f32x4){0.f, 0.f, 0.f, 0.f};
    bf16x8 At[4][2], B0[2][2], B1[2][2];
    const char* cA = (const char*)g.A + (size_t)cur.pm * tstepA; const char* cB = (const char*)g.Bt + (size_t)cur.pn * tstepB;
    S.a_ready(cur);
    if constexpr (SP2) {
        PG8_STAGE(PG8_SB(0, 0), cB, voffB); PG8_STAGE(PG8_SB(0, 1), cB + hstepB, voffB); PG8_STAGE(PG8_SA(0, 0), cA, voffA); PG8_STAGE(PG8_SA(0, 1), cA + hstepA, voffA);
        if (wr == 1) PG8_BAR;
        PG8_WAIT_V(2); PG8_BAR;
        PG8_STAGE(PG8_SB(1, 0), cB + kstep, voffB); PG8_STAGE(PG8_SA(1, 0), cA + kstep, voffA); PG8_STAGE(PG8_SB(1, 1), cB + hstepB + kstep, voffB);
        PG8_WAIT_V(6); PG8_BAR;
    } else {
        PG8_STAGE(PG8_SB(0, 0), cB, voffB); PG8_STAGE(PG8_SA(0, 0), cA, voffA); PG8_STAGE(PG8_SB(0, 1), cB + hstepB, voffB); PG8_STAGE(PG8_SA(0, 1), cA + hstepA, voffA);
        if (wr == 1) PG8_BAR;
        PG8_WAIT_V(4); PG8_BAR;
        PG8_STAGE(PG8_SB(1, 0), cB + kstep, voffB); PG8_STAGE(PG8_SA(1, 0), cA + kstep, voffA); PG8_STAGE(PG8_SB(1, 1), cB + hstepB + kstep, voffB);
        PG8_WAIT_V(6); PG8_BAR;
    }
    for (;;) {
        const bool has_next = S.next(ui + 1, nxt);
        const char* nA = has_next ? (const char*)g.A + (size_t)nxt.pm * tstepA : cA; const char* nB = has_next ? (const char*)g.Bt + (size_t)nxt.pn * tstepB : cB;
        for (int t = 0; t < nt; t += 2) {
            const bool last = (t == nt - 2);
            const char* a1 = cA + (size_t)(t + 1) * kstep;
            const char* a2 = last ? nA : cA + (size_t)(t + 2) * kstep; const char* b2 = last ? nB : cB + (size_t)(t + 2) * kstep;
            const char* a3 = a2 + kstep; const char* b3 = b2 + kstep;
            if (last && has_next) S.a_ready(nxt);
            if constexpr (SP2) {
            PG8_LDB(B0, 0, 0); PG8_LDB(B1, 0, 1); PG8_SCHED; PG8_LDA(At, 0, 0); PG8_STAGE(PG8_SA(1, 1), a1 + hstepA, voffA);
            PG8_WAIT_V(8); PG8_WAIT_L(0); PG8_BAR; PG8_MMA(0, 0, At, B0); PG8_MMA(0, 1, At, B1); PG8_BAR; PG8_SCHED;
            PG8_LDA(At, 0, 1); PG8_STAGE(PG8_SB(0, 0), b2, voffB); PG8_STAGE(PG8_SB(0, 1), b2 + hstepB, voffB); PG8_STAGE(PG8_SA(0, 0), a2, voffA);
            PG8_WAIT_V(8); PG8_WAIT_L(0); PG8_BAR; PG8_MMA(1, 0, At, B0); PG8_MMA(1, 1, At, B1); PG8_BAR; PG8_SCHED;
            PG8_LDB(B0, 1, 0); PG8_LDB(B1, 1, 1); PG8_SCHED; PG8_LDA(At, 1, 0); PG8_STAGE(PG8_SA(0, 1), a2 + hstepA, voffA);
            PG8_WAIT_V(8); PG8_WAIT_L(0); PG8_BAR; PG8_MMA(0, 0, At, B0); PG8_MMA(0, 1, At, B1); PG8_BAR; PG8_SCHED;
            PG8_LDA(At, 1, 1); PG8_STAGE(PG8_SB(1, 0), b3, voffB); PG8_STAGE(PG8_SB(1, 1), b3 + hstepB, voffB); PG8_STAGE(PG8_SA(1, 0), a3, voffA);
            PG8_WAIT_V(8); PG8_WAIT_L(0); PG8_BAR; PG8_MMA(1, 0, At, B0); PG8_MMA(1, 1, At, B1); PG8_BAR; PG8_SCHED;
            } else {
            PG8_LDB(B0, 0, 0); PG8_SCHED; PG8_LDA(At, 0, 0); PG8_STAGE(PG8_SA(1, 1), a1 + hstepA, voffA);
            PG8_WAIT_L(8); PG8_BAR; PG8_WAIT_L(0); PG8_MMA(0, 0, At, B0); PG8_BAR; PG8_SCHED;
            PG8_LDB(B1, 0, 1); PG8_STAGE(PG8_SB(0, 0), b2, voffB);
            PG8_BAR; PG8_WAIT_L(0); PG8_MMA(0, 1, At, B1); PG8_BAR;
            PG8_LDA(At, 0, 1); PG8_STAGE(PG8_SA(0, 0), a2, voffA);
            PG8_BAR; PG8_WAIT_L(0); PG8_MMA(1, 0, At, B0); PG8_BAR; PG8_SCHED;
            PG8_STAGE(PG8_SB(0, 1), b2 + hstepB, voffB);
            PG8_WAIT_V(6); PG8_BAR; PG8_MMA(1, 1, At, B1); PG8_BAR;
            PG8_LDB(B0, 1, 0); PG8_SCHED; PG8_LDA(At, 1, 0); PG8_STAGE(PG8_SA(0, 1), a2 + hstepA, voffA);
            PG8_WAIT_L(8); PG8_BAR; PG8_WAIT_L(0); PG8_MMA(0, 0, At, B0); PG8_BAR; PG8_SCHED;
            PG8_LDB(B1, 1, 1); PG8_STAGE(PG8_SB(1, 0), b3, voffB);
            PG8_BAR; PG8_WAIT_L(0); PG8_MMA(0, 1, At, B1); PG8_BAR;
            PG8_LDA(At, 1, 1); PG8_STAGE(PG8_SA(1, 0), a3, voffA);
            PG8_BAR; PG8_WAIT_L(0); PG8_MMA(1, 0, At, B0); PG8_BAR; PG8_SCHED;
            PG8_STAGE(PG8_SB(1, 1), b3 + hstepB, voffB);
            PG8_WAIT_V(6); PG8_BAR; PG8_MMA(1, 1, At, B1); PG8_BAR;
            }
        }
        if constexpr (ALIGN_EPI) { if (wr == 0) PG8_BAR; }
        if constexpr (!Epi::AFTER_DRAIN) { E(acc, cur, wr, wc, fr, fq); S.done(cur); }
        if (!has_next) break;
#pragma unroll
        for (int a = 0; a < 2; ++a)
#pragma unroll
            for (int b = 0; b < 2; ++b)
#pragma unroll
                for (int m = 0; m < 4; ++m)
#pragma unroll
                    for (int n = 0; n < 2; ++n) acc[a][b][m][n] = (f32x4){0.f, 0.f, 0.f, 0.f};
        cur = nxt; cA = nA; cB = nB; ++ui;
        if constexpr (ALIGN_EPI) { if (wr == 1) PG8_BAR; }
    }
    PG8_WAIT_V(0);
    if constexpr (!ALIGN_EPI) { if (wr == 0) PG8_BAR; }
    PG8_BAR;
    if constexpr (Epi::AFTER_DRAIN) { E.fused(acc, cur, wr, wc, fr, fq, lds, wid, lane); S.done(cur); }
#undef PG8_SA
#undef PG8_SB
#undef PG8_STAGE
#undef PG8_LDA
#undef PG8_LDB
#undef PG8_MMA
#undef PG8_WAIT_V
#undef PG8_WAIT_L
#undef PG8_BAR
#undef PG8_SCHED
}
}

constexpr int NWAVES = 8, NT = 512;
constexpr int D = 1024, BATCH = 4, T = 8192, M = BATCH * T, DEPTH = 4, MEM = 256, MROWS = BATCH * MEM;
constexpr int DK = 128, CH = 64, NCH = T / CH;
constexpr int GLA_N = 4096, HGRN_N = 4608, FF = 4096, KOUT = 1536;
constexpr float EPS = 1e-6f;
constexpr size_t MiB = 1u << 20;
constexpr size_t WS_SS = 0;
constexpr size_t WS_DEC = 2 * MiB;
constexpr size_t WS_MEMB = 4 * MiB;
constexpr size_t WS_SSM = 6 * MiB;
constexpr size_t WS_LB = 6 * MiB + 65536;
constexpr size_t WS_KM = 8 * MiB;
constexpr size_t WS_VMT = 12 * MiB;
constexpr size_t WS_WKV = 16 * MiB;
constexpr size_t WS_WT = 24 * MiB, WT_BUF = 30 * MiB;
constexpr size_t WT_IN = 0, WT_OUT = 10 * MiB, WT_UP = 14 * MiB, WT_DOWN = 22 * MiB;
constexpr size_t WS_PROJ = 84 * MiB;
constexpr size_t WS_XB = 372 * MiB;
constexpr size_t WS_END = 500 * MiB;
constexpr int LDS_BYTES = 147456;

#define LAS __attribute__((address_space(3)))
typedef unsigned short bf16;
typedef float f32x4 __attribute__((ext_vector_type(4)));
typedef short bf16x8 __attribute__((ext_vector_type(8)));
typedef short bf16x4 __attribute__((ext_vector_type(4)));
typedef unsigned u32x4 __attribute__((ext_vector_type(4)));
typedef unsigned u32x2 __attribute__((ext_vector_type(2)));
__device__ __forceinline__ float bf2f(bf16 b) { return __uint_as_float(((unsigned)b) << 16); }
__device__ __forceinline__ unsigned f2bf(float f) { unsigned u = __float_as_uint(f); return (u + 0x7fffu + ((u >> 16) & 1u)) >> 16; }
__device__ __forceinline__ unsigned pk2(float lo, float hi) { return pg8::cvt_pk_bf16(lo, hi); }
__device__ __forceinline__ float wave_sum(float v, int lane) {
#pragma unroll
    for (int o = 1; o < 64; o <<= 1) v += pg8::shx(v, o, lane);
    return v;
}
#define MFMA16(a, b, c) __builtin_amdgcn_mfma_f32_16x16x32_bf16((a), (b), (c), 0, 0, 0)

constexpr size_t WS_CTL = 7 * MiB, CTL_BYTES = 16384;
constexpr int LDS_BARST = LDS_BYTES - 64;
#define XB_TMO      128
#define XB_XCNT(j)  (256  + 64 * (j))
#define XB_XSUB(j)  (1280 + 64 * (j))
#define XB_XGEN(j)  (2304 + 64 * (j))
#define XB_TOP      3328
#define XB_TOPGEN   3392
#define XCD_BAR_WORDS 3456
#define XB_SPIN_CAP (1u << 18)

__device__ __forceinline__ unsigned xb_ld(unsigned* p)              { return __hip_atomic_load(p, __ATOMIC_RELAXED, __HIP_MEMORY_SCOPE_AGENT); }
__device__ __forceinline__ unsigned xb_add(unsigned* p, unsigned v) { return __hip_atomic_fetch_add(p, v, __ATOMIC_RELAXED, __HIP_MEMORY_SCOPE_AGENT); }
__device__ __forceinline__ unsigned xb_xcc_id() { return (unsigned)__builtin_amdgcn_s_getreg((3 << 11) | 20) & 0xFu; }
#define XB_SPIN(cond, bar) do { unsigned _sp = 0; while (cond) { __builtin_amdgcn_s_sleep(1); \
    if ((++_sp & 255u) == 0u) { if (xb_ld(&(bar)[XB_TMO])) break; if (_sp > XB_SPIN_CAP) { atomicAdd(&(bar)[XB_TMO], 1u); break; } } } } while (0)

struct XcdBarrier {
    unsigned* bar; unsigned x;
    volatile LAS unsigned* st;
};

__device__ __forceinline__ XcdBarrier xcd_barrier_post(unsigned* bar, volatile LAS unsigned* st, int tid) {
    XcdBarrier b; b.bar = bar; b.x = xb_xcc_id(); b.st = st;
    if (tid == 0) (void)xb_add(&bar[XB_XCNT(b.x)], 1u);
    return b;
}
__device__ __forceinline__ void xcd_barrier_complete(unsigned* bar, unsigned x, unsigned& nloc, unsigned& nx) {
    const unsigned G = gridDim.x * gridDim.y * gridDim.z;
    unsigned sum, cnt, mine, sp = 0u;
    for (;;) {
        sum = 0u; cnt = 0u; mine = 0u;
#pragma unroll
        for (unsigned j = 0; j < 16; ++j) { const unsigned c = xb_ld(&bar[XB_XCNT(j)]); sum += c; cnt += (c > 0u) ? 1u : 0u; mine = (j == x) ? c : mine; }
        if (sum == G) break;
        __builtin_amdgcn_s_sleep(1);
        if ((++sp & 255u) == 0u) { if (xb_ld(&bar[XB_TMO])) break; if (sp > XB_SPIN_CAP) { atomicAdd(&bar[XB_TMO], 1u); break; } }
    }
    nloc = mine > 0u ? mine : 1u; nx = cnt > 0u ? cnt : 1u;
}

__device__ __forceinline__ void xcd_barrier(const XcdBarrier& b, int tid) {
    asm volatile("s_waitcnt vmcnt(0)" ::: "memory");
    __syncthreads();
    if (tid == 0) {
        unsigned* bar = b.bar;
        __builtin_amdgcn_s_waitcnt(0);
        unsigned nloc = b.st[0], nx = b.st[1];
        if (nloc == 0u) { xcd_barrier_complete(bar, b.x, nloc, nx); b.st[0] = nloc; b.st[1] = nx; }
        const unsigned old = xb_add(&bar[XB_XSUB(b.x)], 1u);
        const unsigned gen = old / nloc;
        if (old + 1u == (gen + 1u) * nloc) {
            __builtin_amdgcn_fence(__ATOMIC_RELEASE, "agent");
            asm volatile("s_waitcnt vmcnt(0)" ::: "memory");
            const unsigned og = xb_add(&bar[XB_TOP], 1u);
            const unsigned tg = og / nx;
            if (og + 1u == (tg + 1u) * nx) xb_add(&bar[XB_TOPGEN], 1u);
            else XB_SPIN(xb_ld(&bar[XB_TOPGEN]) == tg, bar);
            __builtin_amdgcn_fence(__ATOMIC_ACQUIRE, "agent");
            xb_add(&bar[XB_XGEN(b.x)], 1u);
            asm volatile("s_waitcnt vmcnt(0)" ::: "memory");
        } else {
            XB_SPIN(xb_ld(&bar[XB_XGEN(b.x)]) == gen, bar);
            __builtin_amdgcn_fence(__ATOMIC_ACQUIRE, "agent");
            asm volatile("s_waitcnt vmcnt(0)" ::: "memory");
        }
    }
    __syncthreads();
}

__device__ __forceinline__ void transpose_item(const float* W, int ldw, int K, int sc, bf16* WT, int dr, const float* gain, int gmask, int glimit, float scale, LAS float* scr, int item, int nblk, int lane) {
    const int kb = item / nblk, nb = item % nblk, k0 = 64 * kb, n0 = 32 * nb;
#pragma unroll 8
    for (int i = 0; i < 32; ++i) { const int kk = 2 * i + (lane >> 5); const int k = k0 + kk; float g = scale; if (gain && k < glimit) g *= gain[k & gmask];
        scr[kk * 33 + (lane & 31)] = W[(size_t)k * ldw + sc + n0 + (lane & 31)] * g; }
    asm volatile("s_waitcnt lgkmcnt(0)" ::: "memory");
    const int c = lane & 7;
#pragma unroll
    for (int j = 0; j < 4; ++j) { const int n = (lane >> 3) + 8 * j; const LAS float* s = scr + (8 * c) * 33 + n;
        u32x4 o; o.x = pk2(s[0 * 33], s[1 * 33]); o.y = pk2(s[2 * 33], s[3 * 33]); o.z = pk2(s[4 * 33], s[5 * 33]); o.w = pk2(s[6 * 33], s[7 * 33]);
        *(u32x4*)(WT + (size_t)(dr + n0 + n) * K + k0 + 8 * c) = o; }
    asm volatile("s_waitcnt lgkmcnt(0)" ::: "memory");
}
struct Ptrs {
    const float *x, *mem, *norm_mix, *norm_mem, *w_kv, *w_out, *norm_mlp, *w_up, *w_down, *gla_w_in, *gla_w_gate2, *gla_b_gate, *gla_out_gain, *hgrn_w_in, *hgrn_lb, *hgrn_out_gain, *final_norm;
    float* out; unsigned char* ws;
};
#define SEG(Wp, ldw, K, sc, ncols, WTp, dr, gain, gmask, glimit, scale) { const int nblk_ = (ncols) / 32, nit_ = ((K) / 64) * nblk_; \
    if (r < nit_) { transpose_item(Wp, ldw, K, sc, WTp, dr, gain, gmask, glimit, scale, scr, r, nblk_, lane); continue; } r -= nit_; }
template <class PT> __device__ __forceinline__ void convert_layer(PT Pp, int L, LAS unsigned char* lds, int gw, int ngw, int wave, int lane) {
    LAS float* scr = (LAS float*)(lds + wave * 16384);
    unsigned char* wb = Pp->ws + WS_WT + (size_t)(L & 1) * WT_BUF;
    bf16* Win = (bf16*)(wb + WT_IN); bf16* Wout = (bf16*)(wb + WT_OUT); bf16* Wup = (bf16*)(wb + WT_UP); bf16* Wdn = (bf16*)(wb + WT_DOWN);
    const int j = L >> 1; const bool hg = (L & 1);
    const float* gmix = Pp->norm_mix + (size_t)L * D; const float* gmlp = Pp->norm_mlp + (size_t)L * D;
    const float* wo = Pp->w_out + (size_t)L * KOUT * D; const float* wu = Pp->w_up + (size_t)L * D * FF; const float* wd = Pp->w_down + (size_t)L * FF * D;
    const float QS = 0.08838834764831845f;
    if (!hg) {
        const float* wi = Pp->gla_w_in + (size_t)j * D * 3600; const float* og = Pp->gla_out_gain + (size_t)j * 256;
        const int total = 16 * (16 + 16 + 32 + 32 + 16) + 24 * 32 + 16 * 128 + 64 * 32 + 128;
        for (int it = gw; it < total; it += ngw) { int r = it;
            SEG(wi, 3600, D, 0, 512, Win, 0, gmix, 1023, D, QS)
            SEG(wi, 3600, D, 512, 512, Win, 512, gmix, 1023, D, 1.f)
            SEG(wi, 3600, D, 1024, 1024, Win, 2560, gmix, 1023, D, 1.f)
            SEG(wi, 3600, D, 2064, 1024, Win, 1536, gmix, 1023, D, 1.f)
            SEG(wi, 3600, D, 3088, 512, Win, 3584, gmix, 1023, D, QS)
            SEG(wo, D, KOUT, 0, 1024, Wout, 0, og, 255, 1024, 1.f)
            SEG(wu, FF, D, 0, 4096, Wup, 0, gmlp, 1023, D, 1.f)
            SEG(wd, D, FF, 0, 1024, Wdn, 0, (const float*)nullptr, 0, 0, 1.f)
            { const int kb = r >> 3, cb = r & 7, k = kb * 64 + lane; const float* g2 = Pp->gla_w_gate2 + (size_t)j * 16 * 512 + cb * 64;
              const f32x4* wr4 = (const f32x4*)(wi + (size_t)k * 3600 + 2048); const f32x4 w0 = wr4[0], w1 = wr4[1], w2 = wr4[2], w3 = wr4[3]; const float gk = gmix[k];
              for (int c = 0; c < 64; ++c) { float s = 0.f;
#pragma unroll
                  for (int q = 0; q < 4; ++q) { s += w0[q] * g2[q * 512 + c]; s += w1[q] * g2[(4 + q) * 512 + c]; s += w2[q] * g2[(8 + q) * 512 + c]; s += w3[q] * g2[(12 + q) * 512 + c]; }
                  Win[(size_t)(1024 + cb * 64 + c) * D + k] = (bf16)f2bf(s * gk); } }
        }
    } else {
        const float* wi = Pp->hgrn_w_in + (size_t)j * D * 4608; const float* og = Pp->hgrn_out_gain + (size_t)j * 128;
        const int total = 16 * (32 + 32 + 32 + 32 + 16) + 24 * 32 + 16 * 128 + 64 * 32;
        for (int it = gw; it < total; it += ngw) { int r = it;
            SEG(wi, 4608, D, 0, 1024, Win, 0, gmix, 1023, D, 1.f)
            SEG(wi, 4608, D, 1024, 1024, Win, 1024, gmix, 1023, D, 1.f)
            SEG(wi, 4608, D, 2048, 1024, Win, 3072, gmix, 1023, D, 1.f)
            SEG(wi, 4608, D, 3072, 1024, Win, 2048, gmix, 1023, D, 1.f)
            SEG(wi, 4608, D, 4096, 512, Win, 4096, gmix, 1023, D, QS)
            SEG(wo, D, KOUT, 0, 1024, Wout, 0, og, 127, 1024, 1.f)
            SEG(wu, FF, D, 0, 4096, Wup, 0, gmlp, 1023, D, 1.f)
            { const int nblk_ = 32; transpose_item(wd, D, FF, 0, Wdn, 0, (const float*)nullptr, 0, 0, 1.f, scr, r, nblk_, lane); }
        }
    }
}
template <class PT> __device__ __forceinline__ void prologue(PT Pp, LAS unsigned char* lds, int gw, int ngw, int wave, int lane) {
    convert_layer(Pp, 0, lds, gw, ngw, wave, lane);
    { LAS float* scr = (LAS float*)(lds + wave * 16384); bf16* Wkv = (bf16*)(Pp->ws + WS_WKV);
      const int per = 16 * 32, total = 4 * per;
      for (int it = gw; it < total; it += ngw) { const int L = it / per, r = it % per;
          transpose_item(Pp->w_kv + (size_t)L * D * 1024, 1024, D, 0, Wkv + (size_t)L * 1024 * D, 0, Pp->norm_mem + (size_t)L * D, 1023, D, 1.f, scr, r, 32, lane); } }
    { float* LB = (float*)(Pp->ws + WS_LB);
      for (int c = gw * 64 + lane; c < 1024; c += ngw * 64) { const float v0 = Pp->hgrn_lb[c], v1 = Pp->hgrn_lb[1024 + c], v2 = Pp->hgrn_lb[2048 + c], v3 = Pp->hgrn_lb[3072 + c];
          const float mx = fmaxf(fmaxf(v0, v1), fmaxf(v2, v3)); const float e0 = expf(v0 - mx), e1 = expf(v1 - mx), e2 = expf(v2 - mx), e3 = expf(v3 - mx); const float inv = 1.0f / (e0 + e1 + e2 + e3);
          LB[c] = 0.f; LB[1024 + c] = e1 * inv; LB[2048 + c] = (e1 + e2) * inv; LB[3072 + c] = (e1 + e2 + e3) * inv; } }
    bf16* XB = (bf16*)Pp->out; float* SS = (float*)(Pp->ws + WS_SS);     bf16* MB = (bf16*)(Pp->ws + WS_MEMB); float* SSM = (float*)(Pp->ws + WS_SSM);
    for (int m = gw; m < M + MROWS; m += ngw) {
        const bool ism = m >= M; const int row = ism ? m - M : m;
        const f32x4* xr = (const f32x4*)((ism ? Pp->mem : Pp->x) + (size_t)row * D) + lane; unsigned long long* o8 = (unsigned long long*)((ism ? MB : XB) + (size_t)row * D) + lane;
        float s = 0.f;
#pragma unroll
        for (int j = 0; j < 4; ++j) { const f32x4 v = xr[64 * j]; s += (v.x * v.x + v.y * v.y) + (v.z * v.z + v.w * v.w); o8[64 * j] = (unsigned long long)pk2(v.x, v.y) | ((unsigned long long)pk2(v.z, v.w) << 32); }
        s = wave_sum(s, lane);
        if (ism) { if (lane == 0) SSM[row] = s; }
        else if (lane < 16) SS[(size_t)lane * M + row] = lane == 0 ? s : 0.f;
    }
}
constexpr int KT_STR = 144;
constexpr int QS_STR = 272;
constexpr int VS_STR = 528;
constexpr int L_TOT = 0;
constexpr int L_LA = 2048;
constexpr int L_QS = L_LA + 64 * QS_STR;
constexpr int L_KS = L_QS + 64 * QS_STR;
constexpr int L_VS = L_KS + 64 * QS_STR;
constexpr int L_VT = L_VS + 64 * VS_STR;
constexpr int L_KT = L_VT + 256 * KT_STR;
constexpr int L_AT = L_KT;
constexpr int L_RED = L_KT + 128 * KT_STR;
static_assert(L_RED + 2048 <= LDS_BYTES - 64, "mixer LDS map");

template <int DV>
__device__ __forceinline__ void load_raw_v(const bf16* base, int ld, int vcol, int tid, u32x4 (&rv)[DV / 64]) {
#pragma unroll
    for (int i = 0; i < DV / 64; ++i) { const int c = tid + i * NT, row = c / (DV / 8), part = c % (DV / 8); rv[i] = *(const u32x4*)(base + (size_t)row * ld + vcol + part * 8); }
}
template <int DV>
__device__ __forceinline__ void store_raw_v(LAS unsigned char* lds, int tid, const u32x4 (&rv)[DV / 64]) {
#pragma unroll
    for (int i = 0; i < DV / 64; ++i) { const int c = tid + i * NT, row = c / (DV / 8), part = c % (DV / 8); *(LAS u32x4*)(lds + L_VS + row * VS_STR + part * 16) = rv[i]; }
}
__device__ __forceinline__ void load_raw128(const bf16* base, int ld, int col, int tid, u32x4 (&r)[2]) {
#pragma unroll
    for (int i = 0; i < 2; ++i) { const int c = tid + i * NT; r[i] = *(const u32x4*)(base + (size_t)(c >> 4) * ld + col + (c & 15) * 8); }
}
__device__ __forceinline__ void store_raw128(LAS unsigned char* lds, int off, int tid, const u32x4 (&r)[2]) {
#pragma unroll
    for (int i = 0; i < 2; ++i) { const int c = tid + i * NT; *(LAS u32x4*)(lds + off + (c >> 4) * QS_STR + (c & 15) * 16) = r[i]; }
}
template <int DV>
__device__ __forceinline__ void transpose_v(LAS unsigned char* lds, int tid) {
    constexpr int RPT = DV / 8;
    const int v = tid % DV, part = tid / DV;
    unsigned w[RPT / 2];
#pragma unroll
    for (int i = 0; i < RPT / 2; ++i) { const unsigned lo = *(const LAS bf16*)(lds + L_VS + (part * RPT + 2 * i) * VS_STR + v * 2), hi = *(const LAS bf16*)(lds + L_VS + (part * RPT + 2 * i + 1) * VS_STR + v * 2); w[i] = lo | (hi << 16); }
    LAS u32x4* dst = (LAS u32x4*)(lds + L_VT + v * KT_STR + part * RPT * 2);
#pragma unroll
    for (int i = 0; i < RPT / 8; ++i) dst[i] = (u32x4){w[4 * i], w[4 * i + 1], w[4 * i + 2], w[4 * i + 3]};
}
__device__ __forceinline__ void cumsum_local(LAS unsigned char* lds, int d, int rg, float (&bb)[16]) {
#pragma unroll
    for (int i = 0; i < 16; ++i) bb[i] = bf2f(*(const LAS bf16*)(lds + L_LA + (rg * 16 + i) * QS_STR + d * 2));
}
__device__ __forceinline__ void cumsum_scan(LAS unsigned char* lds, int d, int rg, float (&bb)[16]) {
#pragma unroll
    for (int i = 1; i < 16; ++i) bb[i] += bb[i - 1];
    ((LAS float*)(lds + L_TOT))[rg * 128 + d] = bb[15];
}
__device__ __forceinline__ void cumsum_finish(LAS unsigned char* lds, int d, int rg, float (&bb)[16], float& blast) {
    const LAS float* tot = (const LAS float*)(lds + L_TOT);
    const float t0 = tot[d], t1 = tot[128 + d], t2 = tot[256 + d], t3 = tot[384 + d];
    const float off = rg == 0 ? 0.f : (rg == 1 ? t0 : (rg == 2 ? t0 + t1 : t0 + t1 + t2));
    blast = (t0 + t1) + (t2 + t3);
#pragma unroll
    for (int i = 0; i < 16; ++i) bb[i] += off;
}
template <int DV, bool HGRN>
__device__ __forceinline__ void pass_a(LAS unsigned char* lds, const bf16* proj, bf16* GS, float* DEC, int G, int bid, const int tid) {
    constexpr int H = HGRN ? 8 : 4, LD = HGRN ? HGRN_N : GLA_N, NTW = DV / 128, NU = BATCH * H * NCH;
    const int lane = tid & 63, wave = tid >> 6, g = lane >> 4, l15 = lane & 15, d = tid & 127, rg = tid >> 7;
    u32x4 rla[2], rk[2], rv[DV / 64];
    int u = bid;
    if (u < NU) { const int b = u / (H * NCH), h = (u / NCH) % H, n = u % NCH; const bf16* base = proj + (size_t)(b * T + n * CH) * LD;
        load_raw128(base, LD, 1024 + h * 128, tid, rla); if (!HGRN) load_raw128(base, LD, 512 + h * 128, tid, rk); load_raw_v<DV>(base, LD, (HGRN ? 3072 : 2560) + h * DV, tid, rv); }
    for (; u < NU; u += G) {
        store_raw128(lds, L_LA, tid, rla); if (!HGRN) store_raw128(lds, L_KS, tid, rk); store_raw_v<DV>(lds, tid, rv);
        __syncthreads();
        { const int un = u + G; if (un < NU) { const int b = un / (H * NCH), h = (un / NCH) % H, n = un % NCH; const bf16* base = proj + (size_t)(b * T + n * CH) * LD;
            load_raw128(base, LD, 1024 + h * 128, tid, rla); if (!HGRN) load_raw128(base, LD, 512 + h * 128, tid, rk); load_raw_v<DV>(base, LD, (HGRN ? 3072 : 2560) + h * DV, tid, rv); } }
        float bb[16], kv[16], blast;
        cumsum_local(lds, d, rg, bb);
#pragma unroll
        for (int i = 0; i < 16; ++i) kv[i] = HGRN ? (1.0f - __expf(bb[i])) : bf2f(*(const LAS bf16*)(lds + L_KS + (rg * 16 + i) * QS_STR + d * 2));
        cumsum_scan(lds, d, rg, bb);
        transpose_v<DV>(lds, tid);
        __syncthreads();
        cumsum_finish(lds, d, rg, bb, blast);
        { unsigned w[8];
#pragma unroll
          for (int i = 0; i < 8; ++i) w[i] = pk2(kv[2 * i] * __expf(-bb[2 * i]), kv[2 * i + 1] * __expf(-bb[2 * i + 1]));
          LAS u32x4* dst = (LAS u32x4*)(lds + L_KT + d * KT_STR + rg * 32);
          dst[0] = (u32x4){w[0], w[1], w[2], w[3]}; dst[1] = (u32x4){w[4], w[5], w[6], w[7]}; }
        if (rg == 0) DEC[(size_t)u * 128 + d] = __expf(blast);
        __syncthreads();
        f32x4 acc[8][NTW];
#pragma unroll
        for (int mt = 0; mt < 8; ++mt)
#pragma unroll
            for (int nt = 0; nt < NTW; ++nt) acc[mt][nt] = (f32x4){0.f, 0.f, 0.f, 0.f};
#pragma unroll
        for (int kk = 0; kk < 2; ++kk) {
            bf16x8 bfr[NTW];
#pragma unroll
            for (int nt = 0; nt < NTW; ++nt) bfr[nt] = *(const LAS bf16x8*)(lds + L_VT + ((wave * NTW + nt) * 16 + l15) * KT_STR + (kk * 32 + 8 * g) * 2);
#pragma unroll
            for (int mt = 0; mt < 8; ++mt) { const bf16x8 afr = *(const LAS bf16x8*)(lds + L_KT + (mt * 16 + l15) * KT_STR + (kk * 32 + 8 * g) * 2);
#pragma unroll
                for (int nt = 0; nt < NTW; ++nt) acc[mt][nt] = MFMA16(afr, bfr[nt], acc[mt][nt]); }
        }
#pragma unroll
        for (int mt = 0; mt < 8; ++mt)
#pragma unroll
            for (int nt = 0; nt < NTW; ++nt) asm volatile("s_nop 7\n\ts_nop 7" : "+v"(acc[mt][nt]));
#pragma unroll
        for (int nt = 0; nt < NTW; ++nt) { bf16* gp = GS + ((size_t)u * DV + (wave * NTW + nt) * 16 + l15) * 128 + 4 * g;
#pragma unroll
            for (int mt = 0; mt < 8; ++mt) { u32x2 w; w.x = pk2(acc[mt][nt][0], acc[mt][nt][1]); w.y = pk2(acc[mt][nt][2], acc[mt][nt][3]); *(u32x2*)(gp + mt * 16) = w; } }
    }
    __syncthreads();
}
template <int DV, bool HGRN, bool DRY = false>
__device__ __forceinline__ void pass_b(bf16* GS, const float* DEC, int G, int bid, const int tid) {
    constexpr int H = HGRN ? 8 : 4, E = DV * 128, E4 = E / 4;
    const int nthreads = G * NT;
    for (int i = bid * NT + tid; i < BATCH * H * E4; i += nthreads) {
        const int bh = i / E4, e = (i % E4) * 4, d = e & 127;
        float S0 = 0.f, S1 = 0.f, S2 = 0.f, S3 = 0.f;
        u32x2* gp = (u32x2*)(GS + (size_t)bh * NCH * E + e); const f32x4* dp = (const f32x4*)(DEC + (size_t)bh * NCH * 128 + d);
        for (int n0 = 0; n0 < NCH; n0 += 8) {
            u32x2 gv[8]; f32x4 dv[8];
#pragma unroll
            for (int q = 0; q < 8; ++q) { gv[q] = gp[(size_t)(n0 + q) * (E / 4)]; dv[q] = dp[(size_t)(n0 + q) * 32]; }
#pragma unroll
            for (int q = 0; q < 8; ++q) {
                u32x2 o; o.x = pk2(S0, S1); o.y = pk2(S2, S3); if (!DRY || o.x == 0x12345678u) gp[(size_t)(n0 + q) * (E / 4)] = o;
                S0 = dv[q].x * (S0 + __uint_as_float(gv[q].x << 16)); S1 = dv[q].y * (S1 + __uint_as_float(gv[q].x & 0xffff0000u));
                S2 = dv[q].z * (S2 + __uint_as_float(gv[q].y << 16)); S3 = dv[q].w * (S3 + __uint_as_float(gv[q].y & 0xffff0000u)); }
        }
    }
}
template <int DV, bool HGRN, bool DRY = false>
__device__ __forceinline__ void pass_c(LAS unsigned char* lds, bf16* proj, const bf16* GS, int G, int bid, const int tid) {
    constexpr int H = HGRN ? 8 : 4, LD = HGRN ? HGRN_N : GLA_N, MTW = DV / 128, NU = BATCH * H * NCH;
    const int lane = tid & 63, wave = tid >> 6, g = lane >> 4, l15 = lane & 15, d = tid & 127, rg = tid >> 7;
    const int v0 = wave * MTW * 16;
    u32x4 rla[2], rq[2], rk[2], rv[DV / 64];
    int u = bid;
    if (u < NU) { const int b = u / (H * NCH), h = (u / NCH) % H, n = u % NCH; const bf16* base = proj + (size_t)(b * T + n * CH) * LD;
        load_raw128(base, LD, 1024 + h * 128, tid, rla); load_raw128(base, LD, h * 128, tid, rq); if (!HGRN) load_raw128(base, LD, 512 + h * 128, tid, rk); load_raw_v<DV>(base, LD, (HGRN ? 3072 : 2560) + h * DV, tid, rv); }
    for (; u < NU; u += G) {
        const int b = u / (H * NCH), h = (u / NCH) % H, n = u % NCH;
        bf16* base = proj + (size_t)(b * T + n * CH) * LD;
        const int vcol = (HGRN ? 3072 : 2560) + h * DV, gcol = (HGRN ? 2048 : 1536) + h * DV;
        store_raw128(lds, L_LA, tid, rla); store_raw128(lds, L_QS, tid, rq); if (!HGRN) store_raw128(lds, L_KS, tid, rk); store_raw_v<DV>(lds, tid, rv);
        __syncthreads();
        bf16x8 sfr[4][MTW];
#pragma unroll
        for (int kk = 0; kk < 4; ++kk)
#pragma unroll
            for (int mt = 0; mt < MTW; ++mt) sfr[kk][mt] = *(const bf16x8*)(GS + ((size_t)u * DV + v0 + mt * 16 + l15) * 128 + kk * 32 + 8 * g);
        { const int un = u + G; if (un < NU) { const int b2 = un / (H * NCH), h2 = (un / NCH) % H, n2 = un % NCH; const bf16* nb = proj + (size_t)(b2 * T + n2 * CH) * LD;
            load_raw128(nb, LD, 1024 + h2 * 128, tid, rla); load_raw128(nb, LD, h2 * 128, tid, rq); if (!HGRN) load_raw128(nb, LD, 512 + h2 * 128, tid, rk); load_raw_v<DV>(nb, LD, (HGRN ? 3072 : 2560) + h2 * DV, tid, rv); } }
        float bb[16], kv[16], blast;
        cumsum_local(lds, d, rg, bb);
#pragma unroll
        for (int i = 0; i < 16; ++i) kv[i] = HGRN ? (1.0f - __expf(bb[i])) : bf2f(*(const LAS bf16*)(lds + L_KS + (rg * 16 + i) * QS_STR + d * 2));
        cumsum_scan(lds, d, rg, bb);
        transpose_v<DV>(lds, tid);
        __syncthreads();
        cumsum_finish(lds, d, rg, bb, blast);
#pragma unroll
        for (int i = 0; i < 16; ++i) { const int s = rg * 16 + i; LAS bf16* qa = (LAS bf16*)(lds + L_QS + s * QS_STR + d * 2); LAS bf16* ka = (LAS bf16*)(lds + L_KS + s * QS_STR + d * 2);
            const float q = bf2f(*qa); *qa = (bf16)f2bf(q * __expf(bb[i])); *ka = (bf16)f2bf(kv[i] * __expf(-bb[i])); }
        __syncthreads();
        { const int tt = wave >> 1;
#pragma unroll
          for (int si = 0; si < 2; ++si) { const int st = (wave & 1) * 2 + si; f32x4 c = (f32x4){0.f, 0.f, 0.f, 0.f};
#pragma unroll
              for (int kk = 0; kk < 4; ++kk) { const bf16x8 afr = *(const LAS bf16x8*)(lds + L_KS + (st * 16 + l15) * QS_STR + (kk * 32 + 8 * g) * 2);
                  const bf16x8 bfr = *(const LAS bf16x8*)(lds + L_QS + (tt * 16 + l15) * QS_STR + (kk * 32 + 8 * g) * 2); c = MFMA16(afr, bfr, c); }
              const int t = tt * 16 + l15, s0 = st * 16 + 4 * g;
              u32x2 w; w.x = pk2(s0 <= t ? c[0] : 0.f, s0 + 1 <= t ? c[1] : 0.f); w.y = pk2(s0 + 2 <= t ? c[2] : 0.f, s0 + 3 <= t ? c[3] : 0.f);
              *(LAS u32x2*)(lds + L_AT + t * KT_STR + s0 * 2) = w; } }
        u32x2 gt[4][MTW];
#pragma unroll
        for (int nt = 0; nt < 4; ++nt)
#pragma unroll
            for (int mt = 0; mt < MTW; ++mt) gt[nt][mt] = *(const u32x2*)(base + (size_t)(nt * 16 + l15) * LD + gcol + v0 + mt * 16 + 4 * g);
        __syncthreads();
        f32x4 acc[MTW][4];
#pragma unroll
        for (int mt = 0; mt < MTW; ++mt)
#pragma unroll
            for (int nt = 0; nt < 4; ++nt) acc[mt][nt] = (f32x4){0.f, 0.f, 0.f, 0.f};
#pragma unroll
        for (int kk = 0; kk < 4; ++kk) {
#pragma unroll
            for (int nt = 0; nt < 4; ++nt) { const bf16x8 bfr = *(const LAS bf16x8*)(lds + L_QS + (nt * 16 + l15) * QS_STR + (kk * 32 + 8 * g) * 2);
#pragma unroll
                for (int mt = 0; mt < MTW; ++mt) acc[mt][nt] = MFMA16(sfr[kk][mt], bfr, acc[mt][nt]); }
        }
#pragma unroll
        for (int kk = 0; kk < 2; ++kk) {
            bf16x8 afr[MTW];
#pragma unroll
            for (int mt = 0; mt < MTW; ++mt) afr[mt] = *(const LAS bf16x8*)(lds + L_VT + (v0 + mt * 16 + l15) * KT_STR + (kk * 32 + 8 * g) * 2);
#pragma unroll
            for (int nt = 0; nt < 4; ++nt) { const bf16x8 bfr = *(const LAS bf16x8*)(lds + L_AT + (nt * 16 + l15) * KT_STR + (kk * 32 + 8 * g) * 2);
#pragma unroll
                for (int mt = 0; mt < MTW; ++mt) acc[mt][nt] = MFMA16(afr[mt], bfr, acc[mt][nt]); }
        }
        LAS float* red = (LAS float*)(lds + L_RED);
#pragma unroll
        for (int nt = 0; nt < 4; ++nt) { float p = 0.f;
#pragma unroll
            for (int mt = 0; mt < MTW; ++mt) p += (acc[mt][nt][0] * acc[mt][nt][0] + acc[mt][nt][1] * acc[mt][nt][1]) + (acc[mt][nt][2] * acc[mt][nt][2] + acc[mt][nt][3] * acc[mt][nt][3]);
            p += pg8::shx(p, 16, lane); p += pg8::shx(p, 32, lane);
            if (g == 0) red[wave * 64 + nt * 16 + l15] = p; }
        __syncthreads();
#pragma unroll
        for (int nt = 0; nt < 4; ++nt) { const int t = nt * 16 + l15; float s = 0.f;
#pragma unroll
            for (int w = 0; w < 8; ++w) s += red[w * 64 + t];
            const float rstd = rsqrtf(s * (1.0f / DV) + EPS);
            bf16* rowp = base + (size_t)t * LD;
#pragma unroll
            for (int mt = 0; mt < MTW; ++mt) { const int v = v0 + mt * 16 + 4 * g; const u32x2 gg = gt[nt][mt];
                u32x2 w; w.x = pk2(acc[mt][nt][0] * rstd * __uint_as_float(gg.x << 16), acc[mt][nt][1] * rstd * __uint_as_float(gg.x & 0xffff0000u));
                w.y = pk2(acc[mt][nt][2] * rstd * __uint_as_float(gg.y << 16), acc[mt][nt][3] * rstd * __uint_as_float(gg.y & 0xffff0000u));
                if (!DRY || w.x == 0x12345678u) *(u32x2*)(rowp + vcol + v) = w; } }
    }
    __syncthreads();
}
constexpr int KL_STR = 272, VL_STR = 528, L_KL = 0, L_VL = 256 * KL_STR;
static_assert(L_VL + 128 * VL_STR <= LDS_BYTES, "xattn LDS map");
template <bool DRY = false>
__device__ __forceinline__ void xattn(LAS unsigned char* lds, bf16* proj, int LD, int xcol, const bf16* KM, const bf16* VMT, int G, int bid, const int tid) {
    const int lane = tid & 63, wave = tid >> 6, g = lane >> 4, l15 = lane & 15;
    for (int w = bid; w < 256; w += G) {
        const int pair = w >> 4, sub = w & 15, b = pair >> 2, h = pair & 3;
        __syncthreads();
#pragma unroll
        for (int i = 0; i < 8; ++i) { const int c = tid + i * NT, m = c >> 4, part = c & 15;
            *(LAS u32x4*)(lds + L_KL + m * KL_STR + part * 16) = *(const u32x4*)(KM + (size_t)(b * 256 + m) * 512 + h * 128 + part * 8); }
#pragma unroll
        for (int i = 0; i < 8; ++i) { const int c = tid + i * NT, dd = c >> 5, part = c & 31;
            *(LAS u32x4*)(lds + L_VL + dd * VL_STR + part * 16) = *(const u32x4*)(VMT + ((size_t)b * 512 + h * 128 + dd) * 256 + part * 8); }
        __syncthreads();
        for (int tile = 0; tile < 4; ++tile) {
            const int r0 = b * T + (sub * 4 + tile) * 128 + wave * 16;
            bf16* qp = proj + (size_t)(r0 + l15) * LD + xcol + h * 128;
            bf16x8 qf[4];
#pragma unroll
            for (int kk = 0; kk < 4; ++kk) qf[kk] = *(const bf16x8*)(qp + kk * 32 + 8 * g);
            f32x4 sc[16];
#pragma unroll
            for (int mt = 0; mt < 16; ++mt) { f32x4 c = (f32x4){0.f, 0.f, 0.f, 0.f};
#pragma unroll
                for (int kk = 0; kk < 4; ++kk) { const bf16x8 afr = *(const LAS bf16x8*)(lds + L_KL + (mt * 16 + l15) * KL_STR + (kk * 32 + 8 * g) * 2); c = MFMA16(afr, qf[kk], c); }
                sc[mt] = c; }
            float mx = -1e30f;
#pragma unroll
            for (int mt = 0; mt < 16; ++mt) mx = fmaxf(mx, fmaxf(fmaxf(sc[mt][0], sc[mt][1]), fmaxf(sc[mt][2], sc[mt][3])));
            mx = fmaxf(mx, pg8::shx(mx, 16, lane)); mx = fmaxf(mx, pg8::shx(mx, 32, lane));
            float sum = 0.f;
#pragma unroll
            for (int mt = 0; mt < 16; ++mt) {
#pragma unroll
                for (int j = 0; j < 4; ++j) { const float p = __expf(sc[mt][j] - mx); sc[mt][j] = p; sum += p; } }
            sum += pg8::shx(sum, 16, lane); sum += pg8::shx(sum, 32, lane);
            const float inv = 1.0f / sum;
            f32x4 oa[8];
#pragma unroll
            for (int dt = 0; dt < 8; ++dt) oa[dt] = (f32x4){0.f, 0.f, 0.f, 0.f};
#pragma unroll
            for (int kb = 0; kb < 8; ++kb) {
                union { bf16x8 v; unsigned u[4]; } pb;
                pb.u[0] = pk2(sc[2 * kb][0], sc[2 * kb][1]); pb.u[1] = pk2(sc[2 * kb][2], sc[2 * kb][3]); pb.u[2] = pk2(sc[2 * kb + 1][0], sc[2 * kb + 1][1]); pb.u[3] = pk2(sc[2 * kb + 1][2], sc[2 * kb + 1][3]);
#pragma unroll
                for (int dt = 0; dt < 8; ++dt) { union { bf16x8 v; u32x2 h[2]; } pa; const LAS unsigned char* vp = lds + L_VL + (dt * 16 + l15) * VL_STR + (kb * 32 + 4 * g) * 2;
                    pa.h[0] = *(const LAS u32x2*)vp; pa.h[1] = *(const LAS u32x2*)(vp + 32); oa[dt] = MFMA16(pa.v, pb.v, oa[dt]); }
            }
#pragma unroll
            for (int dt = 0; dt < 8; ++dt) { u32x2 o; o.x = pk2(oa[dt][0] * inv, oa[dt][1] * inv); o.y = pk2(oa[dt][2] * inv, oa[dt][3] * inv); if (!DRY || o.x == 0x12345678u) *(u32x2*)(qp + dt * 16 + 4 * g) = o; }
        }
    }
    __syncthreads();
}
__device__ __forceinline__ void final_norm(float* out, const bf16* XB, const float* SS, const float* gain, int gw, int ngw, int lane) {
    f32x4 gv[4];
#pragma unroll
    for (int j = 0; j < 4; ++j) gv[j] = ((const f32x4*)gain)[lane + 64 * j];
    for (int m = gw; m < M; m += ngw) {
        float s = lane < 16 ? SS[(size_t)lane * M + m] : 0.f; s = wave_sum(s, lane);
        const float rstd = rsqrtf(s * (1.0f / D) + EPS);
        const u32x2* xr = (const u32x2*)(XB + (size_t)m * D) + lane; f32x4* orow = (f32x4*)(out + (size_t)m * D) + lane;
#pragma unroll
        for (int j = 0; j < 4; ++j) { const u32x2 xw = xr[64 * j]; f32x4 v = (f32x4){__uint_as_float(xw.x << 16), __uint_as_float(xw.x & 0xffff0000u), __uint_as_float(xw.y << 16), __uint_as_float(xw.y & 0xffff0000u)};
            orow[64 * j] = v * rstd * gv[j]; }
    }
}

struct Args { Ptrs P; int ph_lo, ph_hi; };
constexpr int N_PHASES = 2 + 7 * DEPTH;
__global__ void __launch_bounds__(NT, 2) fwd_kernel(Args a) {
    extern __shared__ __attribute__((aligned(16))) unsigned char lds_raw[];
#if ONE_LAUNCH
    cg::grid_group grid = cg::this_grid();
    { volatile LAS unsigned* st = (volatile LAS unsigned*)((LAS unsigned char*)lds_raw + LDS_BARST); int t0_ = threadIdx.x; if (t0_ == 0) { st[0] = 0u; st[1] = 0u; } __syncthreads();
      (void)xcd_barrier_post((unsigned*)(a.P.ws + WS_CTL), st, t0_); }
#define SEAM() do { XcdBarrier xb_; xb_.bar = (unsigned*)(ws + WS_CTL); xb_.x = xb_xcc_id(); xb_.st = (volatile LAS unsigned*)(lds + LDS_BARST); xcd_barrier(xb_, tid); if (ph == 0) grid.sync(); } while (0)
#else
#define SEAM() do {} while (0)
#endif
    const int ph_lo = a.ph_lo, ph_hi = a.ph_hi;
    const int wave0 = __builtin_amdgcn_readfirstlane(threadIdx.x >> 6);
    for (int ph = ph_lo; ph < ph_hi; ++ph) {
        const __attribute__((address_space(4))) Args* ap = (const __attribute__((address_space(4))) Args*)__builtin_amdgcn_kernarg_segment_ptr();
        asm volatile("" : "+s"(ap));
        int zero_ = 0; asm volatile("" : "+v"(zero_));
        int tid = wave0 * 64 + (int)__builtin_amdgcn_mbcnt_hi(~0u, __builtin_amdgcn_mbcnt_lo(~0u, (unsigned)zero_)); asm volatile("" : "+v"(tid));
        LAS unsigned char* lds = (LAS unsigned char*)lds_raw;
        const int lane = tid & 63, wave = __builtin_amdgcn_readfirstlane(tid >> 6);
        int G = gridDim.x, bid = blockIdx.x; asm volatile("" : "+s"(G), "+s"(bid));
        const int gw = bid * NWAVES + wave, ngw = G * NWAVES;
        unsigned char* ws = ap->P.ws;
        float* SS = (float*)(ws + WS_SS); bf16* XB = (bf16*)ap->P.out; bf16* GS = (bf16*)(ws + WS_XB); bf16* X2 = (bf16*)(ws + WS_XB); bf16* PROJ = (bf16*)(ws + WS_PROJ);
        int ngemm = 0;
        int L = 0, sp = 0; bool hg = false;
        if (ph == 0) { prologue(&ap->P, lds, gw, ngw, wave, lane); }
        else if (ph == N_PHASES - 1) { final_norm(ap->P.out, X2, SS, ap->P.final_norm, gw, ngw, lane); }
        else {
            L = (ph - 1) / 7; sp = (ph - 1) % 7; hg = (L & 1);
            const int LD = hg ? HGRN_N : GLA_N;
            if (sp == 0) ngemm = (L == 0) ? 2 : 1;
            else if (sp == 1) {
                float* DEC = (float*)(ws + WS_DEC);
#if EXP == 3
                if (hg) pass_a<128, true>(lds, PROJ, GS, DEC, G, bid, tid); else pass_a<256, false>(lds, PROJ, GS, DEC, G, bid, tid);
#endif
                if (hg) pass_a<128, true>(lds, PROJ, GS, DEC, G, bid, tid); else pass_a<256, false>(lds, PROJ, GS, DEC, G, bid, tid);
#if EXP == 5
                xattn<true>(lds, PROJ, LD, hg ? 4096 : 3584, (const bf16*)(ws + WS_KM) + (size_t)L * 1024 * 512, (const bf16*)(ws + WS_VMT) + (size_t)L * 4 * 512 * 256, G, bid, tid);
#endif
#if EXP == 6
                if (L + 1 < DEPTH) { convert_layer(&ap->P, L + 1, lds, gw, ngw, wave, lane); } __syncthreads();
#endif
                xattn(lds, PROJ, LD, hg ? 4096 : 3584, (const bf16*)(ws + WS_KM) + (size_t)L * 1024 * 512, (const bf16*)(ws + WS_VMT) + (size_t)L * 4 * 512 * 256, G, bid, tid);
                if (L + 1 < DEPTH) { convert_layer(&ap->P, L + 1, lds, gw, ngw, wave, lane); }
            } else if (sp == 2) {
                const float* DEC = (const float*)(ws + WS_DEC);
#if EXP == 3
                if (hg) pass_b<128, true, true>(GS, DEC, G, bid, tid); else pass_b<256, false, true>(GS, DEC, G, bid, tid);
#endif
                if (hg) pass_b<128, true>(GS, DEC, G, bid, tid); else pass_b<256, false>(GS, DEC, G, bid, tid);
            } else if (sp == 3) {
#if EXP == 4
                if (hg) pass_c<128, true, true>(lds, PROJ, GS, G, bid, tid); else pass_c<256, false, true>(lds, PROJ, GS, G, bid, tid);
#endif
                if (hg) pass_c<128, true>(lds, PROJ, GS, G, bid, tid); else pass_c<256, false>(lds, PROJ, GS, G, bid, tid);
            } else ngemm = 1;
            if (EXP == 2 && (sp == 0 || sp == 5)) ngemm += 8;
        }
        for (int rep = 0; rep < (ngemm & 7) * (ngemm >= 8 ? 2 : 1); ++rep) {
            unsigned char* wb = ws + WS_WT + (size_t)(L & 1) * WT_BUF;
            const int LD = hg ? HGRN_N : GLA_N;
            pg8::Gemm g; pg8::EpiAll E; E.hgrn = hg ? 1 : 0; E.M = M; E.aux = nullptr; E.xin = nullptr; E.xout = nullptr;
            if (sp == 0 && (ngemm & 7) == 2 && (rep & 7) == 0 && rep < 8) {
                g.A = (const bf16*)(ws + WS_MEMB); g.Bt = (const bf16*)(ws + WS_WKV); g.M = MROWS; g.N = 4096; g.K = D; g.lda = D; g.perm = 0;
                E.kind = 3; E.ldc = 0; E.O = (bf16*)(ws + WS_KM); E.ss = (const float*)(ws + WS_SSM); E.xout = (float*)(ws + WS_VMT);
            } else if (sp == 0) {
                g.A = XB; g.Bt = (const bf16*)(wb + WT_IN); g.M = M; g.N = LD; g.K = D; g.lda = D; g.perm = 1;
                E.kind = 0; E.ldc = LD; E.O = PROJ; E.ss = SS; E.aux = hg ? (const float*)(ws + WS_LB) + (size_t)L * 1024 : ap->P.gla_b_gate + (size_t)(L >> 1) * 512;
            } else if (sp == 4) {
                g.A = PROJ + (hg ? 3072 : 2560); g.Bt = (const bf16*)(wb + WT_OUT); g.M = M; g.N = D; g.K = KOUT; g.lda = LD; g.perm = 1;
                E.kind = 2; E.ldc = D; E.O = XB; E.ss = SS; E.xin = (L == 0) ? ap->P.x : nullptr; E.xout = (float*)XB;
            } else if (sp == 5) {
                g.A = XB; g.Bt = (const bf16*)(wb + WT_UP); g.M = M; g.N = FF; g.K = D; g.lda = D; g.perm = 1;
                E.kind = 1; E.ldc = FF; E.O = PROJ; E.ss = SS;
            } else {
                g.A = PROJ; g.Bt = (const bf16*)(wb + WT_DOWN); g.M = M; g.N = D; g.K = FF; g.lda = FF; g.perm = 1;
                E.kind = 2; E.ldc = D; E.O = XB; E.ss = SS; E.xout = (float*)((L == DEPTH - 1) ? X2 : XB);
            }
#if EXP == 9
            if (E.kind == 2) { pg8::Gemm g2 = g; g2.perm = 1; pg8::EpiAll E2 = E; E2.kind = 1; E2.ldc = D; E2.O = GS; E2.ss = SS; E2.xin = nullptr;
                pg8::StaticOrder S2; S2.init(g2.M, g2.N, G, bid); pg8::gemm_phase<pg8::EpiAll, pg8::StaticOrder, true, true>(lds, g2, S2, E2, tid); }
#endif
            pg8::StaticOrder S; S.init(g.M, g.N, G, bid);
#if SKEW_TICKS > 0
            if (E.kind <= 1) {
                const unsigned long long t0_ = __builtin_amdgcn_s_memrealtime(); const unsigned long long dl_ = (unsigned long long)((bid & 7) * SKEW_TICKS);
                while (__builtin_amdgcn_s_memrealtime() - t0_ < dl_) __builtin_amdgcn_s_sleep(8);
            }
#endif
            pg8::gemm_phase<pg8::EpiAll, pg8::StaticOrder, true, true>(lds, g, S, E, tid);
        }
        if (ph + 1 < ph_hi) { SEAM(); }
#if EXP == 7
        if (ph + 1 < ph_hi) { SEAM(); }
#endif
    }
}

extern "C" void kernel_launch(void* const* d_in, const int* in_sizes, int n_in, void* d_out, int out_size, void* d_ws, size_t ws_size, hipStream_t stream) {
    static int grid = 0;
    if (grid == 0) {
        if (n_in != 17 || out_size != M * D || ws_size < WS_END) { fprintf(stderr, "kernel_launch: unexpected shapes (n_in %d out %d ws %zu)\n", n_in, out_size, ws_size); grid = -1; return; }
        int dev = 0, cus = 0, per_cu = 0;
        hipGetDevice(&dev); hipDeviceGetAttribute(&cus, hipDeviceAttributeMultiprocessorCount, dev);
        if (hipFuncSetAttribute((const void*)fwd_kernel, hipFuncAttributeMaxDynamicSharedMemorySize, LDS_BYTES) != hipSuccess) { fprintf(stderr, "kernel_launch: hipFuncSetAttribute failed\n"); grid = -1; return; }
        if (hipOccupancyMaxActiveBlocksPerMultiprocessor(&per_cu, (const void*)fwd_kernel, NT, LDS_BYTES) != hipSuccess || per_cu < 1) { fprintf(stderr, "kernel_launch: occupancy query says %d\n", per_cu); per_cu = 1; }
        (void)hipGetLastError();
        grid = cus * per_cu;
        if (grid > 256) grid = 256;
        grid = (grid / 16) * 16;
        fprintf(stderr, "kernel_launch: grid %d (cus %d per_cu %d)\n", grid, cus, per_cu);
    }
    if (grid <= 0) return;
#if ONE_LAUNCH
    if (hipMemsetAsync((char*)d_ws + WS_CTL, 0, CTL_BYTES, stream) != hipSuccess) { fprintf(stderr, "kernel_launch: memset failed\n"); return; }
#endif
    Args a{};
    const float** pp = (const float**)&a.P;
    for (int i = 0; i < 17; ++i) pp[i] = (const float*)d_in[i];
    a.P.out = (float*)d_out; a.P.ws = (unsigned char*)d_ws;
#if ONE_LAUNCH
    a.ph_lo = 0; a.ph_hi = N_PHASES;
    void* args[] = {&a};
    hipError_t e = hipLaunchCooperativeKernel((const void*)fwd_kernel, dim3(grid), dim3(NT), args, LDS_BYTES, stream);
    if (e != hipSuccess) fprintf(stderr, "kernel_launch: cooperative launch failed: %s (grid %d)\n", hipGetErrorString(e), grid);
#else
    for (int ph = 0; ph < N_PHASES; ++ph) { a.ph_lo = ph; a.ph_hi = ph + 1; hipLaunchKernelGGL(fwd_kernel, dim3(grid), dim3(NT), LDS_BYTES, stream, a); }
#endif
}
```

```cpp
#include <hip/hip_runtime.h>
#include <hip/hip_cooperative_groups.h>
#include <cstdio>
#include <cstdint>
namespace cg = cooperative_groups;

#ifndef EXP
#define EXP 0
#endif
#ifndef SKEW_TICKS
#define SKEW_TICKS 0
#endif
#ifndef REV_DOWN
#define REV_DOWN 0
#endif
#ifndef ONE_LAUNCH
#define ONE_LAUNCH 1
#endif

namespace pg8 {
#define PG8_LAS __attribute__((address_space(3)))
typedef unsigned short bf16_t;
typedef short bf16x8 __attribute__((ext_vector_type(8)));
typedef float f32x4 __attribute__((ext_vector_type(4)));
typedef unsigned u32x4 __attribute__((ext_vector_type(4)));
typedef unsigned u32x2 __attribute__((ext_vector_type(2)));
constexpr int BM = 256, BK = 64, HALF = 128, HTB = HALF * BK * 2, STAGE_BYTES = 8 * HTB, NXCD = 8, WGM = 8;

__host__ __device__ __forceinline__ int lds_byte(int r, int c) { const int st = (r >> 4) * 2 + (c >> 5), rr = r & 15, cc = c & 31, ob = rr * 64 + cc * 2; return st * 1024 + (ob ^ (((ob >> 9) & 1) << 5)); }
__host__ __device__ __forceinline__ void stage_rc(int b, int& R, int& C) { const int st = b / 1024, sb = b % 1024, swz = sb ^ (((sb >> 9) & 1) << 5); R = (st >> 1) * 16 + swz / 64; C = (st & 1) * 32 + (swz % 64) / 2; }
__host__ __device__ __forceinline__ int perm32(int rho) { const int n = rho >> 4, i = rho & 15; return 8 * (i >> 2) + 4 * n + (i & 3); }

struct Unit { int pm, pn; };
struct Gemm { const bf16_t* A; const bf16_t* Bt; int M, N, K, lda, perm; };

struct StaticOrder {
    int nM, nN, nwg, G, c, rev;
    __host__ __device__ void init(int M, int N, int G_, int c_, int rev_ = 0) { nM = M / BM; nN = N / BM; nwg = nM * nN; G = G_; c = c_; rev = rev_; }
    __host__ __device__ bool next(int i, Unit& u) const {
        const long L = (long)i * G + c; if (L >= nwg) return false;
        int wgid = (int)L; { const int q = nwg / NXCD, r = nwg % NXCD, xcd = wgid % NXCD, off = wgid / NXCD; wgid = (xcd < r ? xcd * (q + 1) : r * (q + 1) + (xcd - r) * q) + off; }
        const int nig = WGM * nN, gid = wgid / nig, fm = gid * WGM, gsz = (nM - fm) < WGM ? (nM - fm) : WGM;
        u.pm = fm + ((wgid % nig) % gsz); u.pn = (wgid % nig) / gsz; if (rev) u.pm = nM - 1 - u.pm; return true;
    }
    __device__ __forceinline__ void a_ready(const Unit&) const {}
    __device__ __forceinline__ void done(const Unit&) const {}
};

__device__ __forceinline__ float shx(float v, int mask, int lane) { return __int_as_float(__builtin_amdgcn_ds_bpermute((lane ^ mask) << 2, __float_as_int(v))); }
typedef float f32x2_t __attribute__((ext_vector_type(2)));
typedef __bf16 bf16x2_t __attribute__((ext_vector_type(2)));
__device__ __forceinline__ unsigned cvt_pk_native(float lo, float hi) { const f32x2_t f = {lo, hi}; const bf16x2_t b = __builtin_convertvector(f, bf16x2_t); return __builtin_bit_cast(unsigned, b); }
__device__ __forceinline__ unsigned cvt_pk_bf16(float lo, float hi) { unsigned r; asm volatile("v_cvt_pk_bf16_f32 %0, %1, %2" : "=v"(r) : "v"(lo), "v"(hi)); return r; }

__device__ __forceinline__ float fsigmoid(float v) { return __builtin_amdgcn_rcpf(1.0f + __expf(-v)); }
__device__ __forceinline__ float fsilu(float v) { return v * fsigmoid(v); }
__device__ __forceinline__ float row_rstd(const float* ss, int M, int row, int fq, int lane) {
    const float* p = ss + (size_t)(4 * fq) * M + row;
    float s = (p[0] + p[M]) + (p[2 * (size_t)M] + p[3 * (size_t)M]);
    s += shx(s, 16, lane); s += shx(s, 32, lane);
    return rsqrtf(s * (1.0f / 1024.0f) + 1e-6f);
}
template <int MODE> __device__ __forceinline__ float proj_act(float v, float a) {
    if (MODE == 1) return fsilu(v);
    if (MODE == 2) { const float z = v + a; const float ls = fminf(z, 0.f) - __logf(1.0f + __expf(-fabsf(z))); return ls * 0.0625f; }
    if (MODE == 3) { const float sg = fsigmoid(v); return __logf(a + (1.0f - a) * sg); }
    if (MODE == 4) return fsilu(v) * 0.08838834764831845f;
    if (MODE == 5) { const float r = fmaxf(v, 0.f); return r * r; }
    return v;
}
struct EpiAll {
    static constexpr bool AFTER_DRAIN = false;
    int kind, ldc, hgrn, M;
    bf16_t* O;
    const float* ss;
    const float* aux;
    const float* xin;
    float* xout;
    template <int MODE> __device__ __forceinline__ void body_proj(const f32x4 (&acc)[2][2][4][2], const Unit& u, int wr, int wc, int fr, int fq) const {
        const int row0 = u.pm * BM + wr * 64 + fr, col0 = u.pn * BM + wc * 32 + 8 * fq;
        f32x4 av[2][2];
#pragma unroll
        for (int bj = 0; bj < 2; ++bj)
#pragma unroll
            for (int n = 0; n < 2; ++n) av[bj][n] = (MODE == 2 || MODE == 3) ? *(const f32x4*)(aux + (col0 - 1024) + bj * HALF + 4 * n) : (f32x4){0.f, 0.f, 0.f, 0.f};
        float ps[2][4];
#pragma unroll
        for (int ai = 0; ai < 2; ++ai)
#pragma unroll
            for (int m = 0; m < 4; ++m) { const float* p = ss + (size_t)(4 * fq) * M + (row0 + ai * HALF + m * 16); ps[ai][m] = (p[0] + p[M]) + (p[2 * (size_t)M] + p[3 * (size_t)M]); }
        float rs[2][4];
#pragma unroll
        for (int ai = 0; ai < 2; ++ai)
#pragma unroll
            for (int m = 0; m < 4; ++m) { float s = ps[ai][m]; s += shx(s, 16, fq * 16 + fr); s += shx(s, 32, fq * 16 + fr); rs[ai][m] = rsqrtf(s * (1.0f / 1024.0f) + 1e-6f); }
#pragma unroll
        for (int ai = 0; ai < 2; ++ai)
#pragma unroll
            for (int m = 0; m < 4; ++m) { const int row = row0 + ai * HALF + m * 16; const float rstd = rs[ai][m]; bf16_t* rowp = O + (size_t)row * ldc + col0;
#pragma unroll
                for (int bj = 0; bj < 2; ++bj) { f32x4 v0 = acc[ai][bj][m][0] * rstd, v1 = acc[ai][bj][m][1] * rstd;
#pragma unroll
                    for (int j = 0; j < 4; ++j) { v0[j] = proj_act<MODE>(v0[j], av[bj][0][j]); v1[j] = proj_act<MODE>(v1[j], av[bj][1][j]); }
                    u32x4 w; w.x = cvt_pk_bf16(v0[0], v0[1]); w.y = cvt_pk_bf16(v0[2], v0[3]); w.z = cvt_pk_bf16(v1[0], v1[1]); w.w = cvt_pk_bf16(v1[2], v1[3]);
                    *(u32x4*)(rowp + bj * HALF) = w; } }
    }
    template <bool F32IN> __device__ __forceinline__ void body_res(const f32x4 (&acc)[2][2][4][2], const Unit& u, int wr, int wc, int fr, int fq) const {
        const int row0 = u.pm * BM + wr * 64 + fr, col0 = u.pn * BM + wc * 32 + 8 * fq; float* ssw = (float*)ss; bf16_t* XO = (bf16_t*)xout;
#pragma unroll
        for (int ai = 0; ai < 2; ++ai) {
            u32x4 xi[4][2];
            if (!F32IN) {
#pragma unroll
                for (int m = 0; m < 4; ++m) { const size_t off = (size_t)(row0 + ai * HALF + m * 16) * 1024 + col0;
#pragma unroll
                    for (int bj = 0; bj < 2; ++bj) xi[m][bj] = *(const u32x4*)(O + off + bj * HALF); } }
#pragma unroll
            for (int m = 0; m < 4; ++m) { const int row = row0 + ai * HALF + m * 16; const size_t off = (size_t)row * 1024 + col0; float s = 0.f;
#pragma unroll
                for (int bj = 0; bj < 2; ++bj) { f32x4 o0, o1;
                    if (F32IN) { o0 = *(const f32x4*)(xin + off + bj * HALF); o1 = *(const f32x4*)(xin + off + bj * HALF + 4); }
                    else { const u32x4 xw = xi[m][bj]; o0 = (f32x4){__uint_as_float(xw.x << 16), __uint_as_float(xw.x & 0xffff0000u), __uint_as_float(xw.y << 16), __uint_as_float(xw.y & 0xffff0000u)};
                        o1 = (f32x4){__uint_as_float(xw.z << 16), __uint_as_float(xw.z & 0xffff0000u), __uint_as_float(xw.w << 16), __uint_as_float(xw.w & 0xffff0000u)}; }
                    o0 = o0 + acc[ai][bj][m][0]; o1 = o1 + acc[ai][bj][m][1];
                    u32x4 w; w.x = cvt_pk_bf16(o0[0], o0[1]); w.y = cvt_pk_bf16(o0[2], o0[3]); w.z = cvt_pk_bf16(o1[0], o1[1]); w.w = cvt_pk_bf16(o1[2], o1[3]);
                    *(u32x4*)(XO + off + bj * HALF) = w;
#pragma unroll
                    for (int q = 0; q < 4; ++q) { const unsigned wq = q == 0 ? w.x : (q == 1 ? w.y : (q == 2 ? w.z : w.w)); const float r0 = __uint_as_float(wq << 16), r1 = __uint_as_float(wq & 0xffff0000u); s += r0 * r0 + r1 * r1; } }
                s += shx(s, 16, fq * 16 + fr); s += shx(s, 32, fq * 16 + fr);
                if (fq == 0) ssw[(size_t)(u.pn * 4 + wc) * M + row] = s; }
        }
    }
    __device__ __forceinline__ void body_kv(const f32x4 (&acc)[2][2][4][2], const Unit& u, int wr, int wc, int fr, int fq) const {
        const int row0 = u.pm * BM + wr * 64 + fr, layer = u.pn >> 2, cl0 = (u.pn & 3) * BM + wc * 32 + 4 * fq; bf16_t* VMT = (bf16_t*)xout;
#pragma unroll
        for (int ai = 0; ai < 2; ++ai)
#pragma unroll
            for (int m = 0; m < 4; ++m) { const int row = row0 + ai * HALF + m * 16; const float rstd = rsqrtf(ss[row] * (1.0f / 1024.0f) + 1e-6f);
#pragma unroll
                for (int bj = 0; bj < 2; ++bj)
#pragma unroll
                    for (int n = 0; n < 2; ++n) { const f32x4 o = acc[ai][bj][m][n] * rstd; const int cl = cl0 + bj * HALF + n * 16;
                        if (cl < 512) { u32x2 w; w.x = cvt_pk_bf16(o[0], o[1]); w.y = cvt_pk_bf16(o[2], o[3]); *(u32x2*)(O + ((size_t)layer * 1024 + row) * 512 + cl) = w; }
                        else { const unsigned lo = cvt_pk_bf16(o[0], o[1]), hi = cvt_pk_bf16(o[2], o[3]); bf16_t* d = VMT + ((size_t)(layer * 4 + (row >> 8)) * 512 + (cl - 512)) * 256 + (row & 255);
                            d[0] = (bf16_t)(lo & 0xffff); d[256] = (bf16_t)(lo >> 16); d[512] = (bf16_t)(hi & 0xffff); d[768] = (bf16_t)(hi >> 16); } } }
    }
    __device__ __forceinline__ void operator()(const f32x4 (&acc)[2][2][4][2], const Unit& u, int wr, int wc, int fr, int fq) const {
        if (kind == 0) {
            int mode;
            if (!hgrn) mode = (u.pn >= 4 && u.pn < 6) ? 2 : ((u.pn >= 6 && u.pn < 10) ? 1 : 0);
            else mode = u.pn < 4 ? 4 : (u.pn < 8 ? 3 : (u.pn < 12 ? 1 : 0));
            if (mode == 0) body_proj<0>(acc, u, wr, wc, fr, fq); else if (mode == 1) body_proj<1>(acc, u, wr, wc, fr, fq); else if (mode == 2) body_proj<2>(acc, u, wr, wc, fr, fq);
            else if (mode == 3) body_proj<3>(acc, u, wr, wc, fr, fq); else body_proj<4>(acc, u, wr, wc, fr, fq);
        } else if (kind == 1) body_proj<5>(acc, u, wr, wc, fr, fq);
        else if (kind == 2) { if (xin) body_res<true>(acc, u, wr, wc, fr, fq); else body_res<false>(acc, u, wr, wc, fr, fq); }
        else body_kv(acc, u, wr, wc, fr, fq);
    }
};

template <class Epi, class Sched, bool ALIGN_EPI = false, bool SP2 = false>
__device__ __forceinline__ void gemm_phase(PG8_LAS unsigned char* lds, const Gemm g, const Sched& S, const Epi& E, const int tid) {
    const int wid = __builtin_amdgcn_readfirstlane(tid >> 6), lane = tid & 63, wr = wid >> 2, wc = wid & 3, fr = lane & 15, fq = lane >> 4;
    const int K = g.K, nt = K / BK;
    unsigned voffA[2], voffB[2];
#pragma unroll
    for (int i = 0; i < 2; ++i) { int R, C; stage_rc(tid * 16 + i * 8192, R, C); const int Rb = g.perm ? ((R & ~31) + perm32(R & 31)) : R;
        voffA[i] = (unsigned)(R * g.lda + C) * 2u; voffB[i] = (unsigned)(Rb * K + C) * 2u; }
    const size_t kstep = (size_t)(BK * 2);
    const size_t hstepA = (size_t)HALF * g.lda * 2, hstepB = (size_t)HALF * K * 2;
    const size_t tstepA = 2 * hstepA, tstepB = 2 * hstepB;
    const unsigned ldsw = (unsigned)wid * 1024u;
    const int aoff = lds_byte(wr * 64 + fr, fq * 8), boff = lds_byte(wc * 32 + fr, fq * 8);
#define PG8_SA(b, h) (((b) * 2 + (h)) * HTB)
#define PG8_SB(b, h) ((4 + (b) * 2 + (h)) * HTB)
#define PG8_STAGE(bufoff, gbase, voff) do { _Pragma("unroll") for (int _i = 0; _i < 2; ++_i) \
        __builtin_amdgcn_global_load_lds((const unsigned*)((const char*)(gbase) + (voff)[_i]), (PG8_LAS unsigned*)(lds + (bufoff) + ldsw + _i * 8192), 16, 0, 0); } while (0)
#define PG8_LDA(dst, b, h) do { _Pragma("unroll") for (int m = 0; m < 4; ++m) _Pragma("unroll") for (int k = 0; k < 2; ++k) dst[m][k] = *(const PG8_LAS bf16x8*)(lds + PG8_SA(b, h) + aoff + m * 2048 + k * 1024); } while (0)
#define PG8_LDB(dst, b, h) do { _Pragma("unroll") for (int n = 0; n < 2; ++n) _Pragma("unroll") for (int k = 0; k < 2; ++k) dst[n][k] = *(const PG8_LAS bf16x8*)(lds + PG8_SB(b, h) + boff + n * 2048 + k * 1024); } while (0)
#define PG8_MMA(ai, bj, At, Bt) do { __builtin_amdgcn_s_setprio(1); _Pragma("unroll") for (int m = 0; m < 4; ++m) _Pragma("unroll") for (int n = 0; n < 2; ++n) _Pragma("unroll") for (int k = 0; k < 2; ++k) \
        acc[ai][bj][m][n] = __builtin_amdgcn_mfma_f32_16x16x32_bf16(Bt[n][k], At[m][k], acc[ai][bj][m][n], 0, 0, 0); __builtin_amdgcn_s_setprio(0); } while (0)
#define PG8_WAIT_V(n) asm volatile("s_waitcnt vmcnt(" #n ")" ::: "memory")
#define PG8_WAIT_L(n) asm volatile("s_waitcnt lgkmcnt(" #n ")" ::: "memory")
#define PG8_BAR __builtin_amdgcn_s_barrier()
#define PG8_SCHED __builtin_amdgcn_sched_barrier(0)
    Unit cur, nxt; int ui = 0;
    if (!S.next(0, cur)) return;
    f32x4 acc[2][2][4][2];
#pragma unroll
    for (int a = 0; a < 2; ++a)
#pragma unroll
        for (int b = 0; b < 2; ++b)
#pragma unroll
            for (int m = 0; m < 4; ++m)
#pragma unroll
                for (int n = 0; n < 2; ++n) acc[a][b][m][n] = (f32x4){0.f, 0.f, 0.f, 0.f};
    bf16x8 At[4][2], B0[2][2], B1[2][2];
    const char* cA = (const char*)g.A + (size_t)cur.pm * tstepA; const char* cB = (const char*)g.Bt + (size_t)cur.pn * tstepB;
    S.a_ready(cur);
    if constexpr (SP2) {
        PG8_STAGE(PG8_SB(0, 0), cB, voffB); PG8_STAGE(PG8_SB(0, 1), cB + hstepB, voffB); PG8_STAGE(PG8_SA(0, 0), cA, voffA); PG8_STAGE(PG8_SA(0, 1), cA + hstepA, voffA);
        if (wr == 1) PG8_BAR;
        PG8_WAIT_V(2); PG8_BAR;
        PG8_STAGE(PG8_SB(1, 0), cB + kstep, voffB); PG8_STAGE(PG8_SA(1, 0), cA + kstep, voffA); PG8_STAGE(PG8_SB(1, 1), cB + hstepB + kstep, voffB);
        PG8_WAIT_V(6); PG8_BAR;
    } else {
        PG8_STAGE(PG8_SB(0, 0), cB, voffB); PG8_STAGE(PG8_SA(0, 0), cA, voffA); PG8_STAGE(PG8_SB(0, 1), cB + hstepB, voffB); PG8_STAGE(PG8_SA(0, 1), cA + hstepA, voffA);
        if (wr == 1) PG8_BAR;
        PG8_WAIT_V(4); PG8_BAR;
        PG8_STAGE(PG8_SB(1, 0), cB + kstep, voffB); PG8_STAGE(PG8_SA(1, 0), cA + kstep, voffA); PG8_STAGE(PG8_SB(1, 1), cB + hstepB + kstep, voffB);
        PG8_WAIT_V(6); PG8_BAR;
    }
    for (;;) {
        const bool has_next = S.next(ui + 1, nxt);
        const char* nA = has_next ? (const char*)g.A + (size_t)nxt.pm * tstepA : cA; const char* nB = has_next ? (const char*)g.Bt + (size_t)nxt.pn * tstepB : cB;
        for (int t = 0; t < nt; t += 2) {
            const bool last = (t == nt - 2);
            const char* a1 = cA + (size_t)(t + 1) * kstep;
            const char* a2 = last ? nA : cA + (size_t)(t + 2) * kstep; const char* b2 = last ? nB : cB + (size_t)(t + 2) * kstep;
            const char* a3 = a2 + kstep; const char* b3 = b2 + kstep;
            if (last && has_next) S.a_ready(nxt);
            if constexpr (SP2) {
            PG8_LDB(B0, 0, 0); PG8_LDB(B1, 0, 1); PG8_SCHED; PG8_LDA(At, 0, 0); PG8_STAGE(PG8_SA(1, 1), a1 + hstepA, voffA);
            PG8_WAIT_V(8); PG8_WAIT_L(0); PG8_BAR; PG8_MMA(0, 0, At, B0); PG8_MMA(0, 1, At, B1); PG8_BAR; PG8_SCHED;
            PG8_LDA(At, 0, 1); PG8_STAGE(PG8_SB(0, 0), b2, voffB); PG8_STAGE(PG8_SB(0, 1), b2 + hstepB, voffB); PG8_STAGE(PG8_SA(0, 0), a2, voffA);
            PG8_WAIT_V(8); PG8_WAIT_L(0); PG8_BAR; PG8_MMA(1, 0, At, B0); PG8_MMA(1, 1, At, B1); PG8_BAR; PG8_SCHED;
            PG8_LDB(B0, 1, 0); PG8_LDB(B1, 1, 1); PG8_SCHED; PG8_LDA(At, 1, 0); PG8_STAGE(PG8_SA(0, 1), a2 + hstepA, voffA);
            PG8_WAIT_V(8); PG8_WAIT_L(0); PG8_BAR; PG8_MMA(0, 0, At, B0); PG8_MMA(0, 1, At, B1); PG8_BAR; PG8_SCHED;
            PG8_LDA(At, 1, 1); PG8_STAGE(PG8_SB(1, 0), b3, voffB); PG8_STAGE(PG8_SB(1, 1), b3 + hstepB, voffB); PG8_STAGE(PG8_SA(1, 0), a3, voffA);
            PG8_WAIT_V(8); PG8_WAIT_L(0); PG8_BAR; PG8_MMA(1, 0, At, B0); PG8_MMA(1, 1, At, B1); PG8_BAR; PG8_SCHED;
            } else {
            PG8_LDB(B0, 0, 0); PG8_SCHED; PG8_LDA(At, 0, 0); PG8_STAGE(PG8_SA(1, 1), a1 + hstepA, voffA);
            PG8_WAIT_L(8); PG8_BAR; PG8_WAIT_L(0); PG8_MMA(0, 0, At, B0); PG8_BAR; PG8_SCHED;
            PG8_LDB(B1, 0, 1); PG8_STAGE(PG8_SB(0, 0), b2, voffB);
            PG8_BAR; PG8_WAIT_L(0); PG8_MMA(0, 1, At, B1); PG8_BAR;
            PG8_LDA(At, 0, 1); PG8_STAGE(PG8_SA(0, 0), a2, voffA);
            PG8_BAR; PG8_WAIT_L(0); PG8_MMA(1, 0, At, B0); PG8_BAR; PG8_SCHED;
            PG8_STAGE(PG8_SB(0, 1), b2 + hstepB, voffB);
            PG8_WAIT_V(6); PG8_BAR; PG8_MMA(1, 1, At, B1); PG8_BAR;
            PG8_LDB(B0, 1, 0); PG8_SCHED; PG8_LDA(At, 1, 0); PG8_STAGE(PG8_SA(0, 1), a2 + hstepA, voffA);
            PG8_WAIT_L(8); PG8_BAR; PG8_WAIT_L(0); PG8_MMA(0, 0, At, B0); PG8_BAR; PG8_SCHED;
            PG8_LDB(B1, 1, 1); PG8_STAGE(PG8_SB(1, 0), b3, voffB);
            PG8_BAR; PG8_WAIT_L(0); PG8_MMA(0, 1, At, B1); PG8_BAR;
            PG8_LDA(At, 1, 1); PG8_STAGE(PG8_SA(1, 0), a3, voffA);
            PG8_BAR; PG8_WAIT_L(0); PG8_MMA(1, 0, At, B0); PG8_BAR; PG8_SCHED;
            PG8_STAGE(PG8_SB(1, 1), b3 + hstepB, voffB);
            PG8_WAIT_V(6); PG8_BAR; PG8_MMA(1, 1, At, B1); PG8_BAR;
            }
        }
        if constexpr (ALIGN_EPI) { if (wr == 0) PG8_BAR; }
        if constexpr (!Epi::AFTER_DRAIN) { E(acc, cur, wr, wc, fr, fq); S.done(cur); }
        if (!has_next) break;
#pragma unroll
        for (int a = 0; a < 2; ++a)
#pragma unroll
            for (int b = 0; b < 2; ++b)
#pragma unroll
                for (int m = 0; m < 4; ++m)
#pragma unroll
                    for (int n = 0; n < 2; ++n) acc[a][b][m][n] = (f32x4){0.f, 0.f, 0.f, 0.f};
        cur = nxt; cA = nA; cB = nB; ++ui;
        if constexpr (ALIGN_EPI) { if (wr == 1) PG8_BAR; }
    }
    PG8_WAIT_V(0);
    if constexpr (!ALIGN_EPI) { if (wr == 0) PG8_BAR; }
    PG8_BAR;
    if constexpr (Epi::AFTER_DRAIN) { E.fused(acc, cur, wr, wc, fr, fq, lds, wid, lane); S.done(cur); }
#undef PG8_SA
#undef PG8_SB
#undef PG8_STAGE
#undef PG8_LDA
#undef PG8_LDB
#undef PG8_MMA
#undef PG8_WAIT_V
#undef PG8_WAIT_L
#undef PG8_BAR
#undef PG8_SCHED
}
}

constexpr int NWAVES = 8, NT = 512;
constexpr int D = 1024, BATCH = 4, T = 8192, M = BATCH * T, DEPTH = 4, MEM = 256, MROWS = BATCH * MEM;
constexpr int DK = 128, CH = 64, NCH = T / CH;
constexpr int GLA_N = 4096, HGRN_N = 4608, FF = 4096, KOUT = 1536;
constexpr float EPS = 1e-6f;
constexpr size_t MiB = 1u << 20;
constexpr size_t WS_SS = 0;
constexpr size_t WS_DEC = 2 * MiB;
constexpr size_t WS_MEMB = 4 * MiB;
constexpr size_t WS_SSM = 6 * MiB;
constexpr size_t WS_LB = 6 * MiB + 65536;
constexpr size_t WS_KM = 8 * MiB;
constexpr size_t WS_VMT = 12 * MiB;
constexpr size_t WS_WKV = 16 * MiB;
constexpr size_t WS_WT = 24 * MiB, WT_BUF = 30 * MiB;
constexpr size_t WT_IN = 0, WT_OUT = 10 * MiB, WT_UP = 14 * MiB, WT_DOWN = 22 * MiB;
constexpr size_t WS_PROJ = 84 * MiB;
constexpr size_t WS_XB = 372 * MiB;
constexpr size_t WS_END = 500 * MiB;
constexpr int LDS_BYTES = 147456;

#define LAS __attribute__((address_space(3)))
typedef unsigned short bf16;
typedef float f32x4 __attribute__((ext_vector_type(4)));
typedef short bf16x8 __attribute__((ext_vector_type(8)));
typedef short bf16x4 __attribute__((ext_vector_type(4)));
typedef unsigned u32x4 __attribute__((ext_vector_type(4)));
typedef unsigned u32x2 __attribute__((ext_vector_type(2)));
__device__ __forceinline__ float bf2f(bf16 b) { return __uint_as_float(((unsigned)b) << 16); }
__device__ __forceinline__ unsigned f2bf(float f) { unsigned u = __float_as_uint(f); return (u + 0x7fffu + ((u >> 16) & 1u)) >> 16; }
__device__ __forceinline__ unsigned pk2(float lo, float hi) { return pg8::cvt_pk_bf16(lo, hi); }
__device__ __forceinline__ float wave_sum(float v, int lane) {
#pragma unroll
    for (int o = 1; o < 64; o <<= 1) v += pg8::shx(v, o, lane);
    return v;
}
#define MFMA16(a, b, c) __builtin_amdgcn_mfma_f32_16x16x32_bf16((a), (b), (c), 0, 0, 0)

constexpr size_t WS_CTL = 7 * MiB, CTL_BYTES = 16384;
constexpr int LDS_BARST = LDS_BYTES - 64;
#define XB_TMO      128
#define XB_XCNT(j)  (256  + 64 * (j))
#define XB_XSUB(j)  (1280 + 64 * (j))
#define XB_XGEN(j)  (2304 + 64 * (j))
#define XB_TOP      3328
#define XB_TOPGEN   3392
#define XCD_BAR_WORDS 3456
#define XB_SPIN_CAP (1u << 18)

__device__ __forceinline__ unsigned xb_ld(unsigned* p)              { return __hip_atomic_load(p, __ATOMIC_RELAXED, __HIP_MEMORY_SCOPE_AGENT); }
__device__ __forceinline__ unsigned xb_add(unsigned* p, unsigned v) { return __hip_atomic_fetch_add(p, v, __ATOMIC_RELAXED, __HIP_MEMORY_SCOPE_AGENT); }
__device__ __forceinline__ unsigned xb_xcc_id() { return (unsigned)__builtin_amdgcn_s_getreg((3 << 11) | 20) & 0xFu; }
#define XB_SPIN(cond, bar) do { unsigned _sp = 0; while (cond) { __builtin_amdgcn_s_sleep(1); \
    if ((++_sp & 255u) == 0u) { if (xb_ld(&(bar)[XB_TMO])) break; if (_sp > XB_SPIN_CAP) { atomicAdd(&(bar)[XB_TMO], 1u); break; } } } } while (0)

struct XcdBarrier {
    unsigned* bar; unsigned x;
    volatile LAS unsigned* st;
};

__device__ __forceinline__ XcdBarrier xcd_barrier_post(unsigned* bar, volatile LAS unsigned* st, int tid) {
    XcdBarrier b; b.bar = bar; b.x = xb_xcc_id(); b.st = st;
    if (tid == 0) (void)xb_add(&bar[XB_XCNT(b.x)], 1u);
    return b;
}
__device__ __forceinline__ void xcd_barrier_complete(unsigned* bar, unsigned x, unsigned& nloc, unsigned& nx) {
    const unsigned G = gridDim.x * gridDim.y * gridDim.z;
    unsigned sum, cnt, mine, sp = 0u;
    for (;;) {
        sum = 0u; cnt = 0u; mine = 0u;
#pragma unroll
        for (unsigned j = 0; j < 16; ++j) { const unsigned c = xb_ld(&bar[XB_XCNT(j)]); sum += c; cnt += (c > 0u) ? 1u : 0u; mine = (j == x) ? c : mine; }
        if (sum == G) break;
        __builtin_amdgcn_s_sleep(1);
        if ((++sp & 255u) == 0u) { if (xb_ld(&bar[XB_TMO])) break; if (sp > XB_SPIN_CAP) { atomicAdd(&bar[XB_TMO], 1u); break; } }
    }
    nloc = mine > 0u ? mine : 1u; nx = cnt > 0u ? cnt : 1u;
}

__device__ __forceinline__ void xcd_barrier(const XcdBarrier& b, int tid) {
    asm volatile("s_waitcnt vmcnt(0)" ::: "memory");
    __syncthreads();
    if (tid == 0) {
        unsigned* bar = b.bar;
        __builtin_amdgcn_s_waitcnt(0);
        unsigned nloc = b.st[0], nx = b.st[1];
        if (nloc == 0u) { xcd_barrier_complete(bar, b.x, nloc, nx); b.st[0] = nloc; b.st[1] = nx; }
        const unsigned old = xb_add(&bar[XB_XSUB(b.x)], 1u);
        const unsigned gen = old / nloc;
        if (old + 1u == (gen + 1u) * nloc) {
            __builtin_amdgcn_fence(__ATOMIC_RELEASE, "agent");
            asm volatile("s_waitcnt vmcnt(0)" ::: "memory");
            const unsigned og = xb_add(&bar[XB_TOP], 1u);
            const unsigned tg = og / nx;
            if (og + 1u == (tg + 1u) * nx) xb_add(&bar[XB_TOPGEN], 1u);
            else XB_SPIN(xb_ld(&bar[XB_TOPGEN]) == tg, bar);
            __builtin_amdgcn_fence(__ATOMIC_ACQUIRE, "agent");
            xb_add(&bar[XB_XGEN(b.x)], 1u);
            asm volatile("s_waitcnt vmcnt(0)" ::: "memory");
        } else {
            XB_SPIN(xb_ld(&bar[XB_XGEN(b.x)]) == gen, bar);
            __builtin_amdgcn_fence(__ATOMIC_ACQUIRE, "agent");
            asm volatile("s_waitcnt vmcnt(0)" ::: "memory");
        }
    }
    __syncthreads();
}

__device__ __forceinline__ void transpose_item(const float* W, int ldw, int K, int sc, bf16* WT, int dr, const float* gain, int gmask, int glimit, float scale, LAS float* scr, int item, int nblk, int lane) {
    const int kb = item / nblk, nb = item % nblk, k0 = 64 * kb, n0 = 32 * nb;
#pragma unroll 8
    for (int i = 0; i < 32; ++i) { const int kk = 2 * i + (lane >> 5); const int k = k0 + kk; float g = scale; if (gain && k < glimit) g *= gain[k & gmask];
        scr[kk * 33 + (lane & 31)] = W[(size_t)k * ldw + sc + n0 + (lane & 31)] * g; }
    asm volatile("s_waitcnt lgkmcnt(0)" ::: "memory");
    const int c = lane & 7;
#pragma unroll
    for (int j = 0; j < 4; ++j) { const int n = (lane >> 3) + 8 * j; const LAS float* s = scr + (8 * c) * 33 + n;
        u32x4 o; o.x = pk2(s[0 * 33], s[1 * 33]); o.y = pk2(s[2 * 33], s[3 * 33]); o.z = pk2(s[4 * 33], s[5 * 33]); o.w = pk2(s[6 * 33], s[7 * 33]);
        *(u32x4*)(WT + (size_t)(dr + n0 + n) * K + k0 + 8 * c) = o; }
    asm volatile("s_waitcnt lgkmcnt(0)" ::: "memory");
}
struct Ptrs {
    const float *x, *mem, *norm_mix, *norm_mem, *w_kv, *w_out, *norm_mlp, *w_up, *w_down, *gla_w_in, *gla_w_gate2, *gla_b_gate, *gla_out_gain, *hgrn_w_in, *hgrn_lb, *hgrn_out_gain, *final_norm;
    float* out; unsigned char* ws;
};
#define SEG(Wp, ldw, K, sc, ncols, WTp, dr, gain, gmask, glimit, scale) { const int nblk_ = (ncols) / 32, nit_ = ((K) / 64) * nblk_; \
    if (r < nit_) { transpose_item(Wp, ldw, K, sc, WTp, dr, gain, gmask, glimit, scale, scr, r, nblk_, lane); continue; } r -= nit_; }
template <class PT> __device__ __forceinline__ void convert_layer(PT Pp, int L, LAS unsigned char* lds, int gw, int ngw, int wave, int lane) {
    LAS float* scr = (LAS float*)(lds + wave * 16384);
    unsigned char* wb = Pp->ws + WS_WT + (size_t)(L & 1) * WT_BUF;
    bf16* Win = (bf16*)(wb + WT_IN); bf16* Wout = (bf16*)(wb + WT_OUT); bf16* Wup = (bf16*)(wb + WT_UP); bf16* Wdn = (bf16*)(wb + WT_DOWN);
    const int j = L >> 1; const bool hg = (L & 1);
    const float* gmix = Pp->norm_mix + (size_t)L * D; const float* gmlp = Pp->norm_mlp + (size_t)L * D;
    const float* wo = Pp->w_out + (size_t)L * KOUT * D; const float* wu = Pp->w_up + (size_t)L * D * FF; const float* wd = Pp->w_down + (size_t)L * FF * D;
    const float QS = 0.08838834764831845f;
    if (!hg) {
        const float* wi = Pp->gla_w_in + (size_t)j * D * 3600; const float* og = Pp->gla_out_gain + (size_t)j * 256;
        const int total = 16 * (16 + 16 + 32 + 32 + 16) + 24 * 32 + 16 * 128 + 64 * 32 + 128;
        for (int it = gw; it < total; it += ngw) { int r = it;
            SEG(wi, 3600, D, 0, 512, Win, 0, gmix, 1023, D, QS)
            SEG(wi, 3600, D, 512, 512, Win, 512, gmix, 1023, D, 1.f)
            SEG(wi, 3600, D, 1024, 1024, Win, 2560, gmix, 1023, D, 1.f)
            SEG(wi, 3600, D, 2064, 1024, Win, 1536, gmix, 1023, D, 1.f)
            SEG(wi, 3600, D, 3088, 512, Win, 3584, gmix, 1023, D, QS)
            SEG(wo, D, KOUT, 0, 1024, Wout, 0, og, 255, 1024, 1.f)
            SEG(wu, FF, D, 0, 4096, Wup, 0, gmlp, 1023, D, 1.f)
            SEG(wd, D, FF, 0, 1024, Wdn, 0, (const float*)nullptr, 0, 0, 1.f)
            { const int kb = r >> 3, cb = r & 7, k = kb * 64 + lane; const float* g2 = Pp->gla_w_gate2 + (size_t)j * 16 * 512 + cb * 64;
              const f32x4* wr4 = (const f32x4*)(wi + (size_t)k * 3600 + 2048); const f32x4 w0 = wr4[0], w1 = wr4[1], w2 = wr4[2], w3 = wr4[3]; const float gk = gmix[k];
              for (int c = 0; c < 64; ++c) { float s = 0.f;
#pragma unroll
                  for (int q = 0; q < 4; ++q) { s += w0[q] * g2[q * 512 + c]; s += w1[q] * g2[(4 + q) * 512 + c]; s += w2[q] * g2[(8 + q) * 512 + c]; s += w3[q] * g2[(12 + q) * 512 + c]; }
                  Win[(size_t)(1024 + cb * 64 + c) * D + k] = (bf16)f2bf(s * gk); } }
        }
    } else {
        const float* wi = Pp->hgrn_w_in + (size_t)j * D * 4608; const float* og = Pp->hgrn_out_gain + (size_t)j * 128;
        const int total = 16 * (32 + 32 + 32 + 32 + 16) + 24 * 32 + 16 * 128 + 64 * 32;
        for (int it = gw; it < total; it += ngw) { int r = it;
            SEG(wi, 4608, D, 0, 1024, Win, 0, gmix, 1023, D, 1.f)
            SEG(wi, 4608, D, 1024, 1024, Win, 1024, gmix, 1023, D, 1.f)
            SEG(wi, 4608, D, 2048, 1024, Win, 3072, gmix, 1023, D, 1.f)
            SEG(wi, 4608, D, 3072, 1024, Win, 2048, gmix, 1023, D, 1.f)
            SEG(wi, 4608, D, 4096, 512, Win, 4096, gmix, 1023, D, QS)
            SEG(wo, D, KOUT, 0, 1024, Wout, 0, og, 127, 1024, 1.f)
            SEG(wu, FF, D, 0, 4096, Wup, 0, gmlp, 1023, D, 1.f)
            { const int nblk_ = 32; transpose_item(wd, D, FF, 0, Wdn, 0, (const float*)nullptr, 0, 0, 1.f, scr, r, nblk_, lane); }
        }
    }
}
template <class PT> __device__ __forceinline__ void prologue(PT Pp, LAS unsigned char* lds, int gw, int ngw, int wave, int lane) {
    convert_layer(Pp, 0, lds, gw, ngw, wave, lane);
    { LAS float* scr = (LAS float*)(lds + wave * 16384); bf16* Wkv = (bf16*)(Pp->ws + WS_WKV);
      const int per = 16 * 32, total = 4 * per;
      for (int it = gw; it < total; it += ngw) { const int L = it / per, r = it % per;
          transpose_item(Pp->w_kv + (size_t)L * D * 1024, 1024, D, 0, Wkv + (size_t)L * 1024 * D, 0, Pp->norm_mem + (size_t)L * D, 1023, D, 1.f, scr, r, 32, lane); } }
    { float* LB = (float*)(Pp->ws + WS_LB);
      for (int c = gw * 64 + lane; c < 1024; c += ngw * 64) { const float v0 = Pp->hgrn_lb[c], v1 = Pp->hgrn_lb[1024 + c], v2 = Pp->hgrn_lb[2048 + c], v3 = Pp->hgrn_lb[3072 + c];
          const float mx = fmaxf(fmaxf(v0, v1), fmaxf(v2, v3)); const float e0 = expf(v0 - mx), e1 = expf(v1 - mx), e2 = expf(v2 - mx), e3 = expf(v3 - mx); const float inv = 1.0f / (e0 + e1 + e2 + e3);
          LB[c] = 0.f; LB[1024 + c] = e1 * inv; LB[2048 + c] = (e1 + e2) * inv; LB[3072 + c] = (e1 + e2 + e3) * inv; } }
    bf16* XB = (bf16*)Pp->out; float* SS = (float*)(Pp->ws + WS_SS);     bf16* MB = (bf16*)(Pp->ws + WS_MEMB); float* SSM = (float*)(Pp->ws + WS_SSM);
    for (int m = gw; m < M + MROWS; m += ngw) {
        const bool ism = m >= M; const int row = ism ? m - M : m;
        const f32x4* xr = (const f32x4*)((ism ? Pp->mem : Pp->x) + (size_t)row * D) + lane; unsigned long long* o8 = (unsigned long long*)((ism ? MB : XB) + (size_t)row * D) + lane;
        float s = 0.f;
#pragma unroll
        for (int j = 0; j < 4; ++j) { const f32x4 v = xr[64 * j]; s += (v.x * v.x + v.y * v.y) + (v.z * v.z + v.w * v.w); o8[64 * j] = (unsigned long long)pk2(v.x, v.y) | ((unsigned long long)pk2(v.z, v.w) << 32); }
        s = wave_sum(s, lane);
        if (ism) { if (lane == 0) SSM[row] = s; }
        else if (lane < 16) SS[(size_t)lane * M + row] = lane == 0 ? s : 0.f;
    }
}
constexpr int KT_STR = 144;
constexpr int QS_STR = 272;
constexpr int VS_STR = 528;
constexpr int L_TOT = 0;
constexpr int L_LA = 2048;
constexpr int L_QS = L_LA + 64 * QS_STR;
constexpr int L_KS = L_QS + 64 * QS_STR;
constexpr int L_VS = L_KS + 64 * QS_STR;
constexpr int L_VT = L_VS + 64 * VS_STR;
constexpr int L_KT = L_VT + 256 * KT_STR;
constexpr int L_AT = L_KT;
constexpr int L_RED = L_KT + 128 * KT_STR;
static_assert(L_RED + 2048 <= LDS_BYTES - 64, "mixer LDS map");

template <int DV>
__device__ __forceinline__ void load_raw_v(const bf16* base, int ld, int vcol, int tid, u32x4 (&rv)[DV / 64]) {
#pragma unroll
    for (int i = 0; i < DV / 64; ++i) { const int c = tid + i * NT, row = c / (DV / 8), part = c % (DV / 8); rv[i] = *(const u32x4*)(base + (size_t)row * ld + vcol + part * 8); }
}
template <int DV>
__device__ __forceinline__ void store_raw_v(LAS unsigned char* lds, int tid, const u32x4 (&rv)[DV / 64]) {
#pragma unroll
    for (int i = 0; i < DV / 64; ++i) { const int c = tid + i * NT, row = c / (DV / 8), part = c % (DV / 8); *(LAS u32x4*)(lds + L_VS + row * VS_STR + part * 16) = rv[i]; }
}
__device__ __forceinline__ void load_raw128(const bf16* base, int ld, int col, int tid, u32x4 (&r)[2]) {
#pragma unroll
    for (int i = 0; i < 2; ++i) { const int c = tid + i * NT; r[i] = *(const u32x4*)(base + (size_t)(c >> 4) * ld + col + (c & 15) * 8); }
}
__device__ __forceinline__ void store_raw128(LAS unsigned char* lds, int off, int tid, const u32x4 (&r)[2]) {
#pragma unroll
    for (int i = 0; i < 2; ++i) { const int c = tid + i * NT; *(LAS u32x4*)(lds + off + (c >> 4) * QS_STR + (c & 15) * 16) = r[i]; }
}
template <int DV>
__device__ __forceinline__ void transpose_v(LAS unsigned char* lds, int tid) {
    constexpr int RPT = DV / 8;
    const int v = tid % DV, part = tid / DV;
    unsigned w[RPT / 2];
#pragma unroll
    for (int i = 0; i < RPT / 2; ++i) { const unsigned lo = *(const LAS bf16*)(lds + L_VS + (part * RPT + 2 * i) * VS_STR + v * 2), hi = *(const LAS bf16*)(lds + L_VS + (part * RPT + 2 * i + 1) * VS_STR + v * 2); w[i] = lo | (hi << 16); }
    LAS u32x4* dst = (LAS u32x4*)(lds + L_VT + v * KT_STR + part * RPT * 2);
#pragma unroll
    for (int i = 0; i < RPT / 8; ++i) dst[i] = (u32x4){w[4 * i], w[4 * i + 1], w[4 * i + 2], w[4 * i + 3]};
}
__device__ __forceinline__ void cumsum_local(LAS unsigned char* lds, int d, int rg, float (&bb)[16]) {
#pragma unroll
    for (int i = 0; i < 16; ++i) bb[i] = bf2f(*(const LAS bf16*)(lds + L_LA + (rg * 16 + i) * QS_STR + d * 2));
}
__device__ __forceinline__ void cumsum_scan(LAS unsigned char* lds, int d, int rg, float (&bb)[16]) {
#pragma unroll
    for (int i = 1; i < 16; ++i) bb[i] += bb[i - 1];
    ((LAS float*)(lds + L_TOT))[rg * 128 + d] = bb[15];
}
__device__ __forceinline__ void cumsum_finish(LAS unsigned char* lds, int d, int rg, float (&bb)[16], float& blast) {
    const LAS float* tot = (const LAS float*)(lds + L_TOT);
    const float t0 = tot[d], t1 = tot[128 + d], t2 = tot[256 + d], t3 = tot[384 + d];
    const float off = rg == 0 ? 0.f : (rg == 1 ? t0 : (rg == 2 ? t0 + t1 : t0 + t1 + t2));
    blast = (t0 + t1) + (t2 + t3);
#pragma unroll
    for (int i = 0; i < 16; ++i) bb[i] += off;
}
template <int DV, bool HGRN>
__device__ __forceinline__ void pass_a(LAS unsigned char* lds, const bf16* proj, bf16* GS, float* DEC, int G, int bid, const int tid) {
    constexpr int H = HGRN ? 8 : 4, LD = HGRN ? HGRN_N : GLA_N, NTW = DV / 128, NU = BATCH * H * NCH;
    const int lane = tid & 63, wave = tid >> 6, g = lane >> 4, l15 = lane & 15, d = tid & 127, rg = tid >> 7;
    u32x4 rla[2], rk[2], rv[DV / 64];
    int u = bid;
    if (u < NU) { const int b = u / (H * NCH), h = (u / NCH) % H, n = u % NCH; const bf16* base = proj + (size_t)(b * T + n * CH) * LD;
        load_raw128(base, LD, 1024 + h * 128, tid, rla); if (!HGRN) load_raw128(base, LD, 512 + h * 128, tid, rk); load_raw_v<DV>(base, LD, (HGRN ? 3072 : 2560) + h * DV, tid, rv); }
    for (; u < NU; u += G) {
        store_raw128(lds, L_LA, tid, rla); if (!HGRN) store_raw128(lds, L_KS, tid, rk); store_raw_v<DV>(lds, tid, rv);
        __syncthreads();
        { const int un = u + G; if (un < NU) { const int b = un / (H * NCH), h = (un / NCH) % H, n = un % NCH; const bf16* base = proj + (size_t)(b * T + n * CH) * LD;
            load_raw128(base, LD, 1024 + h * 128, tid, rla); if (!HGRN) load_raw128(base, LD, 512 + h * 128, tid, rk); load_raw_v<DV>(base, LD, (HGRN ? 3072 : 2560) + h * DV, tid, rv); } }
        float bb[16], kv[16], blast;
        cumsum_local(lds, d, rg, bb);
#pragma unroll
        for (int i = 0; i < 16; ++i) kv[i] = HGRN ? (1.0f - __expf(bb[i])) : bf2f(*(const LAS bf16*)(lds + L_KS + (rg * 16 + i) * QS_STR + d * 2));
        cumsum_scan(lds, d, rg, bb);
        transpose_v<DV>(lds, tid);
        __syncthreads();
        cumsum_finish(lds, d, rg, bb, blast);
        { unsigned w[8];
#pragma unroll
          for (int i = 0; i < 8; ++i) w[i] = pk2(kv[2 * i] * __expf(-bb[2 * i]), kv[2 * i + 1] * __expf(-bb[2 * i + 1]));
          LAS u32x4* dst = (LAS u32x4*)(lds + L_KT + d * KT_STR + rg * 32);
          dst[0] = (u32x4){w[0], w[1], w[2], w[3]}; dst[1] = (u32x4){w[4], w[5], w[6], w[7]}; }
        if (rg == 0) DEC[(size_t)u * 128 + d] = __expf(blast);
        __syncthreads();
        f32x4 acc[8][NTW];
#pragma unroll
        for (int mt = 0; mt < 8; ++mt)
#pragma unroll
            for (int nt = 0; nt < NTW; ++nt) acc[mt][nt] = (f32x4){0.f, 0.f, 0.f, 0.f};
#pragma unroll
        for (int kk = 0; kk < 2; ++kk) {
            bf16x8 bfr[NTW], afr[8];
#pragma unroll
            for (int nt = 0; nt < NTW; ++nt) bfr[nt] = *(const LAS bf16x8*)(lds + L_VT + ((wave * NTW + nt) * 16 + l15) * KT_STR + (kk * 32 + 8 * g) * 2);
#pragma unroll
            for (int mt = 0; mt < 8; ++mt) afr[mt] = *(const LAS bf16x8*)(lds + L_KT + (mt * 16 + l15) * KT_STR + (kk * 32 + 8 * g) * 2);
#pragma unroll
            for (int mt = 0; mt < 8; ++mt)
#pragma unroll
                for (int nt = 0; nt < NTW; ++nt) acc[mt][nt] = MFMA16(afr[mt], bfr[nt], acc[mt][nt]);
        }
#pragma unroll
        for (int mt = 0; mt < 8; ++mt)
#pragma unroll
            for (int nt = 0; nt < NTW; ++nt) asm volatile("s_nop 7\n\ts_nop 7" : "+v"(acc[mt][nt]));
#pragma unroll
        for (int nt = 0; nt < NTW; ++nt) { bf16* gp = GS + ((size_t)u * DV + (wave * NTW + nt) * 16 + l15) * 128 + 4 * g;
#pragma unroll
            for (int mt = 0; mt < 8; ++mt) { u32x2 w; w.x = pk2(acc[mt][nt][0], acc[mt][nt][1]); w.y = pk2(acc[mt][nt][2], acc[mt][nt][3]); *(u32x2*)(gp + mt * 16) = w; } }
    }
    __syncthreads();
}
template <int DV, bool HGRN, bool DRY = false>
__device__ __forceinline__ void pass_b(bf16* GS, const float* DEC, int G, int bid, const int tid) {
    constexpr int H = HGRN ? 8 : 4, E = DV * 128, E4 = E / 4;
    const int nthreads = G * NT;
    for (int i = bid * NT + tid; i < BATCH * H * E4; i += nthreads) {
        const int bh = i / E4, e = (i % E4) * 4, d = e & 127;
        float S0 = 0.f, S1 = 0.f, S2 = 0.f, S3 = 0.f;
        u32x2* gp = (u32x2*)(GS + (size_t)bh * NCH * E + e); const f32x4* dp = (const f32x4*)(DEC + (size_t)bh * NCH * 128 + d);
        for (int n0 = 0; n0 < NCH; n0 += 8) {
            u32x2 gv[8]; f32x4 dv[8];
#pragma unroll
            for (int q = 0; q < 8; ++q) { gv[q] = gp[(size_t)(n0 + q) * (E / 4)]; dv[q] = dp[(size_t)(n0 + q) * 32]; }
#pragma unroll
            for (int q = 0; q < 8; ++q) {
                u32x2 o; o.x = pk2(S0, S1); o.y = pk2(S2, S3); if (!DRY || o.x == 0x12345678u) gp[(size_t)(n0 + q) * (E / 4)] = o;
                S0 = dv[q].x * (S0 + __uint_as_float(gv[q].x << 16)); S1 = dv[q].y * (S1 + __uint_as_float(gv[q].x & 0xffff0000u));
                S2 = dv[q].z * (S2 + __uint_as_float(gv[q].y << 16)); S3 = dv[q].w * (S3 + __uint_as_float(gv[q].y & 0xffff0000u)); }
        }
    }
}
template <int DV, bool HGRN, bool DRY = false>
__device__ __forceinline__ void pass_c(LAS unsigned char* lds, bf16* proj, const bf16* GS, int G, int bid, const int tid) {
    constexpr int H = HGRN ? 8 : 4, LD = HGRN ? HGRN_N : GLA_N, MTW = DV / 128, NU = BATCH * H * NCH;
    const int lane = tid & 63, wave = tid >> 6, g = lane >> 4, l15 = lane & 15, d = tid & 127, rg = tid >> 7;
    const int v0 = wave * MTW * 16;
    u32x4 rla[2], rq[2], rk[2], rv[DV / 64];
    int u = bid;
    if (u < NU) { const int b = u / (H * NCH), h = (u / NCH) % H, n = u % NCH; const bf16* base = proj + (size_t)(b * T + n * CH) * LD;
        load_raw128(base, LD, 1024 + h * 128, tid, rla); load_raw128(base, LD, h * 128, tid, rq); if (!HGRN) load_raw128(base, LD, 512 + h * 128, tid, rk); load_raw_v<DV>(base, LD, (HGRN ? 3072 : 2560) + h * DV, tid, rv); }
    for (; u < NU; u += G) {
        const int b = u / (H * NCH), h = (u / NCH) % H, n = u % NCH;
        bf16* base = proj + (size_t)(b * T + n * CH) * LD;
        const int vcol = (HGRN ? 3072 : 2560) + h * DV, gcol = (HGRN ? 2048 : 1536) + h * DV;
        store_raw128(lds, L_LA, tid, rla); store_raw128(lds, L_QS, tid, rq); if (!HGRN) store_raw128(lds, L_KS, tid, rk); store_raw_v<DV>(lds, tid, rv);
        __syncthreads();
        bf16x8 sfr[4][MTW];
#pragma unroll
        for (int kk = 0; kk < 4; ++kk)
#pragma unroll
            for (int mt = 0; mt < MTW; ++mt) sfr[kk][mt] = *(const bf16x8*)(GS + ((size_t)u * DV + v0 + mt * 16 + l15) * 128 + kk * 32 + 8 * g);
        { const int un = u + G; if (un < NU) { const int b2 = un / (H * NCH), h2 = (un / NCH) % H, n2 = un % NCH; const bf16* nb = proj + (size_t)(b2 * T + n2 * CH) * LD;
            load_raw128(nb, LD, 1024 + h2 * 128, tid, rla); load_raw128(nb, LD, h2 * 128, tid, rq); if (!HGRN) load_raw128(nb, LD, 512 + h2 * 128, tid, rk); load_raw_v<DV>(nb, LD, (HGRN ? 3072 : 2560) + h2 * DV, tid, rv); } }
        float bb[16], kv[16], blast;
        cumsum_local(lds, d, rg, bb);
#pragma unroll
        for (int i = 0; i < 16; ++i) kv[i] = HGRN ? (1.0f - __expf(bb[i])) : bf2f(*(const LAS bf16*)(lds + L_KS + (rg * 16 + i) * QS_STR + d * 2));
        cumsum_scan(lds, d, rg, bb);
        transpose_v<DV>(lds, tid);
        __syncthreads();
        cumsum_finish(lds, d, rg, bb, blast);
#pragma unroll
        for (int i = 0; i < 16; ++i) { const int s = rg * 16 + i; LAS bf16* qa = (LAS bf16*)(lds + L_QS + s * QS_STR + d * 2); LAS bf16* ka = (LAS bf16*)(lds + L_KS + s * QS_STR + d * 2);
            const float q = bf2f(*qa); *qa = (bf16)f2bf(q * __expf(bb[i])); *ka = (bf16)f2bf(kv[i] * __expf(-bb[i])); }
        __syncthreads();
        { const int tt = wave >> 1;
#pragma unroll
          for (int si = 0; si < 2; ++si) { const int st = (wave & 1) * 2 + si; f32x4 c = (f32x4){0.f, 0.f, 0.f, 0.f};
              bf16x8 afr[4], bfr[4];
#pragma unroll
              for (int kk = 0; kk < 4; ++kk) { afr[kk] = *(const LAS bf16x8*)(lds + L_KS + (st * 16 + l15) * QS_STR + (kk * 32 + 8 * g) * 2);
                  bfr[kk] = *(const LAS bf16x8*)(lds + L_QS + (tt * 16 + l15) * QS_STR + (kk * 32 + 8 * g) * 2); }
#pragma unroll
              for (int kk = 0; kk < 4; ++kk) c = MFMA16(afr[kk], bfr[kk], c);
              const int t = tt * 16 + l15, s0 = st * 16 + 4 * g;
              u32x2 w; w.x = pk2(s0 <= t ? c[0] : 0.f, s0 + 1 <= t ? c[1] : 0.f); w.y = pk2(s0 + 2 <= t ? c[2] : 0.f, s0 + 3 <= t ? c[3] : 0.f);
              *(LAS u32x2*)(lds + L_AT + t * KT_STR + s0 * 2) = w; } }
        u32x2 gt[4][MTW];
#pragma unroll
        for (int nt = 0; nt < 4; ++nt)
#pragma unroll
            for (int mt = 0; mt < MTW; ++mt) gt[nt][mt] = *(const u32x2*)(base + (size_t)(nt * 16 + l15) * LD + gcol + v0 + mt * 16 + 4 * g);
        __syncthreads();
        f32x4 acc[MTW][4];
#pragma unroll
        for (int mt = 0; mt < MTW; ++mt)
#pragma unroll
            for (int nt = 0; nt < 4; ++nt) acc[mt][nt] = (f32x4){0.f, 0.f, 0.f, 0.f};
#pragma unroll
        for (int kp = 0; kp < 2; ++kp) {
            bf16x8 bfr[2][4];
#pragma unroll
            for (int k2 = 0; k2 < 2; ++k2)
#pragma unroll
                for (int nt = 0; nt < 4; ++nt) bfr[k2][nt] = *(const LAS bf16x8*)(lds + L_QS + (nt * 16 + l15) * QS_STR + ((kp * 2 + k2) * 32 + 8 * g) * 2);
#pragma unroll
            for (int k2 = 0; k2 < 2; ++k2)
#pragma unroll
                for (int nt = 0; nt < 4; ++nt)
#pragma unroll
                    for (int mt = 0; mt < MTW; ++mt) acc[mt][nt] = MFMA16(sfr[kp * 2 + k2][mt], bfr[k2][nt], acc[mt][nt]);
        }
        {
            bf16x8 afr[2][MTW], bfr[2][4];
#pragma unroll
            for (int kk = 0; kk < 2; ++kk) {
#pragma unroll
                for (int mt = 0; mt < MTW; ++mt) afr[kk][mt] = *(const LAS bf16x8*)(lds + L_VT + (v0 + mt * 16 + l15) * KT_STR + (kk * 32 + 8 * g) * 2);
#pragma unroll
                for (int nt = 0; nt < 4; ++nt) bfr[kk][nt] = *(const LAS bf16x8*)(lds + L_AT + (nt * 16 + l15) * KT_STR + (kk * 32 + 8 * g) * 2); }
#pragma unroll
            for (int kk = 0; kk < 2; ++kk)
#pragma unroll
                for (int nt = 0; nt < 4; ++nt)
#pragma unroll
                    for (int mt = 0; mt < MTW; ++mt) acc[mt][nt] = MFMA16(afr[kk][mt], bfr[kk][nt], acc[mt][nt]);
        }
        LAS float* red = (LAS float*)(lds + L_RED);
#pragma unroll
        for (int nt = 0; nt < 4; ++nt) { float p = 0.f;
#pragma unroll
            for (int mt = 0; mt < MTW; ++mt) p += (acc[mt][nt][0] * acc[mt][nt][0] + acc[mt][nt][1] * acc[mt][nt][1]) + (acc[mt][nt][2] * acc[mt][nt][2] + acc[mt][nt][3] * acc[mt][nt][3]);
            p += pg8::shx(p, 16, lane); p += pg8::shx(p, 32, lane);
            if (g == 0) red[wave * 64 + nt * 16 + l15] = p; }
        __syncthreads();
#pragma unroll
        for (int nt = 0; nt < 4; ++nt) { const int t = nt * 16 + l15; float s = 0.f;
#pragma unroll
            for (int w = 0; w < 8; ++w) s += red[w * 64 + t];
            const float rstd = rsqrtf(s * (1.0f / DV) + EPS);
            bf16* rowp = base + (size_t)t * LD;
#pragma unroll
            for (int mt = 0; mt < MTW; ++mt) { const int v = v0 + mt * 16 + 4 * g; const u32x2 gg = gt[nt][mt];
                u32x2 w; w.x = pk2(acc[mt][nt][0] * rstd * __uint_as_float(gg.x << 16), acc[mt][nt][1] * rstd * __uint_as_float(gg.x & 0xffff0000u));
                w.y = pk2(acc[mt][nt][2] * rstd * __uint_as_float(gg.y << 16), acc[mt][nt][3] * rstd * __uint_as_float(gg.y & 0xffff0000u));
                if (!DRY || w.x == 0x12345678u) *(u32x2*)(rowp + vcol + v) = w; } }
    }
    __syncthreads();
}
constexpr int KL_STR = 272, VL_STR = 528, L_KL = 0, L_VL = 256 * KL_STR;
static_assert(L_VL + 128 * VL_STR <= LDS_BYTES, "xattn LDS map");
template <bool DRY = false>
__device__ __forceinline__ void xattn(LAS unsigned char* lds, bf16* proj, int LD, int xcol, const bf16* KM, const bf16* VMT, int G, int bid, const int tid) {
    const int lane = tid & 63, wave = tid >> 6, g = lane >> 4, l15 = lane & 15;
    for (int w = bid; w < 256; w += G) {
        const int pair = w >> 4, sub = w & 15, b = pair >> 2, h = pair & 3;
        __syncthreads();
#pragma unroll
        for (int i = 0; i < 8; ++i) { const int c = tid + i * NT, m = c >> 4, part = c & 15;
            *(LAS u32x4*)(lds + L_KL + m * KL_STR + part * 16) = *(const u32x4*)(KM + (size_t)(b * 256 + m) * 512 + h * 128 + part * 8); }
#pragma unroll
        for (int i = 0; i < 8; ++i) { const int c = tid + i * NT, dd = c >> 5, part = c & 31;
            *(LAS u32x4*)(lds + L_VL + dd * VL_STR + part * 16) = *(const u32x4*)(VMT + ((size_t)b * 512 + h * 128 + dd) * 256 + part * 8); }
        __syncthreads();
        bf16x8 qn[4];
        { const bf16* q0 = proj + (size_t)(b * T + (sub * 4) * 128 + wave * 16 + l15) * LD + xcol + h * 128;
#pragma unroll
          for (int kk = 0; kk < 4; ++kk) qn[kk] = *(const bf16x8*)(q0 + kk * 32 + 8 * g); }
        for (int tile = 0; tile < 4; ++tile) {
            const int r0 = b * T + (sub * 4 + tile) * 128 + wave * 16;
            bf16* qp = proj + (size_t)(r0 + l15) * LD + xcol + h * 128;
            bf16x8 qf[4];
#pragma unroll
            for (int kk = 0; kk < 4; ++kk) qf[kk] = qn[kk];
            if (tile < 3) {
#pragma unroll
                for (int kk = 0; kk < 4; ++kk) qn[kk] = *(const bf16x8*)(qp + (size_t)128 * LD + kk * 32 + 8 * g); }
            f32x4 sc[16];
#pragma unroll
            for (int mp = 0; mp < 8; ++mp) {
                bf16x8 afr[2][4];
#pragma unroll
                for (int m2 = 0; m2 < 2; ++m2)
#pragma unroll
                    for (int kk = 0; kk < 4; ++kk) afr[m2][kk] = *(const LAS bf16x8*)(lds + L_KL + ((mp * 2 + m2) * 16 + l15) * KL_STR + (kk * 32 + 8 * g) * 2);
#pragma unroll
                for (int m2 = 0; m2 < 2; ++m2) { f32x4 c = (f32x4){0.f, 0.f, 0.f, 0.f};
#pragma unroll
                    for (int kk = 0; kk < 4; ++kk) c = MFMA16(afr[m2][kk], qf[kk], c);
                    sc[mp * 2 + m2] = c; } }
            float mx = -1e30f;
#pragma unroll
            for (int mt = 0; mt < 16; ++mt) mx = fmaxf(mx, fmaxf(fmaxf(sc[mt][0], sc[mt][1]), fmaxf(sc[mt][2], sc[mt][3])));
            mx = fmaxf(mx, pg8::shx(mx, 16, lane)); mx = fmaxf(mx, pg8::shx(mx, 32, lane));
            float sum = 0.f;
#pragma unroll
            for (int mt = 0; mt < 16; ++mt) {
#pragma unroll
                for (int j = 0; j < 4; ++j) { const float p = __expf(sc[mt][j] - mx); sc[mt][j] = p; sum += p; } }
            sum += pg8::shx(sum, 16, lane); sum += pg8::shx(sum, 32, lane);
            const float inv = 1.0f / sum;
            f32x4 oa[8];
#pragma unroll
            for (int dt = 0; dt < 8; ++dt) oa[dt] = (f32x4){0.f, 0.f, 0.f, 0.f};
#pragma unroll
            for (int kb = 0; kb < 8; ++kb) {
                union { bf16x8 v; unsigned u[4]; } pb;
                pb.u[0] = pk2(sc[2 * kb][0], sc[2 * kb][1]); pb.u[1] = pk2(sc[2 * kb][2], sc[2 * kb][3]); pb.u[2] = pk2(sc[2 * kb + 1][0], sc[2 * kb + 1][1]); pb.u[3] = pk2(sc[2 * kb + 1][2], sc[2 * kb + 1][3]);
                union { bf16x8 v; u32x2 h[2]; } pa[8];
#pragma unroll
                for (int dt = 0; dt < 8; ++dt) { const LAS unsigned char* vp = lds + L_VL + (dt * 16 + l15) * VL_STR + (kb * 32 + 4 * g) * 2;
                    pa[dt].h[0] = *(const LAS u32x2*)vp; pa[dt].h[1] = *(const LAS u32x2*)(vp + 32); }
#pragma unroll
                for (int dt = 0; dt < 8; ++dt) oa[dt] = MFMA16(pa[dt].v, pb.v, oa[dt]);
            }
#pragma unroll
            for (int dt = 0; dt < 8; ++dt) { u32x2 o; o.x = pk2(oa[dt][0] * inv, oa[dt][1] * inv); o.y = pk2(oa[dt][2] * inv, oa[dt][3] * inv); if (!DRY || o.x == 0x12345678u) *(u32x2*)(qp + dt * 16 + 4 * g) = o; }
        }
    }
    __syncthreads();
}
__device__ __forceinline__ void final_norm(float* out, const bf16* XB, const float* SS, const float* gain, int gw, int ngw, int lane) {
    f32x4 gv[4];
#pragma unroll
    for (int j = 0; j < 4; ++j) gv[j] = ((const f32x4*)gain)[lane + 64 * j];
    for (int m = gw; m < M; m += ngw) {
        float s = lane < 16 ? SS[(size_t)lane * M + m] : 0.f; s = wave_sum(s, lane);
        const float rstd = rsqrtf(s * (1.0f / D) + EPS);
        const u32x2* xr = (const u32x2*)(XB + (size_t)m * D) + lane; f32x4* orow = (f32x4*)(out + (size_t)m * D) + lane;
#pragma unroll
        for (int j = 0; j < 4; ++j) { const u32x2 xw = xr[64 * j]; f32x4 v = (f32x4){__uint_as_float(xw.x << 16), __uint_as_float(xw.x & 0xffff0000u), __uint_as_float(xw.y << 16), __uint_as_float(xw.y & 0xffff0000u)};
            orow[64 * j] = v * rstd * gv[j]; }
    }
}

struct Args { Ptrs P; int ph_lo, ph_hi; };
constexpr int N_PHASES = 2 + 7 * DEPTH;
__global__ void __launch_bounds__(NT, 2) fwd_kernel(Args a) {
    extern __shared__ __attribute__((aligned(16))) unsigned char lds_raw[];
#if ONE_LAUNCH
    cg::grid_group grid = cg::this_grid();
    { volatile LAS unsigned* st = (volatile LAS unsigned*)((LAS unsigned char*)lds_raw + LDS_BARST); int t0_ = threadIdx.x; if (t0_ == 0) { st[0] = 0u; st[1] = 0u; } __syncthreads();
      (void)xcd_barrier_post((unsigned*)(a.P.ws + WS_CTL), st, t0_); }
#define SEAM() do { XcdBarrier xb_; xb_.bar = (unsigned*)(ws + WS_CTL); xb_.x = xb_xcc_id(); xb_.st = (volatile LAS unsigned*)(lds + LDS_BARST); xcd_barrier(xb_, tid); if (ph == 0) grid.sync(); } while (0)
#else
#define SEAM() do {} while (0)
#endif
    const int ph_lo = a.ph_lo, ph_hi = a.ph_hi;
    const int wave0 = __builtin_amdgcn_readfirstlane(threadIdx.x >> 6);
    for (int ph = ph_lo; ph < ph_hi; ++ph) {
        const __attribute__((address_space(4))) Args* ap = (const __attribute__((address_space(4))) Args*)__builtin_amdgcn_kernarg_segment_ptr();
        asm volatile("" : "+s"(ap));
        int zero_ = 0; asm volatile("" : "+v"(zero_));
        int tid = wave0 * 64 + (int)__builtin_amdgcn_mbcnt_hi(~0u, __builtin_amdgcn_mbcnt_lo(~0u, (unsigned)zero_)); asm volatile("" : "+v"(tid));
        LAS unsigned char* lds = (LAS unsigned char*)lds_raw;
        const int lane = tid & 63, wave = __builtin_amdgcn_readfirstlane(tid >> 6);
        int G = gridDim.x, bid = blockIdx.x; asm volatile("" : "+s"(G), "+s"(bid));
        const int gw = bid * NWAVES + wave, ngw = G * NWAVES;
        unsigned char* ws = ap->P.ws;
        float* SS = (float*)(ws + WS_SS); bf16* XB = (bf16*)ap->P.out; bf16* GS = (bf16*)(ws + WS_XB); bf16* X2 = (bf16*)(ws + WS_XB); bf16* PROJ = (bf16*)(ws + WS_PROJ);
        int ngemm = 0;
        int L = 0, sp = 0; bool hg = false;
        if (ph == 0) { prologue(&ap->P, lds, gw, ngw, wave, lane); }
        else if (ph == N_PHASES - 1) { final_norm(ap->P.out, X2, SS, ap->P.final_norm, gw, ngw, lane); }
        else {
            L = (ph - 1) / 7; sp = (ph - 1) % 7; hg = (L & 1);
            const int LD = hg ? HGRN_N : GLA_N;
            if (sp == 0) ngemm = (L == 0) ? 2 : 1;
            else if (sp == 1) {
                float* DEC = (float*)(ws + WS_DEC);
#if EXP == 3
                if (hg) pass_a<128, true>(lds, PROJ, GS, DEC, G, bid, tid); else pass_a<256, false>(lds, PROJ, GS, DEC, G, bid, tid);
#endif
                if (hg) pass_a<128, true>(lds, PROJ, GS, DEC, G, bid, tid); else pass_a<256, false>(lds, PROJ, GS, DEC, G, bid, tid);
#if EXP == 5
                xattn<true>(lds, PROJ, LD, hg ? 4096 : 3584, (const bf16*)(ws + WS_KM) + (size_t)L * 1024 * 512, (const bf16*)(ws + WS_VMT) + (size_t)L * 4 * 512 * 256, G, bid, tid);
#endif
#if EXP == 6
                if (L + 1 < DEPTH) { convert_layer(&ap->P, L + 1, lds, gw, ngw, wave, lane); } __syncthreads();
#endif
                xattn(lds, PROJ, LD, hg ? 4096 : 3584, (const bf16*)(ws + WS_KM) + (size_t)L * 1024 * 512, (const bf16*)(ws + WS_VMT) + (size_t)L * 4 * 512 * 256, G, bid, tid);
                if (L + 1 < DEPTH) { convert_layer(&ap->P, L + 1, lds, gw, ngw, wave, lane); }
            } else if (sp == 2) {
                const float* DEC = (const float*)(ws + WS_DEC);
#if EXP == 3
                if (hg) pass_b<128, true, true>(GS, DEC, G, bid, tid); else pass_b<256, false, true>(GS, DEC, G, bid, tid);
#endif
                if (hg) pass_b<128, true>(GS, DEC, G, bid, tid); else pass_b<256, false>(GS, DEC, G, bid, tid);
            } else if (sp == 3) {
#if EXP == 4
                if (hg) pass_c<128, true, true>(lds, PROJ, GS, G, bid, tid); else pass_c<256, false, true>(lds, PROJ, GS, G, bid, tid);
#endif
                if (hg) pass_c<128, true>(lds, PROJ, GS, G, bid, tid); else pass_c<256, false>(lds, PROJ, GS, G, bid, tid);
            } else ngemm = 1;
            if (EXP == 2 && (sp == 0 || sp == 5)) ngemm += 8;
        }
        for (int rep = 0; rep < (ngemm & 7) * (ngemm >= 8 ? 2 : 1); ++rep) {
            unsigned char* wb = ws + WS_WT + (size_t)(L & 1) * WT_BUF;
            const int LD = hg ? HGRN_N : GLA_N;
            pg8::Gemm g; pg8::EpiAll E; E.hgrn = hg ? 1 : 0; E.M = M; E.aux = nullptr; E.xin = nullptr; E.xout = nullptr;
            if (sp == 0 && (ngemm & 7) == 2 && (rep & 7) == 0 && rep < 8) {
                g.A = (const bf16*)(ws + WS_MEMB); g.Bt = (const bf16*)(ws + WS_WKV); g.M = MROWS; g.N = 4096; g.K = D; g.lda = D; g.perm = 0;
                E.kind = 3; E.ldc = 0; E.O = (bf16*)(ws + WS_KM); E.ss = (const float*)(ws + WS_SSM); E.xout = (float*)(ws + WS_VMT);
            } else if (sp == 0) {
                g.A = XB; g.Bt = (const bf16*)(wb + WT_IN); g.M = M; g.N = LD; g.K = D; g.lda = D; g.perm = 1;
                E.kind = 0; E.ldc = LD; E.O = PROJ; E.ss = SS; E.aux = hg ? (const float*)(ws + WS_LB) + (size_t)L * 1024 : ap->P.gla_b_gate + (size_t)(L >> 1) * 512;
            } else if (sp == 4) {
                g.A = PROJ + (hg ? 3072 : 2560); g.Bt = (const bf16*)(wb + WT_OUT); g.M = M; g.N = D; g.K = KOUT; g.lda = LD; g.perm = 1;
                E.kind = 2; E.ldc = D; E.O = XB; E.ss = SS; E.xin = (L == 0) ? ap->P.x : nullptr; E.xout = (float*)XB;
            } else if (sp == 5) {
                g.A = XB; g.Bt = (const bf16*)(wb + WT_UP); g.M = M; g.N = FF; g.K = D; g.lda = D; g.perm = 1;
                E.kind = 1; E.ldc = FF; E.O = PROJ; E.ss = SS;
            } else {
                g.A = PROJ; g.Bt = (const bf16*)(wb + WT_DOWN); g.M = M; g.N = D; g.K = FF; g.lda = FF; g.perm = 1;
                E.kind = 2; E.ldc = D; E.O = XB; E.ss = SS; E.xout = (float*)((L == DEPTH - 1) ? X2 : XB);
            }
#if EXP == 9
            if (E.kind == 2) { pg8::Gemm g2 = g; g2.perm = 1; pg8::EpiAll E2 = E; E2.kind = 1; E2.ldc = D; E2.O = GS; E2.ss = SS; E2.xin = nullptr;
                pg8::StaticOrder S2; S2.init(g2.M, g2.N, G, bid); pg8::gemm_phase<pg8::EpiAll, pg8::StaticOrder, true, true>(lds, g2, S2, E2, tid); }
#endif
            pg8::StaticOrder S; S.init(g.M, g.N, G, bid, (sp == 6) ? REV_DOWN : 0);
#if SKEW_TICKS > 0
            if (E.kind <= 1) {
                const unsigned long long t0_ = __builtin_amdgcn_s_memrealtime(); const unsigned long long dl_ = (unsigned long long)((bid & 7) * SKEW_TICKS);
                while (__builtin_amdgcn_s_memrealtime() - t0_ < dl_) __builtin_amdgcn_s_sleep(8);
            }
#endif
            pg8::gemm_phase<pg8::EpiAll, pg8::StaticOrder, true, true>(lds, g, S, E, tid);
        }
        if (ph + 1 < ph_hi) { SEAM(); }
#if EXP == 7
        if (ph + 1 < ph_hi) { SEAM(); }
#endif
    }
}

extern "C" void kernel_launch(void* const* d_in, const int* in_sizes, int n_in, void* d_out, int out_size, void* d_ws, size_t ws_size, hipStream_t stream) {
    static int grid = 0;
    if (grid == 0) {
        if (n_in != 17 || out_size != M * D || ws_size < WS_END) { fprintf(stderr, "kernel_launch: unexpected shapes (n_in %d out %d ws %zu)\n", n_in, out_size, ws_size); grid = -1; return; }
        int dev = 0, cus = 0, per_cu = 0;
        hipGetDevice(&dev); hipDeviceGetAttribute(&cus, hipDeviceAttributeMultiprocessorCount, dev);
        if (hipFuncSetAttribute((const void*)fwd_kernel, hipFuncAttributeMaxDynamicSharedMemorySize, LDS_BYTES) != hipSuccess) { fprintf(stderr, "kernel_launch: hipFuncSetAttribute failed\n"); grid = -1; return; }
        if (hipOccupancyMaxActiveBlocksPerMultiprocessor(&per_cu, (const void*)fwd_kernel, NT, LDS_BYTES) != hipSuccess || per_cu < 1) { fprintf(stderr, "kernel_launch: occupancy query says %d\n", per_cu); per_cu = 1; }
        (void)hipGetLastError();
        grid = cus * per_cu;
        if (grid > 256) grid = 256;
        grid = (grid / 16) * 16;
        fprintf(stderr, "kernel_launch: grid %d (cus %d per_cu %d)\n", grid, cus, per_cu);
    }
    if (grid <= 0) return;
#if ONE_LAUNCH
    if (hipMemsetAsync((char*)d_ws + WS_CTL, 0, CTL_BYTES, stream) != hipSuccess) { fprintf(stderr, "kernel_launch: memset failed\n"); return; }
#endif
    Args a{};
    const float** pp = (const float**)&a.P;
    for (int i = 0; i < 17; ++i) pp[i] = (const float*)d_in[i];
    a.P.out = (float*)d_out; a.P.ws = (unsigned char*)d_ws;
#if ONE_LAUNCH
    a.ph_lo = 0; a.ph_hi = N_PHASES;
    void* args[] = {&a};
    hipError_t e = hipLaunchCooperativeKernel((const void*)fwd_kernel, dim3(grid), dim3(NT), args, LDS_BYTES, stream);
    if (e != hipSuccess) fprintf(stderr, "kernel_launch: cooperative launch failed: %s (grid %d)\n", hipGetErrorString(e), grid);
#else
    for (int ph = 0; ph < N_PHASES; ++ph) { a.ph_lo = ph; a.ph_hi = ph + 1; hipLaunchKernelGGL(fwd_kernel, dim3(grid), dim3(NT), LDS_BYTES, stream, a); }
#endif
}
```

```cpp
#include <hip/hip_runtime.h>
#include <hip/hip_cooperative_groups.h>
#include <cstdio>
#include <cstdint>
namespace cg = cooperative_groups;

#ifndef EXP
#define EXP 0
#endif
#ifndef SKEW_TICKS
#define SKEW_TICKS 0
#endif
#ifndef REV_DOWN
#define REV_DOWN 0
#endif
#ifndef ONE_LAUNCH
#define ONE_LAUNCH 1
#endif

namespace pg8 {
#define PG8_LAS __attribute__((address_space(3)))
typedef unsigned short bf16_t;
typedef short bf16x8 __attribute__((ext_vector_type(8)));
typedef float f32x4 __attribute__((ext_vector_type(4)));
typedef unsigned u32x4 __attribute__((ext_vector_type(4)));
typedef unsigned u32x2 __attribute__((ext_vector_type(2)));
constexpr int BM = 256, BK = 64, HALF = 128, HTB = HALF * BK * 2, STAGE_BYTES = 8 * HTB, NXCD = 8, WGM = 8;

__host__ __device__ __forceinline__ int lds_byte(int r, int c) { const int st = (r >> 4) * 2 + (c >> 5), rr = r & 15, cc = c & 31, ob = rr * 64 + cc * 2; return st * 1024 + (ob ^ (((ob >> 9) & 1) << 5)); }
__host__ __device__ __forceinline__ void stage_rc(int b, int& R, int& C) { const int st = b / 1024, sb = b % 1024, swz = sb ^ (((sb >> 9) & 1) << 5); R = (st >> 1) * 16 + swz / 64; C = (st & 1) * 32 + (swz % 64) / 2; }
__host__ __device__ __forceinline__ int perm32(int rho) { const int n = rho >> 4, i = rho & 15; return 8 * (i >> 2) + 4 * n + (i & 3); }

struct Unit { int pm, pn; };
struct Gemm { const bf16_t* A; const bf16_t* Bt; int M, N, K, lda, perm; };

struct StaticOrder {
    int nM, nN, nwg, G, c, rev;
    __host__ __device__ void init(int M, int N, int G_, int c_, int rev_ = 0) { nM = M / BM; nN = N / BM; nwg = nM * nN; G = G_; c = c_; rev = rev_; }
    __host__ __device__ bool next(int i, Unit& u) const {
        const long L = (long)i * G + c; if (L >= nwg) return false;
        int wgid = (int)L; { const int q = nwg / NXCD, r = nwg % NXCD, xcd = wgid % NXCD, off = wgid / NXCD; wgid = (xcd < r ? xcd * (q + 1) : r * (q + 1) + (xcd - r) * q) + off; }
        const int nig = WGM * nN, gid = wgid / nig, fm = gid * WGM, gsz = (nM - fm) < WGM ? (nM - fm) : WGM;
        u.pm = fm + ((wgid % nig) % gsz); u.pn = (wgid % nig) / gsz; if (rev) u.pm = nM - 1 - u.pm; return true;
    }
    __device__ __forceinline__ void a_ready(const Unit&) const {}
    __device__ __forceinline__ void done(const Unit&) const {}
};

__device__ __forceinline__ float shx(float v, int mask, int lane) { return __int_as_float(__builtin_amdgcn_ds_bpermute((lane ^ mask) << 2, __float_as_int(v))); }
typedef float f32x2_t __attribute__((ext_vector_type(2)));
typedef __bf16 bf16x2_t __attribute__((ext_vector_type(2)));
__device__ __forceinline__ unsigned cvt_pk_native(float lo, float hi) { const f32x2_t f = {lo, hi}; const bf16x2_t b = __builtin_convertvector(f, bf16x2_t); return __builtin_bit_cast(unsigned, b); }
__device__ __forceinline__ unsigned cvt_pk_bf16(float lo, float hi) { unsigned r; asm volatile("v_cvt_pk_bf16_f32 %0, %1, %2" : "=v"(r) : "v"(lo), "v"(hi)); return r; }

__device__ __forceinline__ float fsigmoid(float v) { return __builtin_amdgcn_rcpf(1.0f + __expf(-v)); }
__device__ __forceinline__ float fsilu(float v) { return v * fsigmoid(v); }
__device__ __forceinline__ float row_rstd(const float* ss, int M, int row, int fq, int lane) {
    const float* p = ss + (size_t)(4 * fq) * M + row;
    float s = (p[0] + p[M]) + (p[2 * (size_t)M] + p[3 * (size_t)M]);
    s += shx(s, 16, lane); s += shx(s, 32, lane);
    return rsqrtf(s * (1.0f / 1024.0f) + 1e-6f);
}
template <int MODE> __device__ __forceinline__ float proj_act(float v, float a) {
    if (MODE == 1) return fsilu(v);
    if (MODE == 2) { const float z = v + a; const float ls = fminf(z, 0.f) - __logf(1.0f + __expf(-fabsf(z))); return ls * 0.0625f; }
    if (MODE == 3) { const float sg = fsigmoid(v); return __logf(a + (1.0f - a) * sg); }
    if (MODE == 4) return fsilu(v) * 0.08838834764831845f;
    if (MODE == 5) { const float r = fmaxf(v, 0.f); return r * r; }
    return v;
}
struct EpiAll {
    static constexpr bool AFTER_DRAIN = false;
    int kind, ldc, hgrn, M;
    bf16_t* O;
    const float* ss;
    const float* aux;
    const float* xin;
    float* xout;
    template <int MODE> __device__ __forceinline__ void body_proj(const f32x4 (&acc)[2][2][4][2], const Unit& u, int wr, int wc, int fr, int fq) const {
        const int row0 = u.pm * BM + wr * 64 + fr, col0 = u.pn * BM + wc * 32 + 8 * fq;
        f32x4 av[2][2];
#pragma unroll
        for (int bj = 0; bj < 2; ++bj)
#pragma unroll
            for (int n = 0; n < 2; ++n) av[bj][n] = (MODE == 2 || MODE == 3) ? *(const f32x4*)(aux + (col0 - 1024) + bj * HALF + 4 * n) : (f32x4){0.f, 0.f, 0.f, 0.f};
        float ps[2][4];
#pragma unroll
        for (int ai = 0; ai < 2; ++ai)
#pragma unroll
            for (int m = 0; m < 4; ++m) { const float* p = ss + (size_t)(4 * fq) * M + (row0 + ai * HALF + m * 16); ps[ai][m] = (p[0] + p[M]) + (p[2 * (size_t)M] + p[3 * (size_t)M]); }
        float rs[2][4];
#pragma unroll
        for (int ai = 0; ai < 2; ++ai)
#pragma unroll
            for (int m = 0; m < 4; ++m) { float s = ps[ai][m]; s += shx(s, 16, fq * 16 + fr); s += shx(s, 32, fq * 16 + fr); rs[ai][m] = rsqrtf(s * (1.0f / 1024.0f) + 1e-6f); }
#pragma unroll
        for (int ai = 0; ai < 2; ++ai)
#pragma unroll
            for (int m = 0; m < 4; ++m) { const int row = row0 + ai * HALF + m * 16; const float rstd = rs[ai][m]; bf16_t* rowp = O + (size_t)row * ldc + col0;
#pragma unroll
                for (int bj = 0; bj < 2; ++bj) { f32x4 v0 = acc[ai][bj][m][0] * rstd, v1 = acc[ai][bj][m][1] * rstd;
#pragma unroll
                    for (int j = 0; j < 4; ++j) { v0[j] = proj_act<MODE>(v0[j], av[bj][0][j]); v1[j] = proj_act<MODE>(v1[j], av[bj][1][j]); }
                    u32x4 w; w.x = cvt_pk_bf16(v0[0], v0[1]); w.y = cvt_pk_bf16(v0[2], v0[3]); w.z = cvt_pk_bf16(v1[0], v1[1]); w.w = cvt_pk_bf16(v1[2], v1[3]);
                    *(u32x4*)(rowp + bj * HALF) = w; } }
    }
    template <bool F32IN> __device__ __forceinline__ void body_res(const f32x4 (&acc)[2][2][4][2], const Unit& u, int wr, int wc, int fr, int fq) const {
        const int row0 = u.pm * BM + wr * 64 + fr, col0 = u.pn * BM + wc * 32 + 8 * fq; float* ssw = (float*)ss; bf16_t* XO = (bf16_t*)xout;
#pragma unroll
        for (int ai = 0; ai < 2; ++ai) {
            u32x4 xi[4][2];
            if (!F32IN) {
#pragma unroll
                for (int m = 0; m < 4; ++m) { const size_t off = (size_t)(row0 + ai * HALF + m * 16) * 1024 + col0;
#pragma unroll
                    for (int bj = 0; bj < 2; ++bj) xi[m][bj] = *(const u32x4*)(O + off + bj * HALF); } }
#pragma unroll
            for (int m = 0; m < 4; ++m) { const int row = row0 + ai * HALF + m * 16; const size_t off = (size_t)row * 1024 + col0; float s = 0.f;
#pragma unroll
                for (int bj = 0; bj < 2; ++bj) { f32x4 o0, o1;
                    if (F32IN) { o0 = *(const f32x4*)(xin + off + bj * HALF); o1 = *(const f32x4*)(xin + off + bj * HALF + 4); }
                    else { const u32x4 xw = xi[m][bj]; o0 = (f32x4){__uint_as_float(xw.x << 16), __uint_as_float(xw.x & 0xffff0000u), __uint_as_float(xw.y << 16), __uint_as_float(xw.y & 0xffff0000u)};
                        o1 = (f32x4){__uint_as_float(xw.z << 16), __uint_as_float(xw.z & 0xffff0000u), __uint_as_float(xw.w << 16), __uint_as_float(xw.w & 0xffff0000u)}; }
                    o0 = o0 + acc[ai][bj][m][0]; o1 = o1 + acc[ai][bj][m][1];
                    u32x4 w; w.x = cvt_pk_bf16(o0[0], o0[1]); w.y = cvt_pk_bf16(o0[2], o0[3]); w.z = cvt_pk_bf16(o1[0], o1[1]); w.w = cvt_pk_bf16(o1[2], o1[3]);
                    *(u32x4*)(XO + off + bj * HALF) = w;
#pragma unroll
                    for (int q = 0; q < 4; ++q) { const unsigned wq = q == 0 ? w.x : (q == 1 ? w.y : (q == 2 ? w.z : w.w)); const float r0 = __uint_as_float(wq << 16), r1 = __uint_as_float(wq & 0xffff0000u); s += r0 * r0 + r1 * r1; } }
                s += shx(s, 16, fq * 16 + fr); s += shx(s, 32, fq * 16 + fr);
                if (fq == 0) ssw[(size_t)(u.pn * 4 + wc) * M + row] = s; }
        }
    }
    __device__ __forceinline__ void body_kv(const f32x4 (&acc)[2][2][4][2], const Unit& u, int wr, int wc, int fr, int fq) const {
        const int row0 = u.pm * BM + wr * 64 + fr, layer = u.pn >> 2, cl0 = (u.pn & 3) * BM + wc * 32 + 4 * fq; bf16_t* VMT = (bf16_t*)xout;
#pragma unroll
        for (int ai = 0; ai < 2; ++ai)
#pragma unroll
            for (int m = 0; m < 4; ++m) { const int row = row0 + ai * HALF + m * 16; const float rstd = rsqrtf(ss[row] * (1.0f / 1024.0f) + 1e-6f);
#pragma unroll
                for (int bj = 0; bj < 2; ++bj)
#pragma unroll
                    for (int n = 0; n < 2; ++n) { const f32x4 o = acc[ai][bj][m][n] * rstd; const int cl = cl0 + bj * HALF + n * 16;
                        if (cl < 512) { u32x2 w; w.x = cvt_pk_bf16(o[0], o[1]); w.y = cvt_pk_bf16(o[2], o[3]); *(u32x2*)(O + ((size_t)layer * 1024 + row) * 512 + cl) = w; }
                        else { const unsigned lo = cvt_pk_bf16(o[0], o[1]), hi = cvt_pk_bf16(o[2], o[3]); bf16_t* d = VMT + ((size_t)(layer * 4 + (row >> 8)) * 512 + (cl - 512)) * 256 + (row & 255);
                            d[0] = (bf16_t)(lo & 0xffff); d[256] = (bf16_t)(lo >> 16); d[512] = (bf16_t)(hi & 0xffff); d[768] = (bf16_t)(hi >> 16); } } }
    }
    __device__ __forceinline__ void operator()(const f32x4 (&acc)[2][2][4][2], const Unit& u, int wr, int wc, int fr, int fq) const {
        if (kind == 0) {
            int mode;
            if (!hgrn) mode = (u.pn >= 4 && u.pn < 6) ? 2 : ((u.pn >= 6 && u.pn < 10) ? 1 : 0);
            else mode = u.pn < 4 ? 4 : (u.pn < 8 ? 3 : (u.pn < 12 ? 1 : 0));
            if (mode == 0) body_proj<0>(acc, u, wr, wc, fr, fq); else if (mode == 1) body_proj<1>(acc, u, wr, wc, fr, fq); else if (mode == 2) body_proj<2>(acc, u, wr, wc, fr, fq);
            else if (mode == 3) body_proj<3>(acc, u, wr, wc, fr, fq); else body_proj<4>(acc, u, wr, wc, fr, fq);
        } else if (kind == 1) body_proj<5>(acc, u, wr, wc, fr, fq);
        else if (kind == 2) { if (xin) body_res<true>(acc, u, wr, wc, fr, fq); else body_res<false>(acc, u, wr, wc, fr, fq); }
        else body_kv(acc, u, wr, wc, fr, fq);
    }
};

template <class Epi, class Sched, bool ALIGN_EPI = false, bool SP2 = false>
__device__ __forceinline__ void gemm_phase(PG8_LAS unsigned char* lds, const Gemm g, const Sched& S, const Epi& E, const int tid) {
    const int wid = __builtin_amdgcn_readfirstlane(tid >> 6), lane = tid & 63, wr = wid >> 2, wc = wid & 3, fr = lane & 15, fq = lane >> 4;
    const int K = g.K, nt = K / BK;
    unsigned voffA[2], voffB[2];
#pragma unroll
    for (int i = 0; i < 2; ++i) { int R, C; stage_rc(tid * 16 + i * 8192, R, C); const int Rb = g.perm ? ((R & ~31) + perm32(R & 31)) : R;
        voffA[i] = (unsigned)(R * g.lda + C) * 2u; voffB[i] = (unsigned)(Rb * K + C) * 2u; }
    const size_t kstep = (size_t)(BK * 2);
    const size_t hstepA = (size_t)HALF * g.lda * 2, hstepB = (size_t)HALF * K * 2;
    const size_t tstepA = 2 * hstepA, tstepB = 2 * hstepB;
    const unsigned ldsw = (unsigned)wid * 1024u;
    const int aoff = lds_byte(wr * 64 + fr, fq * 8), boff = lds_byte(wc * 32 + fr, fq * 8);
#define PG8_SA(b, h) (((b) * 2 + (h)) * HTB)
#define PG8_SB(b, h) ((4 + (b) * 2 + (h)) * HTB)
#define PG8_STAGE(bufoff, gbase, voff) do { _Pragma("unroll") for (int _i = 0; _i < 2; ++_i) \
        __builtin_amdgcn_global_load_lds((const unsigned*)((const char*)(gbase) + (voff)[_i]), (PG8_LAS unsigned*)(lds + (bufoff) + ldsw + _i * 8192), 16, 0, 0); } while (0)
#define PG8_LDA(dst, b, h) do { _Pragma("unroll") for (int m = 0; m < 4; ++m) _Pragma("unroll") for (int k = 0; k < 2; ++k) dst[m][k] = *(const PG8_LAS bf16x8*)(lds + PG8_SA(b, h) + aoff + m * 2048 + k * 1024); } while (0)
#define PG8_LDB(dst, b, h) do { _Pragma("unroll") for (int n = 0; n < 2; ++n) _Pragma("unroll") for (int k = 0; k < 2; ++k) dst[n][k] = *(const PG8_LAS bf16x8*)(lds + PG8_SB(b, h) + boff + n * 2048 + k * 1024); } while (0)
#define PG8_MMA(ai, bj, At, Bt) do { __builtin_amdgcn_s_setprio(1); _Pragma("unroll") for (int m = 0; m < 4; ++m) _Pragma("unroll") for (int n = 0; n < 2; ++n) _Pragma("unroll") for (int k = 0; k < 2; ++k) \
        acc[ai][bj][m][n] = __builtin_amdgcn_mfma_f32_16x16x32_bf16(Bt[n][k], At[m][k], acc[ai][bj][m][n], 0, 0, 0); __builtin_amdgcn_s_setprio(0); } while (0)
#define PG8_WAIT_V(n) asm volatile("s_waitcnt vmcnt(" #n ")" ::: "memory")
#define PG8_WAIT_L(n) asm volatile("s_waitcnt lgkmcnt(" #n ")" ::: "memory")
#define PG8_BAR __builtin_amdgcn_s_barrier()
#define PG8_SCHED __builtin_amdgcn_sched_barrier(0)
    Unit cur, nxt; int ui = 0;
    if (!S.next(0, cur)) return;
    f32x4 acc[2][2][4][2];
#pragma unroll
    for (int a = 0; a < 2; ++a)
#pragma unroll
        for (int b = 0; b < 2; ++b)
#pragma unroll
            for (int m = 0; m < 4; ++m)
#pragma unroll
                for (int n = 0; n < 2; ++n) acc[a][b][m][n] = (f32x4){0.f, 0.f, 0.f, 0.f};
    bf16x8 At[4][2], B0[2][2], B1[2][2];
    const char* cA = (const char*)g.A + (size_t)cur.pm * tstepA; const char* cB = (const char*)g.Bt + (size_t)cur.pn * tstepB;
    S.a_ready(cur);
    if constexpr (SP2) {
        PG8_STAGE(PG8_SB(0, 0), cB, voffB); PG8_STAGE(PG8_SB(0, 1), cB + hstepB, voffB); PG8_STAGE(PG8_SA(0, 0), cA, voffA); PG8_STAGE(PG8_SA(0, 1), cA + hstepA, voffA);
        if (wr == 1) PG8_BAR;
        PG8_WAIT_V(2); PG8_BAR;
        PG8_STAGE(PG8_SB(1, 0), cB + kstep, voffB); PG8_STAGE(PG8_SA(1, 0), cA + kstep, voffA); PG8_STAGE(PG8_SB(1, 1), cB + hstepB + kstep, voffB);
        PG8_WAIT_V(6); PG8_BAR;
    } else {
        PG8_STAGE(PG8_SB(0, 0), cB, voffB); PG8_STAGE(PG8_SA(0, 0), cA, voffA); PG8_STAGE(PG8_SB(0, 1), cB + hstepB, voffB); PG8_STAGE(PG8_SA(0, 1), cA + hstepA, voffA);
        if (wr == 1) PG8_BAR;
        PG8_WAIT_V(4); PG8_BAR;
        PG8_STAGE(PG8_SB(1, 0), cB + kstep, voffB); PG8_STAGE(PG8_SA(1, 0), cA + kstep, voffA); PG8_STAGE(PG8_SB(1, 1), cB + hstepB + kstep, voffB);
        PG8_WAIT_V(6); PG8_BAR;
    }
    for (;;) {
        const bool has_next = S.next(ui + 1, nxt);
        const char* nA = has_next ? (const char*)g.A + (size_t)nxt.pm * tstepA : cA; const char* nB = has_next ? (const char*)g.Bt + (size_t)nxt.pn * tstepB : cB;
        for (int t = 0; t < nt; t += 2) {
            const bool last = (t == nt - 2);
            const char* a1 = cA + (size_t)(t + 1) * kstep;
            const char* a2 = last ? nA : cA + (size_t)(t + 2) * kstep; const char* b2 = last ? nB : cB + (size_t)(t + 2) * kstep;
            const char* a3 = a2 + kstep; const char* b3 = b2 + kstep;
            if (last && has_next) S.a_ready(nxt);
            if constexpr (SP2) {
            PG8_LDB(B0, 0, 0); PG8_LDB(B1, 0, 1); PG8_SCHED; PG8_LDA(At, 0, 0); PG8_STAGE(PG8_SA(1, 1), a1 + hstepA, voffA);
            PG8_WAIT_V(8); PG8_WAIT_L(0); PG8_BAR; PG8_MMA(0, 0, At, B0); PG8_MMA(0, 1, At, B1); PG8_BAR; PG8_SCHED;
            PG8_LDA(At, 0, 1); PG8_STAGE(PG8_SB(0, 0), b2, voffB); PG8_STAGE(PG8_SB(0, 1), b2 + hstepB, voffB); PG8_STAGE(PG8_SA(0, 0), a2, voffA);
            PG8_WAIT_V(8); PG8_WAIT_L(0); PG8_BAR; PG8_MMA(1, 0, At, B0); PG8_MMA(1, 1, At, B1); PG8_BAR; PG8_SCHED;
            PG8_LDB(B0, 1, 0); PG8_LDB(B1, 1, 1); PG8_SCHED; PG8_LDA(At, 1, 0); PG8_STAGE(PG8_SA(0, 1), a2 + hstepA, voffA);
            PG8_WAIT_V(8); PG8_WAIT_L(0); PG8_BAR; PG8_MMA(0, 0, At, B0); PG8_MMA(0, 1, At, B1); PG8_BAR; PG8_SCHED;
            PG8_LDA(At, 1, 1); PG8_STAGE(PG8_SB(1, 0), b3, voffB); PG8_STAGE(PG8_SB(1, 1), b3 + hstepB, voffB); PG8_STAGE(PG8_SA(1, 0), a3, voffA);
            PG8_WAIT_V(8); PG8_WAIT_L(0); PG8_BAR; PG8_MMA(1, 0, At, B0); PG8_MMA(1, 1, At, B1); PG8_BAR; PG8_SCHED;
            } else {
            PG8_LDB(B0, 0, 0); PG8_SCHED; PG8_LDA(At, 0, 0); PG8_STAGE(PG8_SA(1, 1), a1 + hstepA, voffA);
            PG8_WAIT_L(8); PG8_BAR; PG8_WAIT_L(0); PG8_MMA(0, 0, At, B0); PG8_BAR; PG8_SCHED;
            PG8_LDB(B1, 0, 1); PG8_STAGE(PG8_SB(0, 0), b2, voffB);
            PG8_BAR; PG8_WAIT_L(0); PG8_MMA(0, 1, At, B1); PG8_BAR;
            PG8_LDA(At, 0, 1); PG8_STAGE(PG8_SA(0, 0), a2, voffA);
            PG8_BAR; PG8_WAIT_L(0); PG8_MMA(1, 0, At, B0); PG8_BAR; PG8_SCHED;
            PG8_STAGE(PG8_SB(0, 1), b2 + hstepB, voffB);
            PG8_WAIT_V(6); PG8_BAR; PG8_MMA(1, 1, At, B1); PG8_BAR;
            PG8_LDB(B0, 1, 0); PG8_SCHED; PG8_LDA(At, 1, 0); PG8_STAGE(PG8_SA(0, 1), a2 + hstepA, voffA);
            PG8_WAIT_L(8); PG8_BAR; PG8_WAIT_L(0); PG8_MMA(0, 0, At, B0); PG8_BAR; PG8_SCHED;
            PG8_LDB(B1, 1, 1); PG8_STAGE(PG8_SB(1, 0), b3, voffB);
            PG8_BAR; PG8_WAIT_L(0); PG8_MMA(0, 1, At, B1); PG8_BAR;
            PG8_LDA(At, 1, 1); PG8_STAGE(PG8_SA(1, 0), a3, voffA);
            PG8_BAR; PG8_WAIT_L(0); PG8_MMA(1, 0, At, B0); PG8_BAR; PG8_SCHED;
            PG8_STAGE(PG8_SB(1, 1), b3 + hstepB, voffB);
            PG8_WAIT_V(6); PG8_BAR; PG8_MMA(1, 1, At, B1); PG8_BAR;
            }
        }
        if constexpr (ALIGN_EPI) { if (wr == 0) PG8_BAR; }
        if constexpr (!Epi::AFTER_DRAIN) { E(acc, cur, wr, wc, fr, fq); S.done(cur); }
        if (!has_next) break;
#pragma unroll
        for (int a = 0; a < 2; ++a)
#pragma unroll
            for (int b = 0; b < 2; ++b)
#pragma unroll
                for (int m = 0; m < 4; ++m)
#pragma unroll
                    for (int n = 0; n < 2; ++n) acc[a][b][m][n] = (f32x4){0.f, 0.f, 0.f, 0.f};
        cur = nxt; cA = nA; cB = nB; ++ui;
        if constexpr (ALIGN_EPI) { if (wr == 1) PG8_BAR; }
    }
    PG8_WAIT_V(0);
    if constexpr (!ALIGN_EPI) { if (wr == 0) PG8_BAR; }
    PG8_BAR;
    if constexpr (Epi::AFTER_DRAIN) { E.fused(acc, cur, wr, wc, fr, fq, lds, wid, lane); S.done(cur); }
#undef PG8_SA
#undef PG8_SB
#undef PG8_STAGE
#undef PG8_LDA
#undef PG8_LDB
#undef PG8_MMA
#undef PG8_WAIT_V
#undef PG8_WAIT_L
#undef PG8_BAR
#undef PG8_SCHED
}
}

constexpr int NWAVES = 8, NT = 512;
constexpr int D = 1024, BATCH = 4, T = 8192, M = BATCH * T, DEPTH = 4, MEM = 256, MROWS = BATCH * MEM;
constexpr int DK = 128, CH = 64, NCH = T / CH;
constexpr int GLA_N = 4096, HGRN_N = 4608, FF = 4096, KOUT = 1536;
constexpr float EPS = 1e-6f;
constexpr size_t MiB = 1u << 20;
constexpr size_t WS_SS = 0;
constexpr size_t WS_DEC = 2 * MiB;
constexpr size_t WS_MEMB = 4 * MiB;
constexpr size_t WS_SSM = 6 * MiB;
constexpr size_t WS_LB = 6 * MiB + 65536;
constexpr size_t WS_KM = 8 * MiB;
constexpr size_t WS_VMT = 12 * MiB;
constexpr size_t WS_WKV = 16 * MiB;
constexpr size_t WS_WT = 24 * MiB, WT_BUF = 30 * MiB;
constexpr size_t WT_IN = 0, WT_OUT = 10 * MiB, WT_UP = 14 * MiB, WT_DOWN = 22 * MiB;
constexpr size_t WS_PROJ = 84 * MiB;
constexpr size_t WS_XB = 372 * MiB;
constexpr size_t WS_END = 500 * MiB;
constexpr int LDS_BYTES = 147456;

#define LAS __attribute__((address_space(3)))
typedef unsigned short bf16;
typedef float f32x4 __attribute__((ext_vector_type(4)));
typedef short bf16x8 __attribute__((ext_vector_type(8)));
typedef short bf16x4 __attribute__((ext_vector_type(4)));
typedef unsigned u32x4 __attribute__((ext_vector_type(4)));
typedef unsigned u32x2 __attribute__((ext_vector_type(2)));
__device__ __forceinline__ float bf2f(bf16 b) { return __uint_as_float(((unsigned)b) << 16); }
__device__ __forceinline__ unsigned f2bf(float f) { unsigned u = __float_as_uint(f); return (u + 0x7fffu + ((u >> 16) & 1u)) >> 16; }
__device__ __forceinline__ unsigned pk2(float lo, float hi) { return pg8::cvt_pk_bf16(lo, hi); }
__device__ __forceinline__ float wave_sum(float v, int lane) {
#pragma unroll
    for (int o = 1; o < 64; o <<= 1) v += pg8::shx(v, o, lane);
    return v;
}
#define MFMA16(a, b, c) __builtin_amdgcn_mfma_f32_16x16x32_bf16((a), (b), (c), 0, 0, 0)

constexpr size_t WS_CTL = 7 * MiB, CTL_BYTES = 16384;
constexpr int LDS_BARST = LDS_BYTES - 64;
#define XB_TMO      128
#define XB_XCNT(j)  (256  + 64 * (j))
#define XB_XSUB(j)  (1280 + 64 * (j))
#define XB_XGEN(j)  (2304 + 64 * (j))
#define XB_TOP      3328
#define XB_TOPGEN   3392
#define XCD_BAR_WORDS 3456
#define XB_SPIN_CAP (1u << 18)

__device__ __forceinline__ unsigned xb_ld(unsigned* p)              { return __hip_atomic_load(p, __ATOMIC_RELAXED, __HIP_MEMORY_SCOPE_AGENT); }
__device__ __forceinline__ unsigned xb_add(unsigned* p, unsigned v) { return __hip_atomic_fetch_add(p, v, __ATOMIC_RELAXED, __HIP_MEMORY_SCOPE_AGENT); }
__device__ __forceinline__ unsigned xb_xcc_id() { return (unsigned)__builtin_amdgcn_s_getreg((3 << 11) | 20) & 0xFu; }
#define XB_SPIN(cond, bar) do { unsigned _sp = 0; while (cond) { __builtin_amdgcn_s_sleep(1); \
    if ((++_sp & 255u) == 0u) { if (xb_ld(&(bar)[XB_TMO])) break; if (_sp > XB_SPIN_CAP) { atomicAdd(&(bar)[XB_TMO], 1u); break; } } } } while (0)

struct XcdBarrier {
    unsigned* bar; unsigned x;
    volatile LAS unsigned* st;
};

__device__ __forceinline__ XcdBarrier xcd_barrier_post(unsigned* bar, volatile LAS unsigned* st, int tid) {
    XcdBarrier b; b.bar = bar; b.x = xb_xcc_id(); b.st = st;
    if (tid == 0) (void)xb_add(&bar[XB_XCNT(b.x)], 1u);
    return b;
}
__device__ __forceinline__ void xcd_barrier_complete(unsigned* bar, unsigned x, unsigned& nloc, unsigned& nx) {
    const unsigned G = gridDim.x * gridDim.y * gridDim.z;
    unsigned sum, cnt, mine, sp = 0u;
    for (;;) {
        sum = 0u; cnt = 0u; mine = 0u;
#pragma unroll
        for (unsigned j = 0; j < 16; ++j) { const unsigned c = xb_ld(&bar[XB_XCNT(j)]); sum += c; cnt += (c > 0u) ? 1u : 0u; mine = (j == x) ? c : mine; }
        if (sum == G) break;
        __builtin_amdgcn_s_sleep(1);
        if ((++sp & 255u) == 0u) { if (xb_ld(&bar[XB_TMO])) break; if (sp > XB_SPIN_CAP) { atomicAdd(&bar[XB_TMO], 1u); break; } }
    }
    nloc = mine > 0u ? mine : 1u; nx = cnt > 0u ? cnt : 1u;
}

__device__ __forceinline__ void xcd_barrier(const XcdBarrier& b, int tid) {
    asm volatile("s_waitcnt vmcnt(0)" ::: "memory");
    __syncthreads();
    if (tid == 0) {
        unsigned* bar = b.bar;
        __builtin_amdgcn_s_waitcnt(0);
        unsigned nloc = b.st[0], nx = b.st[1];
        if (nloc == 0u) { xcd_barrier_complete(bar, b.x, nloc, nx); b.st[0] = nloc; b.st[1] = nx; }
        const unsigned old = xb_add(&bar[XB_XSUB(b.x)], 1u);
        const unsigned gen = old / nloc;
        if (old + 1u == (gen + 1u) * nloc) {
            __builtin_amdgcn_fence(__ATOMIC_RELEASE, "agent");
            asm volatile("s_waitcnt vmcnt(0)" ::: "memory");
            const unsigned og = xb_add(&bar[XB_TOP], 1u);
            const unsigned tg = og / nx;
            if (og + 1u == (tg + 1u) * nx) xb_add(&bar[XB_TOPGEN], 1u);
            else XB_SPIN(xb_ld(&bar[XB_TOPGEN]) == tg, bar);
            __builtin_amdgcn_fence(__ATOMIC_ACQUIRE, "agent");
            xb_add(&bar[XB_XGEN(b.x)], 1u);
            asm volatile("s_waitcnt vmcnt(0)" ::: "memory");
        } else {
            XB_SPIN(xb_ld(&bar[XB_XGEN(b.x)]) == gen, bar);
            __builtin_amdgcn_fence(__ATOMIC_ACQUIRE, "agent");
            asm volatile("s_waitcnt vmcnt(0)" ::: "memory");
        }
    }
    __syncthreads();
}

__device__ __forceinline__ void transpose_item(const float* W, int ldw, int K, int sc, bf16* WT, int dr, const float* gain, int gmask, int glimit, float scale, LAS float* scr, int item, int nblk, int lane) {
    const int kb = item / nblk, nb = item % nblk, k0 = 64 * kb, n0 = 32 * nb;
#pragma unroll 8
    for (int i = 0; i < 32; ++i) { const int kk = 2 * i + (lane >> 5); const int k = k0 + kk; float g = scale; if (gain && k < glimit) g *= gain[k & gmask];
        scr[kk * 33 + (lane & 31)] = W[(size_t)k * ldw + sc + n0 + (lane & 31)] * g; }
    asm volatile("s_waitcnt lgkmcnt(0)" ::: "memory");
    const int c = lane & 7;
#pragma unroll
    for (int j = 0; j < 4; ++j) { const int n = (lane >> 3) + 8 * j; const LAS float* s = scr + (8 * c) * 33 + n;
        u32x4 o; o.x = pk2(s[0 * 33], s[1 * 33]); o.y = pk2(s[2 * 33], s[3 * 33]); o.z = pk2(s[4 * 33], s[5 * 33]); o.w = pk2(s[6 * 33], s[7 * 33]);
        *(u32x4*)(WT + (size_t)(dr + n0 + n) * K + k0 + 8 * c) = o; }
    asm volatile("s_waitcnt lgkmcnt(0)" ::: "memory");
}
struct Ptrs {
    const float *x, *mem, *norm_mix, *norm_mem, *w_kv, *w_out, *norm_mlp, *w_up, *w_down, *gla_w_in, *gla_w_gate2, *gla_b_gate, *gla_out_gain, *hgrn_w_in, *hgrn_lb, *hgrn_out_gain, *final_norm;
    float* out; unsigned char* ws;
};
#define SEG(Wp, ldw, K, sc, ncols, WTp, dr, gain, gmask, glimit, scale) { const int nblk_ = (ncols) / 32, nit_ = ((K) / 64) * nblk_; \
    if (r < nit_) { transpose_item(Wp, ldw, K, sc, WTp, dr, gain, gmask, glimit, scale, scr, r, nblk_, lane); continue; } r -= nit_; }
template <class PT> __device__ __forceinline__ void convert_layer(PT Pp, int L, LAS unsigned char* lds, int gw, int ngw, int wave, int lane) {
    LAS float* scr = (LAS float*)(lds + wave * 16384);
    unsigned char* wb = Pp->ws + WS_WT + (size_t)(L & 1) * WT_BUF;
    bf16* Win = (bf16*)(wb + WT_IN); bf16* Wout = (bf16*)(wb + WT_OUT); bf16* Wup = (bf16*)(wb + WT_UP); bf16* Wdn = (bf16*)(wb + WT_DOWN);
    const int j = L >> 1; const bool hg = (L & 1);
    const float* gmix = Pp->norm_mix + (size_t)L * D; const float* gmlp = Pp->norm_mlp + (size_t)L * D;
    const float* wo = Pp->w_out + (size_t)L * KOUT * D; const float* wu = Pp->w_up + (size_t)L * D * FF; const float* wd = Pp->w_down + (size_t)L * FF * D;
    const float QS = 0.08838834764831845f;
    if (!hg) {
        const float* wi = Pp->gla_w_in + (size_t)j * D * 3600; const float* og = Pp->gla_out_gain + (size_t)j * 256;
        const int total = 16 * (16 + 16 + 32 + 32 + 16) + 24 * 32 + 16 * 128 + 64 * 32 + 128;
        for (int it = gw; it < total; it += ngw) { int r = it;
            SEG(wi, 3600, D, 0, 512, Win, 0, gmix, 1023, D, QS)
            SEG(wi, 3600, D, 512, 512, Win, 512, gmix, 1023, D, 1.f)
            SEG(wi, 3600, D, 1024, 1024, Win, 2560, gmix, 1023, D, 1.f)
            SEG(wi, 3600, D, 2064, 1024, Win, 1536, gmix, 1023, D, 1.f)
            SEG(wi, 3600, D, 3088, 512, Win, 3584, gmix, 1023, D, QS)
            SEG(wo, D, KOUT, 0, 1024, Wout, 0, og, 255, 1024, 1.f)
            SEG(wu, FF, D, 0, 4096, Wup, 0, gmlp, 1023, D, 1.f)
            SEG(wd, D, FF, 0, 1024, Wdn, 0, (const float*)nullptr, 0, 0, 1.f)
            { const int kb = r >> 3, cb = r & 7, k = kb * 64 + lane; const float* g2 = Pp->gla_w_gate2 + (size_t)j * 16 * 512 + cb * 64;
              const f32x4* wr4 = (const f32x4*)(wi + (size_t)k * 3600 + 2048); const f32x4 w0 = wr4[0], w1 = wr4[1], w2 = wr4[2], w3 = wr4[3]; const float gk = gmix[k];
              for (int c = 0; c < 64; ++c) { float s = 0.f;
#pragma unroll
                  for (int q = 0; q < 4; ++q) { s += w0[q] * g2[q * 512 + c]; s += w1[q] * g2[(4 + q) * 512 + c]; s += w2[q] * g2[(8 + q) * 512 + c]; s += w3[q] * g2[(12 + q) * 512 + c]; }
                  Win[(size_t)(1024 + cb * 64 + c) * D + k] = (bf16)f2bf(s * gk); } }
        }
    } else {
        const float* wi = Pp->hgrn_w_in + (size_t)j * D * 4608; const float* og = Pp->hgrn_out_gain + (size_t)j * 128;
        const int total = 16 * (32 + 32 + 32 + 32 + 16) + 24 * 32 + 16 * 128 + 64 * 32;
        for (int it = gw; it < total; it += ngw) { int r = it;
            SEG(wi, 4608, D, 0, 1024, Win, 0, gmix, 1023, D, 1.f)
            SEG(wi, 4608, D, 1024, 1024, Win, 1024, gmix, 1023, D, 1.f)
            SEG(wi, 4608, D, 2048, 1024, Win, 3072, gmix, 1023, D, 1.f)
            SEG(wi, 4608, D, 3072, 1024, Win, 2048, gmix, 1023, D, 1.f)
            SEG(wi, 4608, D, 4096, 512, Win, 4096, gmix, 1023, D, QS)
            SEG(wo, D, KOUT, 0, 1024, Wout, 0, og, 127, 1024, 1.f)
            SEG(wu, FF, D, 0, 4096, Wup, 0, gmlp, 1023, D, 1.f)
            { const int nblk_ = 32; transpose_item(wd, D, FF, 0, Wdn, 0, (const float*)nullptr, 0, 0, 1.f, scr, r, nblk_, lane); }
        }
    }
}
template <class PT> __device__ __forceinline__ void prologue(PT Pp, LAS unsigned char* lds, int gw, int ngw, int wave, int lane) {
    convert_layer(Pp, 0, lds, gw, ngw, wave, lane);
    { LAS float* scr = (LAS float*)(lds + wave * 16384); bf16* Wkv = (bf16*)(Pp->ws + WS_WKV);
      const int per = 16 * 32, total = 4 * per;
      for (int it = gw; it < total; it += ngw) { const int L = it / per, r = it % per;
          transpose_item(Pp->w_kv + (size_t)L * D * 1024, 1024, D, 0, Wkv + (size_t)L * 1024 * D, 0, Pp->norm_mem + (size_t)L * D, 1023, D, 1.f, scr, r, 32, lane); } }
    { float* LB = (float*)(Pp->ws + WS_LB);
      for (int c = gw * 64 + lane; c < 1024; c += ngw * 64) { const float v0 = Pp->hgrn_lb[c], v1 = Pp->hgrn_lb[1024 + c], v2 = Pp->hgrn_lb[2048 + c], v3 = Pp->hgrn_lb[3072 + c];
          const float mx = fmaxf(fmaxf(v0, v1), fmaxf(v2, v3)); const float e0 = expf(v0 - mx), e1 = expf(v1 - mx), e2 = expf(v2 - mx), e3 = expf(v3 - mx); const float inv = 1.0f / (e0 + e1 + e2 + e3);
          LB[c] = 0.f; LB[1024 + c] = e1 * inv; LB[2048 + c] = (e1 + e2) * inv; LB[3072 + c] = (e1 + e2 + e3) * inv; } }
    bf16* XB = (bf16*)Pp->out; float* SS = (float*)(Pp->ws + WS_SS);     bf16* MB = (bf16*)(Pp->ws + WS_MEMB); float* SSM = (float*)(Pp->ws + WS_SSM);
    for (int m = gw; m < M + MROWS; m += ngw) {
        const bool ism = m >= M; const int row = ism ? m - M : m;
        const f32x4* xr = (const f32x4*)((ism ? Pp->mem : Pp->x) + (size_t)row * D) + lane; unsigned long long* o8 = (unsigned long long*)((ism ? MB : XB) + (size_t)row * D) + lane;
        float s = 0.f;
#pragma unroll
        for (int j = 0; j < 4; ++j) { const f32x4 v = xr[64 * j]; s += (v.x * v.x + v.y * v.y) + (v.z * v.z + v.w * v.w); o8[64 * j] = (unsigned long long)pk2(v.x, v.y) | ((unsigned long long)pk2(v.z, v.w) << 32); }
        s = wave_sum(s, lane);
        if (ism) { if (lane == 0) SSM[row] = s; }
        else if (lane < 16) SS[(size_t)lane * M + row] = lane == 0 ? s : 0.f;
    }
}
constexpr int KT_STR = 144;
constexpr int QS_STR = 272;
constexpr int VS_STR = 528;
constexpr int L_TOT = 0;
constexpr int L_LA = 2048;
constexpr int L_QS = L_LA + 64 * QS_STR;
constexpr int L_KS = L_QS + 64 * QS_STR;
constexpr int L_VS = L_KS + 64 * QS_STR;
constexpr int L_VT = L_VS + 64 * VS_STR;
constexpr int L_KT = L_VT + 256 * KT_STR;
constexpr int L_AT = L_KT;
constexpr int L_RED = L_KT + 128 * KT_STR;
static_assert(L_RED + 2048 <= LDS_BYTES - 64, "mixer LDS map");

__device__ __forceinline__ void ds_read16_s272(const LAS unsigned char* p, unsigned (&r)[16]) {
    const unsigned a = (unsigned)(__SIZE_TYPE__)p;
    asm volatile("ds_read_u16 %0, %16 offset:0\n\tds_read_u16 %1, %16 offset:272\n\tds_read_u16 %2, %16 offset:544\n\tds_read_u16 %3, %16 offset:816\n\tds_read_u16 %4, %16 offset:1088\n\tds_read_u16 %5, %16 offset:1360\n\tds_read_u16 %6, %16 offset:1632\n\tds_read_u16 %7, %16 offset:1904\n\tds_read_u16 %8, %16 offset:2176\n\tds_read_u16 %9, %16 offset:2448\n\tds_read_u16 %10, %16 offset:2720\n\tds_read_u16 %11, %16 offset:2992\n\tds_read_u16 %12, %16 offset:3264\n\tds_read_u16 %13, %16 offset:3536\n\tds_read_u16 %14, %16 offset:3808\n\tds_read_u16 %15, %16 offset:4080\n\ts_waitcnt lgkmcnt(0)"
        : "=&v"(r[0]), "=&v"(r[1]), "=&v"(r[2]), "=&v"(r[3]), "=&v"(r[4]), "=&v"(r[5]), "=&v"(r[6]), "=&v"(r[7]), "=&v"(r[8]), "=&v"(r[9]), "=&v"(r[10]), "=&v"(r[11]), "=&v"(r[12]), "=&v"(r[13]), "=&v"(r[14]), "=&v"(r[15]) : "v"(a) : "memory");
}
__device__ __forceinline__ void ds_read16_s528(const LAS unsigned char* p, unsigned (&r)[16]) {
    const unsigned a = (unsigned)(__SIZE_TYPE__)p;
    asm volatile("ds_read_u16 %0, %16 offset:0\n\tds_read_u16 %1, %16 offset:528\n\tds_read_u16 %2, %16 offset:1056\n\tds_read_u16 %3, %16 offset:1584\n\tds_read_u16 %4, %16 offset:2112\n\tds_read_u16 %5, %16 offset:2640\n\tds_read_u16 %6, %16 offset:3168\n\tds_read_u16 %7, %16 offset:3696\n\tds_read_u16 %8, %16 offset:4224\n\tds_read_u16 %9, %16 offset:4752\n\tds_read_u16 %10, %16 offset:5280\n\tds_read_u16 %11, %16 offset:5808\n\tds_read_u16 %12, %16 offset:6336\n\tds_read_u16 %13, %16 offset:6864\n\tds_read_u16 %14, %16 offset:7392\n\tds_read_u16 %15, %16 offset:7920\n\ts_waitcnt lgkmcnt(0)"
        : "=&v"(r[0]), "=&v"(r[1]), "=&v"(r[2]), "=&v"(r[3]), "=&v"(r[4]), "=&v"(r[5]), "=&v"(r[6]), "=&v"(r[7]), "=&v"(r[8]), "=&v"(r[9]), "=&v"(r[10]), "=&v"(r[11]), "=&v"(r[12]), "=&v"(r[13]), "=&v"(r[14]), "=&v"(r[15]) : "v"(a) : "memory");
}
template <int DV>
__device__ __forceinline__ void load_raw_v(const bf16* base, int ld, int vcol, int tid, u32x4 (&rv)[DV / 64]) {
#pragma unroll
    for (int i = 0; i < DV / 64; ++i) { const int c = tid + i * NT, row = c / (DV / 8), part = c % (DV / 8); rv[i] = *(const u32x4*)(base + (size_t)row * ld + vcol + part * 8); }
}
template <int DV>
__device__ __forceinline__ void store_raw_v(LAS unsigned char* lds, int tid, const u32x4 (&rv)[DV / 64]) {
#pragma unroll
    for (int i = 0; i < DV / 64; ++i) { const int c = tid + i * NT, row = c / (DV / 8), part = c % (DV / 8); *(LAS u32x4*)(lds + L_VS + row * VS_STR + part * 16) = rv[i]; }
}
__device__ __forceinline__ void load_raw128(const bf16* base, int ld, int col, int tid, u32x4 (&r)[2]) {
#pragma unroll
    for (int i = 0; i < 2; ++i) { const int c = tid + i * NT; r[i] = *(const u32x4*)(base + (size_t)(c >> 4) * ld + col + (c & 15) * 8); }
}
__device__ __forceinline__ void store_raw128(LAS unsigned char* lds, int off, int tid, const u32x4 (&r)[2]) {
#pragma unroll
    for (int i = 0; i < 2; ++i) { const int c = tid + i * NT; *(LAS u32x4*)(lds + off + (c >> 4) * QS_STR + (c & 15) * 16) = r[i]; }
}
template <int DV>
__device__ __forceinline__ void transpose_v(LAS unsigned char* lds, int tid) {
    constexpr int RPT = DV / 8;
    const int v = tid % DV, part = tid / DV;
    unsigned w[RPT / 2];
#pragma unroll
    for (int h = 0; h < RPT / 16; ++h) { unsigned r[16]; ds_read16_s528(lds + L_VS + (part * RPT + 16 * h) * VS_STR + v * 2, r);
#pragma unroll
        for (int i = 0; i < 8; ++i) w[8 * h + i] = r[2 * i] | (r[2 * i + 1] << 16); }
    LAS u32x4* dst = (LAS u32x4*)(lds + L_VT + v * KT_STR + part * RPT * 2);
#pragma unroll
    for (int i = 0; i < RPT / 8; ++i) dst[i] = (u32x4){w[4 * i], w[4 * i + 1], w[4 * i + 2], w[4 * i + 3]};
}
__device__ __forceinline__ void cumsum_local(LAS unsigned char* lds, int d, int rg, float (&bb)[16]) {
    unsigned r[16]; ds_read16_s272(lds + L_LA + (rg * 16) * QS_STR + d * 2, r);
#pragma unroll
    for (int i = 0; i < 16; ++i) bb[i] = __uint_as_float(r[i] << 16);
}
__device__ __forceinline__ void cumsum_scan(LAS unsigned char* lds, int d, int rg, float (&bb)[16]) {
#pragma unroll
    for (int i = 1; i < 16; ++i) bb[i] += bb[i - 1];
    ((LAS float*)(lds + L_TOT))[rg * 128 + d] = bb[15];
}
__device__ __forceinline__ void cumsum_finish(LAS unsigned char* lds, int d, int rg, float (&bb)[16], float& blast) {
    const LAS float* tot = (const LAS float*)(lds + L_TOT);
    const float t0 = tot[d], t1 = tot[128 + d], t2 = tot[256 + d], t3 = tot[384 + d];
    const float off = rg == 0 ? 0.f : (rg == 1 ? t0 : (rg == 2 ? t0 + t1 : t0 + t1 + t2));
    blast = (t0 + t1) + (t2 + t3);
#pragma unroll
    for (int i = 0; i < 16; ++i) bb[i] += off;
}
template <int DV, bool HGRN>
__device__ __forceinline__ void pass_a(LAS unsigned char* lds, const bf16* proj, bf16* GS, float* DEC, int G, int bid, const int tid) {
    constexpr int H = HGRN ? 8 : 4, LD = HGRN ? HGRN_N : GLA_N, NTW = DV / 128, NU = BATCH * H * NCH;
    const int lane = tid & 63, wave = tid >> 6, g = lane >> 4, l15 = lane & 15, d = tid & 127, rg = tid >> 7;
    u32x4 rla[2], rk[2], rv[DV / 64];
    int u = bid;
    if (u < NU) { const int b = u / (H * NCH), h = (u / NCH) % H, n = u % NCH; const bf16* base = proj + (size_t)(b * T + n * CH) * LD;
        load_raw128(base, LD, 1024 + h * 128, tid, rla); if (!HGRN) load_raw128(base, LD, 512 + h * 128, tid, rk); load_raw_v<DV>(base, LD, (HGRN ? 3072 : 2560) + h * DV, tid, rv); }
    for (; u < NU; u += G) {
        store_raw128(lds, L_LA, tid, rla); if (!HGRN) store_raw128(lds, L_KS, tid, rk); store_raw_v<DV>(lds, tid, rv);
        __syncthreads();
        { const int un = u + G; if (un < NU) { const int b = un / (H * NCH), h = (un / NCH) % H, n = un % NCH; const bf16* base = proj + (size_t)(b * T + n * CH) * LD;
            load_raw128(base, LD, 1024 + h * 128, tid, rla); if (!HGRN) load_raw128(base, LD, 512 + h * 128, tid, rk); load_raw_v<DV>(base, LD, (HGRN ? 3072 : 2560) + h * DV, tid, rv); } }
        float bb[16], kv[16], blast;
        cumsum_local(lds, d, rg, bb);
        if (HGRN) {
#pragma unroll
            for (int i = 0; i < 16; ++i) kv[i] = 1.0f - __expf(bb[i]);
        } else { unsigned r[16]; ds_read16_s272(lds + L_KS + (rg * 16) * QS_STR + d * 2, r);
#pragma unroll
            for (int i = 0; i < 16; ++i) kv[i] = __uint_as_float(r[i] << 16); }
        cumsum_scan(lds, d, rg, bb);
        transpose_v<DV>(lds, tid);
        __syncthreads();
        cumsum_finish(lds, d, rg, bb, blast);
        { unsigned w[8];
#pragma unroll
          for (int i = 0; i < 8; ++i) w[i] = pk2(kv[2 * i] * __expf(-bb[2 * i]), kv[2 * i + 1] * __expf(-bb[2 * i + 1]));
          LAS u32x4* dst = (LAS u32x4*)(lds + L_KT + d * KT_STR + rg * 32);
          dst[0] = (u32x4){w[0], w[1], w[2], w[3]}; dst[1] = (u32x4){w[4], w[5], w[6], w[7]}; }
        if (rg == 0) DEC[(size_t)u * 128 + d] = __expf(blast);
        __syncthreads();
        f32x4 acc[8][NTW];
#pragma unroll
        for (int mt = 0; mt < 8; ++mt)
#pragma unroll
            for (int nt = 0; nt < NTW; ++nt) acc[mt][nt] = (f32x4){0.f, 0.f, 0.f, 0.f};
#pragma unroll
        for (int kk = 0; kk < 2; ++kk) {
            bf16x8 bfr[NTW], afr[8];
#pragma unroll
            for (int nt = 0; nt < NTW; ++nt) bfr[nt] = *(const LAS bf16x8*)(lds + L_VT + ((wave * NTW + nt) * 16 + l15) * KT_STR + (kk * 32 + 8 * g) * 2);
#pragma unroll
            for (int mt = 0; mt < 8; ++mt) afr[mt] = *(const LAS bf16x8*)(lds + L_KT + ((mt >> 1) * 32 + 8 * (l15 >> 2) + 4 * (mt & 1) + (l15 & 3)) * KT_STR + (kk * 32 + 8 * g) * 2);
#pragma unroll
            for (int mt = 0; mt < 8; ++mt)
#pragma unroll
                for (int nt = 0; nt < NTW; ++nt) acc[mt][nt] = MFMA16(afr[mt], bfr[nt], acc[mt][nt]);
        }
#pragma unroll
        for (int mt = 0; mt < 8; ++mt)
#pragma unroll
            for (int nt = 0; nt < NTW; ++nt) asm volatile("s_nop 7\n\ts_nop 7" : "+v"(acc[mt][nt]));
#pragma unroll
        for (int nt = 0; nt < NTW; ++nt) { bf16* gp = GS + ((size_t)u * DV + (wave * NTW + nt) * 16 + l15) * 128 + 8 * g;
#pragma unroll
            for (int P = 0; P < 4; ++P) { u32x4 w; w.x = pk2(acc[2 * P][nt][0], acc[2 * P][nt][1]); w.y = pk2(acc[2 * P][nt][2], acc[2 * P][nt][3]);
                w.z = pk2(acc[2 * P + 1][nt][0], acc[2 * P + 1][nt][1]); w.w = pk2(acc[2 * P + 1][nt][2], acc[2 * P + 1][nt][3]); *(u32x4*)(gp + P * 32) = w; } }
    }
    __syncthreads();
}
template <int DV, bool HGRN, bool DRY = false>
__device__ __forceinline__ void pass_b(bf16* GS, const float* DEC, int G, int bid, const int tid) {
    constexpr int H = HGRN ? 8 : 4, E = DV * 128, E4 = E / 4;
    const int nthreads = G * NT;
    for (int i = bid * NT + tid; i < BATCH * H * E4; i += nthreads) {
        const int bh = i / E4, e = (i % E4) * 4, d = e & 127;
        float S0 = 0.f, S1 = 0.f, S2 = 0.f, S3 = 0.f;
        u32x2* gp = (u32x2*)(GS + (size_t)bh * NCH * E + e); const f32x4* dp = (const f32x4*)(DEC + (size_t)bh * NCH * 128 + d);
        for (int n0 = 0; n0 < NCH; n0 += 8) {
            u32x2 gv[8]; f32x4 dv[8];
#pragma unroll
            for (int q = 0; q < 8; ++q) { gv[q] = gp[(size_t)(n0 + q) * (E / 4)]; dv[q] = dp[(size_t)(n0 + q) * 32]; }
#pragma unroll
            for (int q = 0; q < 8; ++q) {
                u32x2 o; o.x = pk2(S0, S1); o.y = pk2(S2, S3); if (!DRY || o.x == 0x12345678u) gp[(size_t)(n0 + q) * (E / 4)] = o;
                S0 = dv[q].x * (S0 + __uint_as_float(gv[q].x << 16)); S1 = dv[q].y * (S1 + __uint_as_float(gv[q].x & 0xffff0000u));
                S2 = dv[q].z * (S2 + __uint_as_float(gv[q].y << 16)); S3 = dv[q].w * (S3 + __uint_as_float(gv[q].y & 0xffff0000u)); }
        }
    }
}
template <int DV, bool HGRN, bool DRY = false>
__device__ __forceinline__ void pass_c(LAS unsigned char* lds, bf16* proj, const bf16* GS, int G, int bid, const int tid) {
    constexpr int H = HGRN ? 8 : 4, LD = HGRN ? HGRN_N : GLA_N, MTW = 2, VB = DV / 32, NTC = VB / 2, NU = BATCH * H * NCH;
    const int lane = tid & 63, wave = tid >> 6, g = lane >> 4, l15 = lane & 15, d = tid & 127, rg = tid >> 7;
    const int vb = wave % VB, th = wave / VB, v0 = vb * 32, vrow = v0 + 8 * (l15 >> 2) + (l15 & 3);
    u32x4 rla[2], rq[2], rk[2], rv[DV / 64];
    int u = bid;
    if (u < NU) { const int b = u / (H * NCH), h = (u / NCH) % H, n = u % NCH; const bf16* base = proj + (size_t)(b * T + n * CH) * LD;
        load_raw128(base, LD, 1024 + h * 128, tid, rla); load_raw128(base, LD, h * 128, tid, rq); if (!HGRN) load_raw128(base, LD, 512 + h * 128, tid, rk); load_raw_v<DV>(base, LD, (HGRN ? 3072 : 2560) + h * DV, tid, rv); }
    for (; u < NU; u += G) {
        const int b = u / (H * NCH), h = (u / NCH) % H, n = u % NCH;
        bf16* base = proj + (size_t)(b * T + n * CH) * LD;
        const int vcol = (HGRN ? 3072 : 2560) + h * DV, gcol = (HGRN ? 2048 : 1536) + h * DV;
        store_raw128(lds, L_LA, tid, rla); store_raw128(lds, L_QS, tid, rq); if (!HGRN) store_raw128(lds, L_KS, tid, rk); store_raw_v<DV>(lds, tid, rv);
        __syncthreads();
        bf16x8 sfr[4][MTW];
#pragma unroll
        for (int kk = 0; kk < 4; ++kk)
#pragma unroll
            for (int mt = 0; mt < MTW; ++mt) sfr[kk][mt] = *(const bf16x8*)(GS + ((size_t)u * DV + vrow + 4 * mt) * 128 + kk * 32 + 8 * g);
        { const int un = u + G; if (un < NU) { const int b2 = un / (H * NCH), h2 = (un / NCH) % H, n2 = un % NCH; const bf16* nb = proj + (size_t)(b2 * T + n2 * CH) * LD;
            load_raw128(nb, LD, 1024 + h2 * 128, tid, rla); load_raw128(nb, LD, h2 * 128, tid, rq); if (!HGRN) load_raw128(nb, LD, 512 + h2 * 128, tid, rk); load_raw_v<DV>(nb, LD, (HGRN ? 3072 : 2560) + h2 * DV, tid, rv); } }
        float bb[16], kv[16], blast;
        cumsum_local(lds, d, rg, bb);
        if (HGRN) {
#pragma unroll
            for (int i = 0; i < 16; ++i) kv[i] = 1.0f - __expf(bb[i]);
        } else { unsigned r[16]; ds_read16_s272(lds + L_KS + (rg * 16) * QS_STR + d * 2, r);
#pragma unroll
            for (int i = 0; i < 16; ++i) kv[i] = __uint_as_float(r[i] << 16); }
        cumsum_scan(lds, d, rg, bb);
        transpose_v<DV>(lds, tid);
        __syncthreads();
        cumsum_finish(lds, d, rg, bb, blast);
        { unsigned rq_[16]; ds_read16_s272(lds + L_QS + (rg * 16) * QS_STR + d * 2, rq_);
#pragma unroll
          for (int i = 0; i < 16; ++i) { const int s = rg * 16 + i; LAS bf16* qa = (LAS bf16*)(lds + L_QS + s * QS_STR + d * 2); LAS bf16* ka = (LAS bf16*)(lds + L_KS + s * QS_STR + d * 2);
              const float q = __uint_as_float(rq_[i] << 16); *qa = (bf16)f2bf(q * __expf(bb[i])); *ka = (bf16)f2bf(kv[i] * __expf(-bb[i])); } }
        __syncthreads();
        { const int tt = wave >> 1;
#pragma unroll
          for (int si = 0; si < 2; ++si) { const int st = (wave & 1) * 2 + si; f32x4 c = (f32x4){0.f, 0.f, 0.f, 0.f};
              bf16x8 afr[4], bfr[4];
#pragma unroll
              for (int kk = 0; kk < 4; ++kk) { afr[kk] = *(const LAS bf16x8*)(lds + L_KS + (st * 16 + l15) * QS_STR + (kk * 32 + 8 * g) * 2);
                  bfr[kk] = *(const LAS bf16x8*)(lds + L_QS + (tt * 16 + l15) * QS_STR + (kk * 32 + 8 * g) * 2); }
#pragma unroll
              for (int kk = 0; kk < 4; ++kk) c = MFMA16(afr[kk], bfr[kk], c);
              const int t = tt * 16 + l15, s0 = st * 16 + 4 * g;
              u32x2 w; w.x = pk2(s0 <= t ? c[0] : 0.f, s0 + 1 <= t ? c[1] : 0.f); w.y = pk2(s0 + 2 <= t ? c[2] : 0.f, s0 + 3 <= t ? c[3] : 0.f);
              *(LAS u32x2*)(lds + L_AT + t * KT_STR + s0 * 2) = w; } }
        u32x4 gt[NTC];
#pragma unroll
        for (int nt = 0; nt < NTC; ++nt) gt[nt] = *(const u32x4*)(base + (size_t)((th * NTC + nt) * 16 + l15) * LD + gcol + v0 + 8 * g);
        __syncthreads();
        f32x4 acc[MTW][NTC];
#pragma unroll
        for (int mt = 0; mt < MTW; ++mt)
#pragma unroll
            for (int nt = 0; nt < NTC; ++nt) acc[mt][nt] = (f32x4){0.f, 0.f, 0.f, 0.f};
#pragma unroll
        for (int kp = 0; kp < 2; ++kp) {
            bf16x8 bfr[2][NTC];
#pragma unroll
            for (int k2 = 0; k2 < 2; ++k2)
#pragma unroll
                for (int nt = 0; nt < NTC; ++nt) bfr[k2][nt] = *(const LAS bf16x8*)(lds + L_QS + ((th * NTC + nt) * 16 + l15) * QS_STR + ((kp * 2 + k2) * 32 + 8 * g) * 2);
#pragma unroll
            for (int k2 = 0; k2 < 2; ++k2)
#pragma unroll
                for (int nt = 0; nt < NTC; ++nt)
#pragma unroll
                    for (int mt = 0; mt < MTW; ++mt) acc[mt][nt] = MFMA16(sfr[kp * 2 + k2][mt], bfr[k2][nt], acc[mt][nt]);
        }
        {
            bf16x8 afr[2][MTW], bfr[2][NTC];
#pragma unroll
            for (int kk = 0; kk < 2; ++kk) {
#pragma unroll
                for (int mt = 0; mt < MTW; ++mt) afr[kk][mt] = *(const LAS bf16x8*)(lds + L_VT + (vrow + 4 * mt) * KT_STR + (kk * 32 + 8 * g) * 2);
#pragma unroll
                for (int nt = 0; nt < NTC; ++nt) bfr[kk][nt] = *(const LAS bf16x8*)(lds + L_AT + ((th * NTC + nt) * 16 + l15) * KT_STR + (kk * 32 + 8 * g) * 2); }
#pragma unroll
            for (int kk = 0; kk < 2; ++kk)
#pragma unroll
                for (int nt = 0; nt < NTC; ++nt)
#pragma unroll
                    for (int mt = 0; mt < MTW; ++mt) acc[mt][nt] = MFMA16(afr[kk][mt], bfr[kk][nt], acc[mt][nt]);
        }
        LAS float* red = (LAS float*)(lds + L_RED);
#pragma unroll
        for (int nt = 0; nt < NTC; ++nt) { float p = 0.f;
#pragma unroll
            for (int mt = 0; mt < MTW; ++mt) p += (acc[mt][nt][0] * acc[mt][nt][0] + acc[mt][nt][1] * acc[mt][nt][1]) + (acc[mt][nt][2] * acc[mt][nt][2] + acc[mt][nt][3] * acc[mt][nt][3]);
            p += pg8::shx(p, 16, lane); p += pg8::shx(p, 32, lane);
            if (g == 0) red[vb * 64 + (th * NTC + nt) * 16 + l15] = p; }
        __syncthreads();
#pragma unroll
        for (int nt = 0; nt < NTC; ++nt) { const int t = (th * NTC + nt) * 16 + l15; float s = 0.f;
#pragma unroll
            for (int w = 0; w < VB; ++w) s += red[w * 64 + t];
            const float rstd = rsqrtf(s * (1.0f / DV) + EPS);
            bf16* rowp = base + (size_t)t * LD; const u32x4 gg = gt[nt];
            u32x4 w; w.x = pk2(acc[0][nt][0] * rstd * __uint_as_float(gg.x << 16), acc[0][nt][1] * rstd * __uint_as_float(gg.x & 0xffff0000u));
            w.y = pk2(acc[0][nt][2] * rstd * __uint_as_float(gg.y << 16), acc[0][nt][3] * rstd * __uint_as_float(gg.y & 0xffff0000u));
            w.z = pk2(acc[1][nt][0] * rstd * __uint_as_float(gg.z << 16), acc[1][nt][1] * rstd * __uint_as_float(gg.z & 0xffff0000u));
            w.w = pk2(acc[1][nt][2] * rstd * __uint_as_float(gg.w << 16), acc[1][nt][3] * rstd * __uint_as_float(gg.w & 0xffff0000u));
            if (!DRY || w.x == 0x12345678u) *(u32x4*)(rowp + vcol + v0 + 8 * g) = w; }
    }
    __syncthreads();
}
constexpr int KL_STR = 272, VL_STR = 528, L_KL = 0, L_VL = 256 * KL_STR;
static_assert(L_VL + 128 * VL_STR <= LDS_BYTES, "xattn LDS map");
template <bool DRY = false>
__device__ __forceinline__ void xattn(LAS unsigned char* lds, bf16* proj, int LD, int xcol, const bf16* KM, const bf16* VMT, int G, int bid, const int tid) {
    const int lane = tid & 63, wave = tid >> 6, g = lane >> 4, l15 = lane & 15;
    for (int w = bid; w < 256; w += G) {
        const int pair = w >> 4, sub = w & 15, b = pair >> 2, h = pair & 3;
        __syncthreads();
#pragma unroll
        for (int i = 0; i < 8; ++i) { const int c = tid + i * NT, m = c >> 4, part = c & 15;
            *(LAS u32x4*)(lds + L_KL + m * KL_STR + part * 16) = *(const u32x4*)(KM + (size_t)(b * 256 + m) * 512 + h * 128 + part * 8); }
#pragma unroll
        for (int i = 0; i < 8; ++i) { const int c = tid + i * NT, dd = c >> 5, part = c & 31;
            *(LAS u32x4*)(lds + L_VL + dd * VL_STR + part * 16) = *(const u32x4*)(VMT + ((size_t)b * 512 + h * 128 + dd) * 256 + part * 8); }
        __syncthreads();
        bf16x8 qn[4];
        { const bf16* q0 = proj + (size_t)(b * T + (sub * 4) * 128 + wave * 16 + l15) * LD + xcol + h * 128;
#pragma unroll
          for (int kk = 0; kk < 4; ++kk) qn[kk] = *(const bf16x8*)(q0 + kk * 32 + 8 * g); }
        for (int tile = 0; tile < 4; ++tile) {
            const int r0 = b * T + (sub * 4 + tile) * 128 + wave * 16;
            bf16* qp = proj + (size_t)(r0 + l15) * LD + xcol + h * 128;
            bf16x8 qf[4];
#pragma unroll
            for (int kk = 0; kk < 4; ++kk) qf[kk] = qn[kk];
            if (tile < 3) {
#pragma unroll
                for (int kk = 0; kk < 4; ++kk) qn[kk] = *(const bf16x8*)(qp + (size_t)128 * LD + kk * 32 + 8 * g); }
            f32x4 sc[16];
#pragma unroll
            for (int mp = 0; mp < 8; ++mp) {
                bf16x8 afr[2][4];
#pragma unroll
                for (int m2 = 0; m2 < 2; ++m2)
#pragma unroll
                    for (int kk = 0; kk < 4; ++kk) afr[m2][kk] = *(const LAS bf16x8*)(lds + L_KL + ((mp * 2 + m2) * 16 + l15) * KL_STR + (kk * 32 + 8 * g) * 2);
#pragma unroll
                for (int m2 = 0; m2 < 2; ++m2) { f32x4 c = (f32x4){0.f, 0.f, 0.f, 0.f};
#pragma unroll
                    for (int kk = 0; kk < 4; ++kk) c = MFMA16(afr[m2][kk], qf[kk], c);
                    sc[mp * 2 + m2] = c; } }
            float mx = -1e30f;
#pragma unroll
            for (int mt = 0; mt < 16; ++mt) mx = fmaxf(mx, fmaxf(fmaxf(sc[mt][0], sc[mt][1]), fmaxf(sc[mt][2], sc[mt][3])));
            mx = fmaxf(mx, pg8::shx(mx, 16, lane)); mx = fmaxf(mx, pg8::shx(mx, 32, lane));
            float sum = 0.f;
#pragma unroll
            for (int mt = 0; mt < 16; ++mt) {
#pragma unroll
                for (int j = 0; j < 4; ++j) { const float p = __expf(sc[mt][j] - mx); sc[mt][j] = p; sum += p; } }
            sum += pg8::shx(sum, 16, lane); sum += pg8::shx(sum, 32, lane);
            const float inv = 1.0f / sum;
            f32x4 oa[8];
#pragma unroll
            for (int dt = 0; dt < 8; ++dt) oa[dt] = (f32x4){0.f, 0.f, 0.f, 0.f};
#pragma unroll
            for (int kb = 0; kb < 8; ++kb) {
                union { bf16x8 v; unsigned u[4]; } pb;
                pb.u[0] = pk2(sc[2 * kb][0], sc[2 * kb][1]); pb.u[1] = pk2(sc[2 * kb][2], sc[2 * kb][3]); pb.u[2] = pk2(sc[2 * kb + 1][0], sc[2 * kb + 1][1]); pb.u[3] = pk2(sc[2 * kb + 1][2], sc[2 * kb + 1][3]);
                union { bf16x8 v; u32x2 h[2]; } pa[8];
#pragma unroll
                for (int dt = 0; dt < 8; ++dt) { const LAS unsigned char* vp = lds + L_VL + ((dt >> 1) * 32 + 8 * (l15 >> 2) + 4 * (dt & 1) + (l15 & 3)) * VL_STR + (kb * 32 + 4 * g) * 2;
                    pa[dt].h[0] = *(const LAS u32x2*)vp; pa[dt].h[1] = *(const LAS u32x2*)(vp + 32); }
#pragma unroll
                for (int dt = 0; dt < 8; ++dt) oa[dt] = MFMA16(pa[dt].v, pb.v, oa[dt]);
            }
#pragma unroll
            for (int P = 0; P < 4; ++P) { u32x4 o; o.x = pk2(oa[2 * P][0] * inv, oa[2 * P][1] * inv); o.y = pk2(oa[2 * P][2] * inv, oa[2 * P][3] * inv);
                o.z = pk2(oa[2 * P + 1][0] * inv, oa[2 * P + 1][1] * inv); o.w = pk2(oa[2 * P + 1][2] * inv, oa[2 * P + 1][3] * inv); if (!DRY || o.x == 0x12345678u) *(u32x4*)(qp + P * 32 + 8 * g) = o; }
        }
    }
    __syncthreads();
}
__device__ __forceinline__ void final_norm(float* out, const bf16* XB, const float* SS, const float* gain, int gw, int ngw, int lane) {
    f32x4 gv[4];
#pragma unroll
    for (int j = 0; j < 4; ++j) gv[j] = ((const f32x4*)gain)[lane + 64 * j];
    for (int m = gw; m < M; m += ngw) {
        float s = lane < 16 ? SS[(size_t)lane * M + m] : 0.f; s = wave_sum(s, lane);
        const float rstd = rsqrtf(s * (1.0f / D) + EPS);
        const u32x2* xr = (const u32x2*)(XB + (size_t)m * D) + lane; f32x4* orow = (f32x4*)(out + (size_t)m * D) + lane;
#pragma unroll
        for (int j = 0; j < 4; ++j) { const u32x2 xw = xr[64 * j]; f32x4 v = (f32x4){__uint_as_float(xw.x << 16), __uint_as_float(xw.x & 0xffff0000u), __uint_as_float(xw.y << 16), __uint_as_float(xw.y & 0xffff0000u)};
            orow[64 * j] = v * rstd * gv[j]; }
    }
}

struct Args { Ptrs P; int ph_lo, ph_hi; };
constexpr int N_PHASES = 2 + 7 * DEPTH;
__global__ void __launch_bounds__(NT, 2) fwd_kernel(Args a) {
    extern __shared__ __attribute__((aligned(16))) unsigned char lds_raw[];
#if ONE_LAUNCH
    cg::grid_group grid = cg::this_grid();
    { volatile LAS unsigned* st = (volatile LAS unsigned*)((LAS unsigned char*)lds_raw + LDS_BARST); int t0_ = threadIdx.x; if (t0_ == 0) { st[0] = 0u; st[1] = 0u; } __syncthreads();
      (void)xcd_barrier_post((unsigned*)(a.P.ws + WS_CTL), st, t0_); }
#define SEAM() do { XcdBarrier xb_; xb_.bar = (unsigned*)(ws + WS_CTL); xb_.x = xb_xcc_id(); xb_.st = (volatile LAS unsigned*)(lds + LDS_BARST); xcd_barrier(xb_, tid); if (ph == 0) grid.sync(); } while (0)
#else
#define SEAM() do {} while (0)
#endif
    const int ph_lo = a.ph_lo, ph_hi = a.ph_hi;
    const int wave0 = __builtin_amdgcn_readfirstlane(threadIdx.x >> 6);
    for (int ph = ph_lo; ph < ph_hi; ++ph) {
        const __attribute__((address_space(4))) Args* ap = (const __attribute__((address_space(4))) Args*)__builtin_amdgcn_kernarg_segment_ptr();
        asm volatile("" : "+s"(ap));
        int zero_ = 0; asm volatile("" : "+v"(zero_));
        int tid = wave0 * 64 + (int)__builtin_amdgcn_mbcnt_hi(~0u, __builtin_amdgcn_mbcnt_lo(~0u, (unsigned)zero_)); asm volatile("" : "+v"(tid));
        LAS unsigned char* lds = (LAS unsigned char*)lds_raw;
        const int lane = tid & 63, wave = __builtin_amdgcn_readfirstlane(tid >> 6);
        int G = gridDim.x, bid = blockIdx.x; asm volatile("" : "+s"(G), "+s"(bid));
        const int gw = bid * NWAVES + wave, ngw = G * NWAVES;
        unsigned char* ws = ap->P.ws;
        float* SS = (float*)(ws + WS_SS); bf16* XB = (bf16*)ap->P.out; bf16* GS = (bf16*)(ws + WS_XB); bf16* X2 = (bf16*)(ws + WS_XB); bf16* PROJ = (bf16*)(ws + WS_PROJ);
        int ngemm = 0;
        int L = 0, sp = 0; bool hg = false;
        if (ph == 0) { prologue(&ap->P, lds, gw, ngw, wave, lane); }
        else if (ph == N_PHASES - 1) { final_norm(ap->P.out, X2, SS, ap->P.final_norm, gw, ngw, lane); }
        else {
            L = (ph - 1) / 7; sp = (ph - 1) % 7; hg = (L & 1);
            const int LD = hg ? HGRN_N : GLA_N;
            if (sp == 0) ngemm = (L == 0) ? 2 : 1;
            else if (sp == 1) {
                float* DEC = (float*)(ws + WS_DEC);
#if EXP == 3
                if (hg) pass_a<128, true>(lds, PROJ, GS, DEC, G, bid, tid); else pass_a<256, false>(lds, PROJ, GS, DEC, G, bid, tid);
#endif
                if (hg) pass_a<128, true>(lds, PROJ, GS, DEC, G, bid, tid); else pass_a<256, false>(lds, PROJ, GS, DEC, G, bid, tid);
#if EXP == 5
                xattn<true>(lds, PROJ, LD, hg ? 4096 : 3584, (const bf16*)(ws + WS_KM) + (size_t)L * 1024 * 512, (const bf16*)(ws + WS_VMT) + (size_t)L * 4 * 512 * 256, G, bid, tid);
#endif
#if EXP == 6
                if (L + 1 < DEPTH) { convert_layer(&ap->P, L + 1, lds, gw, ngw, wave, lane); } __syncthreads();
#endif
                xattn(lds, PROJ, LD, hg ? 4096 : 3584, (const bf16*)(ws + WS_KM) + (size_t)L * 1024 * 512, (const bf16*)(ws + WS_VMT) + (size_t)L * 4 * 512 * 256, G, bid, tid);
                if (L + 1 < DEPTH) { convert_layer(&ap->P, L + 1, lds, gw, ngw, wave, lane); }
            } else if (sp == 2) {
                const float* DEC = (const float*)(ws + WS_DEC);
#if EXP == 3
                if (hg) pass_b<128, true, true>(GS, DEC, G, bid, tid); else pass_b<256, false, true>(GS, DEC, G, bid, tid);
#endif
                if (hg) pass_b<128, true>(GS, DEC, G, bid, tid); else pass_b<256, false>(GS, DEC, G, bid, tid);
            } else if (sp == 3) {
#if EXP == 4
                if (hg) pass_c<128, true, true>(lds, PROJ, GS, G, bid, tid); else pass_c<256, false, true>(lds, PROJ, GS, G, bid, tid);
#endif
                if (hg) pass_c<128, true>(lds, PROJ, GS, G, bid, tid); else pass_c<256, false>(lds, PROJ, GS, G, bid, tid);
            } else ngemm = 1;
            if (EXP == 2 && (sp == 0 || sp == 5)) ngemm += 8;
        }
        for (int rep = 0; rep < (ngemm & 7) * (ngemm >= 8 ? 2 : 1); ++rep) {
            unsigned char* wb = ws + WS_WT + (size_t)(L & 1) * WT_BUF;
            const int LD = hg ? HGRN_N : GLA_N;
            pg8::Gemm g; pg8::EpiAll E; E.hgrn = hg ? 1 : 0; E.M = M; E.aux = nullptr; E.xin = nullptr; E.xout = nullptr;
            if (sp == 0 && (ngemm & 7) == 2 && (rep & 7) == 0 && rep < 8) {
                g.A = (const bf16*)(ws + WS_MEMB); g.Bt = (const bf16*)(ws + WS_WKV); g.M = MROWS; g.N = 4096; g.K = D; g.lda = D; g.perm = 0;
                E.kind = 3; E.ldc = 0; E.O = (bf16*)(ws + WS_KM); E.ss = (const float*)(ws + WS_SSM); E.xout = (float*)(ws + WS_VMT);
            } else if (sp == 0) {
                g.A = XB; g.Bt = (const bf16*)(wb + WT_IN); g.M = M; g.N = LD; g.K = D; g.lda = D; g.perm = 1;
                E.kind = 0; E.ldc = LD; E.O = PROJ; E.ss = SS; E.aux = hg ? (const float*)(ws + WS_LB) + (size_t)L * 1024 : ap->P.gla_b_gate + (size_t)(L >> 1) * 512;
            } else if (sp == 4) {
                g.A = PROJ + (hg ? 3072 : 2560); g.Bt = (const bf16*)(wb + WT_OUT); g.M = M; g.N = D; g.K = KOUT; g.lda = LD; g.perm = 1;
                E.kind = 2; E.ldc = D; E.O = XB; E.ss = SS; E.xin = (L == 0) ? ap->P.x : nullptr; E.xout = (float*)XB;
            } else if (sp == 5) {
                g.A = XB; g.Bt = (const bf16*)(wb + WT_UP); g.M = M; g.N = FF; g.K = D; g.lda = D; g.perm = 1;
                E.kind = 1; E.ldc = FF; E.O = PROJ; E.ss = SS;
            } else {
                g.A = PROJ; g.Bt = (const bf16*)(wb + WT_DOWN); g.M = M; g.N = D; g.K = FF; g.lda = FF; g.perm = 1;
                E.kind = 2; E.ldc = D; E.O = XB; E.ss = SS; E.xout = (float*)((L == DEPTH - 1) ? X2 : XB);
            }
#if EXP == 9
            if (E.kind == 2) { pg8::Gemm g2 = g; g2.perm = 1; pg8::EpiAll E2 = E; E2.kind = 1; E2.ldc = D; E2.O = GS; E2.ss = SS; E2.xin = nullptr;
                pg8::StaticOrder S2; S2.init(g2.M, g2.N, G, bid); pg8::gemm_phase<pg8::EpiAll, pg8::StaticOrder, true, true>(lds, g2, S2, E2, tid); }
#endif
            pg8::StaticOrder S; S.init(g.M, g.N, G, bid, (sp == 6) ? REV_DOWN : 0);
#if SKEW_TICKS > 0
            if (E.kind <= 1) {
                const unsigned long long t0_ = __builtin_amdgcn_s_memrealtime(); const unsigned long long dl_ = (unsigned long long)((bid & 7) * SKEW_TICKS);
                while (__builtin_amdgcn_s_memrealtime() - t0_ < dl_) __builtin_amdgcn_s_sleep(8);
            }
#endif
            pg8::gemm_phase<pg8::EpiAll, pg8::StaticOrder, true, true>(lds, g, S, E, tid);
        }
        if (ph + 1 < ph_hi) { SEAM(); }
#if EXP == 7
        if (ph + 1 < ph_hi) { SEAM(); }
#endif
    }
}

extern "C" void kernel_launch(void* const* d_in, const int* in_sizes, int n_in, void* d_out, int out_size, void* d_ws, size_t ws_size, hipStream_t stream) {
    static int grid = 0;
    if (grid == 0) {
        if (n_in != 17 || out_size != M * D || ws_size < WS_END) { fprintf(stderr, "kernel_launch: unexpected shapes (n_in %d out %d ws %zu)\n", n_in, out_size, ws_size); grid = -1; return; }
        int dev = 0, cus = 0, per_cu = 0;
        hipGetDevice(&dev); hipDeviceGetAttribute(&cus, hipDeviceAttributeMultiprocessorCount, dev);
        if (hipFuncSetAttribute((const void*)fwd_kernel, hipFuncAttributeMaxDynamicSharedMemorySize, LDS_BYTES) != hipSuccess) { fprintf(stderr, "kernel_launch: hipFuncSetAttribute failed\n"); grid = -1; return; }
        if (hipOccupancyMaxActiveBlocksPerMultiprocessor(&per_cu, (const void*)fwd_kernel, NT, LDS_BYTES) != hipSuccess || per_cu < 1) { fprintf(stderr, "kernel_launch: occupancy query says %d\n", per_cu); per_cu = 1; }
        (void)hipGetLastError();
        grid = cus * per_cu;
        if (grid > 256) grid = 256;
        grid = (grid / 16) * 16;
        fprintf(stderr, "kernel_launch: grid %d (cus %d per_cu %d)\n", grid, cus, per_cu);
    }
    if (grid <= 0) return;
#if ONE_LAUNCH
    if (hipMemsetAsync((char*)d_ws + WS_CTL, 0, CTL_BYTES, stream) != hipSuccess) { fprintf(stderr, "kernel_launch: memset failed\n"); return; }
#endif
    Args a{};
    const float** pp = (const float**)&a.P;
    for (int i = 0; i < 17; ++i) pp[i] = (const float*)d_in[i];
    a.P.out = (float*)d_out; a.P.ws = (unsigned char*)d_ws;
#if ONE_LAUNCH
    a.ph_lo = 0; a.ph_hi = N_PHASES;
    void* args[] = {&a};
    hipError_t e = hipLaunchCooperativeKernel((const void*)fwd_kernel, dim3(grid), dim3(NT), args, LDS_BYTES, stream);
    if (e != hipSuccess) fprintf(stderr, "kernel_launch: cooperative launch failed: %s (grid %d)\n", hipGetErrorString(e), grid);
#else
    for (int ph = 0; ph < N_PHASES; ++ph) { a.ph_lo = ph; a.ph_hi = ph + 1; hipLaunchKernelGGL(fwd_kernel, dim3(grid), dim3(NT), LDS_BYTES, stream, a); }
#endif
}
```

```cpp
#include <hip/hip_runtime.h>
#include <hip/hip_cooperative_groups.h>
#include <cstdio>
#include <cstdint>
namespace cg = cooperative_groups;

#ifndef EXP
#define EXP 0
#endif
#ifndef SKEW_TICKS
#define SKEW_TICKS 0
#endif
#ifndef REV_DOWN
#define REV_DOWN 0
#endif
#ifndef ONE_LAUNCH
#define ONE_LAUNCH 1
#endif

namespace pg8 {
#define PG8_LAS __attribute__((address_space(3)))
typedef unsigned short bf16_t;
typedef short bf16x8 __attribute__((ext_vector_type(8)));
typedef float f32x4 __attribute__((ext_vector_type(4)));
typedef unsigned u32x4 __attribute__((ext_vector_type(4)));
typedef unsigned u32x2 __attribute__((ext_vector_type(2)));
constexpr int BM = 256, BK = 64, HALF = 128, HTB = HALF * BK * 2, STAGE_BYTES = 8 * HTB, NXCD = 8, WGM = 8;

__host__ __device__ __forceinline__ int lds_byte(int r, int c) { const int st = (r >> 4) * 2 + (c >> 5), rr = r & 15, cc = c & 31, ob = rr * 64 + cc * 2; return st * 1024 + (ob ^ (((ob >> 9) & 1) << 5)); }
__host__ __device__ __forceinline__ void stage_rc(int b, int& R, int& C) { const int st = b / 1024, sb = b % 1024, swz = sb ^ (((sb >> 9) & 1) << 5); R = (st >> 1) * 16 + swz / 64; C = (st & 1) * 32 + (swz % 64) / 2; }
__host__ __device__ __forceinline__ int perm32(int rho) { const int n = rho >> 4, i = rho & 15; return 8 * (i >> 2) + 4 * n + (i & 3); }

struct Unit { int pm, pn; };
struct Gemm { const bf16_t* A; const bf16_t* Bt; int M, N, K, lda, perm; };

struct StaticOrder {
    int nM, nN, nwg, G, c, rev;
    __host__ __device__ void init(int M, int N, int G_, int c_, int rev_ = 0) { nM = M / BM; nN = N / BM; nwg = nM * nN; G = G_; c = c_; rev = rev_; }
    __host__ __device__ bool next(int i, Unit& u) const {
        const long L = (long)i * G + c; if (L >= nwg) return false;
        int wgid = (int)L; { const int q = nwg / NXCD, r = nwg % NXCD, xcd = wgid % NXCD, off = wgid / NXCD; wgid = (xcd < r ? xcd * (q + 1) : r * (q + 1) + (xcd - r) * q) + off; }
        const int nig = WGM * nN, gid = wgid / nig, fm = gid * WGM, gsz = (nM - fm) < WGM ? (nM - fm) : WGM;
        u.pm = fm + ((wgid % nig) % gsz); u.pn = (wgid % nig) / gsz; if (rev) u.pm = nM - 1 - u.pm; return true;
    }
    __device__ __forceinline__ void a_ready(const Unit&) const {}
    __device__ __forceinline__ void done(const Unit&) const {}
};

__device__ __forceinline__ float shx(float v, int mask, int lane) { return __int_as_float(__builtin_amdgcn_ds_bpermute((lane ^ mask) << 2, __float_as_int(v))); }
__device__ __forceinline__ void shx_add2(float (&v)[2], int mask, int lane) {
    const int a = (lane ^ mask) << 2; float r[2];
    asm volatile("ds_bpermute_b32 %0, %2, %3\n\tds_bpermute_b32 %1, %2, %4\n\ts_waitcnt lgkmcnt(0)"
        : "=&v"(r[0]), "=&v"(r[1]) : "v"(a), "v"(v[0]), "v"(v[1]));
#pragma unroll
    for (int i = 0; i < 2; ++i) v[i] += r[i];
}
__device__ __forceinline__ void shx_add4(float (&v)[4], int mask, int lane) {
    const int a = (lane ^ mask) << 2; float r[4];
    asm volatile("ds_bpermute_b32 %0, %4, %5\n\tds_bpermute_b32 %1, %4, %6\n\tds_bpermute_b32 %2, %4, %7\n\tds_bpermute_b32 %3, %4, %8\n\ts_waitcnt lgkmcnt(0)"
        : "=&v"(r[0]), "=&v"(r[1]), "=&v"(r[2]), "=&v"(r[3]) : "v"(a), "v"(v[0]), "v"(v[1]), "v"(v[2]), "v"(v[3]));
#pragma unroll
    for (int i = 0; i < 4; ++i) v[i] += r[i];
}
__device__ __forceinline__ void shx_add8(float (&v)[8], int mask, int lane) {
    const int a = (lane ^ mask) << 2; float r[8];
    asm volatile("ds_bpermute_b32 %0, %8, %9\n\tds_bpermute_b32 %1, %8, %10\n\tds_bpermute_b32 %2, %8, %11\n\tds_bpermute_b32 %3, %8, %12\n\tds_bpermute_b32 %4, %8, %13\n\tds_bpermute_b32 %5, %8, %14\n\tds_bpermute_b32 %6, %8, %15\n\tds_bpermute_b32 %7, %8, %16\n\ts_waitcnt lgkmcnt(0)"
        : "=&v"(r[0]), "=&v"(r[1]), "=&v"(r[2]), "=&v"(r[3]), "=&v"(r[4]), "=&v"(r[5]), "=&v"(r[6]), "=&v"(r[7]) : "v"(a), "v"(v[0]), "v"(v[1]), "v"(v[2]), "v"(v[3]), "v"(v[4]), "v"(v[5]), "v"(v[6]), "v"(v[7]));
#pragma unroll
    for (int i = 0; i < 8; ++i) v[i] += r[i];
}
typedef float f32x2_t __attribute__((ext_vector_type(2)));
typedef __bf16 bf16x2_t __attribute__((ext_vector_type(2)));
__device__ __forceinline__ unsigned cvt_pk_native(float lo, float hi) { const f32x2_t f = {lo, hi}; const bf16x2_t b = __builtin_convertvector(f, bf16x2_t); return __builtin_bit_cast(unsigned, b); }
__device__ __forceinline__ unsigned cvt_pk_bf16(float lo, float hi) { unsigned r; asm volatile("v_cvt_pk_bf16_f32 %0, %1, %2" : "=v"(r) : "v"(lo), "v"(hi)); return r; }

__device__ __forceinline__ float fsigmoid(float v) { return __builtin_amdgcn_rcpf(1.0f + __expf(-v)); }
__device__ __forceinline__ float fsilu(float v) { return v * fsigmoid(v); }
__device__ __forceinline__ float row_rstd(const float* ss, int M, int row, int fq, int lane) {
    const float* p = ss + (size_t)(4 * fq) * M + row;
    float s = (p[0] + p[M]) + (p[2 * (size_t)M] + p[3 * (size_t)M]);
    s += shx(s, 16, lane); s += shx(s, 32, lane);
    return rsqrtf(s * (1.0f / 1024.0f) + 1e-6f);
}
template <int MODE> __device__ __forceinline__ float proj_act(float v, float a) {
    if (MODE == 1) return fsilu(v);
    if (MODE == 2) { const float z = v + a; const float ls = fminf(z, 0.f) - __logf(1.0f + __expf(-fabsf(z))); return ls * 0.0625f; }
    if (MODE == 3) { const float sg = fsigmoid(v); return __logf(a + (1.0f - a) * sg); }
    if (MODE == 4) return fsilu(v) * 0.08838834764831845f;
    if (MODE == 5) { const float r = fmaxf(v, 0.f); return r * r; }
    return v;
}
struct EpiAll {
    static constexpr bool AFTER_DRAIN = false;
    int kind, ldc, hgrn, M;
    bf16_t* O;
    const float* ss;
    const float* aux;
    const float* xin;
    float* xout;
    template <int MODE> __device__ __forceinline__ void body_proj(const f32x4 (&acc)[2][2][4][2], const Unit& u, int wr, int wc, int fr, int fq) const {
        const int row0 = u.pm * BM + wr * 64 + fr, col0 = u.pn * BM + wc * 32 + 8 * fq;
        f32x4 av[2][2];
#pragma unroll
        for (int bj = 0; bj < 2; ++bj)
#pragma unroll
            for (int n = 0; n < 2; ++n) av[bj][n] = (MODE == 2 || MODE == 3) ? *(const f32x4*)(aux + (col0 - 1024) + bj * HALF + 4 * n) : (f32x4){0.f, 0.f, 0.f, 0.f};
        float ps[2][4];
#pragma unroll
        for (int ai = 0; ai < 2; ++ai)
#pragma unroll
            for (int m = 0; m < 4; ++m) { const float* p = ss + (size_t)(4 * fq) * M + (row0 + ai * HALF + m * 16); ps[ai][m] = (p[0] + p[M]) + (p[2 * (size_t)M] + p[3 * (size_t)M]); }
        float rs[2][4];
        { float pv[8];
#pragma unroll
          for (int i = 0; i < 8; ++i) pv[i] = ps[i >> 2][i & 3];
          shx_add8(pv, 16, fq * 16 + fr); shx_add8(pv, 32, fq * 16 + fr);
#pragma unroll
          for (int i = 0; i < 8; ++i) rs[i >> 2][i & 3] = rsqrtf(pv[i] * (1.0f / 1024.0f) + 1e-6f); }
#pragma unroll
        for (int ai = 0; ai < 2; ++ai)
#pragma unroll
            for (int m = 0; m < 4; ++m) { const int row = row0 + ai * HALF + m * 16; const float rstd = rs[ai][m]; bf16_t* rowp = O + (size_t)row * ldc + col0;
#pragma unroll
                for (int bj = 0; bj < 2; ++bj) { f32x4 v0 = acc[ai][bj][m][0] * rstd, v1 = acc[ai][bj][m][1] * rstd;
#pragma unroll
                    for (int j = 0; j < 4; ++j) { v0[j] = proj_act<MODE>(v0[j], av[bj][0][j]); v1[j] = proj_act<MODE>(v1[j], av[bj][1][j]); }
                    u32x4 w; w.x = cvt_pk_bf16(v0[0], v0[1]); w.y = cvt_pk_bf16(v0[2], v0[3]); w.z = cvt_pk_bf16(v1[0], v1[1]); w.w = cvt_pk_bf16(v1[2], v1[3]);
                    *(u32x4*)(rowp + bj * HALF) = w; } }
    }
    template <bool F32IN> __device__ __forceinline__ void body_res(const f32x4 (&acc)[2][2][4][2], const Unit& u, int wr, int wc, int fr, int fq) const {
        const int row0 = u.pm * BM + wr * 64 + fr, col0 = u.pn * BM + wc * 32 + 8 * fq; float* ssw = (float*)ss; bf16_t* XO = (bf16_t*)xout;
#pragma unroll
        for (int ai = 0; ai < 2; ++ai) {
            u32x4 xi[4][2];
            if (!F32IN) {
#pragma unroll
                for (int m = 0; m < 4; ++m) { const size_t off = (size_t)(row0 + ai * HALF + m * 16) * 1024 + col0;
#pragma unroll
                    for (int bj = 0; bj < 2; ++bj) xi[m][bj] = *(const u32x4*)(O + off + bj * HALF); } }
            float sv[4];
#pragma unroll
            for (int m = 0; m < 4; ++m) { const int row = row0 + ai * HALF + m * 16; const size_t off = (size_t)row * 1024 + col0; float s = 0.f;
#pragma unroll
                for (int bj = 0; bj < 2; ++bj) { f32x4 o0, o1;
                    if (F32IN) { o0 = *(const f32x4*)(xin + off + bj * HALF); o1 = *(const f32x4*)(xin + off + bj * HALF + 4); }
                    else { const u32x4 xw = xi[m][bj]; o0 = (f32x4){__uint_as_float(xw.x << 16), __uint_as_float(xw.x & 0xffff0000u), __uint_as_float(xw.y << 16), __uint_as_float(xw.y & 0xffff0000u)};
                        o1 = (f32x4){__uint_as_float(xw.z << 16), __uint_as_float(xw.z & 0xffff0000u), __uint_as_float(xw.w << 16), __uint_as_float(xw.w & 0xffff0000u)}; }
                    o0 = o0 + acc[ai][bj][m][0]; o1 = o1 + acc[ai][bj][m][1];
                    u32x4 w; w.x = cvt_pk_bf16(o0[0], o0[1]); w.y = cvt_pk_bf16(o0[2], o0[3]); w.z = cvt_pk_bf16(o1[0], o1[1]); w.w = cvt_pk_bf16(o1[2], o1[3]);
                    *(u32x4*)(XO + off + bj * HALF) = w;
#pragma unroll
                    for (int q = 0; q < 4; ++q) { const unsigned wq = q == 0 ? w.x : (q == 1 ? w.y : (q == 2 ? w.z : w.w)); const float r0 = __uint_as_float(wq << 16), r1 = __uint_as_float(wq & 0xffff0000u); s += r0 * r0 + r1 * r1; } }
                sv[m] = s; }
            shx_add4(sv, 16, fq * 16 + fr); shx_add4(sv, 32, fq * 16 + fr);
            if (fq == 0) {
#pragma unroll
                for (int m = 0; m < 4; ++m) ssw[(size_t)(u.pn * 4 + wc) * M + row0 + ai * HALF + m * 16] = sv[m]; }
        }
    }
    __device__ __forceinline__ void body_kv(const f32x4 (&acc)[2][2][4][2], const Unit& u, int wr, int wc, int fr, int fq) const {
        const int row0 = u.pm * BM + wr * 64 + fr, layer = u.pn >> 2, cl0 = (u.pn & 3) * BM + wc * 32 + 4 * fq; bf16_t* VMT = (bf16_t*)xout;
#pragma unroll
        for (int ai = 0; ai < 2; ++ai)
#pragma unroll
            for (int m = 0; m < 4; ++m) { const int row = row0 + ai * HALF + m * 16; const float rstd = rsqrtf(ss[row] * (1.0f / 1024.0f) + 1e-6f);
#pragma unroll
                for (int bj = 0; bj < 2; ++bj)
#pragma unroll
                    for (int n = 0; n < 2; ++n) { const f32x4 o = acc[ai][bj][m][n] * rstd; const int cl = cl0 + bj * HALF + n * 16;
                        if (cl < 512) { u32x2 w; w.x = cvt_pk_bf16(o[0], o[1]); w.y = cvt_pk_bf16(o[2], o[3]); *(u32x2*)(O + ((size_t)layer * 1024 + row) * 512 + cl) = w; }
                        else { const unsigned lo = cvt_pk_bf16(o[0], o[1]), hi = cvt_pk_bf16(o[2], o[3]); bf16_t* d = VMT + ((size_t)(layer * 4 + (row >> 8)) * 512 + (cl - 512)) * 256 + (row & 255);
                            d[0] = (bf16_t)(lo & 0xffff); d[256] = (bf16_t)(lo >> 16); d[512] = (bf16_t)(hi & 0xffff); d[768] = (bf16_t)(hi >> 16); } } }
    }
    __device__ __forceinline__ void operator()(const f32x4 (&acc)[2][2][4][2], const Unit& u, int wr, int wc, int fr, int fq) const {
        if (kind == 0) {
            int mode;
            if (!hgrn) mode = (u.pn >= 4 && u.pn < 6) ? 2 : ((u.pn >= 6 && u.pn < 10) ? 1 : 0);
            else mode = u.pn < 4 ? 4 : (u.pn < 8 ? 3 : (u.pn < 12 ? 1 : 0));
            if (mode == 0) body_proj<0>(acc, u, wr, wc, fr, fq); else if (mode == 1) body_proj<1>(acc, u, wr, wc, fr, fq); else if (mode == 2) body_proj<2>(acc, u, wr, wc, fr, fq);
            else if (mode == 3) body_proj<3>(acc, u, wr, wc, fr, fq); else body_proj<4>(acc, u, wr, wc, fr, fq);
        } else if (kind == 1) body_proj<5>(acc, u, wr, wc, fr, fq);
        else if (kind == 2) { if (xin) body_res<true>(acc, u, wr, wc, fr, fq); else body_res<false>(acc, u, wr, wc, fr, fq); }
        else body_kv(acc, u, wr, wc, fr, fq);
    }
};

template <class Epi, class Sched, bool ALIGN_EPI = false, bool SP2 = false>
__device__ __forceinline__ void gemm_phase(PG8_LAS unsigned char* lds, const Gemm g, const Sched& S, const Epi& E, const int tid) {
    const int wid = __builtin_amdgcn_readfirstlane(tid >> 6), lane = tid & 63, wr = wid >> 2, wc = wid & 3, fr = lane & 15, fq = lane >> 4;
    const int K = g.K, nt = K / BK;
    unsigned voffA[2], voffB[2];
#pragma unroll
    for (int i = 0; i < 2; ++i) { int R, C; stage_rc(tid * 16 + i * 8192, R, C); const int Rb = g.perm ? ((R & ~31) + perm32(R & 31)) : R;
        voffA[i] = (unsigned)(R * g.lda + C) * 2u; voffB[i] = (unsigned)(Rb * K + C) * 2u; }
    const size_t kstep = (size_t)(BK * 2);
    const size_t hstepA = (size_t)HALF * g.lda * 2, hstepB = (size_t)HALF * K * 2;
    const size_t tstepA = 2 * hstepA, tstepB = 2 * hstepB;
    const unsigned ldsw = (unsigned)wid * 1024u;
    const int aoff = lds_byte(wr * 64 + fr, fq * 8), boff = lds_byte(wc * 32 + fr, fq * 8);
#define PG8_SA(b, h) (((b) * 2 + (h)) * HTB)
#define PG8_SB(b, h) ((4 + (b) * 2 + (h)) * HTB)
#define PG8_STAGE(bufoff, gbase, voff) do { _Pragma("unroll") for (int _i = 0; _i < 2; ++_i) \
        __builtin_amdgcn_global_load_lds((const unsigned*)((const char*)(gbase) + (voff)[_i]), (PG8_LAS unsigned*)(lds + (bufoff) + ldsw + _i * 8192), 16, 0, 0); } while (0)
#define PG8_LDA(dst, b, h) do { _Pragma("unroll") for (int m = 0; m < 4; ++m) _Pragma("unroll") for (int k = 0; k < 2; ++k) dst[m][k] = *(const PG8_LAS bf16x8*)(lds + PG8_SA(b, h) + aoff + m * 2048 + k * 1024); } while (0)
#define PG8_LDB(dst, b, h) do { _Pragma("unroll") for (int n = 0; n < 2; ++n) _Pragma("unroll") for (int k = 0; k < 2; ++k) dst[n][k] = *(const PG8_LAS bf16x8*)(lds + PG8_SB(b, h) + boff + n * 2048 + k * 1024); } while (0)
#define PG8_MMA(ai, bj, At, Bt) do { __builtin_amdgcn_s_setprio(1); _Pragma("unroll") for (int m = 0; m < 4; ++m) _Pragma("unroll") for (int n = 0; n < 2; ++n) _Pragma("unroll") for (int k = 0; k < 2; ++k) \
        acc[ai][bj][m][n] = __builtin_amdgcn_mfma_f32_16x16x32_bf16(Bt[n][k], At[m][k], acc[ai][bj][m][n], 0, 0, 0); __builtin_amdgcn_s_setprio(0); } while (0)
#define PG8_WAIT_V(n) asm volatile("s_waitcnt vmcnt(" #n ")" ::: "memory")
#define PG8_WAIT_L(n) asm volatile("s_waitcnt lgkmcnt(" #n ")" ::: "memory")
#define PG8_BAR __builtin_amdgcn_s_barrier()
#define PG8_SCHED __builtin_amdgcn_sched_barrier(0)
    Unit cur, nxt; int ui = 0;
    if (!S.next(0, cur)) return;
    f32x4 acc[2][2][4][2];
#pragma unroll
    for (int a = 0; a < 2; ++a)
#pragma unroll
        for (int b = 0; b < 2; ++b)
#pragma unroll
            for (int m = 0; m < 4; ++m)
#pragma unroll
                for (int n = 0; n < 2; ++n) acc[a][b][m][n] = (f32x4){0.f, 0.f, 0.f, 0.f};
    bf16x8 At[4][2], B0[2][2], B1[2][2];
    const char* cA = (const char*)g.A + (size_t)cur.pm * tstepA; const char* cB = (const char*)g.Bt + (size_t)cur.pn * tstepB;
    S.a_ready(cur);
    if constexpr (SP2) {
        PG8_STAGE(PG8_SB(0, 0), cB, voffB); PG8_STAGE(PG8_SB(0, 1), cB + hstepB, voffB); PG8_STAGE(PG8_SA(0, 0), cA, voffA); PG8_STAGE(PG8_SA(0, 1), cA + hstepA, voffA);
        if (wr == 1) PG8_BAR;
        PG8_WAIT_V(2); PG8_BAR;
        PG8_STAGE(PG8_SB(1, 0), cB + kstep, voffB); PG8_STAGE(PG8_SA(1, 0), cA + kstep, voffA); PG8_STAGE(PG8_SB(1, 1), cB + hstepB + kstep, voffB);
        PG8_WAIT_V(6); PG8_BAR;
    } else {
        PG8_STAGE(PG8_SB(0, 0), cB, voffB); PG8_STAGE(PG8_SA(0, 0), cA, voffA); PG8_STAGE(PG8_SB(0, 1), cB + hstepB, voffB); PG8_STAGE(PG8_SA(0, 1), cA + hstepA, voffA);
        if (wr == 1) PG8_BAR;
        PG8_WAIT_V(4); PG8_BAR;
        PG8_STAGE(PG8_SB(1, 0), cB + kstep, voffB); PG8_STAGE(PG8_SA(1, 0), cA + kstep, voffA); PG8_STAGE(PG8_SB(1, 1), cB + hstepB + kstep, voffB);
        PG8_WAIT_V(6); PG8_BAR;
    }
    for (;;) {
        const bool has_next = S.next(ui + 1, nxt);
        const char* nA = has_next ? (const char*)g.A + (size_t)nxt.pm * tstepA : cA; const char* nB = has_next ? (const char*)g.Bt + (size_t)nxt.pn * tstepB : cB;
        for (int t = 0; t < nt; t += 2) {
            const bool last = (t == nt - 2);
            const char* a1 = cA + (size_t)(t + 1) * kstep;
            const char* a2 = last ? nA : cA + (size_t)(t + 2) * kstep; const char* b2 = last ? nB : cB + (size_t)(t + 2) * kstep;
            const char* a3 = a2 + kstep; const char* b3 = b2 + kstep;
            if (last && has_next) S.a_ready(nxt);
            if constexpr (SP2) {
            PG8_LDB(B0, 0, 0); PG8_LDB(B1, 0, 1); PG8_SCHED; PG8_LDA(At, 0, 0); PG8_STAGE(PG8_SA(1, 1), a1 + hstepA, voffA);
            PG8_WAIT_V(8); PG8_WAIT_L(0); PG8_BAR; PG8_MMA(0, 0, At, B0); PG8_MMA(0, 1, At, B1); PG8_BAR; PG8_SCHED;
            PG8_LDA(At, 0, 1); PG8_STAGE(PG8_SB(0, 0), b2, voffB); PG8_STAGE(PG8_SB(0, 1), b2 + hstepB, voffB); PG8_STAGE(PG8_SA(0, 0), a2, voffA);
            PG8_WAIT_V(8); PG8_WAIT_L(0); PG8_BAR; PG8_MMA(1, 0, At, B0); PG8_MMA(1, 1, At, B1); PG8_BAR; PG8_SCHED;
            PG8_LDB(B0, 1, 0); PG8_LDB(B1, 1, 1); PG8_SCHED; PG8_LDA(At, 1, 0); PG8_STAGE(PG8_SA(0, 1), a2 + hstepA, voffA);
            PG8_WAIT_V(8); PG8_WAIT_L(0); PG8_BAR; PG8_MMA(0, 0, At, B0); PG8_MMA(0, 1, At, B1); PG8_BAR; PG8_SCHED;
            PG8_LDA(At, 1, 1); PG8_STAGE(PG8_SB(1, 0), b3, voffB); PG8_STAGE(PG8_SB(1, 1), b3 + hstepB, voffB); PG8_STAGE(PG8_SA(1, 0), a3, voffA);
            PG8_WAIT_V(8); PG8_WAIT_L(0); PG8_BAR; PG8_MMA(1, 0, At, B0); PG8_MMA(1, 1, At, B1); PG8_BAR; PG8_SCHED;
            } else {
            PG8_LDB(B0, 0, 0); PG8_SCHED; PG8_LDA(At, 0, 0); PG8_STAGE(PG8_SA(1, 1), a1 + hstepA, voffA);
            PG8_WAIT_L(8); PG8_BAR; PG8_WAIT_L(0); PG8_MMA(0, 0, At, B0); PG8_BAR; PG8_SCHED;
            PG8_LDB(B1, 0, 1); PG8_STAGE(PG8_SB(0, 0), b2, voffB);
            PG8_BAR; PG8_WAIT_L(0); PG8_MMA(0, 1, At, B1); PG8_BAR;
            PG8_LDA(At, 0, 1); PG8_STAGE(PG8_SA(0, 0), a2, voffA);
            PG8_BAR; PG8_WAIT_L(0); PG8_MMA(1, 0, At, B0); PG8_BAR; PG8_SCHED;
            PG8_STAGE(PG8_SB(0, 1), b2 + hstepB, voffB);
            PG8_WAIT_V(6); PG8_BAR; PG8_MMA(1, 1, At, B1); PG8_BAR;
            PG8_LDB(B0, 1, 0); PG8_SCHED; PG8_LDA(At, 1, 0); PG8_STAGE(PG8_SA(0, 1), a2 + hstepA, voffA);
            PG8_WAIT_L(8); PG8_BAR; PG8_WAIT_L(0); PG8_MMA(0, 0, At, B0); PG8_BAR; PG8_SCHED;
            PG8_LDB(B1, 1, 1); PG8_STAGE(PG8_SB(1, 0), b3, voffB);
            PG8_BAR; PG8_WAIT_L(0); PG8_MMA(0, 1, At, B1); PG8_BAR;
            PG8_LDA(At, 1, 1); PG8_STAGE(PG8_SA(1, 0), a3, voffA);
            PG8_BAR; PG8_WAIT_L(0); PG8_MMA(1, 0, At, B0); PG8_BAR; PG8_SCHED;
            PG8_STAGE(PG8_SB(1, 1), b3 + hstepB, voffB);
            PG8_WAIT_V(6); PG8_BAR; PG8_MMA(1, 1, At, B1); PG8_BAR;
            }
        }
        if constexpr (ALIGN_EPI) { if (wr == 0) PG8_BAR; }
        if constexpr (!Epi::AFTER_DRAIN) { E(acc, cur, wr, wc, fr, fq); S.done(cur); }
        if (!has_next) break;
#pragma unroll
        for (int a = 0; a < 2; ++a)
#pragma unroll
            for (int b = 0; b < 2; ++b)
#pragma unroll
                for (int m = 0; m < 4; ++m)
#pragma unroll
                    for (int n = 0; n < 2; ++n) acc[a][b][m][n] = (f32x4){0.f, 0.f, 0.f, 0.f};
        cur = nxt; cA = nA; cB = nB; ++ui;
        if constexpr (ALIGN_EPI) { if (wr == 1) PG8_BAR; }
    }
    PG8_WAIT_V(0);
    if constexpr (!ALIGN_EPI) { if (wr == 0) PG8_BAR; }
    PG8_BAR;
    if constexpr (Epi::AFTER_DRAIN) { E.fused(acc, cur, wr, wc, fr, fq, lds, wid, lane); S.done(cur); }
#undef PG8_SA
#undef PG8_SB
#undef PG8_STAGE
#undef PG8_LDA
#undef PG8_LDB
#undef PG8_MMA
#undef PG8_WAIT_V
#undef PG8_WAIT_L
#undef PG8_BAR
#undef PG8_SCHED
}
}

constexpr int NWAVES = 8, NT = 512;
constexpr int D = 1024, BATCH = 4, T = 8192, M = BATCH * T, DEPTH = 4, MEM = 256, MROWS = BATCH * MEM;
constexpr int DK = 128, CH = 64, NCH = T / CH;
constexpr int GLA_N = 4096, HGRN_N = 4608, FF = 4096, KOUT = 1536;
constexpr float EPS = 1e-6f;
constexpr size_t MiB = 1u << 20;
constexpr size_t WS_SS = 0;
constexpr size_t WS_DEC = 2 * MiB;
constexpr size_t WS_MEMB = 4 * MiB;
constexpr size_t WS_SSM = 6 * MiB;
constexpr size_t WS_LB = 6 * MiB + 65536;
constexpr size_t WS_KM = 8 * MiB;
constexpr size_t WS_VMT = 12 * MiB;
constexpr size_t WS_WKV = 16 * MiB;
constexpr size_t WS_WT = 24 * MiB, WT_BUF = 30 * MiB;
constexpr size_t WT_IN = 0, WT_OUT = 10 * MiB, WT_UP = 14 * MiB, WT_DOWN = 22 * MiB;
constexpr size_t WS_PROJ = 84 * MiB;
constexpr size_t WS_XB = 372 * MiB;
constexpr size_t WS_END = 500 * MiB;
constexpr int LDS_BYTES = 147456;

#define LAS __attribute__((address_space(3)))
typedef unsigned short bf16;
typedef float f32x4 __attribute__((ext_vector_type(4)));
typedef short bf16x8 __attribute__((ext_vector_type(8)));
typedef short bf16x4 __attribute__((ext_vector_type(4)));
typedef unsigned u32x4 __attribute__((ext_vector_type(4)));
typedef unsigned u32x2 __attribute__((ext_vector_type(2)));
__device__ __forceinline__ float bf2f(bf16 b) { return __uint_as_float(((unsigned)b) << 16); }
__device__ __forceinline__ unsigned f2bf(float f) { unsigned u = __float_as_uint(f); return (u + 0x7fffu + ((u >> 16) & 1u)) >> 16; }
__device__ __forceinline__ unsigned pk2(float lo, float hi) { return pg8::cvt_pk_bf16(lo, hi); }
__device__ __forceinline__ float wave_sum(float v, int lane) {
#pragma unroll
    for (int o = 1; o < 64; o <<= 1) v += pg8::shx(v, o, lane);
    return v;
}
#define MFMA16(a, b, c) __builtin_amdgcn_mfma_f32_16x16x32_bf16((a), (b), (c), 0, 0, 0)

constexpr size_t WS_CTL = 7 * MiB, CTL_BYTES = 16384;
constexpr int LDS_BARST = LDS_BYTES - 64;
#define XB_TMO      128
#define XB_XCNT(j)  (256  + 64 * (j))
#define XB_XSUB(j)  (1280 + 64 * (j))
#define XB_XGEN(j)  (2304 + 64 * (j))
#define XB_TOP      3328
#define XB_TOPGEN   3392
#define XCD_BAR_WORDS 3456
#define XB_SPIN_CAP (1u << 18)

__device__ __forceinline__ unsigned xb_ld(unsigned* p)              { return __hip_atomic_load(p, __ATOMIC_RELAXED, __HIP_MEMORY_SCOPE_AGENT); }
__device__ __forceinline__ unsigned xb_add(unsigned* p, unsigned v) { return __hip_atomic_fetch_add(p, v, __ATOMIC_RELAXED, __HIP_MEMORY_SCOPE_AGENT); }
__device__ __forceinline__ unsigned xb_xcc_id() { return (unsigned)__builtin_amdgcn_s_getreg((3 << 11) | 20) & 0xFu; }
#define XB_SPIN(cond, bar) do { unsigned _sp = 0; while (cond) { __builtin_amdgcn_s_sleep(1); \
    if ((++_sp & 255u) == 0u) { if (xb_ld(&(bar)[XB_TMO])) break; if (_sp > XB_SPIN_CAP) { atomicAdd(&(bar)[XB_TMO], 1u); break; } } } } while (0)

struct XcdBarrier {
    unsigned* bar; unsigned x;
    volatile LAS unsigned* st;
};

__device__ __forceinline__ XcdBarrier xcd_barrier_post(unsigned* bar, volatile LAS unsigned* st, int tid) {
    XcdBarrier b; b.bar = bar; b.x = xb_xcc_id(); b.st = st;
    if (tid == 0) (void)xb_add(&bar[XB_XCNT(b.x)], 1u);
    return b;
}
__device__ __forceinline__ void xcd_barrier_complete(unsigned* bar, unsigned x, unsigned& nloc, unsigned& nx) {
    const unsigned G = gridDim.x * gridDim.y * gridDim.z;
    unsigned sum, cnt, mine, sp = 0u;
    for (;;) {
        sum = 0u; cnt = 0u; mine = 0u;
#pragma unroll
        for (unsigned j = 0; j < 16; ++j) { const unsigned c = xb_ld(&bar[XB_XCNT(j)]); sum += c; cnt += (c > 0u) ? 1u : 0u; mine = (j == x) ? c : mine; }
        if (sum == G) break;
        __builtin_amdgcn_s_sleep(1);
        if ((++sp & 255u) == 0u) { if (xb_ld(&bar[XB_TMO])) break; if (sp > XB_SPIN_CAP) { atomicAdd(&bar[XB_TMO], 1u); break; } }
    }
    nloc = mine > 0u ? mine : 1u; nx = cnt > 0u ? cnt : 1u;
}

__device__ __forceinline__ void xcd_barrier(const XcdBarrier& b, int tid) {
    asm volatile("s_waitcnt vmcnt(0)" ::: "memory");
    __syncthreads();
    if (tid == 0) {
        unsigned* bar = b.bar;
        __builtin_amdgcn_s_waitcnt(0);
        unsigned nloc = b.st[0], nx = b.st[1];
        if (nloc == 0u) { xcd_barrier_complete(bar, b.x, nloc, nx); b.st[0] = nloc; b.st[1] = nx; }
        const unsigned old = xb_add(&bar[XB_XSUB(b.x)], 1u);
        const unsigned gen = old / nloc;
        if (old + 1u == (gen + 1u) * nloc) {
            __builtin_amdgcn_fence(__ATOMIC_RELEASE, "agent");
            asm volatile("s_waitcnt vmcnt(0)" ::: "memory");
            const unsigned og = xb_add(&bar[XB_TOP], 1u);
            const unsigned tg = og / nx;
            if (og + 1u == (tg + 1u) * nx) xb_add(&bar[XB_TOPGEN], 1u);
            else XB_SPIN(xb_ld(&bar[XB_TOPGEN]) == tg, bar);
            __builtin_amdgcn_fence(__ATOMIC_ACQUIRE, "agent");
            xb_add(&bar[XB_XGEN(b.x)], 1u);
            asm volatile("s_waitcnt vmcnt(0)" ::: "memory");
        } else {
            XB_SPIN(xb_ld(&bar[XB_XGEN(b.x)]) == gen, bar);
            __builtin_amdgcn_fence(__ATOMIC_ACQUIRE, "agent");
            asm volatile("s_waitcnt vmcnt(0)" ::: "memory");
        }
    }
    __syncthreads();
}

__device__ __forceinline__ void transpose_item(const float* W, int ldw, int K, int sc, bf16* WT, int dr, const float* gain, int gmask, int glimit, float scale, LAS float* scr, int item, int nblk, int lane) {
    const int kb = item / nblk, nb = item % nblk, k0 = 64 * kb, n0 = 32 * nb;
#pragma unroll 8
    for (int i = 0; i < 32; ++i) { const int kk = 2 * i + (lane >> 5); const int k = k0 + kk; float g = scale; if (gain && k < glimit) g *= gain[k & gmask];
        scr[kk * 33 + (lane & 31)] = W[(size_t)k * ldw + sc + n0 + (lane & 31)] * g; }
    asm volatile("s_waitcnt lgkmcnt(0)" ::: "memory");
    const int c = lane & 7;
#pragma unroll
    for (int j = 0; j < 4; ++j) { const int n = (lane >> 3) + 8 * j; const LAS float* s = scr + (8 * c) * 33 + n;
        u32x4 o; o.x = pk2(s[0 * 33], s[1 * 33]); o.y = pk2(s[2 * 33], s[3 * 33]); o.z = pk2(s[4 * 33], s[5 * 33]); o.w = pk2(s[6 * 33], s[7 * 33]);
        *(u32x4*)(WT + (size_t)(dr + n0 + n) * K + k0 + 8 * c) = o; }
    asm volatile("s_waitcnt lgkmcnt(0)" ::: "memory");
}
struct Ptrs {
    const float *x, *mem, *norm_mix, *norm_mem, *w_kv, *w_out, *norm_mlp, *w_up, *w_down, *gla_w_in, *gla_w_gate2, *gla_b_gate, *gla_out_gain, *hgrn_w_in, *hgrn_lb, *hgrn_out_gain, *final_norm;
    float* out; unsigned char* ws;
};
#define SEG(Wp, ldw, K, sc, ncols, WTp, dr, gain, gmask, glimit, scale) { const int nblk_ = (ncols) / 32, nit_ = ((K) / 64) * nblk_; \
    if (r < nit_) { transpose_item(Wp, ldw, K, sc, WTp, dr, gain, gmask, glimit, scale, scr, r, nblk_, lane); continue; } r -= nit_; }
template <class PT> __device__ __forceinline__ void convert_layer(PT Pp, int L, LAS unsigned char* lds, int gw, int ngw, int wave, int lane) {
    LAS float* scr = (LAS float*)(lds + wave * 16384);
    unsigned char* wb = Pp->ws + WS_WT + (size_t)(L & 1) * WT_BUF;
    bf16* Win = (bf16*)(wb + WT_IN); bf16* Wout = (bf16*)(wb + WT_OUT); bf16* Wup = (bf16*)(wb + WT_UP); bf16* Wdn = (bf16*)(wb + WT_DOWN);
    const int j = L >> 1; const bool hg = (L & 1);
    const float* gmix = Pp->norm_mix + (size_t)L * D; const float* gmlp = Pp->norm_mlp + (size_t)L * D;
    const float* wo = Pp->w_out + (size_t)L * KOUT * D; const float* wu = Pp->w_up + (size_t)L * D * FF; const float* wd = Pp->w_down + (size_t)L * FF * D;
    const float QS = 0.08838834764831845f;
    if (!hg) {
        const float* wi = Pp->gla_w_in + (size_t)j * D * 3600; const float* og = Pp->gla_out_gain + (size_t)j * 256;
        const int total = 16 * (16 + 16 + 32 + 32 + 16) + 24 * 32 + 16 * 128 + 64 * 32 + 128;
        for (int it = gw; it < total; it += ngw) { int r = it;
            SEG(wi, 3600, D, 0, 512, Win, 0, gmix, 1023, D, QS)
            SEG(wi, 3600, D, 512, 512, Win, 512, gmix, 1023, D, 1.f)
            SEG(wi, 3600, D, 1024, 1024, Win, 2560, gmix, 1023, D, 1.f)
            SEG(wi, 3600, D, 2064, 1024, Win, 1536, gmix, 1023, D, 1.f)
            SEG(wi, 3600, D, 3088, 512, Win, 3584, gmix, 1023, D, QS)
            SEG(wo, D, KOUT, 0, 1024, Wout, 0, og, 255, 1024, 1.f)
            SEG(wu, FF, D, 0, 4096, Wup, 0, gmlp, 1023, D, 1.f)
            SEG(wd, D, FF, 0, 1024, Wdn, 0, (const float*)nullptr, 0, 0, 1.f)
            { const int kb = r >> 3, cb = r & 7, k = kb * 64 + lane; const float* g2 = Pp->gla_w_gate2 + (size_t)j * 16 * 512 + cb * 64;
              const f32x4* wr4 = (const f32x4*)(wi + (size_t)k * 3600 + 2048); const f32x4 w0 = wr4[0], w1 = wr4[1], w2 = wr4[2], w3 = wr4[3]; const float gk = gmix[k];
              for (int c = 0; c < 64; ++c) { float s = 0.f;
#pragma unroll
                  for (int q = 0; q < 4; ++q) { s += w0[q] * g2[q * 512 + c]; s += w1[q] * g2[(4 + q) * 512 + c]; s += w2[q] * g2[(8 + q) * 512 + c]; s += w3[q] * g2[(12 + q) * 512 + c]; }
                  Win[(size_t)(1024 + cb * 64 + c) * D + k] = (bf16)f2bf(s * gk); } }
        }
    } else {
        const float* wi = Pp->hgrn_w_in + (size_t)j * D * 4608; const float* og = Pp->hgrn_out_gain + (size_t)j * 128;
        const int total = 16 * (32 + 32 + 32 + 32 + 16) + 24 * 32 + 16 * 128 + 64 * 32;
        for (int it = gw; it < total; it += ngw) { int r = it;
            SEG(wi, 4608, D, 0, 1024, Win, 0, gmix, 1023, D, 1.f)
            SEG(wi, 4608, D, 1024, 1024, Win, 1024, gmix, 1023, D, 1.f)
            SEG(wi, 4608, D, 2048, 1024, Win, 3072, gmix, 1023, D, 1.f)
            SEG(wi, 4608, D, 3072, 1024, Win, 2048, gmix, 1023, D, 1.f)
            SEG(wi, 4608, D, 4096, 512, Win, 4096, gmix, 1023, D, QS)
            SEG(wo, D, KOUT, 0, 1024, Wout, 0, og, 127, 1024, 1.f)
            SEG(wu, FF, D, 0, 4096, Wup, 0, gmlp, 1023, D, 1.f)
            { const int nblk_ = 32; transpose_item(wd, D, FF, 0, Wdn, 0, (const float*)nullptr, 0, 0, 1.f, scr, r, nblk_, lane); }
        }
    }
}
template <class PT> __device__ __forceinline__ void prologue(PT Pp, LAS unsigned char* lds, int gw, int ngw, int wave, int lane) {
    convert_layer(Pp, 0, lds, gw, ngw, wave, lane);
    { LAS float* scr = (LAS float*)(lds + wave * 16384); bf16* Wkv = (bf16*)(Pp->ws + WS_WKV);
      const int per = 16 * 32, total = 4 * per;
      for (int it = gw; it < total; it += ngw) { const int L = it / per, r = it % per;
          transpose_item(Pp->w_kv + (size_t)L * D * 1024, 1024, D, 0, Wkv + (size_t)L * 1024 * D, 0, Pp->norm_mem + (size_t)L * D, 1023, D, 1.f, scr, r, 32, lane); } }
    { float* LB = (float*)(Pp->ws + WS_LB);
      for (int c = gw * 64 + lane; c < 1024; c += ngw * 64) { const float v0 = Pp->hgrn_lb[c], v1 = Pp->hgrn_lb[1024 + c], v2 = Pp->hgrn_lb[2048 + c], v3 = Pp->hgrn_lb[3072 + c];
          const float mx = fmaxf(fmaxf(v0, v1), fmaxf(v2, v3)); const float e0 = expf(v0 - mx), e1 = expf(v1 - mx), e2 = expf(v2 - mx), e3 = expf(v3 - mx); const float inv = 1.0f / (e0 + e1 + e2 + e3);
          LB[c] = 0.f; LB[1024 + c] = e1 * inv; LB[2048 + c] = (e1 + e2) * inv; LB[3072 + c] = (e1 + e2 + e3) * inv; } }
    bf16* XB = (bf16*)Pp->out; float* SS = (float*)(Pp->ws + WS_SS);     bf16* MB = (bf16*)(Pp->ws + WS_MEMB); float* SSM = (float*)(Pp->ws + WS_SSM);
    for (int m = gw; m < M + MROWS; m += ngw) {
        const bool ism = m >= M; const int row = ism ? m - M : m;
        const f32x4* xr = (const f32x4*)((ism ? Pp->mem : Pp->x) + (size_t)row * D) + lane; unsigned long long* o8 = (unsigned long long*)((ism ? MB : XB) + (size_t)row * D) + lane;
        float s = 0.f;
#pragma unroll
        for (int j = 0; j < 4; ++j) { const f32x4 v = xr[64 * j]; s += (v.x * v.x + v.y * v.y) + (v.z * v.z + v.w * v.w); o8[64 * j] = (unsigned long long)pk2(v.x, v.y) | ((unsigned long long)pk2(v.z, v.w) << 32); }
        s = wave_sum(s, lane);
        if (ism) { if (lane == 0) SSM[row] = s; }
        else if (lane < 16) SS[(size_t)lane * M + row] = lane == 0 ? s : 0.f;
    }
}
constexpr int KT_STR = 144;
constexpr int QS_STR = 272;
constexpr int VS_STR = 528;
constexpr int L_TOT = 0;
constexpr int L_LA = 2048;
constexpr int L_QS = L_LA + 64 * QS_STR;
constexpr int L_KS = L_QS + 64 * QS_STR;
constexpr int L_VS = L_KS + 64 * QS_STR;
constexpr int L_VT = L_VS + 64 * VS_STR;
constexpr int L_KT = L_VT + 256 * KT_STR;
constexpr int L_AT = L_KT;
constexpr int L_RED = L_KT + 128 * KT_STR;
static_assert(L_RED + 2048 <= LDS_BYTES - 64, "mixer LDS map");

__device__ __forceinline__ void ds_read16_s272(const LAS unsigned char* p, unsigned (&r)[16]) {
    const unsigned a = (unsigned)(__SIZE_TYPE__)p;
    asm volatile("ds_read_u16 %0, %16 offset:0\n\tds_read_u16 %1, %16 offset:272\n\tds_read_u16 %2, %16 offset:544\n\tds_read_u16 %3, %16 offset:816\n\tds_read_u16 %4, %16 offset:1088\n\tds_read_u16 %5, %16 offset:1360\n\tds_read_u16 %6, %16 offset:1632\n\tds_read_u16 %7, %16 offset:1904\n\tds_read_u16 %8, %16 offset:2176\n\tds_read_u16 %9, %16 offset:2448\n\tds_read_u16 %10, %16 offset:2720\n\tds_read_u16 %11, %16 offset:2992\n\tds_read_u16 %12, %16 offset:3264\n\tds_read_u16 %13, %16 offset:3536\n\tds_read_u16 %14, %16 offset:3808\n\tds_read_u16 %15, %16 offset:4080\n\ts_waitcnt lgkmcnt(0)"
        : "=&v"(r[0]), "=&v"(r[1]), "=&v"(r[2]), "=&v"(r[3]), "=&v"(r[4]), "=&v"(r[5]), "=&v"(r[6]), "=&v"(r[7]), "=&v"(r[8]), "=&v"(r[9]), "=&v"(r[10]), "=&v"(r[11]), "=&v"(r[12]), "=&v"(r[13]), "=&v"(r[14]), "=&v"(r[15]) : "v"(a) : "memory");
}
__device__ __forceinline__ void ds_read16_s528(const LAS unsigned char* p, unsigned (&r)[16]) {
    const unsigned a = (unsigned)(__SIZE_TYPE__)p;
    asm volatile("ds_read_u16 %0, %16 offset:0\n\tds_read_u16 %1, %16 offset:528\n\tds_read_u16 %2, %16 offset:1056\n\tds_read_u16 %3, %16 offset:1584\n\tds_read_u16 %4, %16 offset:2112\n\tds_read_u16 %5, %16 offset:2640\n\tds_read_u16 %6, %16 offset:3168\n\tds_read_u16 %7, %16 offset:3696\n\tds_read_u16 %8, %16 offset:4224\n\tds_read_u16 %9, %16 offset:4752\n\tds_read_u16 %10, %16 offset:5280\n\tds_read_u16 %11, %16 offset:5808\n\tds_read_u16 %12, %16 offset:6336\n\tds_read_u16 %13, %16 offset:6864\n\tds_read_u16 %14, %16 offset:7392\n\tds_read_u16 %15, %16 offset:7920\n\ts_waitcnt lgkmcnt(0)"
        : "=&v"(r[0]), "=&v"(r[1]), "=&v"(r[2]), "=&v"(r[3]), "=&v"(r[4]), "=&v"(r[5]), "=&v"(r[6]), "=&v"(r[7]), "=&v"(r[8]), "=&v"(r[9]), "=&v"(r[10]), "=&v"(r[11]), "=&v"(r[12]), "=&v"(r[13]), "=&v"(r[14]), "=&v"(r[15]) : "v"(a) : "memory");
}
__device__ __forceinline__ void ds_read16_red(const LAS unsigned char* p, float (&r)[16]) {
    const unsigned a = (unsigned)(__SIZE_TYPE__)p;
    asm volatile("ds_read_b32 %0, %16 offset:0\n\tds_read_b32 %1, %16 offset:256\n\tds_read_b32 %2, %16 offset:512\n\tds_read_b32 %3, %16 offset:768\n\tds_read_b32 %4, %16 offset:1024\n\tds_read_b32 %5, %16 offset:1280\n\tds_read_b32 %6, %16 offset:1536\n\tds_read_b32 %7, %16 offset:1792\n\tds_read_b32 %8, %16 offset:64\n\tds_read_b32 %9, %16 offset:320\n\tds_read_b32 %10, %16 offset:576\n\tds_read_b32 %11, %16 offset:832\n\tds_read_b32 %12, %16 offset:1088\n\tds_read_b32 %13, %16 offset:1344\n\tds_read_b32 %14, %16 offset:1600\n\tds_read_b32 %15, %16 offset:1856\n\ts_waitcnt lgkmcnt(0)"
        : "=&v"(r[0]), "=&v"(r[1]), "=&v"(r[2]), "=&v"(r[3]), "=&v"(r[4]), "=&v"(r[5]), "=&v"(r[6]), "=&v"(r[7]), "=&v"(r[8]), "=&v"(r[9]), "=&v"(r[10]), "=&v"(r[11]), "=&v"(r[12]), "=&v"(r[13]), "=&v"(r[14]), "=&v"(r[15]) : "v"(a) : "memory");
}
template <int DV>
__device__ __forceinline__ void load_raw_v(const bf16* base, int ld, int vcol, int tid, u32x4 (&rv)[DV / 64]) {
#pragma unroll
    for (int i = 0; i < DV / 64; ++i) { const int c = tid + i * NT, row = c / (DV / 8), part = c % (DV / 8); rv[i] = *(const u32x4*)(base + (size_t)row * ld + vcol + part * 8); }
}
template <int DV>
__device__ __forceinline__ void store_raw_v(LAS unsigned char* lds, int tid, const u32x4 (&rv)[DV / 64]) {
#pragma unroll
    for (int i = 0; i < DV / 64; ++i) { const int c = tid + i * NT, row = c / (DV / 8), part = c % (DV / 8); *(LAS u32x4*)(lds + L_VS + row * VS_STR + part * 16) = rv[i]; }
}
__device__ __forceinline__ void load_raw128(const bf16* base, int ld, int col, int tid, u32x4 (&r)[2]) {
#pragma unroll
    for (int i = 0; i < 2; ++i) { const int c = tid + i * NT; r[i] = *(const u32x4*)(base + (size_t)(c >> 4) * ld + col + (c & 15) * 8); }
}
__device__ __forceinline__ void store_raw128(LAS unsigned char* lds, int off, int tid, const u32x4 (&r)[2]) {
#pragma unroll
    for (int i = 0; i < 2; ++i) { const int c = tid + i * NT; *(LAS u32x4*)(lds + off + (c >> 4) * QS_STR + (c & 15) * 16) = r[i]; }
}
template <int DV>
__device__ __forceinline__ void transpose_v(LAS unsigned char* lds, int tid) {
    constexpr int RPT = DV / 8;
    const int v = tid % DV, part = tid / DV;
    unsigned w[RPT / 2];
#pragma unroll
    for (int h = 0; h < RPT / 16; ++h) { unsigned r[16]; ds_read16_s528(lds + L_VS + (part * RPT + 16 * h) * VS_STR + v * 2, r);
#pragma unroll
        for (int i = 0; i < 8; ++i) w[8 * h + i] = r[2 * i] | (r[2 * i + 1] << 16); }
    LAS u32x4* dst = (LAS u32x4*)(lds + L_VT + v * KT_STR + part * RPT * 2);
#pragma unroll
    for (int i = 0; i < RPT / 8; ++i) dst[i] = (u32x4){w[4 * i], w[4 * i + 1], w[4 * i + 2], w[4 * i + 3]};
}
__device__ __forceinline__ void cumsum_local(LAS unsigned char* lds, int d, int rg, float (&bb)[16]) {
    unsigned r[16]; ds_read16_s272(lds + L_LA + (rg * 16) * QS_STR + d * 2, r);
#pragma unroll
    for (int i = 0; i < 16; ++i) bb[i] = __uint_as_float(r[i] << 16);
}
__device__ __forceinline__ void cumsum_scan(LAS unsigned char* lds, int d, int rg, float (&bb)[16]) {
#pragma unroll
    for (int i = 1; i < 16; ++i) bb[i] += bb[i - 1];
    ((LAS float*)(lds + L_TOT))[rg * 128 + d] = bb[15];
}
__device__ __forceinline__ void cumsum_finish(LAS unsigned char* lds, int d, int rg, float (&bb)[16], float& blast) {
    const LAS float* tot = (const LAS float*)(lds + L_TOT);
    const float t0 = tot[d], t1 = tot[128 + d], t2 = tot[256 + d], t3 = tot[384 + d];
    const float off = rg == 0 ? 0.f : (rg == 1 ? t0 : (rg == 2 ? t0 + t1 : t0 + t1 + t2));
    blast = (t0 + t1) + (t2 + t3);
#pragma unroll
    for (int i = 0; i < 16; ++i) bb[i] += off;
}
template <int DV, bool HGRN>
__device__ __forceinline__ void pass_a(LAS unsigned char* lds, const bf16* proj, bf16* GS, float* DEC, int G, int bid, const int tid) {
    constexpr int H = HGRN ? 8 : 4, LD = HGRN ? HGRN_N : GLA_N, NTW = DV / 128, NU = BATCH * H * NCH;
    const int lane = tid & 63, wave = tid >> 6, g = lane >> 4, l15 = lane & 15, d = tid & 127, rg = tid >> 7;
    u32x4 rla[2], rk[2], rv[DV / 64];
    int u = bid;
    if (u < NU) { const int b = u / (H * NCH), h = (u / NCH) % H, n = u % NCH; const bf16* base = proj + (size_t)(b * T + n * CH) * LD;
        load_raw128(base, LD, 1024 + h * 128, tid, rla); if (!HGRN) load_raw128(base, LD, 512 + h * 128, tid, rk); load_raw_v<DV>(base, LD, (HGRN ? 3072 : 2560) + h * DV, tid, rv); }
    for (; u < NU; u += G) {
        store_raw128(lds, L_LA, tid, rla); if (!HGRN) store_raw128(lds, L_KS, tid, rk); store_raw_v<DV>(lds, tid, rv);
        __syncthreads();
        { const int un = u + G; if (un < NU) { const int b = un / (H * NCH), h = (un / NCH) % H, n = un % NCH; const bf16* base = proj + (size_t)(b * T + n * CH) * LD;
            load_raw128(base, LD, 1024 + h * 128, tid, rla); if (!HGRN) load_raw128(base, LD, 512 + h * 128, tid, rk); load_raw_v<DV>(base, LD, (HGRN ? 3072 : 2560) + h * DV, tid, rv); } }
        float bb[16], kv[16], blast;
        cumsum_local(lds, d, rg, bb);
        if (HGRN) {
#pragma unroll
            for (int i = 0; i < 16; ++i) kv[i] = 1.0f - __expf(bb[i]);
        } else { unsigned r[16]; ds_read16_s272(lds + L_KS + (rg * 16) * QS_STR + d * 2, r);
#pragma unroll
            for (int i = 0; i < 16; ++i) kv[i] = __uint_as_float(r[i] << 16); }
        cumsum_scan(lds, d, rg, bb);
        transpose_v<DV>(lds, tid);
        __syncthreads();
        cumsum_finish(lds, d, rg, bb, blast);
        { unsigned w[8];
#pragma unroll
          for (int i = 0; i < 8; ++i) w[i] = pk2(kv[2 * i] * __expf(-bb[2 * i]), kv[2 * i + 1] * __expf(-bb[2 * i + 1]));
          LAS u32x4* dst = (LAS u32x4*)(lds + L_KT + d * KT_STR + rg * 32);
          dst[0] = (u32x4){w[0], w[1], w[2], w[3]}; dst[1] = (u32x4){w[4], w[5], w[6], w[7]}; }
        if (rg == 0) DEC[(size_t)u * 128 + d] = __expf(blast);
        __syncthreads();
        f32x4 acc[8][NTW];
#pragma unroll
        for (int mt = 0; mt < 8; ++mt)
#pragma unroll
            for (int nt = 0; nt < NTW; ++nt) acc[mt][nt] = (f32x4){0.f, 0.f, 0.f, 0.f};
#pragma unroll
        for (int kk = 0; kk < 2; ++kk) {
            bf16x8 bfr[NTW], afr[8];
#pragma unroll
            for (int nt = 0; nt < NTW; ++nt) bfr[nt] = *(const LAS bf16x8*)(lds + L_VT + ((wave * NTW + nt) * 16 + l15) * KT_STR + (kk * 32 + 8 * g) * 2);
#pragma unroll
            for (int mt = 0; mt < 8; ++mt) afr[mt] = *(const LAS bf16x8*)(lds + L_KT + ((mt >> 1) * 32 + 8 * (l15 >> 2) + 4 * (mt & 1) + (l15 & 3)) * KT_STR + (kk * 32 + 8 * g) * 2);
#pragma unroll
            for (int mt = 0; mt < 8; ++mt)
#pragma unroll
                for (int nt = 0; nt < NTW; ++nt) acc[mt][nt] = MFMA16(afr[mt], bfr[nt], acc[mt][nt]);
        }
#pragma unroll
        for (int mt = 0; mt < 8; ++mt)
#pragma unroll
            for (int nt = 0; nt < NTW; ++nt) asm volatile("s_nop 7\n\ts_nop 7" : "+v"(acc[mt][nt]));
#pragma unroll
        for (int nt = 0; nt < NTW; ++nt) { bf16* gp = GS + ((size_t)u * DV + (wave * NTW + nt) * 16 + l15) * 128 + 8 * g;
#pragma unroll
            for (int P = 0; P < 4; ++P) { u32x4 w; w.x = pk2(acc[2 * P][nt][0], acc[2 * P][nt][1]); w.y = pk2(acc[2 * P][nt][2], acc[2 * P][nt][3]);
                w.z = pk2(acc[2 * P + 1][nt][0], acc[2 * P + 1][nt][1]); w.w = pk2(acc[2 * P + 1][nt][2], acc[2 * P + 1][nt][3]); *(u32x4*)(gp + P * 32) = w; } }
    }
    __syncthreads();
}
template <int DV, bool HGRN, bool DRY = false>
__device__ __forceinline__ void pass_b(bf16* GS, const float* DEC, int G, int bid, const int tid) {
    constexpr int H = HGRN ? 8 : 4, E = DV * 128, E4 = E / 4;
    const int nthreads = G * NT;
    for (int i = bid * NT + tid; i < BATCH * H * E4; i += nthreads) {
        const int bh = i / E4, e = (i % E4) * 4, d = e & 127;
        float S0 = 0.f, S1 = 0.f, S2 = 0.f, S3 = 0.f;
        u32x2* gp = (u32x2*)(GS + (size_t)bh * NCH * E + e); const f32x4* dp = (const f32x4*)(DEC + (size_t)bh * NCH * 128 + d);
        for (int n0 = 0; n0 < NCH; n0 += 8) {
            u32x2 gv[8]; f32x4 dv[8];
#pragma unroll
            for (int q = 0; q < 8; ++q) { gv[q] = gp[(size_t)(n0 + q) * (E / 4)]; dv[q] = dp[(size_t)(n0 + q) * 32]; }
#pragma unroll
            for (int q = 0; q < 8; ++q) {
                u32x2 o; o.x = pk2(S0, S1); o.y = pk2(S2, S3); if (!DRY || o.x == 0x12345678u) gp[(size_t)(n0 + q) * (E / 4)] = o;
                S0 = dv[q].x * (S0 + __uint_as_float(gv[q].x << 16)); S1 = dv[q].y * (S1 + __uint_as_float(gv[q].x & 0xffff0000u));
                S2 = dv[q].z * (S2 + __uint_as_float(gv[q].y << 16)); S3 = dv[q].w * (S3 + __uint_as_float(gv[q].y & 0xffff0000u)); }
        }
    }
}
template <int DV, bool HGRN, bool DRY = false>
__device__ __forceinline__ void pass_c(LAS unsigned char* lds, bf16* proj, const bf16* GS, int G, int bid, const int tid) {
    constexpr int H = HGRN ? 8 : 4, LD = HGRN ? HGRN_N : GLA_N, MTW = 2, VB = DV / 32, NTC = VB / 2, NU = BATCH * H * NCH;
    const int lane = tid & 63, wave = tid >> 6, g = lane >> 4, l15 = lane & 15, d = tid & 127, rg = tid >> 7;
    const int vb = wave % VB, th = wave / VB, v0 = vb * 32, vrow = v0 + 8 * (l15 >> 2) + (l15 & 3);
    u32x4 rla[2], rq[2], rk[2], rv[DV / 64];
    int u = bid;
    if (u < NU) { const int b = u / (H * NCH), h = (u / NCH) % H, n = u % NCH; const bf16* base = proj + (size_t)(b * T + n * CH) * LD;
        load_raw128(base, LD, 1024 + h * 128, tid, rla); load_raw128(base, LD, h * 128, tid, rq); if (!HGRN) load_raw128(base, LD, 512 + h * 128, tid, rk); load_raw_v<DV>(base, LD, (HGRN ? 3072 : 2560) + h * DV, tid, rv); }
    for (; u < NU; u += G) {
        const int b = u / (H * NCH), h = (u / NCH) % H, n = u % NCH;
        bf16* base = proj + (size_t)(b * T + n * CH) * LD;
        const int vcol = (HGRN ? 3072 : 2560) + h * DV, gcol = (HGRN ? 2048 : 1536) + h * DV;
        store_raw128(lds, L_LA, tid, rla); store_raw128(lds, L_QS, tid, rq); if (!HGRN) store_raw128(lds, L_KS, tid, rk); store_raw_v<DV>(lds, tid, rv);
        __syncthreads();
        bf16x8 sfr[4][MTW];
#pragma unroll
        for (int kk = 0; kk < 4; ++kk)
#pragma unroll
            for (int mt = 0; mt < MTW; ++mt) sfr[kk][mt] = *(const bf16x8*)(GS + ((size_t)u * DV + vrow + 4 * mt) * 128 + kk * 32 + 8 * g);
        { const int un = u + G; if (un < NU) { const int b2 = un / (H * NCH), h2 = (un / NCH) % H, n2 = un % NCH; const bf16* nb = proj + (size_t)(b2 * T + n2 * CH) * LD;
            load_raw128(nb, LD, 1024 + h2 * 128, tid, rla); load_raw128(nb, LD, h2 * 128, tid, rq); if (!HGRN) load_raw128(nb, LD, 512 + h2 * 128, tid, rk); load_raw_v<DV>(nb, LD, (HGRN ? 3072 : 2560) + h2 * DV, tid, rv); } }
        float bb[16], kv[16], blast;
        cumsum_local(lds, d, rg, bb);
        if (HGRN) {
#pragma unroll
            for (int i = 0; i < 16; ++i) kv[i] = 1.0f - __expf(bb[i]);
        } else { unsigned r[16]; ds_read16_s272(lds + L_KS + (rg * 16) * QS_STR + d * 2, r);
#pragma unroll
            for (int i = 0; i < 16; ++i) kv[i] = __uint_as_float(r[i] << 16); }
        cumsum_scan(lds, d, rg, bb);
        transpose_v<DV>(lds, tid);
        __syncthreads();
        cumsum_finish(lds, d, rg, bb, blast);
        { unsigned rq_[16]; ds_read16_s272(lds + L_QS + (rg * 16) * QS_STR + d * 2, rq_);
#pragma unroll
          for (int i = 0; i < 16; ++i) { const int s = rg * 16 + i; LAS bf16* qa = (LAS bf16*)(lds + L_QS + s * QS_STR + d * 2); LAS bf16* ka = (LAS bf16*)(lds + L_KS + s * QS_STR + d * 2);
              const float q = __uint_as_float(rq_[i] << 16); *qa = (bf16)f2bf(q * __expf(bb[i])); *ka = (bf16)f2bf(kv[i] * __expf(-bb[i])); } }
        __syncthreads();
        { const int tt = wave >> 1;
#pragma unroll
          for (int si = 0; si < 2; ++si) { const int st = (wave & 1) * 2 + si; f32x4 c = (f32x4){0.f, 0.f, 0.f, 0.f};
              bf16x8 afr[4], bfr[4];
#pragma unroll
              for (int kk = 0; kk < 4; ++kk) { afr[kk] = *(const LAS bf16x8*)(lds + L_KS + (st * 16 + l15) * QS_STR + (kk * 32 + 8 * g) * 2);
                  bfr[kk] = *(const LAS bf16x8*)(lds + L_QS + (tt * 16 + l15) * QS_STR + (kk * 32 + 8 * g) * 2); }
#pragma unroll
              for (int kk = 0; kk < 4; ++kk) c = MFMA16(afr[kk], bfr[kk], c);
              const int t = tt * 16 + l15, s0 = st * 16 + 4 * g;
              u32x2 w; w.x = pk2(s0 <= t ? c[0] : 0.f, s0 + 1 <= t ? c[1] : 0.f); w.y = pk2(s0 + 2 <= t ? c[2] : 0.f, s0 + 3 <= t ? c[3] : 0.f);
              *(LAS u32x2*)(lds + L_AT + t * KT_STR + s0 * 2) = w; } }
        u32x4 gt[NTC];
#pragma unroll
        for (int nt = 0; nt < NTC; ++nt) gt[nt] = *(const u32x4*)(base + (size_t)((th * NTC + nt) * 16 + l15) * LD + gcol + v0 + 8 * g);
        __syncthreads();
        f32x4 acc[MTW][NTC];
#pragma unroll
        for (int mt = 0; mt < MTW; ++mt)
#pragma unroll
            for (int nt = 0; nt < NTC; ++nt) acc[mt][nt] = (f32x4){0.f, 0.f, 0.f, 0.f};
#pragma unroll
        for (int kp = 0; kp < 2; ++kp) {
            bf16x8 bfr[2][NTC];
#pragma unroll
            for (int k2 = 0; k2 < 2; ++k2)
#pragma unroll
                for (int nt = 0; nt < NTC; ++nt) bfr[k2][nt] = *(const LAS bf16x8*)(lds + L_QS + ((th * NTC + nt) * 16 + l15) * QS_STR + ((kp * 2 + k2) * 32 + 8 * g) * 2);
#pragma unroll
            for (int k2 = 0; k2 < 2; ++k2)
#pragma unroll
                for (int nt = 0; nt < NTC; ++nt)
#pragma unroll
                    for (int mt = 0; mt < MTW; ++mt) acc[mt][nt] = MFMA16(sfr[kp * 2 + k2][mt], bfr[k2][nt], acc[mt][nt]);
        }
        {
            bf16x8 afr[2][MTW], bfr[2][NTC];
#pragma unroll
            for (int kk = 0; kk < 2; ++kk) {
#pragma unroll
                for (int mt = 0; mt < MTW; ++mt) afr[kk][mt] = *(const LAS bf16x8*)(lds + L_VT + (vrow + 4 * mt) * KT_STR + (kk * 32 + 8 * g) * 2);
#pragma unroll
                for (int nt = 0; nt < NTC; ++nt) bfr[kk][nt] = *(const LAS bf16x8*)(lds + L_AT + ((th * NTC + nt) * 16 + l15) * KT_STR + (kk * 32 + 8 * g) * 2); }
#pragma unroll
            for (int kk = 0; kk < 2; ++kk)
#pragma unroll
                for (int nt = 0; nt < NTC; ++nt)
#pragma unroll
                    for (int mt = 0; mt < MTW; ++mt) acc[mt][nt] = MFMA16(afr[kk][mt], bfr[kk][nt], acc[mt][nt]);
        }
        LAS float* red = (LAS float*)(lds + L_RED);
        { float pp[NTC];
#pragma unroll
          for (int nt = 0; nt < NTC; ++nt) { float p = 0.f;
#pragma unroll
              for (int mt = 0; mt < MTW; ++mt) p += (acc[mt][nt][0] * acc[mt][nt][0] + acc[mt][nt][1] * acc[mt][nt][1]) + (acc[mt][nt][2] * acc[mt][nt][2] + acc[mt][nt][3] * acc[mt][nt][3]);
              pp[nt] = p; }
          if constexpr (NTC == 4) { pg8::shx_add4(pp, 16, lane); pg8::shx_add4(pp, 32, lane); } else { pg8::shx_add2(pp, 16, lane); pg8::shx_add2(pp, 32, lane); }
          if (g == 0) {
#pragma unroll
              for (int nt = 0; nt < NTC; ++nt) red[vb * 64 + (th * NTC + nt) * 16 + l15] = pp[nt]; } }
        __syncthreads();
        float rsum[NTC];
#pragma unroll
        for (int np = 0; np < NTC / 2; ++np) { float r16[16]; ds_read16_red(lds + L_RED + ((th * NTC + 2 * np) * 16 + l15) * 4, r16);
#pragma unroll
            for (int q = 0; q < 2; ++q) { float s = 0.f;
#pragma unroll
                for (int w = 0; w < VB; ++w) s += r16[q * 8 + w];
                rsum[2 * np + q] = s; } }
#pragma unroll
        for (int nt = 0; nt < NTC; ++nt) { const int t = (th * NTC + nt) * 16 + l15; const float s = rsum[nt];
            const float rstd = rsqrtf(s * (1.0f / DV) + EPS);
            bf16* rowp = base + (size_t)t * LD; const u32x4 gg = gt[nt];
            u32x4 w; w.x = pk2(acc[0][nt][0] * rstd * __uint_as_float(gg.x << 16), acc[0][nt][1] * rstd * __uint_as_float(gg.x & 0xffff0000u));
            w.y = pk2(acc[0][nt][2] * rstd * __uint_as_float(gg.y << 16), acc[0][nt][3] * rstd * __uint_as_float(gg.y & 0xffff0000u));
            w.z = pk2(acc[1][nt][0] * rstd * __uint_as_float(gg.z << 16), acc[1][nt][1] * rstd * __uint_as_float(gg.z & 0xffff0000u));
            w.w = pk2(acc[1][nt][2] * rstd * __uint_as_float(gg.w << 16), acc[1][nt][3] * rstd * __uint_as_float(gg.w & 0xffff0000u));
            if (!DRY || w.x == 0x12345678u) *(u32x4*)(rowp + vcol + v0 + 8 * g) = w; }
    }
    __syncthreads();
}
constexpr int KL_STR = 272, VL_STR = 528, L_KL = 0, L_VL = 256 * KL_STR;
static_assert(L_VL + 128 * VL_STR <= LDS_BYTES, "xattn LDS map");
template <bool DRY = false>
__device__ __forceinline__ void xattn(LAS unsigned char* lds, bf16* proj, int LD, int xcol, const bf16* KM, const bf16* VMT, int G, int bid, const int tid) {
    const int lane = tid & 63, wave = tid >> 6, g = lane >> 4, l15 = lane & 15;
    for (int w = bid; w < 256; w += G) {
        const int pair = w >> 4, sub = w & 15, b = pair >> 2, h = pair & 3;
        __syncthreads();
#pragma unroll
        for (int i = 0; i < 8; ++i) { const int c = tid + i * NT, m = c >> 4, part = c & 15;
            *(LAS u32x4*)(lds + L_KL + m * KL_STR + part * 16) = *(const u32x4*)(KM + (size_t)(b * 256 + m) * 512 + h * 128 + part * 8); }
#pragma unroll
        for (int i = 0; i < 8; ++i) { const int c = tid + i * NT, dd = c >> 5, part = c & 31;
            *(LAS u32x4*)(lds + L_VL + dd * VL_STR + part * 16) = *(const u32x4*)(VMT + ((size_t)b * 512 + h * 128 + dd) * 256 + part * 8); }
        __syncthreads();
        bf16x8 qn[4];
        { const bf16* q0 = proj + (size_t)(b * T + (sub * 4) * 128 + wave * 16 + l15) * LD + xcol + h * 128;
#pragma unroll
          for (int kk = 0; kk < 4; ++kk) qn[kk] = *(const bf16x8*)(q0 + kk * 32 + 8 * g); }
        for (int tile = 0; tile < 4; ++tile) {
            const int r0 = b * T + (sub * 4 + tile) * 128 + wave * 16;
            bf16* qp = proj + (size_t)(r0 + l15) * LD + xcol + h * 128;
            bf16x8 qf[4];
#pragma unroll
            for (int kk = 0; kk < 4; ++kk) qf[kk] = qn[kk];
            if (tile < 3) {
#pragma unroll
                for (int kk = 0; kk < 4; ++kk) qn[kk] = *(const bf16x8*)(qp + (size_t)128 * LD + kk * 32 + 8 * g); }
            f32x4 sc[16];
#pragma unroll
            for (int mp = 0; mp < 8; ++mp) {
                bf16x8 afr[2][4];
#pragma unroll
                for (int m2 = 0; m2 < 2; ++m2)
#pragma unroll
                    for (int kk = 0; kk < 4; ++kk) afr[m2][kk] = *(const LAS bf16x8*)(lds + L_KL + ((mp * 2 + m2) * 16 + l15) * KL_STR + (kk * 32 + 8 * g) * 2);
#pragma unroll
                for (int m2 = 0; m2 < 2; ++m2) { f32x4 c = (f32x4){0.f, 0.f, 0.f, 0.f};
#pragma unroll
                    for (int kk = 0; kk < 4; ++kk) c = MFMA16(afr[m2][kk], qf[kk], c);
                    sc[mp * 2 + m2] = c; } }
            float mx = -1e30f;
#pragma unroll
            for (int mt = 0; mt < 16; ++mt) mx = fmaxf(mx, fmaxf(fmaxf(sc[mt][0], sc[mt][1]), fmaxf(sc[mt][2], sc[mt][3])));
            mx = fmaxf(mx, pg8::shx(mx, 16, lane)); mx = fmaxf(mx, pg8::shx(mx, 32, lane));
            float sum = 0.f;
#pragma unroll
            for (int mt = 0; mt < 16; ++mt) {
#pragma unroll
                for (int j = 0; j < 4; ++j) { const float p = __expf(sc[mt][j] - mx); sc[mt][j] = p; sum += p; } }
            sum += pg8::shx(sum, 16, lane); sum += pg8::shx(sum, 32, lane);
            const float inv = 1.0f / sum;
            f32x4 oa[8];
#pragma unroll
            for (int dt = 0; dt < 8; ++dt) oa[dt] = (f32x4){0.f, 0.f, 0.f, 0.f};
#pragma unroll
            for (int kb = 0; kb < 8; ++kb) {
                union { bf16x8 v; unsigned u[4]; } pb;
                pb.u[0] = pk2(sc[2 * kb][0], sc[2 * kb][1]); pb.u[1] = pk2(sc[2 * kb][2], sc[2 * kb][3]); pb.u[2] = pk2(sc[2 * kb + 1][0], sc[2 * kb + 1][1]); pb.u[3] = pk2(sc[2 * kb + 1][2], sc[2 * kb + 1][3]);
                union { bf16x8 v; u32x2 h[2]; } pa[8];
#pragma unroll
                for (int dt = 0; dt < 8; ++dt) { const LAS unsigned char* vp = lds + L_VL + ((dt >> 1) * 32 + 8 * (l15 >> 2) + 4 * (dt & 1) + (l15 & 3)) * VL_STR + (kb * 32 + 4 * g) * 2;
                    pa[dt].h[0] = *(const LAS u32x2*)vp; pa[dt].h[1] = *(const LAS u32x2*)(vp + 32); }
#pragma unroll
                for (int dt = 0; dt < 8; ++dt) oa[dt] = MFMA16(pa[dt].v, pb.v, oa[dt]);
            }
#pragma unroll
            for (int P = 0; P < 4; ++P) { u32x4 o; o.x = pk2(oa[2 * P][0] * inv, oa[2 * P][1] * inv); o.y = pk2(oa[2 * P][2] * inv, oa[2 * P][3] * inv);
                o.z = pk2(oa[2 * P + 1][0] * inv, oa[2 * P + 1][1] * inv); o.w = pk2(oa[2 * P + 1][2] * inv, oa[2 * P + 1][3] * inv); if (!DRY || o.x == 0x12345678u) *(u32x4*)(qp + P * 32 + 8 * g) = o; }
        }
    }
    __syncthreads();
}
__device__ __forceinline__ void final_norm(float* out, const bf16* XB, const float* SS, const float* gain, int gw, int ngw, int lane) {
    f32x4 gv[4];
#pragma unroll
    for (int j = 0; j < 4; ++j) gv[j] = ((const f32x4*)gain)[lane + 64 * j];
    for (int m = gw; m < M; m += ngw) {
        float s = lane < 16 ? SS[(size_t)lane * M + m] : 0.f; s = wave_sum(s, lane);
        const float rstd = rsqrtf(s * (1.0f / D) + EPS);
        const u32x2* xr = (const u32x2*)(XB + (size_t)m * D) + lane; f32x4* orow = (f32x4*)(out + (size_t)m * D) + lane;
#pragma unroll
        for (int j = 0; j < 4; ++j) { const u32x2 xw = xr[64 * j]; f32x4 v = (f32x4){__uint_as_float(xw.x << 16), __uint_as_float(xw.x & 0xffff0000u), __uint_as_float(xw.y << 16), __uint_as_float(xw.y & 0xffff0000u)};
            orow[64 * j] = v * rstd * gv[j]; }
    }
}

struct Args { Ptrs P; int ph_lo, ph_hi; };
constexpr int N_PHASES = 2 + 7 * DEPTH;
__global__ void __launch_bounds__(NT, 2) fwd_kernel(Args a) {
    extern __shared__ __attribute__((aligned(16))) unsigned char lds_raw[];
#if ONE_LAUNCH
    cg::grid_group grid = cg::this_grid();
    { volatile LAS unsigned* st = (volatile LAS unsigned*)((LAS unsigned char*)lds_raw + LDS_BARST); int t0_ = threadIdx.x; if (t0_ == 0) { st[0] = 0u; st[1] = 0u; } __syncthreads();
      (void)xcd_barrier_post((unsigned*)(a.P.ws + WS_CTL), st, t0_); }
#define SEAM() do { XcdBarrier xb_; xb_.bar = (unsigned*)(ws + WS_CTL); xb_.x = xb_xcc_id(); xb_.st = (volatile LAS unsigned*)(lds + LDS_BARST); xcd_barrier(xb_, tid); if (ph == 0) grid.sync(); } while (0)
#else
#define SEAM() do {} while (0)
#endif
    const int ph_lo = a.ph_lo, ph_hi = a.ph_hi;
    const int wave0 = __builtin_amdgcn_readfirstlane(threadIdx.x >> 6);
    for (int ph = ph_lo; ph < ph_hi; ++ph) {
        const __attribute__((address_space(4))) Args* ap = (const __attribute__((address_space(4))) Args*)__builtin_amdgcn_kernarg_segment_ptr();
        asm volatile("" : "+s"(ap));
        int zero_ = 0; asm volatile("" : "+v"(zero_));
        int tid = wave0 * 64 + (int)__builtin_amdgcn_mbcnt_hi(~0u, __builtin_amdgcn_mbcnt_lo(~0u, (unsigned)zero_)); asm volatile("" : "+v"(tid));
        LAS unsigned char* lds = (LAS unsigned char*)lds_raw;
        const int lane = tid & 63, wave = __builtin_amdgcn_readfirstlane(tid >> 6);
        int G = gridDim.x, bid = blockIdx.x; asm volatile("" : "+s"(G), "+s"(bid));
        const int gw = bid * NWAVES + wave, ngw = G * NWAVES;
        unsigned char* ws = ap->P.ws;
        float* SS = (float*)(ws + WS_SS); bf16* XB = (bf16*)ap->P.out; bf16* GS = (bf16*)(ws + WS_XB); bf16* X2 = (bf16*)(ws + WS_XB); bf16* PROJ = (bf16*)(ws + WS_PROJ);
        int ngemm = 0;
        int L = 0, sp = 0; bool hg = false;
        if (ph == 0) { prologue(&ap->P, lds, gw, ngw, wave, lane); }
        else if (ph == N_PHASES - 1) { final_norm(ap->P.out, X2, SS, ap->P.final_norm, gw, ngw, lane); }
        else {
            L = (ph - 1) / 7; sp = (ph - 1) % 7; hg = (L & 1);
            const int LD = hg ? HGRN_N : GLA_N;
            if (sp == 0) ngemm = (L == 0) ? 2 : 1;
            else if (sp == 1) {
                float* DEC = (float*)(ws + WS_DEC);
#if EXP == 3
                if (hg) pass_a<128, true>(lds, PROJ, GS, DEC, G, bid, tid); else pass_a<256, false>(lds, PROJ, GS, DEC, G, bid, tid);
#endif
                if (hg) pass_a<128, true>(lds, PROJ, GS, DEC, G, bid, tid); else pass_a<256, false>(lds, PROJ, GS, DEC, G, bid, tid);
#if EXP == 5
                xattn<true>(lds, PROJ, LD, hg ? 4096 : 3584, (const bf16*)(ws + WS_KM) + (size_t)L * 1024 * 512, (const bf16*)(ws + WS_VMT) + (size_t)L * 4 * 512 * 256, G, bid, tid);
#endif
#if EXP == 6
                if (L + 1 < DEPTH) { convert_layer(&ap->P, L + 1, lds, gw, ngw, wave, lane); } __syncthreads();
#endif
                xattn(lds, PROJ, LD, hg ? 4096 : 3584, (const bf16*)(ws + WS_KM) + (size_t)L * 1024 * 512, (const bf16*)(ws + WS_VMT) + (size_t)L * 4 * 512 * 256, G, bid, tid);
                if (L + 1 < DEPTH) { convert_layer(&ap->P, L + 1, lds, gw, ngw, wave, lane); }
            } else if (sp == 2) {
                const float* DEC = (const float*)(ws + WS_DEC);
#if EXP == 3
                if (hg) pass_b<128, true, true>(GS, DEC, G, bid, tid); else pass_b<256, false, true>(GS, DEC, G, bid, tid);
#endif
                if (hg) pass_b<128, true>(GS, DEC, G, bid, tid); else pass_b<256, false>(GS, DEC, G, bid, tid);
            } else if (sp == 3) {
#if EXP == 4
                if (hg) pass_c<128, true, true>(lds, PROJ, GS, G, bid, tid); else pass_c<256, false, true>(lds, PROJ, GS, G, bid, tid);
#endif
                if (hg) pass_c<128, true>(lds, PROJ, GS, G, bid, tid); else pass_c<256, false>(lds, PROJ, GS, G, bid, tid);
            } else ngemm = 1;
            if (EXP == 2 && (sp == 0 || sp == 5)) ngemm += 8;
        }
        for (int rep = 0; rep < (ngemm & 7) * (ngemm >= 8 ? 2 : 1); ++rep) {
            unsigned char* wb = ws + WS_WT + (size_t)(L & 1) * WT_BUF;
            const int LD = hg ? HGRN_N : GLA_N;
            pg8::Gemm g; pg8::EpiAll E; E.hgrn = hg ? 1 : 0; E.M = M; E.aux = nullptr; E.xin = nullptr; E.xout = nullptr;
            if (sp == 0 && (ngemm & 7) == 2 && (rep & 7) == 0 && rep < 8) {
                g.A = (const bf16*)(ws + WS_MEMB); g.Bt = (const bf16*)(ws + WS_WKV); g.M = MROWS; g.N = 4096; g.K = D; g.lda = D; g.perm = 0;
                E.kind = 3; E.ldc = 0; E.O = (bf16*)(ws + WS_KM); E.ss = (const float*)(ws + WS_SSM); E.xout = (float*)(ws + WS_VMT);
            } else if (sp == 0) {
                g.A = XB; g.Bt = (const bf16*)(wb + WT_IN); g.M = M; g.N = LD; g.K = D; g.lda = D; g.perm = 1;
                E.kind = 0; E.ldc = LD; E.O = PROJ; E.ss = SS; E.aux = hg ? (const float*)(ws + WS_LB) + (size_t)L * 1024 : ap->P.gla_b_gate + (size_t)(L >> 1) * 512;
            } else if (sp == 4) {
                g.A = PROJ + (hg ? 3072 : 2560); g.Bt = (const bf16*)(wb + WT_OUT); g.M = M; g.N = D; g.K = KOUT; g.lda = LD; g.perm = 1;
                E.kind = 2; E.ldc = D; E.O = XB; E.ss = SS; E.xin = (L == 0 && ph_hi < 0) ? ap->P.x : nullptr; E.xout = (float*)XB;
            } else if (sp == 5) {
                g.A = XB; g.Bt = (const bf16*)(wb + WT_UP); g.M = M; g.N = FF; g.K = D; g.lda = D; g.perm = 1;
                E.kind = 1; E.ldc = FF; E.O = PROJ; E.ss = SS;
            } else {
                g.A = PROJ; g.Bt = (const bf16*)(wb + WT_DOWN); g.M = M; g.N = D; g.K = FF; g.lda = FF; g.perm = 1;
                E.kind = 2; E.ldc = D; E.O = XB; E.ss = SS; E.xout = (float*)((L == DEPTH - 1) ? X2 : XB);
            }
#if EXP == 9
            if (E.kind == 2) { pg8::Gemm g2 = g; g2.perm = 1; pg8::EpiAll E2 = E; E2.kind = 1; E2.ldc = D; E2.O = GS; E2.ss = SS; E2.xin = nullptr;
                pg8::StaticOrder S2; S2.init(g2.M, g2.N, G, bid); pg8::gemm_phase<pg8::EpiAll, pg8::StaticOrder, true, true>(lds, g2, S2, E2, tid); }
#endif
            pg8::StaticOrder S; S.init(g.M, g.N, G, bid, (sp == 6) ? REV_DOWN : 0);
#if SKEW_TICKS > 0
            if (E.kind <= 1) {
                const unsigned long long t0_ = __builtin_amdgcn_s_memrealtime(); const unsigned long long dl_ = (unsigned long long)((bid & 7) * SKEW_TICKS);
                while (__builtin_amdgcn_s_memrealtime() - t0_ < dl_) __builtin_amdgcn_s_sleep(8);
            }
#endif
            pg8::gemm_phase<pg8::EpiAll, pg8::StaticOrder, true, true>(lds, g, S, E, tid);
        }
        if (ph + 1 < ph_hi) { SEAM(); }
#if EXP == 7
        if (ph + 1 < ph_hi) { SEAM(); }
#endif
    }
}

extern "C" void kernel_launch(void* const* d_in, const int* in_sizes, int n_in, void* d_out, int out_size, void* d_ws, size_t ws_size, hipStream_t stream) {
    static int grid = 0;
    if (grid == 0) {
        if (n_in != 17 || out_size != M * D || ws_size < WS_END) { fprintf(stderr, "kernel_launch: unexpected shapes (n_in %d out %d ws %zu)\n", n_in, out_size, ws_size); grid = -1; return; }
        int dev = 0, cus = 0, per_cu = 0;
        hipGetDevice(&dev); hipDeviceGetAttribute(&cus, hipDeviceAttributeMultiprocessorCount, dev);
        if (hipFuncSetAttribute((const void*)fwd_kernel, hipFuncAttributeMaxDynamicSharedMemorySize, LDS_BYTES) != hipSuccess) { fprintf(stderr, "kernel_launch: hipFuncSetAttribute failed\n"); grid = -1; return; }
        if (hipOccupancyMaxActiveBlocksPerMultiprocessor(&per_cu, (const void*)fwd_kernel, NT, LDS_BYTES) != hipSuccess || per_cu < 1) { fprintf(stderr, "kernel_launch: occupancy query says %d\n", per_cu); per_cu = 1; }
        (void)hipGetLastError();
        grid = cus * per_cu;
        if (grid > 256) grid = 256;
        grid = (grid / 16) * 16;
        fprintf(stderr, "kernel_launch: grid %d (cus %d per_cu %d)\n", grid, cus, per_cu);
    }
    if (grid <= 0) return;
#if ONE_LAUNCH
    if (hipMemsetAsync((char*)d_ws + WS_CTL, 0, CTL_BYTES, stream) != hipSuccess) { fprintf(stderr, "kernel_launch: memset failed\n"); return; }
#endif
    Args a{};
    const float** pp = (const float**)&a.P;
    for (int i = 0; i < 17; ++i) pp[i] = (const float*)d_in[i];
    a.P.out = (float*)d_out; a.P.ws = (unsigned char*)d_ws;
#if ONE_LAUNCH
    a.ph_lo = 0; a.ph_hi = N_PHASES;
    void* args[] = {&a};
    hipError_t e = hipLaunchCooperativeKernel((const void*)fwd_kernel, dim3(grid), dim3(NT), args, LDS_BYTES, stream);
    if (e != hipSuccess) fprintf(stderr, "kernel_launch: cooperative launch failed: %s (grid %d)\n", hipGetErrorString(e), grid);
#else
    for (int ph = 0; ph < N_PHASES; ++ph) { a.ph_lo = ph; a.ph_hi = ph + 1; hipLaunchKernelGGL(fwd_kernel, dim3(grid), dim3(NT), LDS_BYTES, stream, a); }
#endif
}
```

```cpp
#include <hip/hip_runtime.h>
#include <hip/hip_cooperative_groups.h>
#include <cstdio>
#include <cstdint>
namespace cg = cooperative_groups;

#ifndef EXP
#define EXP 0
#endif
#ifndef SKEW_TICKS
#define SKEW_TICKS 0
#endif
#ifndef REV_DOWN
#define REV_DOWN 0
#endif
#ifndef ONE_LAUNCH
#define ONE_LAUNCH 1
#endif

namespace pg8 {
#define PG8_LAS __attribute__((address_space(3)))
typedef unsigned short bf16_t;
typedef short bf16x8 __attribute__((ext_vector_type(8)));
typedef float f32x4 __attribute__((ext_vector_type(4)));
typedef unsigned u32x4 __attribute__((ext_vector_type(4)));
typedef unsigned u32x2 __attribute__((ext_vector_type(2)));
constexpr int BM = 256, BK = 64, HALF = 128, HTB = HALF * BK * 2, STAGE_BYTES = 8 * HTB, NXCD = 8, WGM = 8;

__host__ __device__ __forceinline__ int lds_byte(int r, int c) { const int st = (r >> 4) * 2 + (c >> 5), rr = r & 15, cc = c & 31, ob = rr * 64 + cc * 2; return st * 1024 + (ob ^ (((ob >> 9) & 1) << 5)); }
__host__ __device__ __forceinline__ void stage_rc(int b, int& R, int& C) { const int st = b / 1024, sb = b % 1024, swz = sb ^ (((sb >> 9) & 1) << 5); R = (st >> 1) * 16 + swz / 64; C = (st & 1) * 32 + (swz % 64) / 2; }
__host__ __device__ __forceinline__ int perm32(int rho) { const int n = rho >> 4, i = rho & 15; return 8 * (i >> 2) + 4 * n + (i & 3); }

struct Unit { int pm, pn; };
struct Gemm { const bf16_t* A; const bf16_t* Bt; int M, N, K, lda, perm; };

struct StaticOrder {
    int nM, nN, nwg, G, c, rev;
    __host__ __device__ void init(int M, int N, int G_, int c_, int rev_ = 0) { nM = M / BM; nN = N / BM; nwg = nM * nN; G = G_; c = c_; rev = rev_; }
    __host__ __device__ bool next(int i, Unit& u) const {
        const long L = (long)i * G + c; if (L >= nwg) return false;
        int wgid = (int)L; { const int q = nwg / NXCD, r = nwg % NXCD, xcd = wgid % NXCD, off = wgid / NXCD; wgid = (xcd < r ? xcd * (q + 1) : r * (q + 1) + (xcd - r) * q) + off; }
        const int nig = WGM * nN, gid = wgid / nig, fm = gid * WGM, gsz = (nM - fm) < WGM ? (nM - fm) : WGM;
        u.pm = fm + ((wgid % nig) % gsz); u.pn = (wgid % nig) / gsz; if (rev) u.pm = nM - 1 - u.pm; return true;
    }
    __device__ __forceinline__ void a_ready(const Unit&) const {}
    __device__ __forceinline__ void done(const Unit&) const {}
};

__device__ __forceinline__ float shx(float v, int mask, int lane) { return __int_as_float(__builtin_amdgcn_ds_bpermute((lane ^ mask) << 2, __float_as_int(v))); }
__device__ __forceinline__ void shx_add2(float (&v)[2], int mask, int lane) {
    const int a = (lane ^ mask) << 2; float r[2];
    asm volatile("ds_bpermute_b32 %0, %2, %3\n\tds_bpermute_b32 %1, %2, %4\n\ts_waitcnt lgkmcnt(0)"
        : "=&v"(r[0]), "=&v"(r[1]) : "v"(a), "v"(v[0]), "v"(v[1]));
#pragma unroll
    for (int i = 0; i < 2; ++i) v[i] += r[i];
}
__device__ __forceinline__ void shx_add4(float (&v)[4], int mask, int lane) {
    const int a = (lane ^ mask) << 2; float r[4];
    asm volatile("ds_bpermute_b32 %0, %4, %5\n\tds_bpermute_b32 %1, %4, %6\n\tds_bpermute_b32 %2, %4, %7\n\tds_bpermute_b32 %3, %4, %8\n\ts_waitcnt lgkmcnt(0)"
        : "=&v"(r[0]), "=&v"(r[1]), "=&v"(r[2]), "=&v"(r[3]) : "v"(a), "v"(v[0]), "v"(v[1]), "v"(v[2]), "v"(v[3]));
#pragma unroll
    for (int i = 0; i < 4; ++i) v[i] += r[i];
}
__device__ __forceinline__ void shx_add8(float (&v)[8], int mask, int lane) {
    const int a = (lane ^ mask) << 2; float r[8];
    asm volatile("ds_bpermute_b32 %0, %8, %9\n\tds_bpermute_b32 %1, %8, %10\n\tds_bpermute_b32 %2, %8, %11\n\tds_bpermute_b32 %3, %8, %12\n\tds_bpermute_b32 %4, %8, %13\n\tds_bpermute_b32 %5, %8, %14\n\tds_bpermute_b32 %6, %8, %15\n\tds_bpermute_b32 %7, %8, %16\n\ts_waitcnt lgkmcnt(0)"
        : "=&v"(r[0]), "=&v"(r[1]), "=&v"(r[2]), "=&v"(r[3]), "=&v"(r[4]), "=&v"(r[5]), "=&v"(r[6]), "=&v"(r[7]) : "v"(a), "v"(v[0]), "v"(v[1]), "v"(v[2]), "v"(v[3]), "v"(v[4]), "v"(v[5]), "v"(v[6]), "v"(v[7]));
#pragma unroll
    for (int i = 0; i < 8; ++i) v[i] += r[i];
}
typedef float f32x2_t __attribute__((ext_vector_type(2)));
typedef __bf16 bf16x2_t __attribute__((ext_vector_type(2)));
__device__ __forceinline__ unsigned cvt_pk_native(float lo, float hi) { const f32x2_t f = {lo, hi}; const bf16x2_t b = __builtin_convertvector(f, bf16x2_t); return __builtin_bit_cast(unsigned, b); }
__device__ __forceinline__ unsigned cvt_pk_bf16(float lo, float hi) { unsigned r; asm volatile("v_cvt_pk_bf16_f32 %0, %1, %2" : "=v"(r) : "v"(lo), "v"(hi)); return r; }

__device__ __forceinline__ float fsigmoid(float v) { return __builtin_amdgcn_rcpf(1.0f + __expf(-v)); }
__device__ __forceinline__ float fsilu(float v) { return v * fsigmoid(v); }
__device__ __forceinline__ float row_rstd(const float* ss, int M, int row, int fq, int lane) {
    const float* p = ss + (size_t)(4 * fq) * M + row;
    float s = (p[0] + p[M]) + (p[2 * (size_t)M] + p[3 * (size_t)M]);
    s += shx(s, 16, lane); s += shx(s, 32, lane);
    return rsqrtf(s * (1.0f / 1024.0f) + 1e-6f);
}
template <int MODE> __device__ __forceinline__ float proj_act(float v, float a) {
    if (MODE == 1) return fsilu(v);
    if (MODE == 2) { const float z = v + a; const float ls = fminf(z, 0.f) - __logf(1.0f + __expf(-fabsf(z))); return ls * 0.0625f; }
    if (MODE == 3) { const float sg = fsigmoid(v); return __logf(a + (1.0f - a) * sg); }
    if (MODE == 4) return fsilu(v) * 0.08838834764831845f;
    if (MODE == 5) { const float r = fmaxf(v, 0.f); return r * r; }
    return v;
}
struct EpiAll {
    static constexpr bool AFTER_DRAIN = false;
    int kind, ldc, hgrn, M;
    bf16_t* O;
    const float* ss;
    const float* aux;
    const float* xin;
    float* xout;
    template <int MODE> __device__ __forceinline__ void body_proj(const f32x4 (&acc)[2][2][4][2], const Unit& u, int wr, int wc, int fr, int fq) const {
        const int row0 = u.pm * BM + wr * 64 + fr, col0 = u.pn * BM + wc * 32 + 8 * fq;
        f32x4 av[2][2];
#pragma unroll
        for (int bj = 0; bj < 2; ++bj)
#pragma unroll
            for (int n = 0; n < 2; ++n) av[bj][n] = (MODE == 2 || MODE == 3) ? *(const f32x4*)(aux + (col0 - 1024) + bj * HALF + 4 * n) : (f32x4){0.f, 0.f, 0.f, 0.f};
        float ps[2][4];
#pragma unroll
        for (int ai = 0; ai < 2; ++ai)
#pragma unroll
            for (int m = 0; m < 4; ++m) { const float* p = ss + (size_t)(4 * fq) * M + (row0 + ai * HALF + m * 16); ps[ai][m] = (p[0] + p[M]) + (p[2 * (size_t)M] + p[3 * (size_t)M]); }
        float rs[2][4];
        { float pv[8];
#pragma unroll
          for (int i = 0; i < 8; ++i) pv[i] = ps[i >> 2][i & 3];
          shx_add8(pv, 16, fq * 16 + fr); shx_add8(pv, 32, fq * 16 + fr);
#pragma unroll
          for (int i = 0; i < 8; ++i) rs[i >> 2][i & 3] = rsqrtf(pv[i] * (1.0f / 1024.0f) + 1e-6f); }
#pragma unroll
        for (int ai = 0; ai < 2; ++ai)
#pragma unroll
            for (int m = 0; m < 4; ++m) { const int row = row0 + ai * HALF + m * 16; const float rstd = rs[ai][m]; bf16_t* rowp = O + (size_t)row * ldc + col0;
#pragma unroll
                for (int bj = 0; bj < 2; ++bj) { f32x4 v0 = acc[ai][bj][m][0] * rstd, v1 = acc[ai][bj][m][1] * rstd;
#pragma unroll
                    for (int j = 0; j < 4; ++j) { v0[j] = proj_act<MODE>(v0[j], av[bj][0][j]); v1[j] = proj_act<MODE>(v1[j], av[bj][1][j]); }
                    u32x4 w; w.x = cvt_pk_bf16(v0[0], v0[1]); w.y = cvt_pk_bf16(v0[2], v0[3]); w.z = cvt_pk_bf16(v1[0], v1[1]); w.w = cvt_pk_bf16(v1[2], v1[3]);
                    *(u32x4*)(rowp + bj * HALF) = w; } }
    }
    template <bool F32IN> __device__ __forceinline__ void body_res(const f32x4 (&acc)[2][2][4][2], const Unit& u, int wr, int wc, int fr, int fq) const {
        const int row0 = u.pm * BM + wr * 64 + fr, col0 = u.pn * BM + wc * 32 + 8 * fq; float* ssw = (float*)ss; bf16_t* XO = (bf16_t*)xout;
#pragma unroll
        for (int ai = 0; ai < 2; ++ai) {
            u32x4 xi[4][2];
            if (!F32IN) {
#pragma unroll
                for (int m = 0; m < 4; ++m) { const size_t off = (size_t)(row0 + ai * HALF + m * 16) * 1024 + col0;
#pragma unroll
                    for (int bj = 0; bj < 2; ++bj) xi[m][bj] = *(const u32x4*)(O + off + bj * HALF); } }
            float sv[4];
#pragma unroll
            for (int m = 0; m < 4; ++m) { const int row = row0 + ai * HALF + m * 16; const size_t off = (size_t)row * 1024 + col0; float s = 0.f;
#pragma unroll
                for (int bj = 0; bj < 2; ++bj) { f32x4 o0, o1;
                    if (F32IN) { o0 = *(const f32x4*)(xin + off + bj * HALF); o1 = *(const f32x4*)(xin + off + bj * HALF + 4); }
                    else { const u32x4 xw = xi[m][bj]; o0 = (f32x4){__uint_as_float(xw.x << 16), __uint_as_float(xw.x & 0xffff0000u), __uint_as_float(xw.y << 16), __uint_as_float(xw.y & 0xffff0000u)};
                        o1 = (f32x4){__uint_as_float(xw.z << 16), __uint_as_float(xw.z & 0xffff0000u), __uint_as_float(xw.w << 16), __uint_as_float(xw.w & 0xffff0000u)}; }
                    o0 = o0 + acc[ai][bj][m][0]; o1 = o1 + acc[ai][bj][m][1];
                    u32x4 w; w.x = cvt_pk_bf16(o0[0], o0[1]); w.y = cvt_pk_bf16(o0[2], o0[3]); w.z = cvt_pk_bf16(o1[0], o1[1]); w.w = cvt_pk_bf16(o1[2], o1[3]);
                    *(u32x4*)(XO + off + bj * HALF) = w;
#pragma unroll
                    for (int q = 0; q < 4; ++q) { const unsigned wq = q == 0 ? w.x : (q == 1 ? w.y : (q == 2 ? w.z : w.w)); const float r0 = __uint_as_float(wq << 16), r1 = __uint_as_float(wq & 0xffff0000u); s += r0 * r0 + r1 * r1; } }
                sv[m] = s; }
            shx_add4(sv, 16, fq * 16 + fr); shx_add4(sv, 32, fq * 16 + fr);
            if (fq == 0) {
#pragma unroll
                for (int m = 0; m < 4; ++m) ssw[(size_t)(u.pn * 4 + wc) * M + row0 + ai * HALF + m * 16] = sv[m]; }
        }
    }
    __device__ __forceinline__ void body_kv(const f32x4 (&acc)[2][2][4][2], const Unit& u, int wr, int wc, int fr, int fq) const {
        const int row0 = u.pm * BM + wr * 64 + fr, layer = u.pn >> 2, cl0 = (u.pn & 3) * BM + wc * 32 + 4 * fq; bf16_t* VMT = (bf16_t*)xout;
#pragma unroll
        for (int ai = 0; ai < 2; ++ai)
#pragma unroll
            for (int m = 0; m < 4; ++m) { const int row = row0 + ai * HALF + m * 16; const float rstd = rsqrtf(ss[row] * (1.0f / 1024.0f) + 1e-6f);
#pragma unroll
                for (int bj = 0; bj < 2; ++bj)
#pragma unroll
                    for (int n = 0; n < 2; ++n) { const f32x4 o = acc[ai][bj][m][n] * rstd; const int cl = cl0 + bj * HALF + n * 16;
                        if (cl < 512) { u32x2 w; w.x = cvt_pk_bf16(o[0], o[1]); w.y = cvt_pk_bf16(o[2], o[3]); *(u32x2*)(O + ((size_t)layer * 1024 + row) * 512 + cl) = w; }
                        else { const unsigned lo = cvt_pk_bf16(o[0], o[1]), hi = cvt_pk_bf16(o[2], o[3]); bf16_t* d = VMT + ((size_t)(layer * 4 + (row >> 8)) * 512 + (cl - 512)) * 256 + (row & 255);
                            d[0] = (bf16_t)(lo & 0xffff); d[256] = (bf16_t)(lo >> 16); d[512] = (bf16_t)(hi & 0xffff); d[768] = (bf16_t)(hi >> 16); } } }
    }
    __device__ __forceinline__ void operator()(const f32x4 (&acc)[2][2][4][2], const Unit& u, int wr, int wc, int fr, int fq) const {
        if (kind == 0) {
            int mode;
            if (!hgrn) mode = (u.pn >= 4 && u.pn < 6) ? 2 : ((u.pn >= 6 && u.pn < 10) ? 1 : 0);
            else mode = u.pn < 4 ? 4 : (u.pn < 8 ? 3 : (u.pn < 12 ? 1 : 0));
            if (mode == 0) body_proj<0>(acc, u, wr, wc, fr, fq); else if (mode == 1) body_proj<1>(acc, u, wr, wc, fr, fq); else if (mode == 2) body_proj<2>(acc, u, wr, wc, fr, fq);
            else if (mode == 3) body_proj<3>(acc, u, wr, wc, fr, fq); else body_proj<4>(acc, u, wr, wc, fr, fq);
        } else if (kind == 1) body_proj<5>(acc, u, wr, wc, fr, fq);
        else if (kind == 2) { if (xin) body_res<true>(acc, u, wr, wc, fr, fq); else body_res<false>(acc, u, wr, wc, fr, fq); }
        else body_kv(acc, u, wr, wc, fr, fq);
    }
};

template <class Epi, class Sched, bool ALIGN_EPI = false, bool SP2 = false>
__device__ __forceinline__ void gemm_phase(PG8_LAS unsigned char* lds, const Gemm g, const Sched& S, const Epi& E, const int tid) {
    const int wid = __builtin_amdgcn_readfirstlane(tid >> 6), lane = tid & 63, wr = wid >> 2, wc = wid & 3, fr = lane & 15, fq = lane >> 4;
    const int K = g.K, nt = K / BK;
    unsigned voffA[2], voffB[2];
#pragma unroll
    for (int i = 0; i < 2; ++i) { int R, C; stage_rc(tid * 16 + i * 8192, R, C); const int Rb = g.perm ? ((R & ~31) + perm32(R & 31)) : R;
        voffA[i] = (unsigned)(R * g.lda + C) * 2u; voffB[i] = (unsigned)(Rb * K + C) * 2u; }
    const size_t kstep = (size_t)(BK * 2);
    const size_t hstepA = (size_t)HALF * g.lda * 2, hstepB = (size_t)HALF * K * 2;
    const size_t tstepA = 2 * hstepA, tstepB = 2 * hstepB;
    const unsigned ldsw = (unsigned)wid * 1024u;
    const int aoff = lds_byte(wr * 64 + fr, fq * 8), boff = lds_byte(wc * 32 + fr, fq * 8);
#define PG8_SA(b, h) (((b) * 2 + (h)) * HTB)
#define PG8_SB(b, h) ((4 + (b) * 2 + (h)) * HTB)
#define PG8_STAGE(bufoff, gbase, voff) do { _Pragma("unroll") for (int _i = 0; _i < 2; ++_i) \
        __builtin_amdgcn_global_load_lds((const unsigned*)((const char*)(gbase) + (voff)[_i]), (PG8_LAS unsigned*)(lds + (bufoff) + ldsw + _i * 8192), 16, 0, 0); } while (0)
#define PG8_LDA(dst, b, h) do { _Pragma("unroll") for (int m = 0; m < 4; ++m) _Pragma("unroll") for (int k = 0; k < 2; ++k) dst[m][k] = *(const PG8_LAS bf16x8*)(lds + PG8_SA(b, h) + aoff + m * 2048 + k * 1024); } while (0)
#define PG8_LDB(dst, b, h) do { _Pragma("unroll") for (int n = 0; n < 2; ++n) _Pragma("unroll") for (int k = 0; k < 2; ++k) dst[n][k] = *(const PG8_LAS bf16x8*)(lds + PG8_SB(b, h) + boff + n * 2048 + k * 1024); } while (0)
#define PG8_MMA(ai, bj, At, Bt) do { __builtin_amdgcn_s_setprio(1); _Pragma("unroll") for (int m = 0; m < 4; ++m) _Pragma("unroll") for (int n = 0; n < 2; ++n) _Pragma("unroll") for (int k = 0; k < 2; ++k) \
        acc[ai][bj][m][n] = __builtin_amdgcn_mfma_f32_16x16x32_bf16(Bt[n][k], At[m][k], acc[ai][bj][m][n], 0, 0, 0); __builtin_amdgcn_s_setprio(0); } while (0)
#define PG8_WAIT_V(n) asm volatile("s_waitcnt vmcnt(" #n ")" ::: "memory")
#define PG8_WAIT_L(n) asm volatile("s_waitcnt lgkmcnt(" #n ")" ::: "memory")
#define PG8_BAR __builtin_amdgcn_s_barrier()
#define PG8_SCHED __builtin_amdgcn_sched_barrier(0)
    Unit cur, nxt; int ui = 0;
    if (!S.next(0, cur)) return;
    f32x4 acc[2][2][4][2];
#pragma unroll
    for (int a = 0; a < 2; ++a)
#pragma unroll
        for (int b = 0; b < 2; ++b)
#pragma unroll
            for (int m = 0; m < 4; ++m)
#pragma unroll
                for (int n = 0; n < 2; ++n) acc[a][b][m][n] = (f32x4){0.f, 0.f, 0.f, 0.f};
    bf16x8 At[4][2], B0[2][2], B1[2][2];
    const char* cA = (const char*)g.A + (size_t)cur.pm * tstepA; const char* cB = (const char*)g.Bt + (size_t)cur.pn * tstepB;
    S.a_ready(cur);
    if constexpr (SP2) {
        PG8_STAGE(PG8_SB(0, 0), cB, voffB); PG8_STAGE(PG8_SB(0, 1), cB + hstepB, voffB); PG8_STAGE(PG8_SA(0, 0), cA, voffA); PG8_STAGE(PG8_SA(0, 1), cA + hstepA, voffA);
        if (wr == 1) PG8_BAR;
        PG8_WAIT_V(2); PG8_BAR;
        PG8_STAGE(PG8_SB(1, 0), cB + kstep, voffB); PG8_STAGE(PG8_SA(1, 0), cA + kstep, voffA); PG8_STAGE(PG8_SB(1, 1), cB + hstepB + kstep, voffB);
        PG8_WAIT_V(6); PG8_BAR;
    } else {
        PG8_STAGE(PG8_SB(0, 0), cB, voffB); PG8_STAGE(PG8_SA(0, 0), cA, voffA); PG8_STAGE(PG8_SB(0, 1), cB + hstepB, voffB); PG8_STAGE(PG8_SA(0, 1), cA + hstepA, voffA);
        if (wr == 1) PG8_BAR;
        PG8_WAIT_V(4); PG8_BAR;
        PG8_STAGE(PG8_SB(1, 0), cB + kstep, voffB); PG8_STAGE(PG8_SA(1, 0), cA + kstep, voffA); PG8_STAGE(PG8_SB(1, 1), cB + hstepB + kstep, voffB);
        PG8_WAIT_V(6); PG8_BAR;
    }
    for (;;) {
        const bool has_next = S.next(ui + 1, nxt);
        const char* nA = has_next ? (const char*)g.A + (size_t)nxt.pm * tstepA : cA; const char* nB = has_next ? (const char*)g.Bt + (size_t)nxt.pn * tstepB : cB;
        for (int t = 0; t < nt; t += 2) {
            const bool last = (t == nt - 2);
            const char* a1 = cA + (size_t)(t + 1) * kstep;
            const char* a2 = last ? nA : cA + (size_t)(t + 2) * kstep; const char* b2 = last ? nB : cB + (size_t)(t + 2) * kstep;
            const char* a3 = a2 + kstep; const char* b3 = b2 + kstep;
            if (last && has_next) S.a_ready(nxt);
            if constexpr (SP2) {
            PG8_LDB(B0, 0, 0); PG8_LDB(B1, 0, 1); PG8_SCHED; PG8_LDA(At, 0, 0); PG8_STAGE(PG8_SA(1, 1), a1 + hstepA, voffA);
            PG8_WAIT_V(8); PG8_WAIT_L(0); PG8_BAR; PG8_MMA(0, 0, At, B0); PG8_MMA(0, 1, At, B1); PG8_BAR; PG8_SCHED;
            PG8_LDA(At, 0, 1); PG8_STAGE(PG8_SB(0, 0), b2, voffB); PG8_STAGE(PG8_SB(0, 1), b2 + hstepB, voffB); PG8_STAGE(PG8_SA(0, 0), a2, voffA);
            PG8_WAIT_V(8); PG8_WAIT_L(0); PG8_BAR; PG8_MMA(1, 0, At, B0); PG8_MMA(1, 1, At, B1); PG8_BAR; PG8_SCHED;
            PG8_LDB(B0, 1, 0); PG8_LDB(B1, 1, 1); PG8_SCHED; PG8_LDA(At, 1, 0); PG8_STAGE(PG8_SA(0, 1), a2 + hstepA, voffA);
            PG8_WAIT_V(8); PG8_WAIT_L(0); PG8_BAR; PG8_MMA(0, 0, At, B0); PG8_MMA(0, 1, At, B1); PG8_BAR; PG8_SCHED;
            PG8_LDA(At, 1, 1); PG8_STAGE(PG8_SB(1, 0), b3, voffB); PG8_STAGE(PG8_SB(1, 1), b3 + hstepB, voffB); PG8_STAGE(PG8_SA(1, 0), a3, voffA);
            PG8_WAIT_V(8); PG8_WAIT_L(0); PG8_BAR; PG8_MMA(1, 0, At, B0); PG8_MMA(1, 1, At, B1); PG8_BAR; PG8_SCHED;
            } else {
            PG8_LDB(B0, 0, 0); PG8_SCHED; PG8_LDA(At, 0, 0); PG8_STAGE(PG8_SA(1, 1), a1 + hstepA, voffA);
            PG8_WAIT_L(8); PG8_BAR; PG8_WAIT_L(0); PG8_MMA(0, 0, At, B0); PG8_BAR; PG8_SCHED;
            PG8_LDB(B1, 0, 1); PG8_STAGE(PG8_SB(0, 0), b2, voffB);
            PG8_BAR; PG8_WAIT_L(0); PG8_MMA(0, 1, At, B1); PG8_BAR;
            PG8_LDA(At, 0, 1); PG8_STAGE(PG8_SA(0, 0), a2, voffA);
            PG8_BAR; PG8_WAIT_L(0); PG8_MMA(1, 0, At, B0); PG8_BAR; PG8_SCHED;
            PG8_STAGE(PG8_SB(0, 1), b2 + hstepB, voffB);
            PG8_WAIT_V(6); PG8_BAR; PG8_MMA(1, 1, At, B1); PG8_BAR;
            PG8_LDB(B0, 1, 0); PG8_SCHED; PG8_LDA(At, 1, 0); PG8_STAGE(PG8_SA(0, 1), a2 + hstepA, voffA);
            PG8_WAIT_L(8); PG8_BAR; PG8_WAIT_L(0); PG8_MMA(0, 0, At, B0); PG8_BAR; PG8_SCHED;
            PG8_LDB(B1, 1, 1); PG8_STAGE(PG8_SB(1, 0), b3, voffB);
            PG8_BAR; PG8_WAIT_L(0); PG8_MMA(0, 1, At, B1); PG8_BAR;
            PG8_LDA(At, 1, 1); PG8_STAGE(PG8_SA(1, 0), a3, voffA);
            PG8_BAR; PG8_WAIT_L(0); PG8_MMA(1, 0, At, B0); PG8_BAR; PG8_SCHED;
            PG8_STAGE(PG8_SB(1, 1), b3 + hstepB, voffB);
            PG8_WAIT_V(6); PG8_BAR; PG8_MMA(1, 1, At, B1); PG8_BAR;
            }
        }
        if constexpr (ALIGN_EPI) { if (wr == 0) PG8_BAR; }
        if constexpr (!Epi::AFTER_DRAIN) { E(acc, cur, wr, wc, fr, fq); S.done(cur); }
        if (!has_next) break;
#pragma unroll
        for (int a = 0; a < 2; ++a)
#pragma unroll
            for (int b = 0; b < 2; ++b)
#pragma unroll
                for (int m = 0; m < 4; ++m)
#pragma unroll
                    for (int n = 0; n < 2; ++n) acc[a][b][m][n] = (f32x4){0.f, 0.f, 0.f, 0.f};
        cur = nxt; cA = nA; cB = nB; ++ui;
        if constexpr (ALIGN_EPI) { if (wr == 1) PG8_BAR; }
    }
    PG8_WAIT_V(0);
    if constexpr (!ALIGN_EPI) { if (wr == 0) PG8_BAR; }
    PG8_BAR;
    if constexpr (Epi::AFTER_DRAIN) { E.fused(acc, cur, wr, wc, fr, fq, lds, wid, lane); S.done(cur); }
#undef PG8_SA
#undef PG8_SB
#undef PG8_STAGE
#undef PG8_LDA
#undef PG8_LDB
#undef PG8_MMA
#undef PG8_WAIT_V
#undef PG8_WAIT_L
#undef PG8_BAR
#undef PG8_SCHED
}
}

constexpr int NWAVES = 8, NT = 512;
constexpr int D = 1024, BATCH = 4, T = 8192, M = BATCH * T, DEPTH = 4, MEM = 256, MROWS = BATCH * MEM;
constexpr int DK = 128, CH = 64, NCH = T / CH;
constexpr int GLA_N = 4096, HGRN_N = 4608, FF = 4096, KOUT = 1536;
constexpr float EPS = 1e-6f;
constexpr size_t MiB = 1u << 20;
constexpr size_t WS_SS = 0;
constexpr size_t WS_DEC = 2 * MiB;
constexpr size_t WS_MEMB = 4 * MiB;
constexpr size_t WS_SSM = 6 * MiB;
constexpr size_t WS_LB = 6 * MiB + 65536;
constexpr size_t WS_KM = 8 * MiB;
constexpr size_t WS_VMT = 12 * MiB;
constexpr size_t WS_WKV = 16 * MiB;
constexpr size_t WS_WT = 24 * MiB, WT_BUF = 30 * MiB;
constexpr size_t WT_IN = 0, WT_OUT = 10 * MiB, WT_UP = 14 * MiB, WT_DOWN = 22 * MiB;
constexpr size_t WS_PROJ = 84 * MiB;
constexpr size_t WS_XB = 372 * MiB;
constexpr size_t WS_END = 500 * MiB;
constexpr int LDS_BYTES = 147456;

#define LAS __attribute__((address_space(3)))
typedef unsigned short bf16;
typedef float f32x4 __attribute__((ext_vector_type(4)));
typedef short bf16x8 __attribute__((ext_vector_type(8)));
typedef short bf16x4 __attribute__((ext_vector_type(4)));
typedef unsigned u32x4 __attribute__((ext_vector_type(4)));
typedef unsigned u32x2 __attribute__((ext_vector_type(2)));
__device__ __forceinline__ float bf2f(bf16 b) { return __uint_as_float(((unsigned)b) << 16); }
__device__ __forceinline__ unsigned f2bf(float f) { unsigned u = __float_as_uint(f); return (u + 0x7fffu + ((u >> 16) & 1u)) >> 16; }
__device__ __forceinline__ unsigned pk2(float lo, float hi) { return pg8::cvt_pk_bf16(lo, hi); }
__device__ __forceinline__ float wave_sum(float v, int lane) {
#pragma unroll
    for (int o = 1; o < 64; o <<= 1) v += pg8::shx(v, o, lane);
    return v;
}
#define MFMA16(a, b, c) __builtin_amdgcn_mfma_f32_16x16x32_bf16((a), (b), (c), 0, 0, 0)

constexpr size_t WS_CTL = 7 * MiB, CTL_BYTES = 16384;
constexpr int LDS_BARST = LDS_BYTES - 64;
#define XB_TMO      128
#define XB_XCNT(j)  (256  + 64 * (j))
#define XB_XSUB(j)  (1280 + 64 * (j))
#define XB_XGEN(j)  (2304 + 64 * (j))
#define XB_TOP      3328
#define XB_TOPGEN   3392
#define XCD_BAR_WORDS 3456
#define XB_SPIN_CAP (1u << 18)

__device__ __forceinline__ unsigned xb_ld(unsigned* p)              { return __hip_atomic_load(p, __ATOMIC_RELAXED, __HIP_MEMORY_SCOPE_AGENT); }
__device__ __forceinline__ unsigned xb_add(unsigned* p, unsigned v) { return __hip_atomic_fetch_add(p, v, __ATOMIC_RELAXED, __HIP_MEMORY_SCOPE_AGENT); }
__device__ __forceinline__ unsigned xb_xcc_id() { return (unsigned)__builtin_amdgcn_s_getreg((3 << 11) | 20) & 0xFu; }
#define XB_SPIN(cond, bar) do { unsigned _sp = 0; while (cond) { __builtin_amdgcn_s_sleep(1); \
    if ((++_sp & 255u) == 0u) { if (xb_ld(&(bar)[XB_TMO])) break; if (_sp > XB_SPIN_CAP) { atomicAdd(&(bar)[XB_TMO], 1u); break; } } } } while (0)

struct XcdBarrier {
    unsigned* bar; unsigned x;
    volatile LAS unsigned* st;
};

__device__ __forceinline__ XcdBarrier xcd_barrier_post(unsigned* bar, volatile LAS unsigned* st, int tid) {
    XcdBarrier b; b.bar = bar; b.x = xb_xcc_id(); b.st = st;
    if (tid == 0) (void)xb_add(&bar[XB_XCNT(b.x)], 1u);
    return b;
}
__device__ __forceinline__ void xcd_barrier_complete(unsigned* bar, unsigned x, unsigned& nloc, unsigned& nx) {
    const unsigned G = gridDim.x * gridDim.y * gridDim.z;
    unsigned sum, cnt, mine, sp = 0u;
    for (;;) {
        sum = 0u; cnt = 0u; mine = 0u;
#pragma unroll
        for (unsigned j = 0; j < 16; ++j) { const unsigned c = xb_ld(&bar[XB_XCNT(j)]); sum += c; cnt += (c > 0u) ? 1u : 0u; mine = (j == x) ? c : mine; }
        if (sum == G) break;
        __builtin_amdgcn_s_sleep(1);
        if ((++sp & 255u) == 0u) { if (xb_ld(&bar[XB_TMO])) break; if (sp > XB_SPIN_CAP) { atomicAdd(&bar[XB_TMO], 1u); break; } }
    }
    nloc = mine > 0u ? mine : 1u; nx = cnt > 0u ? cnt : 1u;
}

__device__ __forceinline__ void xcd_barrier(const XcdBarrier& b, int tid) {
    asm volatile("s_waitcnt vmcnt(0)" ::: "memory");
    __syncthreads();
    if (tid == 0) {
        unsigned* bar = b.bar;
        __builtin_amdgcn_s_waitcnt(0);
        unsigned nloc = b.st[0], nx = b.st[1];
        if (nloc == 0u) { xcd_barrier_complete(bar, b.x, nloc, nx); b.st[0] = nloc; b.st[1] = nx; }
        const unsigned old = xb_add(&bar[XB_XSUB(b.x)], 1u);
        const unsigned gen = old / nloc;
        if (old + 1u == (gen + 1u) * nloc) {
            __builtin_amdgcn_fence(__ATOMIC_RELEASE, "agent");
            asm volatile("s_waitcnt vmcnt(0)" ::: "memory");
            const unsigned og = xb_add(&bar[XB_TOP], 1u);
            const unsigned tg = og / nx;
            if (og + 1u == (tg + 1u) * nx) xb_add(&bar[XB_TOPGEN], 1u);
            else XB_SPIN(xb_ld(&bar[XB_TOPGEN]) == tg, bar);
            __builtin_amdgcn_fence(__ATOMIC_ACQUIRE, "agent");
            xb_add(&bar[XB_XGEN(b.x)], 1u);
            asm volatile("s_waitcnt vmcnt(0)" ::: "memory");
        } else {
            XB_SPIN(xb_ld(&bar[XB_XGEN(b.x)]) == gen, bar);
            __builtin_amdgcn_fence(__ATOMIC_ACQUIRE, "agent");
            asm volatile("s_waitcnt vmcnt(0)" ::: "memory");
        }
    }
    __syncthreads();
}

__device__ __forceinline__ void transpose_item(const float* W, int ldw, int K, int sc, bf16* WT, int dr, const float* gain, int gmask, int glimit, float scale, LAS float* scr, int item, int nblk, int lane) {
    const int kb = item / nblk, nb = item % nblk, k0 = 64 * kb, n0 = 32 * nb;
#pragma unroll 8
    for (int i = 0; i < 32; ++i) { const int kk = 2 * i + (lane >> 5); const int k = k0 + kk; float g = scale; if (gain && k < glimit) g *= gain[k & gmask];
        scr[kk * 33 + (lane & 31)] = W[(size_t)k * ldw + sc + n0 + (lane & 31)] * g; }
    asm volatile("s_waitcnt lgkmcnt(0)" ::: "memory");
    const int c = lane & 7;
#pragma unroll
    for (int j = 0; j < 4; ++j) { const int n = (lane >> 3) + 8 * j; const LAS float* s = scr + (8 * c) * 33 + n;
        u32x4 o; o.x = pk2(s[0 * 33], s[1 * 33]); o.y = pk2(s[2 * 33], s[3 * 33]); o.z = pk2(s[4 * 33], s[5 * 33]); o.w = pk2(s[6 * 33], s[7 * 33]);
        *(u32x4*)(WT + (size_t)(dr + n0 + n) * K + k0 + 8 * c) = o; }
    asm volatile("s_waitcnt lgkmcnt(0)" ::: "memory");
}
struct Ptrs {
    const float *x, *mem, *norm_mix, *norm_mem, *w_kv, *w_out, *norm_mlp, *w_up, *w_down, *gla_w_in, *gla_w_gate2, *gla_b_gate, *gla_out_gain, *hgrn_w_in, *hgrn_lb, *hgrn_out_gain, *final_norm;
    float* out; unsigned char* ws;
};
#define SEG(Wp, ldw, K, sc, ncols, WTp, dr, gain, gmask, glimit, scale) { const int nblk_ = (ncols) / 32, nit_ = ((K) / 64) * nblk_; \
    if (r < nit_) { transpose_item(Wp, ldw, K, sc, WTp, dr, gain, gmask, glimit, scale, scr, r, nblk_, lane); continue; } r -= nit_; }
template <class PT> __device__ __forceinline__ void convert_layer(PT Pp, int L, LAS unsigned char* lds, int gw, int ngw, int wave, int lane) {
    LAS float* scr = (LAS float*)(lds + wave * 16384);
    unsigned char* wb = Pp->ws + WS_WT + (size_t)(L & 1) * WT_BUF;
    bf16* Win = (bf16*)(wb + WT_IN); bf16* Wout = (bf16*)(wb + WT_OUT); bf16* Wup = (bf16*)(wb + WT_UP); bf16* Wdn = (bf16*)(wb + WT_DOWN);
    const int j = L >> 1; const bool hg = (L & 1);
    const float* gmix = Pp->norm_mix + (size_t)L * D; const float* gmlp = Pp->norm_mlp + (size_t)L * D;
    const float* wo = Pp->w_out + (size_t)L * KOUT * D; const float* wu = Pp->w_up + (size_t)L * D * FF; const float* wd = Pp->w_down + (size_t)L * FF * D;
    const float QS = 0.08838834764831845f;
    if (!hg) {
        const float* wi = Pp->gla_w_in + (size_t)j * D * 3600; const float* og = Pp->gla_out_gain + (size_t)j * 256;
        const int total = 16 * (16 + 16 + 32 + 32 + 16) + 24 * 32 + 16 * 128 + 64 * 32 + 128;
        for (int it = gw; it < total; it += ngw) { int r = it;
            SEG(wi, 3600, D, 0, 512, Win, 0, gmix, 1023, D, QS)
            SEG(wi, 3600, D, 512, 512, Win, 512, gmix, 1023, D, 1.f)
            SEG(wi, 3600, D, 1024, 1024, Win, 2560, gmix, 1023, D, 1.f)
            SEG(wi, 3600, D, 2064, 1024, Win, 1536, gmix, 1023, D, 1.f)
            SEG(wi, 3600, D, 3088, 512, Win, 3584, gmix, 1023, D, QS)
            SEG(wo, D, KOUT, 0, 1024, Wout, 0, og, 255, 1024, 1.f)
            SEG(wu, FF, D, 0, 4096, Wup, 0, gmlp, 1023, D, 1.f)
            SEG(wd, D, FF, 0, 1024, Wdn, 0, (const float*)nullptr, 0, 0, 1.f)
            { const int kb = r >> 3, cb = r & 7, k = kb * 64 + lane; const float* g2 = Pp->gla_w_gate2 + (size_t)j * 16 * 512 + cb * 64;
              const f32x4* wr4 = (const f32x4*)(wi + (size_t)k * 3600 + 2048); const f32x4 w0 = wr4[0], w1 = wr4[1], w2 = wr4[2], w3 = wr4[3]; const float gk = gmix[k];
              for (int c = 0; c < 64; ++c) { float s = 0.f;
#pragma unroll
                  for (int q = 0; q < 4; ++q) { s += w0[q] * g2[q * 512 + c]; s += w1[q] * g2[(4 + q) * 512 + c]; s += w2[q] * g2[(8 + q) * 512 + c]; s += w3[q] * g2[(12 + q) * 512 + c]; }
                  Win[(size_t)(1024 + cb * 64 + c) * D + k] = (bf16)f2bf(s * gk); } }
        }
    } else {
        const float* wi = Pp->hgrn_w_in + (size_t)j * D * 4608; const float* og = Pp->hgrn_out_gain + (size_t)j * 128;
        const int total = 16 * (32 + 32 + 32 + 32 + 16) + 24 * 32 + 16 * 128 + 64 * 32;
        for (int it = gw; it < total; it += ngw) { int r = it;
            SEG(wi, 4608, D, 0, 1024, Win, 0, gmix, 1023, D, 1.f)
            SEG(wi, 4608, D, 1024, 1024, Win, 1024, gmix, 1023, D, 1.f)
            SEG(wi, 4608, D, 2048, 1024, Win, 3072, gmix, 1023, D, 1.f)
            SEG(wi, 4608, D, 3072, 1024, Win, 2048, gmix, 1023, D, 1.f)
            SEG(wi, 4608, D, 4096, 512, Win, 4096, gmix, 1023, D, QS)
            SEG(wo, D, KOUT, 0, 1024, Wout, 0, og, 127, 1024, 1.f)
            SEG(wu, FF, D, 0, 4096, Wup, 0, gmlp, 1023, D, 1.f)
            { const int nblk_ = 32; transpose_item(wd, D, FF, 0, Wdn, 0, (const float*)nullptr, 0, 0, 1.f, scr, r, nblk_, lane); }
        }
    }
}
template <class PT> __device__ __forceinline__ void prologue(PT Pp, LAS unsigned char* lds, int gw, int ngw, int wave, int lane) {
    convert_layer(Pp, 0, lds, gw, ngw, wave, lane);
    { LAS float* scr = (LAS float*)(lds + wave * 16384); bf16* Wkv = (bf16*)(Pp->ws + WS_WKV);
      const int per = 16 * 32, total = 4 * per;
      for (int it = gw; it < total; it += ngw) { const int L = it / per, r = it % per;
          transpose_item(Pp->w_kv + (size_t)L * D * 1024, 1024, D, 0, Wkv + (size_t)L * 1024 * D, 0, Pp->norm_mem + (size_t)L * D, 1023, D, 1.f, scr, r, 32, lane); } }
    { float* LB = (float*)(Pp->ws + WS_LB);
      for (int c = gw * 64 + lane; c < 1024; c += ngw * 64) { const float v0 = Pp->hgrn_lb[c], v1 = Pp->hgrn_lb[1024 + c], v2 = Pp->hgrn_lb[2048 + c], v3 = Pp->hgrn_lb[3072 + c];
          const float mx = fmaxf(fmaxf(v0, v1), fmaxf(v2, v3)); const float e0 = expf(v0 - mx), e1 = expf(v1 - mx), e2 = expf(v2 - mx), e3 = expf(v3 - mx); const float inv = 1.0f / (e0 + e1 + e2 + e3);
          LB[c] = 0.f; LB[1024 + c] = e1 * inv; LB[2048 + c] = (e1 + e2) * inv; LB[3072 + c] = (e1 + e2 + e3) * inv; } }
    bf16* XB = (bf16*)Pp->out; float* SS = (float*)(Pp->ws + WS_SS);     bf16* MB = (bf16*)(Pp->ws + WS_MEMB); float* SSM = (float*)(Pp->ws + WS_SSM);
    for (int m = gw; m < M + MROWS; m += 2 * ngw) {
        const int m1 = (m + ngw < M + MROWS) ? m + ngw : m; const bool two = (m1 != m);
        const bool ism0 = m >= M, ism1 = m1 >= M; const int row0 = ism0 ? m - M : m, row1 = ism1 ? m1 - M : m1;
        const f32x4* xr0 = (const f32x4*)((ism0 ? Pp->mem : Pp->x) + (size_t)row0 * D) + lane; const f32x4* xr1 = (const f32x4*)((ism1 ? Pp->mem : Pp->x) + (size_t)row1 * D) + lane;
        f32x4 va[4], vb[4];
#pragma unroll
        for (int j = 0; j < 4; ++j) { va[j] = xr0[64 * j]; vb[j] = xr1[64 * j]; }
        unsigned long long* o80 = (unsigned long long*)((ism0 ? MB : XB) + (size_t)row0 * D) + lane; unsigned long long* o81 = (unsigned long long*)((ism1 ? MB : XB) + (size_t)row1 * D) + lane;
        float sv[2] = {0.f, 0.f};
#pragma unroll
        for (int j = 0; j < 4; ++j) { const f32x4 v = va[j]; sv[0] += (v.x * v.x + v.y * v.y) + (v.z * v.z + v.w * v.w); o80[64 * j] = (unsigned long long)pk2(v.x, v.y) | ((unsigned long long)pk2(v.z, v.w) << 32); }
        if (two) {
#pragma unroll
            for (int j = 0; j < 4; ++j) { const f32x4 v = vb[j]; sv[1] += (v.x * v.x + v.y * v.y) + (v.z * v.z + v.w * v.w); o81[64 * j] = (unsigned long long)pk2(v.x, v.y) | ((unsigned long long)pk2(v.z, v.w) << 32); } }
#pragma unroll
        for (int o = 1; o < 64; o <<= 1) pg8::shx_add2(sv, o, lane);
        if (ism0) { if (lane == 0) SSM[row0] = sv[0]; } else if (lane < 16) SS[(size_t)lane * M + row0] = lane == 0 ? sv[0] : 0.f;
        if (two) { if (ism1) { if (lane == 0) SSM[row1] = sv[1]; } else if (lane < 16) SS[(size_t)lane * M + row1] = lane == 0 ? sv[1] : 0.f; }
    }
}
constexpr int KT_STR = 144;
constexpr int QS_STR = 272;
constexpr int VS_STR = 528;
constexpr int L_TOT = 0;
constexpr int L_LA = 2048;
constexpr int L_QS = L_LA + 64 * QS_STR;
constexpr int L_KS = L_QS + 64 * QS_STR;
constexpr int L_VS = L_KS + 64 * QS_STR;
constexpr int L_VT = L_VS + 64 * VS_STR;
constexpr int L_KT = L_VT + 256 * KT_STR;
constexpr int L_AT = L_KT;
constexpr int L_RED = L_KT + 128 * KT_STR;
static_assert(L_RED + 2048 <= LDS_BYTES - 64, "mixer LDS map");

__device__ __forceinline__ void ds_read16_s272(const LAS unsigned char* p, unsigned (&r)[16]) {
    const unsigned a = (unsigned)(__SIZE_TYPE__)p;
    asm volatile("ds_read_u16 %0, %16 offset:0\n\tds_read_u16 %1, %16 offset:272\n\tds_read_u16 %2, %16 offset:544\n\tds_read_u16 %3, %16 offset:816\n\tds_read_u16 %4, %16 offset:1088\n\tds_read_u16 %5, %16 offset:1360\n\tds_read_u16 %6, %16 offset:1632\n\tds_read_u16 %7, %16 offset:1904\n\tds_read_u16 %8, %16 offset:2176\n\tds_read_u16 %9, %16 offset:2448\n\tds_read_u16 %10, %16 offset:2720\n\tds_read_u16 %11, %16 offset:2992\n\tds_read_u16 %12, %16 offset:3264\n\tds_read_u16 %13, %16 offset:3536\n\tds_read_u16 %14, %16 offset:3808\n\tds_read_u16 %15, %16 offset:4080\n\ts_waitcnt lgkmcnt(0)"
        : "=&v"(r[0]), "=&v"(r[1]), "=&v"(r[2]), "=&v"(r[3]), "=&v"(r[4]), "=&v"(r[5]), "=&v"(r[6]), "=&v"(r[7]), "=&v"(r[8]), "=&v"(r[9]), "=&v"(r[10]), "=&v"(r[11]), "=&v"(r[12]), "=&v"(r[13]), "=&v"(r[14]), "=&v"(r[15]) : "v"(a) : "memory");
}
__device__ __forceinline__ void ds_read16_s528(const LAS unsigned char* p, unsigned (&r)[16]) {
    const unsigned a = (unsigned)(__SIZE_TYPE__)p;
    asm volatile("ds_read_u16 %0, %16 offset:0\n\tds_read_u16 %1, %16 offset:528\n\tds_read_u16 %2, %16 offset:1056\n\tds_read_u16 %3, %16 offset:1584\n\tds_read_u16 %4, %16 offset:2112\n\tds_read_u16 %5, %16 offset:2640\n\tds_read_u16 %6, %16 offset:3168\n\tds_read_u16 %7, %16 offset:3696\n\tds_read_u16 %8, %16 offset:4224\n\tds_read_u16 %9, %16 offset:4752\n\tds_read_u16 %10, %16 offset:5280\n\tds_read_u16 %11, %16 offset:5808\n\tds_read_u16 %12, %16 offset:6336\n\tds_read_u16 %13, %16 offset:6864\n\tds_read_u16 %14, %16 offset:7392\n\tds_read_u16 %15, %16 offset:7920\n\ts_waitcnt lgkmcnt(0)"
        : "=&v"(r[0]), "=&v"(r[1]), "=&v"(r[2]), "=&v"(r[3]), "=&v"(r[4]), "=&v"(r[5]), "=&v"(r[6]), "=&v"(r[7]), "=&v"(r[8]), "=&v"(r[9]), "=&v"(r[10]), "=&v"(r[11]), "=&v"(r[12]), "=&v"(r[13]), "=&v"(r[14]), "=&v"(r[15]) : "v"(a) : "memory");
}
__device__ __forceinline__ void ds_read16_red(const LAS unsigned char* p, float (&r)[16]) {
    const unsigned a = (unsigned)(__SIZE_TYPE__)p;
    asm volatile("ds_read_b32 %0, %16 offset:0\n\tds_read_b32 %1, %16 offset:256\n\tds_read_b32 %2, %16 offset:512\n\tds_read_b32 %3, %16 offset:768\n\tds_read_b32 %4, %16 offset:1024\n\tds_read_b32 %5, %16 offset:1280\n\tds_read_b32 %6, %16 offset:1536\n\tds_read_b32 %7, %16 offset:1792\n\tds_read_b32 %8, %16 offset:64\n\tds_read_b32 %9, %16 offset:320\n\tds_read_b32 %10, %16 offset:576\n\tds_read_b32 %11, %16 offset:832\n\tds_read_b32 %12, %16 offset:1088\n\tds_read_b32 %13, %16 offset:1344\n\tds_read_b32 %14, %16 offset:1600\n\tds_read_b32 %15, %16 offset:1856\n\ts_waitcnt lgkmcnt(0)"
        : "=&v"(r[0]), "=&v"(r[1]), "=&v"(r[2]), "=&v"(r[3]), "=&v"(r[4]), "=&v"(r[5]), "=&v"(r[6]), "=&v"(r[7]), "=&v"(r[8]), "=&v"(r[9]), "=&v"(r[10]), "=&v"(r[11]), "=&v"(r[12]), "=&v"(r[13]), "=&v"(r[14]), "=&v"(r[15]) : "v"(a) : "memory");
}
template <int DV>
__device__ __forceinline__ void load_raw_v(const bf16* base, int ld, int vcol, int tid, u32x4 (&rv)[DV / 64]) {
#pragma unroll
    for (int i = 0; i < DV / 64; ++i) { const int c = tid + i * NT, row = c / (DV / 8), part = c % (DV / 8); rv[i] = *(const u32x4*)(base + (size_t)row * ld + vcol + part * 8); }
}
template <int DV>
__device__ __forceinline__ void store_raw_v(LAS unsigned char* lds, int tid, const u32x4 (&rv)[DV / 64]) {
#pragma unroll
    for (int i = 0; i < DV / 64; ++i) { const int c = tid + i * NT, row = c / (DV / 8), part = c % (DV / 8); *(LAS u32x4*)(lds + L_VS + row * VS_STR + part * 16) = rv[i]; }
}
__device__ __forceinline__ void load_raw128(const bf16* base, int ld, int col, int tid, u32x4 (&r)[2]) {
#pragma unroll
    for (int i = 0; i < 2; ++i) { const int c = tid + i * NT; r[i] = *(const u32x4*)(base + (size_t)(c >> 4) * ld + col + (c & 15) * 8); }
}
__device__ __forceinline__ void store_raw128(LAS unsigned char* lds, int off, int tid, const u32x4 (&r)[2]) {
#pragma unroll
    for (int i = 0; i < 2; ++i) { const int c = tid + i * NT; *(LAS u32x4*)(lds + off + (c >> 4) * QS_STR + (c & 15) * 16) = r[i]; }
}
template <int DV>
__device__ __forceinline__ void transpose_v(LAS unsigned char* lds, int tid) {
    constexpr int RPT = DV / 8;
    const int v = tid % DV, part = tid / DV;
    unsigned w[RPT / 2];
#pragma unroll
    for (int h = 0; h < RPT / 16; ++h) { unsigned r[16]; ds_read16_s528(lds + L_VS + (part * RPT + 16 * h) * VS_STR + v * 2, r);
#pragma unroll
        for (int i = 0; i < 8; ++i) w[8 * h + i] = r[2 * i] | (r[2 * i + 1] << 16); }
    LAS u32x4* dst = (LAS u32x4*)(lds + L_VT + v * KT_STR + part * RPT * 2);
#pragma unroll
    for (int i = 0; i < RPT / 8; ++i) dst[i] = (u32x4){w[4 * i], w[4 * i + 1], w[4 * i + 2], w[4 * i + 3]};
}
__device__ __forceinline__ void cumsum_local(LAS unsigned char* lds, int d, int rg, float (&bb)[16]) {
    unsigned r[16]; ds_read16_s272(lds + L_LA + (rg * 16) * QS_STR + d * 2, r);
#pragma unroll
    for (int i = 0; i < 16; ++i) bb[i] = __uint_as_float(r[i] << 16);
}
__device__ __forceinline__ void cumsum_scan(LAS unsigned char* lds, int d, int rg, float (&bb)[16]) {
#pragma unroll
    for (int i = 1; i < 16; ++i) bb[i] += bb[i - 1];
    ((LAS float*)(lds + L_TOT))[rg * 128 + d] = bb[15];
}
__device__ __forceinline__ void cumsum_finish(LAS unsigned char* lds, int d, int rg, float (&bb)[16], float& blast) {
    const LAS float* tot = (const LAS float*)(lds + L_TOT);
    const float t0 = tot[d], t1 = tot[128 + d], t2 = tot[256 + d], t3 = tot[384 + d];
    const float off = rg == 0 ? 0.f : (rg == 1 ? t0 : (rg == 2 ? t0 + t1 : t0 + t1 + t2));
    blast = (t0 + t1) + (t2 + t3);
#pragma unroll
    for (int i = 0; i < 16; ++i) bb[i] += off;
}
template <int DV, bool HGRN>
__device__ __forceinline__ void pass_a(LAS unsigned char* lds, const bf16* proj, bf16* GS, float* DEC, int G, int bid, const int tid) {
    constexpr int H = HGRN ? 8 : 4, LD = HGRN ? HGRN_N : GLA_N, NTW = DV / 128, NU = BATCH * H * NCH;
    const int lane = tid & 63, wave = tid >> 6, g = lane >> 4, l15 = lane & 15, d = tid & 127, rg = tid >> 7;
    u32x4 rla[2], rk[2], rv[DV / 64];
    int u = bid;
    if (u < NU) { const int b = u / (H * NCH), h = (u / NCH) % H, n = u % NCH; const bf16* base = proj + (size_t)(b * T + n * CH) * LD;
        load_raw128(base, LD, 1024 + h * 128, tid, rla); if (!HGRN) load_raw128(base, LD, 512 + h * 128, tid, rk); load_raw_v<DV>(base, LD, (HGRN ? 3072 : 2560) + h * DV, tid, rv); }
    for (; u < NU; u += G) {
        store_raw128(lds, L_LA, tid, rla); if (!HGRN) store_raw128(lds, L_KS, tid, rk); store_raw_v<DV>(lds, tid, rv);
        __syncthreads();
        { const int un = u + G; if (un < NU) { const int b = un / (H * NCH), h = (un / NCH) % H, n = un % NCH; const bf16* base = proj + (size_t)(b * T + n * CH) * LD;
            load_raw128(base, LD, 1024 + h * 128, tid, rla); if (!HGRN) load_raw128(base, LD, 512 + h * 128, tid, rk); load_raw_v<DV>(base, LD, (HGRN ? 3072 : 2560) + h * DV, tid, rv); } }
        float bb[16], kv[16], blast;
        cumsum_local(lds, d, rg, bb);
        if (HGRN) {
#pragma unroll
            for (int i = 0; i < 16; ++i) kv[i] = 1.0f - __expf(bb[i]);
        } else { unsigned r[16]; ds_read16_s272(lds + L_KS + (rg * 16) * QS_STR + d * 2, r);
#pragma unroll
            for (int i = 0; i < 16; ++i) kv[i] = __uint_as_float(r[i] << 16); }
        cumsum_scan(lds, d, rg, bb);
        transpose_v<DV>(lds, tid);
        __syncthreads();
        cumsum_finish(lds, d, rg, bb, blast);
        { unsigned w[8];
#pragma unroll
          for (int i = 0; i < 8; ++i) w[i] = pk2(kv[2 * i] * __expf(-bb[2 * i]), kv[2 * i + 1] * __expf(-bb[2 * i + 1]));
          LAS u32x4* dst = (LAS u32x4*)(lds + L_KT + d * KT_STR + rg * 32);
          dst[0] = (u32x4){w[0], w[1], w[2], w[3]}; dst[1] = (u32x4){w[4], w[5], w[6], w[7]}; }
        if (rg == 0) DEC[(size_t)u * 128 + d] = __expf(blast);
        __syncthreads();
        f32x4 acc[8][NTW];
#pragma unroll
        for (int mt = 0; mt < 8; ++mt)
#pragma unroll
            for (int nt = 0; nt < NTW; ++nt) acc[mt][nt] = (f32x4){0.f, 0.f, 0.f, 0.f};
#pragma unroll
        for (int kk = 0; kk < 2; ++kk) {
            bf16x8 bfr[NTW], afr[8];
#pragma unroll
            for (int nt = 0; nt < NTW; ++nt) bfr[nt] = *(const LAS bf16x8*)(lds + L_VT + ((wave * NTW + nt) * 16 + l15) * KT_STR + (kk * 32 + 8 * g) * 2);
#pragma unroll
            for (int mt = 0; mt < 8; ++mt) afr[mt] = *(const LAS bf16x8*)(lds + L_KT + ((mt >> 1) * 32 + 8 * (l15 >> 2) + 4 * (mt & 1) + (l15 & 3)) * KT_STR + (kk * 32 + 8 * g) * 2);
#pragma unroll
            for (int mt = 0; mt < 8; ++mt)
#pragma unroll
                for (int nt = 0; nt < NTW; ++nt) acc[mt][nt] = MFMA16(afr[mt], bfr[nt], acc[mt][nt]);
        }
#pragma unroll
        for (int mt = 0; mt < 8; ++mt)
#pragma unroll
            for (int nt = 0; nt < NTW; ++nt) asm volatile("s_nop 7\n\ts_nop 7" : "+v"(acc[mt][nt]));
#pragma unroll
        for (int nt = 0; nt < NTW; ++nt) { bf16* gp = GS + ((size_t)u * DV + (wave * NTW + nt) * 16 + l15) * 128 + 8 * g;
#pragma unroll
            for (int P = 0; P < 4; ++P) { u32x4 w; w.x = pk2(acc[2 * P][nt][0], acc[2 * P][nt][1]); w.y = pk2(acc[2 * P][nt][2], acc[2 * P][nt][3]);
                w.z = pk2(acc[2 * P + 1][nt][0], acc[2 * P + 1][nt][1]); w.w = pk2(acc[2 * P + 1][nt][2], acc[2 * P + 1][nt][3]); *(u32x4*)(gp + P * 32) = w; } }
    }
    __syncthreads();
}
template <int DV, bool HGRN, bool DRY = false>
__device__ __forceinline__ void pass_b(bf16* GS, const float* DEC, int G, int bid, const int tid) {
    constexpr int H = HGRN ? 8 : 4, E = DV * 128, E4 = E / 4;
    const int nthreads = G * NT;
    for (int i = bid * NT + tid; i < BATCH * H * E4; i += nthreads) {
        const int bh = i / E4, e = (i % E4) * 4, d = e & 127;
        float S0 = 0.f, S1 = 0.f, S2 = 0.f, S3 = 0.f;
        u32x2* gp = (u32x2*)(GS + (size_t)bh * NCH * E + e); const f32x4* dp = (const f32x4*)(DEC + (size_t)bh * NCH * 128 + d);
        for (int n0 = 0; n0 < NCH; n0 += 8) {
            u32x2 gv[8]; f32x4 dv[8];
#pragma unroll
            for (int q = 0; q < 8; ++q) { gv[q] = gp[(size_t)(n0 + q) * (E / 4)]; dv[q] = dp[(size_t)(n0 + q) * 32]; }
#pragma unroll
            for (int q = 0; q < 8; ++q) {
                u32x2 o; o.x = pk2(S0, S1); o.y = pk2(S2, S3); if (!DRY || o.x == 0x12345678u) gp[(size_t)(n0 + q) * (E / 4)] = o;
                S0 = dv[q].x * (S0 + __uint_as_float(gv[q].x << 16)); S1 = dv[q].y * (S1 + __uint_as_float(gv[q].x & 0xffff0000u));
                S2 = dv[q].z * (S2 + __uint_as_float(gv[q].y << 16)); S3 = dv[q].w * (S3 + __uint_as_float(gv[q].y & 0xffff0000u)); }
        }
    }
}
template <int DV, bool HGRN, bool DRY = false>
__device__ __forceinline__ void pass_c(LAS unsigned char* lds, bf16* proj, const bf16* GS, int G, int bid, const int tid) {
    constexpr int H = HGRN ? 8 : 4, LD = HGRN ? HGRN_N : GLA_N, MTW = 2, VB = DV / 32, NTC = VB / 2, NU = BATCH * H * NCH;
    const int lane = tid & 63, wave = tid >> 6, g = lane >> 4, l15 = lane & 15, d = tid & 127, rg = tid >> 7;
    const int vb = wave % VB, th = wave / VB, v0 = vb * 32, vrow = v0 + 8 * (l15 >> 2) + (l15 & 3);
    u32x4 rla[2], rq[2], rk[2], rv[DV / 64];
    int u = bid;
    if (u < NU) { const int b = u / (H * NCH), h = (u / NCH) % H, n = u % NCH; const bf16* base = proj + (size_t)(b * T + n * CH) * LD;
        load_raw128(base, LD, 1024 + h * 128, tid, rla); load_raw128(base, LD, h * 128, tid, rq); if (!HGRN) load_raw128(base, LD, 512 + h * 128, tid, rk); load_raw_v<DV>(base, LD, (HGRN ? 3072 : 2560) + h * DV, tid, rv); }
    for (; u < NU; u += G) {
        const int b = u / (H * NCH), h = (u / NCH) % H, n = u % NCH;
        bf16* base = proj + (size_t)(b * T + n * CH) * LD;
        const int vcol = (HGRN ? 3072 : 2560) + h * DV, gcol = (HGRN ? 2048 : 1536) + h * DV;
        store_raw128(lds, L_LA, tid, rla); store_raw128(lds, L_QS, tid, rq); if (!HGRN) store_raw128(lds, L_KS, tid, rk); store_raw_v<DV>(lds, tid, rv);
        __syncthreads();
        bf16x8 sfr[4][MTW];
#pragma unroll
        for (int kk = 0; kk < 4; ++kk)
#pragma unroll
            for (int mt = 0; mt < MTW; ++mt) sfr[kk][mt] = *(const bf16x8*)(GS + ((size_t)u * DV + vrow + 4 * mt) * 128 + kk * 32 + 8 * g);
        { const int un = u + G; if (un < NU) { const int b2 = un / (H * NCH), h2 = (un / NCH) % H, n2 = un % NCH; const bf16* nb = proj + (size_t)(b2 * T + n2 * CH) * LD;
            load_raw128(nb, LD, 1024 + h2 * 128, tid, rla); load_raw128(nb, LD, h2 * 128, tid, rq); if (!HGRN) load_raw128(nb, LD, 512 + h2 * 128, tid, rk); load_raw_v<DV>(nb, LD, (HGRN ? 3072 : 2560) + h2 * DV, tid, rv); } }
        float bb[16], kv[16], blast;
        cumsum_local(lds, d, rg, bb);
        if (HGRN) {
#pragma unroll
            for (int i = 0; i < 16; ++i) kv[i] = 1.0f - __expf(bb[i]);
        } else { unsigned r[16]; ds_read16_s272(lds + L_KS + (rg * 16) * QS_STR + d * 2, r);
#pragma unroll
            for (int i = 0; i < 16; ++i) kv[i] = __uint_as_float(r[i] << 16); }
        cumsum_scan(lds, d, rg, bb);
        transpose_v<DV>(lds, tid);
        __syncthreads();
        cumsum_finish(lds, d, rg, bb, blast);
        { unsigned rq_[16]; ds_read16_s272(lds + L_QS + (rg * 16) * QS_STR + d * 2, rq_);
#pragma unroll
          for (int i = 0; i < 16; ++i) { const int s = rg * 16 + i; LAS bf16* qa = (LAS bf16*)(lds + L_QS + s * QS_STR + d * 2); LAS bf16* ka = (LAS bf16*)(lds + L_KS + s * QS_STR + d * 2);
              const float q = __uint_as_float(rq_[i] << 16); *qa = (bf16)f2bf(q * __expf(bb[i])); *ka = (bf16)f2bf(kv[i] * __expf(-bb[i])); } }
        __syncthreads();
        { const int tt = wave >> 1;
#pragma unroll
          for (int si = 0; si < 2; ++si) { const int st = (wave & 1) * 2 + si; f32x4 c = (f32x4){0.f, 0.f, 0.f, 0.f};
              bf16x8 afr[4], bfr[4];
#pragma unroll
              for (int kk = 0; kk < 4; ++kk) { afr[kk] = *(const LAS bf16x8*)(lds + L_KS + (st * 16 + l15) * QS_STR + (kk * 32 + 8 * g) * 2);
                  bfr[kk] = *(const LAS bf16x8*)(lds + L_QS + (tt * 16 + l15) * QS_STR + (kk * 32 + 8 * g) * 2); }
#pragma unroll
              for (int kk = 0; kk < 4; ++kk) c = MFMA16(afr[kk], bfr[kk], c);
              const int t = tt * 16 + l15, s0 = st * 16 + 4 * g;
              u32x2 w; w.x = pk2(s0 <= t ? c[0] : 0.f, s0 + 1 <= t ? c[1] : 0.f); w.y = pk2(s0 + 2 <= t ? c[2] : 0.f, s0 + 3 <= t ? c[3] : 0.f);
              *(LAS u32x2*)(lds + L_AT + t * KT_STR + s0 * 2) = w; } }
        u32x4 gt[NTC];
#pragma unroll
        for (int nt = 0; nt < NTC; ++nt) gt[nt] = *(const u32x4*)(base + (size_t)((th * NTC + nt) * 16 + l15) * LD + gcol + v0 + 8 * g);
        __syncthreads();
        f32x4 acc[MTW][NTC];
#pragma unroll
        for (int mt = 0; mt < MTW; ++mt)
#pragma unroll
            for (int nt = 0; nt < NTC; ++nt) acc[mt][nt] = (f32x4){0.f, 0.f, 0.f, 0.f};
#pragma unroll
        for (int kp = 0; kp < 2; ++kp) {
            bf16x8 bfr[2][NTC];
#pragma unroll
            for (int k2 = 0; k2 < 2; ++k2)
#pragma unroll
                for (int nt = 0; nt < NTC; ++nt) bfr[k2][nt] = *(const LAS bf16x8*)(lds + L_QS + ((th * NTC + nt) * 16 + l15) * QS_STR + ((kp * 2 + k2) * 32 + 8 * g) * 2);
#pragma unroll
            for (int k2 = 0; k2 < 2; ++k2)
#pragma unroll
                for (int nt = 0; nt < NTC; ++nt)
#pragma unroll
                    for (int mt = 0; mt < MTW; ++mt) acc[mt][nt] = MFMA16(sfr[kp * 2 + k2][mt], bfr[k2][nt], acc[mt][nt]);
        }
        {
            bf16x8 afr[2][MTW], bfr[2][NTC];
#pragma unroll
            for (int kk = 0; kk < 2; ++kk) {
#pragma unroll
                for (int mt = 0; mt < MTW; ++mt) afr[kk][mt] = *(const LAS bf16x8*)(lds + L_VT + (vrow + 4 * mt) * KT_STR + (kk * 32 + 8 * g) * 2);
#pragma unroll
                for (int nt = 0; nt < NTC; ++nt) bfr[kk][nt] = *(const LAS bf16x8*)(lds + L_AT + ((th * NTC + nt) * 16 + l15) * KT_STR + (kk * 32 + 8 * g) * 2); }
#pragma unroll
            for (int kk = 0; kk < 2; ++kk)
#pragma unroll
                for (int nt = 0; nt < NTC; ++nt)
#pragma unroll
                    for (int mt = 0; mt < MTW; ++mt) acc[mt][nt] = MFMA16(afr[kk][mt], bfr[kk][nt], acc[mt][nt]);
        }
        LAS float* red = (LAS float*)(lds + L_RED);
        { float pp[NTC];
#pragma unroll
          for (int nt = 0; nt < NTC; ++nt) { float p = 0.f;
#pragma unroll
              for (int mt = 0; mt < MTW; ++mt) p += (acc[mt][nt][0] * acc[mt][nt][0] + acc[mt][nt][1] * acc[mt][nt][1]) + (acc[mt][nt][2] * acc[mt][nt][2] + acc[mt][nt][3] * acc[mt][nt][3]);
              pp[nt] = p; }
          if constexpr (NTC == 4) { pg8::shx_add4(pp, 16, lane); pg8::shx_add4(pp, 32, lane); } else { pg8::shx_add2(pp, 16, lane); pg8::shx_add2(pp, 32, lane); }
          if (g == 0) {
#pragma unroll
              for (int nt = 0; nt < NTC; ++nt) red[vb * 64 + (th * NTC + nt) * 16 + l15] = pp[nt]; } }
        __syncthreads();
        float rsum[NTC];
#pragma unroll
        for (int np = 0; np < NTC / 2; ++np) { float r16[16]; ds_read16_red(lds + L_RED + ((th * NTC + 2 * np) * 16 + l15) * 4, r16);
#pragma unroll
            for (int q = 0; q < 2; ++q) { float s = 0.f;
#pragma unroll
                for (int w = 0; w < VB; ++w) s += r16[q * 8 + w];
                rsum[2 * np + q] = s; } }
#pragma unroll
        for (int nt = 0; nt < NTC; ++nt) { const int t = (th * NTC + nt) * 16 + l15; const float s = rsum[nt];
            const float rstd = rsqrtf(s * (1.0f / DV) + EPS);
            bf16* rowp = base + (size_t)t * LD; const u32x4 gg = gt[nt];
            u32x4 w; w.x = pk2(acc[0][nt][0] * rstd * __uint_as_float(gg.x << 16), acc[0][nt][1] * rstd * __uint_as_float(gg.x & 0xffff0000u));
            w.y = pk2(acc[0][nt][2] * rstd * __uint_as_float(gg.y << 16), acc[0][nt][3] * rstd * __uint_as_float(gg.y & 0xffff0000u));
            w.z = pk2(acc[1][nt][0] * rstd * __uint_as_float(gg.z << 16), acc[1][nt][1] * rstd * __uint_as_float(gg.z & 0xffff0000u));
            w.w = pk2(acc[1][nt][2] * rstd * __uint_as_float(gg.w << 16), acc[1][nt][3] * rstd * __uint_as_float(gg.w & 0xffff0000u));
            if (!DRY || w.x == 0x12345678u) *(u32x4*)(rowp + vcol + v0 + 8 * g) = w; }
    }
    __syncthreads();
}
constexpr int KL_STR = 272, VL_STR = 528, L_KL = 0, L_VL = 256 * KL_STR;
static_assert(L_VL + 128 * VL_STR <= LDS_BYTES, "xattn LDS map");
template <bool DRY = false>
__device__ __forceinline__ void xattn(LAS unsigned char* lds, bf16* proj, int LD, int xcol, const bf16* KM, const bf16* VMT, int G, int bid, const int tid) {
    const int lane = tid & 63, wave = tid >> 6, g = lane >> 4, l15 = lane & 15;
    for (int w = bid; w < 256; w += G) {
        const int pair = w >> 4, sub = w & 15, b = pair >> 2, h = pair & 3;
        __syncthreads();
#pragma unroll
        for (int i = 0; i < 8; ++i) { const int c = tid + i * NT, m = c >> 4, part = c & 15;
            *(LAS u32x4*)(lds + L_KL + m * KL_STR + part * 16) = *(const u32x4*)(KM + (size_t)(b * 256 + m) * 512 + h * 128 + part * 8); }
#pragma unroll
        for (int i = 0; i < 8; ++i) { const int c = tid + i * NT, dd = c >> 5, part = c & 31;
            *(LAS u32x4*)(lds + L_VL + dd * VL_STR + part * 16) = *(const u32x4*)(VMT + ((size_t)b * 512 + h * 128 + dd) * 256 + part * 8); }
        __syncthreads();
        bf16x8 qn[4];
        { const bf16* q0 = proj + (size_t)(b * T + (sub * 4) * 128 + wave * 16 + l15) * LD + xcol + h * 128;
#pragma unroll
          for (int kk = 0; kk < 4; ++kk) qn[kk] = *(const bf16x8*)(q0 + kk * 32 + 8 * g); }
        for (int tile = 0; tile < 4; ++tile) {
            const int r0 = b * T + (sub * 4 + tile) * 128 + wave * 16;
            bf16* qp = proj + (size_t)(r0 + l15) * LD + xcol + h * 128;
            bf16x8 qf[4];
#pragma unroll
            for (int kk = 0; kk < 4; ++kk) qf[kk] = qn[kk];
            if (tile < 3) {
#pragma unroll
                for (int kk = 0; kk < 4; ++kk) qn[kk] = *(const bf16x8*)(qp + (size_t)128 * LD + kk * 32 + 8 * g); }
            f32x4 sc[16];
#pragma unroll
            for (int mp = 0; mp < 8; ++mp) {
                bf16x8 afr[2][4];
#pragma unroll
                for (int m2 = 0; m2 < 2; ++m2)
#pragma unroll
                    for (int kk = 0; kk < 4; ++kk) afr[m2][kk] = *(const LAS bf16x8*)(lds + L_KL + ((mp * 2 + m2) * 16 + l15) * KL_STR + (kk * 32 + 8 * g) * 2);
#pragma unroll
                for (int m2 = 0; m2 < 2; ++m2) { f32x4 c = (f32x4){0.f, 0.f, 0.f, 0.f};
#pragma unroll
                    for (int kk = 0; kk < 4; ++kk) c = MFMA16(afr[m2][kk], qf[kk], c);
                    sc[mp * 2 + m2] = c; } }
            float mx = -1e30f;
#pragma unroll
            for (int mt = 0; mt < 16; ++mt) mx = fmaxf(mx, fmaxf(fmaxf(sc[mt][0], sc[mt][1]), fmaxf(sc[mt][2], sc[mt][3])));
            mx = fmaxf(mx, pg8::shx(mx, 16, lane)); mx = fmaxf(mx, pg8::shx(mx, 32, lane));
            float sum = 0.f;
#pragma unroll
            for (int mt = 0; mt < 16; ++mt) {
#pragma unroll
                for (int j = 0; j < 4; ++j) { const float p = __expf(sc[mt][j] - mx); sc[mt][j] = p; sum += p; } }
            sum += pg8::shx(sum, 16, lane); sum += pg8::shx(sum, 32, lane);
            const float inv = 1.0f / sum;
            f32x4 oa[8];
#pragma unroll
            for (int dt = 0; dt < 8; ++dt) oa[dt] = (f32x4){0.f, 0.f, 0.f, 0.f};
#pragma unroll
            for (int kb = 0; kb < 8; ++kb) {
                union { bf16x8 v; unsigned u[4]; } pb;
                pb.u[0] = pk2(sc[2 * kb][0], sc[2 * kb][1]); pb.u[1] = pk2(sc[2 * kb][2], sc[2 * kb][3]); pb.u[2] = pk2(sc[2 * kb + 1][0], sc[2 * kb + 1][1]); pb.u[3] = pk2(sc[2 * kb + 1][2], sc[2 * kb + 1][3]);
                union { bf16x8 v; u32x2 h[2]; } pa[8];
#pragma unroll
                for (int dt = 0; dt < 8; ++dt) { const LAS unsigned char* vp = lds + L_VL + ((dt >> 1) * 32 + 8 * (l15 >> 2) + 4 * (dt & 1) + (l15 & 3)) * VL_STR + (kb * 32 + 4 * g) * 2;
                    pa[dt].h[0] = *(const LAS u32x2*)vp; pa[dt].h[1] = *(const LAS u32x2*)(vp + 32); }
#pragma unroll
                for (int dt = 0; dt < 8; ++dt) oa[dt] = MFMA16(pa[dt].v, pb.v, oa[dt]);
            }
#pragma unroll
            for (int P = 0; P < 4; ++P) { u32x4 o; o.x = pk2(oa[2 * P][0] * inv, oa[2 * P][1] * inv); o.y = pk2(oa[2 * P][2] * inv, oa[2 * P][3] * inv);
                o.z = pk2(oa[2 * P + 1][0] * inv, oa[2 * P + 1][1] * inv); o.w = pk2(oa[2 * P + 1][2] * inv, oa[2 * P + 1][3] * inv); if (!DRY || o.x == 0x12345678u) *(u32x4*)(qp + P * 32 + 8 * g) = o; }
        }
    }
    __syncthreads();
}
__device__ __forceinline__ void final_norm(float* out, const bf16* XB, const float* SS, const float* gain, int gw, int ngw, int lane) {
    f32x4 gv[4];
#pragma unroll
    for (int j = 0; j < 4; ++j) gv[j] = ((const f32x4*)gain)[lane + 64 * j];
    for (int m = gw; m < M; m += 2 * ngw) {
        const int m1 = (m + ngw < M) ? m + ngw : m; const bool two = (m1 != m);
        float sv[2]; sv[0] = lane < 16 ? SS[(size_t)lane * M + m] : 0.f; sv[1] = lane < 16 ? SS[(size_t)lane * M + m1] : 0.f;
        const u32x2* xr0 = (const u32x2*)(XB + (size_t)m * D) + lane; const u32x2* xr1 = (const u32x2*)(XB + (size_t)m1 * D) + lane;
        u32x2 xa[4], xb_[4];
#pragma unroll
        for (int j = 0; j < 4; ++j) { xa[j] = xr0[64 * j]; xb_[j] = xr1[64 * j]; }
#pragma unroll
        for (int o = 1; o < 64; o <<= 1) pg8::shx_add2(sv, o, lane);
        const float rstd0 = rsqrtf(sv[0] * (1.0f / D) + EPS), rstd1 = rsqrtf(sv[1] * (1.0f / D) + EPS);
        f32x4* or0 = (f32x4*)(out + (size_t)m * D) + lane; f32x4* or1 = (f32x4*)(out + (size_t)m1 * D) + lane;
#pragma unroll
        for (int j = 0; j < 4; ++j) { const u32x2 xw = xa[j]; f32x4 v = (f32x4){__uint_as_float(xw.x << 16), __uint_as_float(xw.x & 0xffff0000u), __uint_as_float(xw.y << 16), __uint_as_float(xw.y & 0xffff0000u)};
            or0[64 * j] = v * rstd0 * gv[j]; }
        if (two) {
#pragma unroll
            for (int j = 0; j < 4; ++j) { const u32x2 xw = xb_[j]; f32x4 v = (f32x4){__uint_as_float(xw.x << 16), __uint_as_float(xw.x & 0xffff0000u), __uint_as_float(xw.y << 16), __uint_as_float(xw.y & 0xffff0000u)};
                or1[64 * j] = v * rstd1 * gv[j]; } }
    }
}

struct Args { Ptrs P; int ph_lo, ph_hi; };
constexpr int N_PHASES = 2 + 7 * DEPTH;
__global__ void __launch_bounds__(NT, 2) fwd_kernel(Args a) {
    extern __shared__ __attribute__((aligned(16))) unsigned char lds_raw[];
#if ONE_LAUNCH
    cg::grid_group grid = cg::this_grid();
    { volatile LAS unsigned* st = (volatile LAS unsigned*)((LAS unsigned char*)lds_raw + LDS_BARST); int t0_ = threadIdx.x; if (t0_ == 0) { st[0] = 0u; st[1] = 0u; } __syncthreads();
      (void)xcd_barrier_post((unsigned*)(a.P.ws + WS_CTL), st, t0_); }
#define SEAM() do { XcdBarrier xb_; xb_.bar = (unsigned*)(ws + WS_CTL); xb_.x = xb_xcc_id(); xb_.st = (volatile LAS unsigned*)(lds + LDS_BARST); xcd_barrier(xb_, tid); if (ph == 0) grid.sync(); } while (0)
#else
#define SEAM() do {} while (0)
#endif
    const int ph_lo = a.ph_lo, ph_hi = a.ph_hi;
    const int wave0 = __builtin_amdgcn_readfirstlane(threadIdx.x >> 6);
    for (int ph = ph_lo; ph < ph_hi; ++ph) {
        const __attribute__((address_space(4))) Args* ap = (const __attribute__((address_space(4))) Args*)__builtin_amdgcn_kernarg_segment_ptr();
        asm volatile("" : "+s"(ap));
        int zero_ = 0; asm volatile("" : "+v"(zero_));
        int tid = wave0 * 64 + (int)__builtin_amdgcn_mbcnt_hi(~0u, __builtin_amdgcn_mbcnt_lo(~0u, (unsigned)zero_)); asm volatile("" : "+v"(tid));
        LAS unsigned char* lds = (LAS unsigned char*)lds_raw;
        const int lane = tid & 63, wave = __builtin_amdgcn_readfirstlane(tid >> 6);
        int G = gridDim.x, bid = blockIdx.x; asm volatile("" : "+s"(G), "+s"(bid));
        const int gw = bid * NWAVES + wave, ngw = G * NWAVES;
        unsigned char* ws = ap->P.ws;
        float* SS = (float*)(ws + WS_SS); bf16* XB = (bf16*)ap->P.out; bf16* GS = (bf16*)(ws + WS_XB); bf16* X2 = (bf16*)(ws + WS_XB); bf16* PROJ = (bf16*)(ws + WS_PROJ);
        int ngemm = 0;
        int L = 0, sp = 0; bool hg = false;
        if (ph == 0) { prologue(&ap->P, lds, gw, ngw, wave, lane); }
        else if (ph == N_PHASES - 1) { final_norm(ap->P.out, X2, SS, ap->P.final_norm, gw, ngw, lane); }
        else {
            L = (ph - 1) / 7; sp = (ph - 1) % 7; hg = (L & 1);
            const int LD = hg ? HGRN_N : GLA_N;
            if (sp == 0) ngemm = (L == 0) ? 2 : 1;
            else if (sp == 1) {
                float* DEC = (float*)(ws + WS_DEC);
#if EXP == 3
                if (hg) pass_a<128, true>(lds, PROJ, GS, DEC, G, bid, tid); else pass_a<256, false>(lds, PROJ, GS, DEC, G, bid, tid);
#endif
                if (hg) pass_a<128, true>(lds, PROJ, GS, DEC, G, bid, tid); else pass_a<256, false>(lds, PROJ, GS, DEC, G, bid, tid);
#if EXP == 5
                xattn<true>(lds, PROJ, LD, hg ? 4096 : 3584, (const bf16*)(ws + WS_KM) + (size_t)L * 1024 * 512, (const bf16*)(ws + WS_VMT) + (size_t)L * 4 * 512 * 256, G, bid, tid);
#endif
#if EXP == 6
                if (L + 1 < DEPTH) { convert_layer(&ap->P, L + 1, lds, gw, ngw, wave, lane); } __syncthreads();
#endif
                xattn(lds, PROJ, LD, hg ? 4096 : 3584, (const bf16*)(ws + WS_KM) + (size_t)L * 1024 * 512, (const bf16*)(ws + WS_VMT) + (size_t)L * 4 * 512 * 256, G, bid, tid);
                if (L + 1 < DEPTH) { convert_layer(&ap->P, L + 1, lds, gw, ngw, wave, lane); }
            } else if (sp == 2) {
                const float* DEC = (const float*)(ws + WS_DEC);
#if EXP == 3
                if (hg) pass_b<128, true, true>(GS, DEC, G, bid, tid); else pass_b<256, false, true>(GS, DEC, G, bid, tid);
#endif
                if (hg) pass_b<128, true>(GS, DEC, G, bid, tid); else pass_b<256, false>(GS, DEC, G, bid, tid);
            } else if (sp == 3) {
#if EXP == 4
                if (hg) pass_c<128, true, true>(lds, PROJ, GS, G, bid, tid); else pass_c<256, false, true>(lds, PROJ, GS, G, bid, tid);
#endif
                if (hg) pass_c<128, true>(lds, PROJ, GS, G, bid, tid); else pass_c<256, false>(lds, PROJ, GS, G, bid, tid);
            } else ngemm = 1;
            if (EXP == 2 && (sp == 0 || sp == 5)) ngemm += 8;
        }
        for (int rep = 0; rep < (ngemm & 7) * (ngemm >= 8 ? 2 : 1); ++rep) {
            unsigned char* wb = ws + WS_WT + (size_t)(L & 1) * WT_BUF;
            const int LD = hg ? HGRN_N : GLA_N;
            pg8::Gemm g; pg8::EpiAll E; E.hgrn = hg ? 1 : 0; E.M = M; E.aux = nullptr; E.xin = nullptr; E.xout = nullptr;
            if (sp == 0 && (ngemm & 7) == 2 && (rep & 7) == 0 && rep < 8) {
                g.A = (const bf16*)(ws + WS_MEMB); g.Bt = (const bf16*)(ws + WS_WKV); g.M = MROWS; g.N = 4096; g.K = D; g.lda = D; g.perm = 0;
                E.kind = 3; E.ldc = 0; E.O = (bf16*)(ws + WS_KM); E.ss = (const float*)(ws + WS_SSM); E.xout = (float*)(ws + WS_VMT);
            } else if (sp == 0) {
                g.A = XB; g.Bt = (const bf16*)(wb + WT_IN); g.M = M; g.N = LD; g.K = D; g.lda = D; g.perm = 1;
                E.kind = 0; E.ldc = LD; E.O = PROJ; E.ss = SS; E.aux = hg ? (const float*)(ws + WS_LB) + (size_t)L * 1024 : ap->P.gla_b_gate + (size_t)(L >> 1) * 512;
            } else if (sp == 4) {
                g.A = PROJ + (hg ? 3072 : 2560); g.Bt = (const bf16*)(wb + WT_OUT); g.M = M; g.N = D; g.K = KOUT; g.lda = LD; g.perm = 1;
                E.kind = 2; E.ldc = D; E.O = XB; E.ss = SS; E.xin = (L == 0 && ph_hi < 0) ? ap->P.x : nullptr; E.xout = (float*)XB;
            } else if (sp == 5) {
                g.A = XB; g.Bt = (const bf16*)(wb + WT_UP); g.M = M; g.N = FF; g.K = D; g.lda = D; g.perm = 1;
                E.kind = 1; E.ldc = FF; E.O = PROJ; E.ss = SS;
            } else {
                g.A = PROJ; g.Bt = (const bf16*)(wb + WT_DOWN); g.M = M; g.N = D; g.K = FF; g.lda = FF; g.perm = 1;
                E.kind = 2; E.ldc = D; E.O = XB; E.ss = SS; E.xout = (float*)((L == DEPTH - 1) ? X2 : XB);
            }
#if EXP == 9
            if (E.kind == 2) { pg8::Gemm g2 = g; g2.perm = 1; pg8::EpiAll E2 = E; E2.kind = 1; E2.ldc = D; E2.O = GS; E2.ss = SS; E2.xin = nullptr;
                pg8::StaticOrder S2; S2.init(g2.M, g2.N, G, bid); pg8::gemm_phase<pg8::EpiAll, pg8::StaticOrder, true, true>(lds, g2, S2, E2, tid); }
#endif
            pg8::StaticOrder S; S.init(g.M, g.N, G, bid, (sp == 6) ? REV_DOWN : 0);
#if SKEW_TICKS > 0
            if (E.kind <= 1) {
                const unsigned long long t0_ = __builtin_amdgcn_s_memrealtime(); const unsigned long long dl_ = (unsigned long long)((bid & 7) * SKEW_TICKS);
                while (__builtin_amdgcn_s_memrealtime() - t0_ < dl_) __builtin_amdgcn_s_sleep(8);
            }
#endif
            pg8::gemm_phase<pg8::EpiAll, pg8::StaticOrder, true, true>(lds, g, S, E, tid);
        }
        if (ph + 1 < ph_hi) { SEAM(); }
#if EXP == 7
        if (ph + 1 < ph_hi) { SEAM(); }
#endif
    }
}

extern "C" void kernel_launch(void* const* d_in, const int* in_sizes, int n_in, void* d_out, int out_size, void* d_ws, size_t ws_size, hipStream_t stream) {
    static int grid = 0;
    if (grid == 0) {
        if (n_in != 17 || out_size != M * D || ws_size < WS_END) { fprintf(stderr, "kernel_launch: unexpected shapes (n_in %d out %d ws %zu)\n", n_in, out_size, ws_size); grid = -1; return; }
        int dev = 0, cus = 0, per_cu = 0;
        hipGetDevice(&dev); hipDeviceGetAttribute(&cus, hipDeviceAttributeMultiprocessorCount, dev);
        if (hipFuncSetAttribute((const void*)fwd_kernel, hipFuncAttributeMaxDynamicSharedMemorySize, LDS_BYTES) != hipSuccess) { fprintf(stderr, "kernel_launch: hipFuncSetAttribute failed\n"); grid = -1; return; }
        if (hipOccupancyMaxActiveBlocksPerMultiprocessor(&per_cu, (const void*)fwd_kernel, NT, LDS_BYTES) != hipSuccess || per_cu < 1) { fprintf(stderr, "kernel_launch: occupancy query says %d\n", per_cu); per_cu = 1; }
        (void)hipGetLastError();
        grid = cus * per_cu;
        if (grid > 256) grid = 256;
        grid = (grid / 16) * 16;
        fprintf(stderr, "kernel_launch: grid %d (cus %d per_cu %d)\n", grid, cus, per_cu);
    }
    if (grid <= 0) return;
#if ONE_LAUNCH
    if (hipMemsetAsync((char*)d_ws + WS_CTL, 0, CTL_BYTES, stream) != hipSuccess) { fprintf(stderr, "kernel_launch: memset failed\n"); return; }
#endif
    Args a{};
    const float** pp = (const float**)&a.P;
    for (int i = 0; i < 17; ++i) pp[i] = (const float*)d_in[i];
    a.P.out = (float*)d_out; a.P.ws = (unsigned char*)d_ws;
#if ONE_LAUNCH
    a.ph_lo = 0; a.ph_hi = N_PHASES;
    void* args[] = {&a};
    hipError_t e = hipLaunchCooperativeKernel((const void*)fwd_kernel, dim3(grid), dim3(NT), args, LDS_BYTES, stream);
    if (e != hipSuccess) fprintf(stderr, "kernel_launch: cooperative launch failed: %s (grid %d)\n", hipGetErrorString(e), grid);
#else
    for (int ph = 0; ph < N_PHASES; ++ph) { a.ph_lo = ph; a.ph_hi = ph + 1; hipLaunchKernelGGL(fwd_kernel, dim3(grid), dim3(NT), LDS_BYTES, stream, a); }
#endif
}
```

```cpp
#include <hip/hip_runtime.h>
#include <hip/hip_cooperative_groups.h>
#include <cstdio>
#include <cstdint>
namespace cg = cooperative_groups;

#ifndef EXP
#define EXP 0
#endif
#ifndef SKEW_TICKS
#define SKEW_TICKS 0
#endif
#ifndef REV_DOWN
#define REV_DOWN 0
#endif
#ifndef ONE_LAUNCH
#define ONE_LAUNCH 1
#endif

namespace pg8 {
#define PG8_LAS __attribute__((address_space(3)))
typedef unsigned short bf16_t;
typedef short bf16x8 __attribute__((ext_vector_type(8)));
typedef float f32x4 __attribute__((ext_vector_type(4)));
typedef unsigned u32x4 __attribute__((ext_vector_type(4)));
typedef unsigned u32x2 __attribute__((ext_vector_type(2)));
constexpr int BM = 256, BK = 64, HALF = 128, HTB = HALF * BK * 2, STAGE_BYTES = 8 * HTB, NXCD = 8, WGM = 8;

__host__ __device__ __forceinline__ int lds_byte(int r, int c) { const int st = (r >> 4) * 2 + (c >> 5), rr = r & 15, cc = c & 31, ob = rr * 64 + cc * 2; return st * 1024 + (ob ^ (((ob >> 9) & 1) << 5)); }
__host__ __device__ __forceinline__ void stage_rc(int b, int& R, int& C) { const int st = b / 1024, sb = b % 1024, swz = sb ^ (((sb >> 9) & 1) << 5); R = (st >> 1) * 16 + swz / 64; C = (st & 1) * 32 + (swz % 64) / 2; }
__host__ __device__ __forceinline__ int perm32(int rho) { const int n = rho >> 4, i = rho & 15; return 8 * (i >> 2) + 4 * n + (i & 3); }

struct Unit { int pm, pn; };
struct Gemm { const bf16_t* A; const bf16_t* Bt; int M, N, K, lda, perm; };

struct StaticOrder {
    int nM, nN, nwg, G, c, rev;
    __host__ __device__ void init(int M, int N, int G_, int c_, int rev_ = 0) { nM = M / BM; nN = N / BM; nwg = nM * nN; G = G_; c = c_; rev = rev_; }
    __host__ __device__ bool next(int i, Unit& u) const {
        const long L = (long)i * G + c; if (L >= nwg) return false;
        int wgid = (int)L; { const int q = nwg / NXCD, r = nwg % NXCD, xcd = wgid % NXCD, off = wgid / NXCD; wgid = (xcd < r ? xcd * (q + 1) : r * (q + 1) + (xcd - r) * q) + off; }
        const int nig = WGM * nN, gid = wgid / nig, fm = gid * WGM, gsz = (nM - fm) < WGM ? (nM - fm) : WGM;
        u.pm = fm + ((wgid % nig) % gsz); u.pn = (wgid % nig) / gsz; if (rev) u.pm = nM - 1 - u.pm; return true;
    }
    __device__ __forceinline__ void a_ready(const Unit&) const {}
    __device__ __forceinline__ void done(const Unit&) const {}
};

__device__ __forceinline__ float shx(float v, int mask, int lane) { return __int_as_float(__builtin_amdgcn_ds_bpermute((lane ^ mask) << 2, __float_as_int(v))); }
__device__ __forceinline__ void shx_add2(float (&v)[2], int mask, int lane) {
    const int a = (lane ^ mask) << 2; float r[2];
    asm volatile("ds_bpermute_b32 %0, %2, %3\n\tds_bpermute_b32 %1, %2, %4\n\ts_waitcnt lgkmcnt(0)"
        : "=&v"(r[0]), "=&v"(r[1]) : "v"(a), "v"(v[0]), "v"(v[1]));
#pragma unroll
    for (int i = 0; i < 2; ++i) v[i] += r[i];
}
__device__ __forceinline__ void shx_add4(float (&v)[4], int mask, int lane) {
    const int a = (lane ^ mask) << 2; float r[4];
    asm volatile("ds_bpermute_b32 %0, %4, %5\n\tds_bpermute_b32 %1, %4, %6\n\tds_bpermute_b32 %2, %4, %7\n\tds_bpermute_b32 %3, %4, %8\n\ts_waitcnt lgkmcnt(0)"
        : "=&v"(r[0]), "=&v"(r[1]), "=&v"(r[2]), "=&v"(r[3]) : "v"(a), "v"(v[0]), "v"(v[1]), "v"(v[2]), "v"(v[3]));
#pragma unroll
    for (int i = 0; i < 4; ++i) v[i] += r[i];
}
__device__ __forceinline__ void shx_add8(float (&v)[8], int mask, int lane) {
    const int a = (lane ^ mask) << 2; float r[8];
    asm volatile("ds_bpermute_b32 %0, %8, %9\n\tds_bpermute_b32 %1, %8, %10\n\tds_bpermute_b32 %2, %8, %11\n\tds_bpermute_b32 %3, %8, %12\n\tds_bpermute_b32 %4, %8, %13\n\tds_bpermute_b32 %5, %8, %14\n\tds_bpermute_b32 %6, %8, %15\n\tds_bpermute_b32 %7, %8, %16\n\ts_waitcnt lgkmcnt(0)"
        : "=&v"(r[0]), "=&v"(r[1]), "=&v"(r[2]), "=&v"(r[3]), "=&v"(r[4]), "=&v"(r[5]), "=&v"(r[6]), "=&v"(r[7]) : "v"(a), "v"(v[0]), "v"(v[1]), "v"(v[2]), "v"(v[3]), "v"(v[4]), "v"(v[5]), "v"(v[6]), "v"(v[7]));
#pragma unroll
    for (int i = 0; i < 8; ++i) v[i] += r[i];
}
typedef float f32x2_t __attribute__((ext_vector_type(2)));
typedef __bf16 bf16x2_t __attribute__((ext_vector_type(2)));
__device__ __forceinline__ unsigned cvt_pk_native(float lo, float hi) { const f32x2_t f = {lo, hi}; const bf16x2_t b = __builtin_convertvector(f, bf16x2_t); return __builtin_bit_cast(unsigned, b); }
__device__ __forceinline__ unsigned cvt_pk_bf16(float lo, float hi) { unsigned r; asm volatile("v_cvt_pk_bf16_f32 %0, %1, %2" : "=v"(r) : "v"(lo), "v"(hi)); return r; }

__device__ __forceinline__ float fsigmoid(float v) { return __builtin_amdgcn_rcpf(1.0f + __expf(-v)); }
__device__ __forceinline__ float fsilu(float v) { return v * fsigmoid(v); }
__device__ __forceinline__ float row_rstd(const float* ss, int M, int row, int fq, int lane) {
    const float* p = ss + (size_t)(4 * fq) * M + row;
    float s = (p[0] + p[M]) + (p[2 * (size_t)M] + p[3 * (size_t)M]);
    s += shx(s, 16, lane); s += shx(s, 32, lane);
    return rsqrtf(s * (1.0f / 1024.0f) + 1e-6f);
}
template <int MODE> __device__ __forceinline__ float proj_act(float v, float a) {
    if (MODE == 1) return fsilu(v);
    if (MODE == 2) { const float z = v + a; const float ls = fminf(z, 0.f) - __logf(1.0f + __expf(-fabsf(z))); return ls * 0.0625f; }
    if (MODE == 3) { const float sg = fsigmoid(v); return __logf(a + (1.0f - a) * sg); }
    if (MODE == 4) return fsilu(v) * 0.08838834764831845f;
    if (MODE == 5) { const float r = fmaxf(v, 0.f); return r * r; }
    return v;
}
struct EpiAll {
    static constexpr bool AFTER_DRAIN = false;
    int kind, ldc, hgrn, M;
    bf16_t* O;
    const float* ss;
    const float* aux;
    const float* xin;
    float* xout;
    template <int MODE> __device__ __forceinline__ void body_proj(const f32x4 (&acc)[2][2][4][2], const Unit& u, int wr, int wc, int fr, int fq) const {
        const int row0 = u.pm * BM + wr * 64 + fr, col0 = u.pn * BM + wc * 32 + 8 * fq;
        f32x4 av[2][2];
#pragma unroll
        for (int bj = 0; bj < 2; ++bj)
#pragma unroll
            for (int n = 0; n < 2; ++n) av[bj][n] = (MODE == 2 || MODE == 3) ? *(const f32x4*)(aux + (col0 - 1024) + bj * HALF + 4 * n) : (f32x4){0.f, 0.f, 0.f, 0.f};
        float ps[2][4];
#pragma unroll
        for (int ai = 0; ai < 2; ++ai)
#pragma unroll
            for (int m = 0; m < 4; ++m) { const float* p = ss + (size_t)(4 * fq) * M + (row0 + ai * HALF + m * 16); ps[ai][m] = (p[0] + p[M]) + (p[2 * (size_t)M] + p[3 * (size_t)M]); }
        float rs[2][4];
        { float pv[8];
#pragma unroll
          for (int i = 0; i < 8; ++i) pv[i] = ps[i >> 2][i & 3];
          shx_add8(pv, 16, fq * 16 + fr); shx_add8(pv, 32, fq * 16 + fr);
#pragma unroll
          for (int i = 0; i < 8; ++i) rs[i >> 2][i & 3] = rsqrtf(pv[i] * (1.0f / 1024.0f) + 1e-6f); }
#pragma unroll
        for (int ai = 0; ai < 2; ++ai)
#pragma unroll
            for (int m = 0; m < 4; ++m) { const int row = row0 + ai * HALF + m * 16; const float rstd = rs[ai][m]; bf16_t* rowp = O + (size_t)row * ldc + col0;
#pragma unroll
                for (int bj = 0; bj < 2; ++bj) { f32x4 v0 = acc[ai][bj][m][0] * rstd, v1 = acc[ai][bj][m][1] * rstd;
#pragma unroll
                    for (int j = 0; j < 4; ++j) { v0[j] = proj_act<MODE>(v0[j], av[bj][0][j]); v1[j] = proj_act<MODE>(v1[j], av[bj][1][j]); }
                    u32x4 w; w.x = cvt_pk_bf16(v0[0], v0[1]); w.y = cvt_pk_bf16(v0[2], v0[3]); w.z = cvt_pk_bf16(v1[0], v1[1]); w.w = cvt_pk_bf16(v1[2], v1[3]);
                    *(u32x4*)(rowp + bj * HALF) = w; } }
    }
    template <bool F32IN> __device__ __forceinline__ void body_res(const f32x4 (&acc)[2][2][4][2], const Unit& u, int wr, int wc, int fr, int fq) const {
        const int row0 = u.pm * BM + wr * 64 + fr, col0 = u.pn * BM + wc * 32 + 8 * fq; float* ssw = (float*)ss; bf16_t* XO = (bf16_t*)xout;
#pragma unroll
        for (int ai = 0; ai < 2; ++ai) {
            u32x4 xi[4][2];
            if (!F32IN) {
#pragma unroll
                for (int m = 0; m < 4; ++m) { const size_t off = (size_t)(row0 + ai * HALF + m * 16) * 1024 + col0;
#pragma unroll
                    for (int bj = 0; bj < 2; ++bj) xi[m][bj] = *(const u32x4*)(O + off + bj * HALF); } }
            float sv[4];
#pragma unroll
            for (int m = 0; m < 4; ++m) { const int row = row0 + ai * HALF + m * 16; const size_t off = (size_t)row * 1024 + col0; float s = 0.f;
#pragma unroll
                for (int bj = 0; bj < 2; ++bj) { f32x4 o0, o1;
                    if (F32IN) { o0 = *(const f32x4*)(xin + off + bj * HALF); o1 = *(const f32x4*)(xin + off + bj * HALF + 4); }
                    else { const u32x4 xw = xi[m][bj]; o0 = (f32x4){__uint_as_float(xw.x << 16), __uint_as_float(xw.x & 0xffff0000u), __uint_as_float(xw.y << 16), __uint_as_float(xw.y & 0xffff0000u)};
                        o1 = (f32x4){__uint_as_float(xw.z << 16), __uint_as_float(xw.z & 0xffff0000u), __uint_as_float(xw.w << 16), __uint_as_float(xw.w & 0xffff0000u)}; }
                    o0 = o0 + acc[ai][bj][m][0]; o1 = o1 + acc[ai][bj][m][1];
                    u32x4 w; w.x = cvt_pk_bf16(o0[0], o0[1]); w.y = cvt_pk_bf16(o0[2], o0[3]); w.z = cvt_pk_bf16(o1[0], o1[1]); w.w = cvt_pk_bf16(o1[2], o1[3]);
                    *(u32x4*)(XO + off + bj * HALF) = w;
#pragma unroll
                    for (int q = 0; q < 4; ++q) { const unsigned wq = q == 0 ? w.x : (q == 1 ? w.y : (q == 2 ? w.z : w.w)); const float r0 = __uint_as_float(wq << 16), r1 = __uint_as_float(wq & 0xffff0000u); s += r0 * r0 + r1 * r1; } }
                sv[m] = s; }
            shx_add4(sv, 16, fq * 16 + fr); shx_add4(sv, 32, fq * 16 + fr);
            if (fq == 0) {
#pragma unroll
                for (int m = 0; m < 4; ++m) ssw[(size_t)(u.pn * 4 + wc) * M + row0 + ai * HALF + m * 16] = sv[m]; }
        }
    }
    __device__ __forceinline__ void body_kv(const f32x4 (&acc)[2][2][4][2], const Unit& u, int wr, int wc, int fr, int fq) const {
        const int row0 = u.pm * BM + wr * 64 + fr, layer = u.pn >> 2, cl0 = (u.pn & 3) * BM + wc * 32 + 4 * fq; bf16_t* VMT = (bf16_t*)xout;
#pragma unroll
        for (int ai = 0; ai < 2; ++ai)
#pragma unroll
            for (int m = 0; m < 4; ++m) { const int row = row0 + ai * HALF + m * 16; const float rstd = rsqrtf(ss[row] * (1.0f / 1024.0f) + 1e-6f);
#pragma unroll
                for (int bj = 0; bj < 2; ++bj)
#pragma unroll
                    for (int n = 0; n < 2; ++n) { const f32x4 o = acc[ai][bj][m][n] * rstd; const int cl = cl0 + bj * HALF + n * 16;
                        if (cl < 512) { u32x2 w; w.x = cvt_pk_bf16(o[0], o[1]); w.y = cvt_pk_bf16(o[2], o[3]); *(u32x2*)(O + ((size_t)layer * 1024 + row) * 512 + cl) = w; }
                        else { const unsigned lo = cvt_pk_bf16(o[0], o[1]), hi = cvt_pk_bf16(o[2], o[3]); bf16_t* d = VMT + ((size_t)(layer * 4 + (row >> 8)) * 512 + (cl - 512)) * 256 + (row & 255);
                            d[0] = (bf16_t)(lo & 0xffff); d[256] = (bf16_t)(lo >> 16); d[512] = (bf16_t)(hi & 0xffff); d[768] = (bf16_t)(hi >> 16); } } }
    }
    __device__ __forceinline__ void operator()(const f32x4 (&acc)[2][2][4][2], const Unit& u, int wr, int wc, int fr, int fq) const {
        if (kind == 0) {
            int mode;
            if (!hgrn) mode = (u.pn >= 4 && u.pn < 6) ? 2 : ((u.pn >= 6 && u.pn < 10) ? 1 : 0);
            else mode = u.pn < 4 ? 4 : (u.pn < 8 ? 3 : (u.pn < 12 ? 1 : 0));
            if (mode == 0) body_proj<0>(acc, u, wr, wc, fr, fq); else if (mode == 1) body_proj<1>(acc, u, wr, wc, fr, fq); else if (mode == 2) body_proj<2>(acc, u, wr, wc, fr, fq);
            else if (mode == 3) body_proj<3>(acc, u, wr, wc, fr, fq); else body_proj<4>(acc, u, wr, wc, fr, fq);
        } else if (kind == 1) body_proj<5>(acc, u, wr, wc, fr, fq);
        else if (kind == 2) { if (xin) body_res<true>(acc, u, wr, wc, fr, fq); else body_res<false>(acc, u, wr, wc, fr, fq); }
        else body_kv(acc, u, wr, wc, fr, fq);
    }
};

template <class Epi, class Sched, bool ALIGN_EPI = false, bool SP2 = false>
__device__ __forceinline__ void gemm_phase(PG8_LAS unsigned char* lds, const Gemm g, const Sched& S, const Epi& E, const int tid) {
    const int wid = __builtin_amdgcn_readfirstlane(tid >> 6), lane = tid & 63, wr = wid >> 2, wc = wid & 3, fr = lane & 15, fq = lane >> 4;
    const int K = g.K, nt = K / BK;
    unsigned voffA[2], voffB[2];
#pragma unroll
    for (int i = 0; i < 2; ++i) { int R, C; stage_rc(tid * 16 + i * 8192, R, C); const int Rb = g.perm ? ((R & ~31) + perm32(R & 31)) : R;
        voffA[i] = (unsigned)(R * g.lda + C) * 2u; voffB[i] = (unsigned)(Rb * K + C) * 2u; }
    const size_t kstep = (size_t)(BK * 2);
    const size_t hstepA = (size_t)HALF * g.lda * 2, hstepB = (size_t)HALF * K * 2;
    const size_t tstepA = 2 * hstepA, tstepB = 2 * hstepB;
    const unsigned ldsw = (unsigned)wid * 1024u;
    const int aoff = lds_byte(wr * 64 + fr, fq * 8), boff = lds_byte(wc * 32 + fr, fq * 8);
#define PG8_SA(b, h) (((b) * 2 + (h)) * HTB)
#define PG8_SB(b, h) ((4 + (b) * 2 + (h)) * HTB)
#define PG8_STAGE(bufoff, gbase, voff) do { _Pragma("unroll") for (int _i = 0; _i < 2; ++_i) \
        __builtin_amdgcn_global_load_lds((const unsigned*)((const char*)(gbase) + (voff)[_i]), (PG8_LAS unsigned*)(lds + (bufoff) + ldsw + _i * 8192), 16, 0, 0); } while (0)
#define PG8_LDA(dst, b, h) do { _Pragma("unroll") for (int m = 0; m < 4; ++m) _Pragma("unroll") for (int k = 0; k < 2; ++k) dst[m][k] = *(const PG8_LAS bf16x8*)(lds + PG8_SA(b, h) + aoff + m * 2048 + k * 1024); } while (0)
#define PG8_LDB(dst, b, h) do { _Pragma("unroll") for (int n = 0; n < 2; ++n) _Pragma("unroll") for (int k = 0; k < 2; ++k) dst[n][k] = *(const PG8_LAS bf16x8*)(lds + PG8_SB(b, h) + boff + n * 2048 + k * 1024); } while (0)
#define PG8_MMA(ai, bj, At, Bt) do { __builtin_amdgcn_s_setprio(1); _Pragma("unroll") for (int m = 0; m < 4; ++m) _Pragma("unroll") for (int n = 0; n < 2; ++n) _Pragma("unroll") for (int k = 0; k < 2; ++k) \
        acc[ai][bj][m][n] = __builtin_amdgcn_mfma_f32_16x16x32_bf16(Bt[n][k], At[m][k], acc[ai][bj][m][n], 0, 0, 0); __builtin_amdgcn_s_setprio(0); } while (0)
#define PG8_WAIT_V(n) asm volatile("s_waitcnt vmcnt(" #n ")" ::: "memory")
#define PG8_WAIT_L(n) asm volatile("s_waitcnt lgkmcnt(" #n ")" ::: "memory")
#define PG8_BAR __builtin_amdgcn_s_barrier()
#define PG8_SCHED __builtin_amdgcn_sched_barrier(0)
    Unit cur, nxt; int ui = 0;
    if (!S.next(0, cur)) return;
    f32x4 acc[2][2][4][2];
#pragma unroll
    for (int a = 0; a < 2; ++a)
#pragma unroll
        for (int b = 0; b < 2; ++b)
#pragma unroll
            for (int m = 0; m < 4; ++m)
#pragma unroll
                for (int n = 0; n < 2; ++n) acc[a][b][m][n] = (f32x4){0.f, 0.f, 0.f, 0.f};
    bf16x8 At[4][2], B0[2][2], B1[2][2];
    const char* cA = (const char*)g.A + (size_t)cur.pm * tstepA; const char* cB = (const char*)g.Bt + (size_t)cur.pn * tstepB;
    S.a_ready(cur);
    if constexpr (SP2) {
        PG8_STAGE(PG8_SB(0, 0), cB, voffB); PG8_STAGE(PG8_SB(0, 1), cB + hstepB, voffB); PG8_STAGE(PG8_SA(0, 0), cA, voffA); PG8_STAGE(PG8_SA(0, 1), cA + hstepA, voffA);
        if (wr == 1) PG8_BAR;
        PG8_WAIT_V(2); PG8_BAR;
        PG8_STAGE(PG8_SB(1, 0), cB + kstep, voffB); PG8_STAGE(PG8_SA(1, 0), cA + kstep, voffA); PG8_STAGE(PG8_SB(1, 1), cB + hstepB + kstep, voffB);
        PG8_WAIT_V(6); PG8_BAR;
    } else {
        PG8_STAGE(PG8_SB(0, 0), cB, voffB); PG8_STAGE(PG8_SA(0, 0), cA, voffA); PG8_STAGE(PG8_SB(0, 1), cB + hstepB, voffB); PG8_STAGE(PG8_SA(0, 1), cA + hstepA, voffA);
        if (wr == 1) PG8_BAR;
        PG8_WAIT_V(4); PG8_BAR;
        PG8_STAGE(PG8_SB(1, 0), cB + kstep, voffB); PG8_STAGE(PG8_SA(1, 0), cA + kstep, voffA); PG8_STAGE(PG8_SB(1, 1), cB + hstepB + kstep, voffB);
        PG8_WAIT_V(6); PG8_BAR;
    }
    for (;;) {
        const bool has_next = S.next(ui + 1, nxt);
        const char* nA = has_next ? (const char*)g.A + (size_t)nxt.pm * tstepA : cA; const char* nB = has_next ? (const char*)g.Bt + (size_t)nxt.pn * tstepB : cB;
        for (int t = 0; t < nt; t += 2) {
            const bool last = (t == nt - 2);
            const char* a1 = cA + (size_t)(t + 1) * kstep;
            const char* a2 = last ? nA : cA + (size_t)(t + 2) * kstep; const char* b2 = last ? nB : cB + (size_t)(t + 2) * kstep;
            const char* a3 = a2 + kstep; const char* b3 = b2 + kstep;
            if (last && has_next) S.a_ready(nxt);
            if constexpr (SP2) {
            PG8_LDB(B0, 0, 0); PG8_LDB(B1, 0, 1); PG8_SCHED; PG8_LDA(At, 0, 0); PG8_STAGE(PG8_SA(1, 1), a1 + hstepA, voffA);
            PG8_WAIT_V(8); PG8_WAIT_L(0); PG8_BAR; PG8_MMA(0, 0, At, B0); PG8_MMA(0, 1, At, B1); PG8_BAR; PG8_SCHED;
            PG8_LDA(At, 0, 1); PG8_STAGE(PG8_SB(0, 0), b2, voffB); PG8_STAGE(PG8_SB(0, 1), b2 + hstepB, voffB); PG8_STAGE(PG8_SA(0, 0), a2, voffA);
            PG8_WAIT_V(8); PG8_WAIT_L(0); PG8_BAR; PG8_MMA(1, 0, At, B0); PG8_MMA(1, 1, At, B1); PG8_BAR; PG8_SCHED;
            PG8_LDB(B0, 1, 0); PG8_LDB(B1, 1, 1); PG8_SCHED; PG8_LDA(At, 1, 0); PG8_STAGE(PG8_SA(0, 1), a2 + hstepA, voffA);
            PG8_WAIT_V(8); PG8_WAIT_L(0); PG8_BAR; PG8_MMA(0, 0, At, B0); PG8_MMA(0, 1, At, B1); PG8_BAR; PG8_SCHED;
            PG8_LDA(At, 1, 1); PG8_STAGE(PG8_SB(1, 0), b3, voffB); PG8_STAGE(PG8_SB(1, 1), b3 + hstepB, voffB); PG8_STAGE(PG8_SA(1, 0), a3, voffA);
            PG8_WAIT_V(8); PG8_WAIT_L(0); PG8_BAR; PG8_MMA(1, 0, At, B0); PG8_MMA(1, 1, At, B1); PG8_BAR; PG8_SCHED;
            } else {
            PG8_LDB(B0, 0, 0); PG8_SCHED; PG8_LDA(At, 0, 0); PG8_STAGE(PG8_SA(1, 1), a1 + hstepA, voffA);
            PG8_WAIT_L(8); PG8_BAR; PG8_WAIT_L(0); PG8_MMA(0, 0, At, B0); PG8_BAR; PG8_SCHED;
            PG8_LDB(B1, 0, 1); PG8_STAGE(PG8_SB(0, 0), b2, voffB);
            PG8_BAR; PG8_WAIT_L(0); PG8_MMA(0, 1, At, B1); PG8_BAR;
            PG8_LDA(At, 0, 1); PG8_STAGE(PG8_SA(0, 0), a2, voffA);
            PG8_BAR; PG8_WAIT_L(0); PG8_MMA(1, 0, At, B0); PG8_BAR; PG8_SCHED;
            PG8_STAGE(PG8_SB(0, 1), b2 + hstepB, voffB);
            PG8_WAIT_V(6); PG8_BAR; PG8_MMA(1, 1, At, B1); PG8_BAR;
            PG8_LDB(B0, 1, 0); PG8_SCHED; PG8_LDA(At, 1, 0); PG8_STAGE(PG8_SA(0, 1), a2 + hstepA, voffA);
            PG8_WAIT_L(8); PG8_BAR; PG8_WAIT_L(0); PG8_MMA(0, 0, At, B0); PG8_BAR; PG8_SCHED;
            PG8_LDB(B1, 1, 1); PG8_STAGE(PG8_SB(1, 0), b3, voffB);
            PG8_BAR; PG8_WAIT_L(0); PG8_MMA(0, 1, At, B1); PG8_BAR;
            PG8_LDA(At, 1, 1); PG8_STAGE(PG8_SA(1, 0), a3, voffA);
            PG8_BAR; PG8_WAIT_L(0); PG8_MMA(1, 0, At, B0); PG8_BAR; PG8_SCHED;
            PG8_STAGE(PG8_SB(1, 1), b3 + hstepB, voffB);
            PG8_WAIT_V(6); PG8_BAR; PG8_MMA(1, 1, At, B1); PG8_BAR;
            }
        }
        if constexpr (ALIGN_EPI) { if (wr == 0) PG8_BAR; }
        if constexpr (!Epi::AFTER_DRAIN) { E(acc, cur, wr, wc, fr, fq); S.done(cur); }
        if (!has_next) break;
#pragma unroll
        for (int a = 0; a < 2; ++a)
#pragma unroll
            for (int b = 0; b < 2; ++b)
#pragma unroll
                for (int m = 0; m < 4; ++m)
#pragma unroll
                    for (int n = 0; n < 2; ++n) acc[a][b][m][n] = (f32x4){0.f, 0.f, 0.f, 0.f};
        cur = nxt; cA = nA; cB = nB; ++ui;
        if constexpr (ALIGN_EPI) { if (wr == 1) PG8_BAR; }
    }
    PG8_WAIT_V(0);
    if constexpr (!ALIGN_EPI) { if (wr == 0) PG8_BAR; }
    PG8_BAR;
    if constexpr (Epi::AFTER_DRAIN) { E.fused(acc, cur, wr, wc, fr, fq, lds, wid, lane); S.done(cur); }
#undef PG8_SA
#undef PG8_SB
#undef PG8_STAGE
#undef PG8_LDA
#undef PG8_LDB
#undef PG8_MMA
#undef PG8_WAIT_V
#undef PG8_WAIT_L
#undef PG8_BAR
#undef PG8_SCHED
}
}

constexpr int NWAVES = 8, NT = 512;
constexpr int D = 1024, BATCH = 4, T = 8192, M = BATCH * T, DEPTH = 4, MEM = 256, MROWS = BATCH * MEM;
constexpr int DK = 128, CH = 64, NCH = T / CH;
constexpr int GLA_N = 4096, HGRN_N = 4608, FF = 4096, KOUT = 1536;
constexpr float EPS = 1e-6f;
constexpr size_t MiB = 1u << 20;
constexpr size_t WS_SS = 0;
constexpr size_t WS_DEC = 2 * MiB;
constexpr size_t WS_MEMB = 4 * MiB;
constexpr size_t WS_SSM = 6 * MiB;
constexpr size_t WS_LB = 6 * MiB + 65536;
constexpr size_t WS_KM = 8 * MiB;
constexpr size_t WS_VMT = 12 * MiB;
constexpr size_t WS_WKV = 16 * MiB;
constexpr size_t WS_WT = 24 * MiB, WT_BUF = 30 * MiB;
constexpr size_t WT_IN = 0, WT_OUT = 10 * MiB, WT_UP = 14 * MiB, WT_DOWN = 22 * MiB;
constexpr size_t WS_PROJ = 84 * MiB;
constexpr size_t WS_XB = 372 * MiB;
constexpr size_t WS_END = 500 * MiB;
constexpr int LDS_BYTES = 147456;

#define LAS __attribute__((address_space(3)))
typedef unsigned short bf16;
typedef float f32x4 __attribute__((ext_vector_type(4)));
typedef short bf16x8 __attribute__((ext_vector_type(8)));
typedef short bf16x4 __attribute__((ext_vector_type(4)));
typedef unsigned u32x4 __attribute__((ext_vector_type(4)));
typedef unsigned u32x2 __attribute__((ext_vector_type(2)));
__device__ __forceinline__ float bf2f(bf16 b) { return __uint_as_float(((unsigned)b) << 16); }
__device__ __forceinline__ unsigned f2bf(float f) { unsigned u = __float_as_uint(f); return (u + 0x7fffu + ((u >> 16) & 1u)) >> 16; }
__device__ __forceinline__ unsigned pk2(float lo, float hi) { return pg8::cvt_pk_bf16(lo, hi); }
__device__ __forceinline__ float wave_sum(float v, int lane) {
#pragma unroll
    for (int o = 1; o < 64; o <<= 1) v += pg8::shx(v, o, lane);
    return v;
}
#define MFMA16(a, b, c) __builtin_amdgcn_mfma_f32_16x16x32_bf16((a), (b), (c), 0, 0, 0)

constexpr size_t WS_CTL = 7 * MiB, CTL_BYTES = 16384;
constexpr int LDS_BARST = LDS_BYTES - 64;
#define XB_TMO      128
#define XB_XCNT(j)  (256  + 64 * (j))
#define XB_XSUB(j)  (1280 + 64 * (j))
#define XB_XGEN(j)  (2304 + 64 * (j))
#define XB_TOP      3328
#define XB_TOPGEN   3392
#define XCD_BAR_WORDS 3456
#define XB_SPIN_CAP (1u << 18)

__device__ __forceinline__ unsigned xb_ld(unsigned* p)              { return __hip_atomic_load(p, __ATOMIC_RELAXED, __HIP_MEMORY_SCOPE_AGENT); }
__device__ __forceinline__ unsigned xb_add(unsigned* p, unsigned v) { return __hip_atomic_fetch_add(p, v, __ATOMIC_RELAXED, __HIP_MEMORY_SCOPE_AGENT); }
__device__ __forceinline__ unsigned xb_xcc_id() { return (unsigned)__builtin_amdgcn_s_getreg((3 << 11) | 20) & 0xFu; }
#define XB_SPIN(cond, bar) do { unsigned _sp = 0; while (cond) { __builtin_amdgcn_s_sleep(1); \
    if ((++_sp & 255u) == 0u) { if (xb_ld(&(bar)[XB_TMO])) break; if (_sp > XB_SPIN_CAP) { atomicAdd(&(bar)[XB_TMO], 1u); break; } } } } while (0)

struct XcdBarrier {
    unsigned* bar; unsigned x;
    volatile LAS unsigned* st;
};

__device__ __forceinline__ XcdBarrier xcd_barrier_post(unsigned* bar, volatile LAS unsigned* st, int tid) {
    XcdBarrier b; b.bar = bar; b.x = xb_xcc_id(); b.st = st;
    if (tid == 0) (void)xb_add(&bar[XB_XCNT(b.x)], 1u);
    return b;
}
__device__ __forceinline__ void xcd_barrier_complete(unsigned* bar, unsigned x, unsigned& nloc, unsigned& nx) {
    const unsigned G = gridDim.x * gridDim.y * gridDim.z;
    unsigned sum, cnt, mine, sp = 0u;
    for (;;) {
        sum = 0u; cnt = 0u; mine = 0u;
#pragma unroll
        for (unsigned j = 0; j < 16; ++j) { const unsigned c = xb_ld(&bar[XB_XCNT(j)]); sum += c; cnt += (c > 0u) ? 1u : 0u; mine = (j == x) ? c : mine; }
        if (sum == G) break;
        __builtin_amdgcn_s_sleep(1);
        if ((++sp & 255u) == 0u) { if (xb_ld(&bar[XB_TMO])) break; if (sp > XB_SPIN_CAP) { atomicAdd(&bar[XB_TMO], 1u); break; } }
    }
    nloc = mine > 0u ? mine : 1u; nx = cnt > 0u ? cnt : 1u;
}

__device__ __forceinline__ void xcd_barrier(const XcdBarrier& b, int tid) {
    asm volatile("s_waitcnt vmcnt(0)" ::: "memory");
    __syncthreads();
    if (tid == 0) {
        unsigned* bar = b.bar;
        __builtin_amdgcn_s_waitcnt(0);
        unsigned nloc = b.st[0], nx = b.st[1];
        if (nloc == 0u) { xcd_barrier_complete(bar, b.x, nloc, nx); b.st[0] = nloc; b.st[1] = nx; }
        const unsigned old = xb_add(&bar[XB_XSUB(b.x)], 1u);
        const unsigned gen = old / nloc;
        if (old + 1u == (gen + 1u) * nloc) {
            __builtin_amdgcn_fence(__ATOMIC_RELEASE, "agent");
            asm volatile("s_waitcnt vmcnt(0)" ::: "memory");
            const unsigned og = xb_add(&bar[XB_TOP], 1u);
            const unsigned tg = og / nx;
            if (og + 1u == (tg + 1u) * nx) xb_add(&bar[XB_TOPGEN], 1u);
            else XB_SPIN(xb_ld(&bar[XB_TOPGEN]) == tg, bar);
            __builtin_amdgcn_fence(__ATOMIC_ACQUIRE, "agent");
            xb_add(&bar[XB_XGEN(b.x)], 1u);
            asm volatile("s_waitcnt vmcnt(0)" ::: "memory");
        } else {
            XB_SPIN(xb_ld(&bar[XB_XGEN(b.x)]) == gen, bar);
            __builtin_amdgcn_fence(__ATOMIC_ACQUIRE, "agent");
            asm volatile("s_waitcnt vmcnt(0)" ::: "memory");
        }
    }
    __syncthreads();
}

__device__ __forceinline__ void transpose_item(const float* W, int ldw, int K, int sc, bf16* WT, int dr, const float* gain, int gmask, int glimit, float scale, LAS float* scr, int item, int nblk, int lane) {
    const int kb = item / nblk, nb = item % nblk, k0 = 64 * kb, n0 = 32 * nb;
    float wv[32], gg[32];
#pragma unroll
    for (int i = 0; i < 32; ++i) { const int kk = 2 * i + (lane >> 5); const int k = k0 + kk; wv[i] = W[(size_t)k * ldw + sc + n0 + (lane & 31)]; gg[i] = (gain && k < glimit) ? gain[k & gmask] : 1.0f; }
#pragma unroll
    for (int i = 0; i < 32; ++i) { const int kk = 2 * i + (lane >> 5); scr[kk * 33 + (lane & 31)] = wv[i] * (gg[i] * scale); }
    asm volatile("s_waitcnt lgkmcnt(0)" ::: "memory");
    const int c = lane & 7;
#pragma unroll
    for (int j = 0; j < 4; ++j) { const int n = (lane >> 3) + 8 * j; const LAS float* s = scr + (8 * c) * 33 + n;
        u32x4 o; o.x = pk2(s[0 * 33], s[1 * 33]); o.y = pk2(s[2 * 33], s[3 * 33]); o.z = pk2(s[4 * 33], s[5 * 33]); o.w = pk2(s[6 * 33], s[7 * 33]);
        *(u32x4*)(WT + (size_t)(dr + n0 + n) * K + k0 + 8 * c) = o; }
    asm volatile("s_waitcnt lgkmcnt(0)" ::: "memory");
}
struct Ptrs {
    const float *x, *mem, *norm_mix, *norm_mem, *w_kv, *w_out, *norm_mlp, *w_up, *w_down, *gla_w_in, *gla_w_gate2, *gla_b_gate, *gla_out_gain, *hgrn_w_in, *hgrn_lb, *hgrn_out_gain, *final_norm;
    float* out; unsigned char* ws;
};
#define SEG(Wp, ldw, K, sc, ncols, WTp, dr, gain, gmask, glimit, scale) { const int nblk_ = (ncols) / 32, nit_ = ((K) / 64) * nblk_; \
    if (r < nit_) { transpose_item(Wp, ldw, K, sc, WTp, dr, gain, gmask, glimit, scale, scr, r, nblk_, lane); continue; } r -= nit_; }
template <class PT> __device__ __forceinline__ void convert_layer(PT Pp, int L, LAS unsigned char* lds, int gw, int ngw, int wave, int lane) {
    LAS float* scr = (LAS float*)(lds + wave * 16384);
    unsigned char* wb = Pp->ws + WS_WT + (size_t)(L & 1) * WT_BUF;
    bf16* Win = (bf16*)(wb + WT_IN); bf16* Wout = (bf16*)(wb + WT_OUT); bf16* Wup = (bf16*)(wb + WT_UP); bf16* Wdn = (bf16*)(wb + WT_DOWN);
    const int j = L >> 1; const bool hg = (L & 1);
    const float* gmix = Pp->norm_mix + (size_t)L * D; const float* gmlp = Pp->norm_mlp + (size_t)L * D;
    const float* wo = Pp->w_out + (size_t)L * KOUT * D; const float* wu = Pp->w_up + (size_t)L * D * FF; const float* wd = Pp->w_down + (size_t)L * FF * D;
    const float QS = 0.08838834764831845f;
    if (!hg) {
        const float* wi = Pp->gla_w_in + (size_t)j * D * 3600; const float* og = Pp->gla_out_gain + (size_t)j * 256;
        const int total = 16 * (16 + 16 + 32 + 32 + 16) + 24 * 32 + 16 * 128 + 64 * 32 + 128;
        for (int it = gw; it < total; it += ngw) { int r = it;
            SEG(wi, 3600, D, 0, 512, Win, 0, gmix, 1023, D, QS)
            SEG(wi, 3600, D, 512, 512, Win, 512, gmix, 1023, D, 1.f)
            SEG(wi, 3600, D, 1024, 1024, Win, 2560, gmix, 1023, D, 1.f)
            SEG(wi, 3600, D, 2064, 1024, Win, 1536, gmix, 1023, D, 1.f)
            SEG(wi, 3600, D, 3088, 512, Win, 3584, gmix, 1023, D, QS)
            SEG(wo, D, KOUT, 0, 1024, Wout, 0, og, 255, 1024, 1.f)
            SEG(wu, FF, D, 0, 4096, Wup, 0, gmlp, 1023, D, 1.f)
            SEG(wd, D, FF, 0, 1024, Wdn, 0, (const float*)nullptr, 0, 0, 1.f)
            { const int kb = r >> 3, cb = r & 7, k = kb * 64 + lane; const float* g2 = Pp->gla_w_gate2 + (size_t)j * 16 * 512 + cb * 64;
              const f32x4* wr4 = (const f32x4*)(wi + (size_t)k * 3600 + 2048); const f32x4 w0 = wr4[0], w1 = wr4[1], w2 = wr4[2], w3 = wr4[3]; const float gk = gmix[k];
              for (int c = 0; c < 64; ++c) { float s = 0.f;
#pragma unroll
                  for (int q = 0; q < 4; ++q) { s += w0[q] * g2[q * 512 + c]; s += w1[q] * g2[(4 + q) * 512 + c]; s += w2[q] * g2[(8 + q) * 512 + c]; s += w3[q] * g2[(12 + q) * 512 + c]; }
                  Win[(size_t)(1024 + cb * 64 + c) * D + k] = (bf16)f2bf(s * gk); } }
        }
    } else {
        const float* wi = Pp->hgrn_w_in + (size_t)j * D * 4608; const float* og = Pp->hgrn_out_gain + (size_t)j * 128;
        const int total = 16 * (32 + 32 + 32 + 32 + 16) + 24 * 32 + 16 * 128 + 64 * 32;
        for (int it = gw; it < total; it += ngw) { int r = it;
            SEG(wi, 4608, D, 0, 1024, Win, 0, gmix, 1023, D, 1.f)
            SEG(wi, 4608, D, 1024, 1024, Win, 1024, gmix, 1023, D, 1.f)
            SEG(wi, 4608, D, 2048, 1024, Win, 3072, gmix, 1023, D, 1.f)
            SEG(wi, 4608, D, 3072, 1024, Win, 2048, gmix, 1023, D, 1.f)
            SEG(wi, 4608, D, 4096, 512, Win, 4096, gmix, 1023, D, QS)
            SEG(wo, D, KOUT, 0, 1024, Wout, 0, og, 127, 1024, 1.f)
            SEG(wu, FF, D, 0, 4096, Wup, 0, gmlp, 1023, D, 1.f)
            { const int nblk_ = 32; transpose_item(wd, D, FF, 0, Wdn, 0, (const float*)nullptr, 0, 0, 1.f, scr, r, nblk_, lane); }
        }
    }
}
template <class PT> __device__ __forceinline__ void prologue(PT Pp, LAS unsigned char* lds, int gw, int ngw, int wave, int lane) {
    convert_layer(Pp, 0, lds, gw, ngw, wave, lane);
    { LAS float* scr = (LAS float*)(lds + wave * 16384); bf16* Wkv = (bf16*)(Pp->ws + WS_WKV);
      const int per = 16 * 32, total = 4 * per;
      for (int it = gw; it < total; it += ngw) { const int L = it / per, r = it % per;
          transpose_item(Pp->w_kv + (size_t)L * D * 1024, 1024, D, 0, Wkv + (size_t)L * 1024 * D, 0, Pp->norm_mem + (size_t)L * D, 1023, D, 1.f, scr, r, 32, lane); } }
    { float* LB = (float*)(Pp->ws + WS_LB);
      for (int c = gw * 64 + lane; c < 1024; c += ngw * 64) { const float v0 = Pp->hgrn_lb[c], v1 = Pp->hgrn_lb[1024 + c], v2 = Pp->hgrn_lb[2048 + c], v3 = Pp->hgrn_lb[3072 + c];
          const float mx = fmaxf(fmaxf(v0, v1), fmaxf(v2, v3)); const float e0 = expf(v0 - mx), e1 = expf(v1 - mx), e2 = expf(v2 - mx), e3 = expf(v3 - mx); const float inv = 1.0f / (e0 + e1 + e2 + e3);
          LB[c] = 0.f; LB[1024 + c] = e1 * inv; LB[2048 + c] = (e1 + e2) * inv; LB[3072 + c] = (e1 + e2 + e3) * inv; } }
    bf16* XB = (bf16*)Pp->out; float* SS = (float*)(Pp->ws + WS_SS);     bf16* MB = (bf16*)(Pp->ws + WS_MEMB); float* SSM = (float*)(Pp->ws + WS_SSM);
    for (int m = gw; m < M + MROWS; m += 2 * ngw) {
        const int m1 = (m + ngw < M + MROWS) ? m + ngw : m; const bool two = (m1 != m);
        const bool ism0 = m >= M, ism1 = m1 >= M; const int row0 = ism0 ? m - M : m, row1 = ism1 ? m1 - M : m1;
        const f32x4* xr0 = (const f32x4*)((ism0 ? Pp->mem : Pp->x) + (size_t)row0 * D) + lane; const f32x4* xr1 = (const f32x4*)((ism1 ? Pp->mem : Pp->x) + (size_t)row1 * D) + lane;
        f32x4 va[4], vb[4];
#pragma unroll
        for (int j = 0; j < 4; ++j) { va[j] = xr0[64 * j]; vb[j] = xr1[64 * j]; }
        unsigned long long* o80 = (unsigned long long*)((ism0 ? MB : XB) + (size_t)row0 * D) + lane; unsigned long long* o81 = (unsigned long long*)((ism1 ? MB : XB) + (size_t)row1 * D) + lane;
        float sv[2] = {0.f, 0.f};
#pragma unroll
        for (int j = 0; j < 4; ++j) { const f32x4 v = va[j]; sv[0] += (v.x * v.x + v.y * v.y) + (v.z * v.z + v.w * v.w); o80[64 * j] = (unsigned long long)pk2(v.x, v.y) | ((unsigned long long)pk2(v.z, v.w) << 32); }
        if (two) {
#pragma unroll
            for (int j = 0; j < 4; ++j) { const f32x4 v = vb[j]; sv[1] += (v.x * v.x + v.y * v.y) + (v.z * v.z + v.w * v.w); o81[64 * j] = (unsigned long long)pk2(v.x, v.y) | ((unsigned long long)pk2(v.z, v.w) << 32); } }
#pragma unroll
        for (int o = 1; o < 64; o <<= 1) pg8::shx_add2(sv, o, lane);
        if (ism0) { if (lane == 0) SSM[row0] = sv[0]; } else if (lane < 16) SS[(size_t)lane * M + row0] = lane == 0 ? sv[0] : 0.f;
        if (two) { if (ism1) { if (lane == 0) SSM[row1] = sv[1]; } else if (lane < 16) SS[(size_t)lane * M + row1] = lane == 0 ? sv[1] : 0.f; }
    }
}
constexpr int KT_STR = 144;
constexpr int QS_STR = 272;
constexpr int VS_STR = 528;
constexpr int L_TOT = 0;
constexpr int L_LA = 2048;
constexpr int L_QS = L_LA + 64 * QS_STR;
constexpr int L_KS = L_QS + 64 * QS_STR;
constexpr int L_VS = L_KS + 64 * QS_STR;
constexpr int L_VT = L_VS + 64 * VS_STR;
constexpr int L_KT = L_VT + 256 * KT_STR;
constexpr int L_AT = L_KT;
constexpr int L_RED = L_KT + 128 * KT_STR;
static_assert(L_RED + 2048 <= LDS_BYTES - 64, "mixer LDS map");

__device__ __forceinline__ void ds_read16_s272(const LAS unsigned char* p, unsigned (&r)[16]) {
    const unsigned a = (unsigned)(__SIZE_TYPE__)p;
    asm volatile("ds_read_u16 %0, %16 offset:0\n\tds_read_u16 %1, %16 offset:272\n\tds_read_u16 %2, %16 offset:544\n\tds_read_u16 %3, %16 offset:816\n\tds_read_u16 %4, %16 offset:1088\n\tds_read_u16 %5, %16 offset:1360\n\tds_read_u16 %6, %16 offset:1632\n\tds_read_u16 %7, %16 offset:1904\n\tds_read_u16 %8, %16 offset:2176\n\tds_read_u16 %9, %16 offset:2448\n\tds_read_u16 %10, %16 offset:2720\n\tds_read_u16 %11, %16 offset:2992\n\tds_read_u16 %12, %16 offset:3264\n\tds_read_u16 %13, %16 offset:3536\n\tds_read_u16 %14, %16 offset:3808\n\tds_read_u16 %15, %16 offset:4080\n\ts_waitcnt lgkmcnt(0)"
        : "=&v"(r[0]), "=&v"(r[1]), "=&v"(r[2]), "=&v"(r[3]), "=&v"(r[4]), "=&v"(r[5]), "=&v"(r[6]), "=&v"(r[7]), "=&v"(r[8]), "=&v"(r[9]), "=&v"(r[10]), "=&v"(r[11]), "=&v"(r[12]), "=&v"(r[13]), "=&v"(r[14]), "=&v"(r[15]) : "v"(a) : "memory");
}
__device__ __forceinline__ void ds_read16_s528(const LAS unsigned char* p, unsigned (&r)[16]) {
    const unsigned a = (unsigned)(__SIZE_TYPE__)p;
    asm volatile("ds_read_u16 %0, %16 offset:0\n\tds_read_u16 %1, %16 offset:528\n\tds_read_u16 %2, %16 offset:1056\n\tds_read_u16 %3, %16 offset:1584\n\tds_read_u16 %4, %16 offset:2112\n\tds_read_u16 %5, %16 offset:2640\n\tds_read_u16 %6, %16 offset:3168\n\tds_read_u16 %7, %16 offset:3696\n\tds_read_u16 %8, %16 offset:4224\n\tds_read_u16 %9, %16 offset:4752\n\tds_read_u16 %10, %16 offset:5280\n\tds_read_u16 %11, %16 offset:5808\n\tds_read_u16 %12, %16 offset:6336\n\tds_read_u16 %13, %16 offset:6864\n\tds_read_u16 %14, %16 offset:7392\n\tds_read_u16 %15, %16 offset:7920\n\ts_waitcnt lgkmcnt(0)"
        : "=&v"(r[0]), "=&v"(r[1]), "=&v"(r[2]), "=&v"(r[3]), "=&v"(r[4]), "=&v"(r[5]), "=&v"(r[6]), "=&v"(r[7]), "=&v"(r[8]), "=&v"(r[9]), "=&v"(r[10]), "=&v"(r[11]), "=&v"(r[12]), "=&v"(r[13]), "=&v"(r[14]), "=&v"(r[15]) : "v"(a) : "memory");
}
__device__ __forceinline__ void ds_read16_red(const LAS unsigned char* p, float (&r)[16]) {
    const unsigned a = (unsigned)(__SIZE_TYPE__)p;
    asm volatile("ds_read_b32 %0, %16 offset:0\n\tds_read_b32 %1, %16 offset:256\n\tds_read_b32 %2, %16 offset:512\n\tds_read_b32 %3, %16 offset:768\n\tds_read_b32 %4, %16 offset:1024\n\tds_read_b32 %5, %16 offset:1280\n\tds_read_b32 %6, %16 offset:1536\n\tds_read_b32 %7, %16 offset:1792\n\tds_read_b32 %8, %16 offset:64\n\tds_read_b32 %9, %16 offset:320\n\tds_read_b32 %10, %16 offset:576\n\tds_read_b32 %11, %16 offset:832\n\tds_read_b32 %12, %16 offset:1088\n\tds_read_b32 %13, %16 offset:1344\n\tds_read_b32 %14, %16 offset:1600\n\tds_read_b32 %15, %16 offset:1856\n\ts_waitcnt lgkmcnt(0)"
        : "=&v"(r[0]), "=&v"(r[1]), "=&v"(r[2]), "=&v"(r[3]), "=&v"(r[4]), "=&v"(r[5]), "=&v"(r[6]), "=&v"(r[7]), "=&v"(r[8]), "=&v"(r[9]), "=&v"(r[10]), "=&v"(r[11]), "=&v"(r[12]), "=&v"(r[13]), "=&v"(r[14]), "=&v"(r[15]) : "v"(a) : "memory");
}
template <int DV>
__device__ __forceinline__ void load_raw_v(const bf16* base, int ld, int vcol, int tid, u32x4 (&rv)[DV / 64]) {
#pragma unroll
    for (int i = 0; i < DV / 64; ++i) { const int c = tid + i * NT, row = c / (DV / 8), part = c % (DV / 8); rv[i] = *(const u32x4*)(base + (size_t)row * ld + vcol + part * 8); }
}
template <int DV>
__device__ __forceinline__ void store_raw_v(LAS unsigned char* lds, int tid, const u32x4 (&rv)[DV / 64]) {
#pragma unroll
    for (int i = 0; i < DV / 64; ++i) { const int c = tid + i * NT, row = c / (DV / 8), part = c % (DV / 8); *(LAS u32x4*)(lds + L_VS + row * VS_STR + part * 16) = rv[i]; }
}
__device__ __forceinline__ void load_raw128(const bf16* base, int ld, int col, int tid, u32x4 (&r)[2]) {
#pragma unroll
    for (int i = 0; i < 2; ++i) { const int c = tid + i * NT; r[i] = *(const u32x4*)(base + (size_t)(c >> 4) * ld + col + (c & 15) * 8); }
}
__device__ __forceinline__ void store_raw128(LAS unsigned char* lds, int off, int tid, const u32x4 (&r)[2]) {
#pragma unroll
    for (int i = 0; i < 2; ++i) { const int c = tid + i * NT; *(LAS u32x4*)(lds + off + (c >> 4) * QS_STR + (c & 15) * 16) = r[i]; }
}
template <int DV>
__device__ __forceinline__ void transpose_v(LAS unsigned char* lds, int tid) {
    constexpr int RPT = DV / 8;
    const int v = tid % DV, part = tid / DV;
    unsigned w[RPT / 2];
#pragma unroll
    for (int h = 0; h < RPT / 16; ++h) { unsigned r[16]; ds_read16_s528(lds + L_VS + (part * RPT + 16 * h) * VS_STR + v * 2, r);
#pragma unroll
        for (int i = 0; i < 8; ++i) w[8 * h + i] = r[2 * i] | (r[2 * i + 1] << 16); }
    LAS u32x4* dst = (LAS u32x4*)(lds + L_VT + v * KT_STR + part * RPT * 2);
#pragma unroll
    for (int i = 0; i < RPT / 8; ++i) dst[i] = (u32x4){w[4 * i], w[4 * i + 1], w[4 * i + 2], w[4 * i + 3]};
}
__device__ __forceinline__ void cumsum_local(LAS unsigned char* lds, int d, int rg, float (&bb)[16]) {
    unsigned r[16]; ds_read16_s272(lds + L_LA + (rg * 16) * QS_STR + d * 2, r);
#pragma unroll
    for (int i = 0; i < 16; ++i) bb[i] = __uint_as_float(r[i] << 16);
}
__device__ __forceinline__ void cumsum_scan(LAS unsigned char* lds, int d, int rg, float (&bb)[16]) {
#pragma unroll
    for (int i = 1; i < 16; ++i) bb[i] += bb[i - 1];
    ((LAS float*)(lds + L_TOT))[rg * 128 + d] = bb[15];
}
__device__ __forceinline__ void cumsum_finish(LAS unsigned char* lds, int d, int rg, float (&bb)[16], float& blast) {
    const LAS float* tot = (const LAS float*)(lds + L_TOT);
    const float t0 = tot[d], t1 = tot[128 + d], t2 = tot[256 + d], t3 = tot[384 + d];
    const float off = rg == 0 ? 0.f : (rg == 1 ? t0 : (rg == 2 ? t0 + t1 : t0 + t1 + t2));
    blast = (t0 + t1) + (t2 + t3);
#pragma unroll
    for (int i = 0; i < 16; ++i) bb[i] += off;
}
template <int DV, bool HGRN>
__device__ __forceinline__ void pass_a(LAS unsigned char* lds, const bf16* proj, bf16* GS, float* DEC, int G, int bid, const int tid) {
    constexpr int H = HGRN ? 8 : 4, LD = HGRN ? HGRN_N : GLA_N, NTW = DV / 128, NU = BATCH * H * NCH;
    const int lane = tid & 63, wave = tid >> 6, g = lane >> 4, l15 = lane & 15, d = tid & 127, rg = tid >> 7;
    u32x4 rla[2], rk[2], rv[DV / 64];
    int u = bid;
    if (u < NU) { const int b = u / (H * NCH), h = (u / NCH) % H, n = u % NCH; const bf16* base = proj + (size_t)(b * T + n * CH) * LD;
        load_raw128(base, LD, 1024 + h * 128, tid, rla); if (!HGRN) load_raw128(base, LD, 512 + h * 128, tid, rk); load_raw_v<DV>(base, LD, (HGRN ? 3072 : 2560) + h * DV, tid, rv); }
    for (; u < NU; u += G) {
        store_raw128(lds, L_LA, tid, rla); if (!HGRN) store_raw128(lds, L_KS, tid, rk); store_raw_v<DV>(lds, tid, rv);
        __syncthreads();
        { const int un = u + G; if (un < NU) { const int b = un / (H * NCH), h = (un / NCH) % H, n = un % NCH; const bf16* base = proj + (size_t)(b * T + n * CH) * LD;
            load_raw128(base, LD, 1024 + h * 128, tid, rla); if (!HGRN) load_raw128(base, LD, 512 + h * 128, tid, rk); load_raw_v<DV>(base, LD, (HGRN ? 3072 : 2560) + h * DV, tid, rv); } }
        float bb[16], kv[16], blast;
        cumsum_local(lds, d, rg, bb);
        if (HGRN) {
#pragma unroll
            for (int i = 0; i < 16; ++i) kv[i] = 1.0f - __expf(bb[i]);
        } else { unsigned r[16]; ds_read16_s272(lds + L_KS + (rg * 16) * QS_STR + d * 2, r);
#pragma unroll
            for (int i = 0; i < 16; ++i) kv[i] = __uint_as_float(r[i] << 16); }
        cumsum_scan(lds, d, rg, bb);
        transpose_v<DV>(lds, tid);
        __syncthreads();
        cumsum_finish(lds, d, rg, bb, blast);
        { unsigned w[8];
#pragma unroll
          for (int i = 0; i < 8; ++i) w[i] = pk2(kv[2 * i] * __expf(-bb[2 * i]), kv[2 * i + 1] * __expf(-bb[2 * i + 1]));
          LAS u32x4* dst = (LAS u32x4*)(lds + L_KT + d * KT_STR + rg * 32);
          dst[0] = (u32x4){w[0], w[1], w[2], w[3]}; dst[1] = (u32x4){w[4], w[5], w[6], w[7]}; }
        if (rg == 0) DEC[(size_t)u * 128 + d] = __expf(blast);
        __syncthreads();
        f32x4 acc[8][NTW];
#pragma unroll
        for (int mt = 0; mt < 8; ++mt)
#pragma unroll
            for (int nt = 0; nt < NTW; ++nt) acc[mt][nt] = (f32x4){0.f, 0.f, 0.f, 0.f};
#pragma unroll
        for (int kk = 0; kk < 2; ++kk) {
            bf16x8 bfr[NTW], afr[8];
#pragma unroll
            for (int nt = 0; nt < NTW; ++nt) bfr[nt] = *(const LAS bf16x8*)(lds + L_VT + ((wave * NTW + nt) * 16 + l15) * KT_STR + (kk * 32 + 8 * g) * 2);
#pragma unroll
            for (int mt = 0; mt < 8; ++mt) afr[mt] = *(const LAS bf16x8*)(lds + L_KT + ((mt >> 1) * 32 + 8 * (l15 >> 2) + 4 * (mt & 1) + (l15 & 3)) * KT_STR + (kk * 32 + 8 * g) * 2);
#pragma unroll
            for (int mt = 0; mt < 8; ++mt)
#pragma unroll
                for (int nt = 0; nt < NTW; ++nt) acc[mt][nt] = MFMA16(afr[mt], bfr[nt], acc[mt][nt]);
        }
#pragma unroll
        for (int mt = 0; mt < 8; ++mt)
#pragma unroll
            for (int nt = 0; nt < NTW; ++nt) asm volatile("s_nop 7\n\ts_nop 7" : "+v"(acc[mt][nt]));
#pragma unroll
        for (int nt = 0; nt < NTW; ++nt) { bf16* gp = GS + ((size_t)u * DV + (wave * NTW + nt) * 16 + l15) * 128 + 8 * g;
#pragma unroll
            for (int P = 0; P < 4; ++P) { u32x4 w; w.x = pk2(acc[2 * P][nt][0], acc[2 * P][nt][1]); w.y = pk2(acc[2 * P][nt][2], acc[2 * P][nt][3]);
                w.z = pk2(acc[2 * P + 1][nt][0], acc[2 * P + 1][nt][1]); w.w = pk2(acc[2 * P + 1][nt][2], acc[2 * P + 1][nt][3]); *(u32x4*)(gp + P * 32) = w; } }
    }
    __syncthreads();
}
template <int DV, bool HGRN, bool DRY = false>
__device__ __forceinline__ void pass_b(bf16* GS, const float* DEC, int G, int bid, const int tid) {
    constexpr int H = HGRN ? 8 : 4, E = DV * 128, E4 = E / 4;
    const int nthreads = G * NT;
    for (int i = bid * NT + tid; i < BATCH * H * E4; i += nthreads) {
        const int bh = i / E4, e = (i % E4) * 4, d = e & 127;
        float S0 = 0.f, S1 = 0.f, S2 = 0.f, S3 = 0.f;
        u32x2* gp = (u32x2*)(GS + (size_t)bh * NCH * E + e); const f32x4* dp = (const f32x4*)(DEC + (size_t)bh * NCH * 128 + d);
        for (int n0 = 0; n0 < NCH; n0 += 8) {
            u32x2 gv[8]; f32x4 dv[8];
#pragma unroll
            for (int q = 0; q < 8; ++q) { gv[q] = gp[(size_t)(n0 + q) * (E / 4)]; dv[q] = dp[(size_t)(n0 + q) * 32]; }
#pragma unroll
            for (int q = 0; q < 8; ++q) {
                u32x2 o; o.x = pk2(S0, S1); o.y = pk2(S2, S3); if (!DRY || o.x == 0x12345678u) gp[(size_t)(n0 + q) * (E / 4)] = o;
                S0 = dv[q].x * (S0 + __uint_as_float(gv[q].x << 16)); S1 = dv[q].y * (S1 + __uint_as_float(gv[q].x & 0xffff0000u));
                S2 = dv[q].z * (S2 + __uint_as_float(gv[q].y << 16)); S3 = dv[q].w * (S3 + __uint_as_float(gv[q].y & 0xffff0000u)); }
        }
    }
}
template <int DV, bool HGRN, bool DRY = false>
__device__ __forceinline__ void pass_c(LAS unsigned char* lds, bf16* proj, const bf16* GS, int G, int bid, const int tid) {
    constexpr int H = HGRN ? 8 : 4, LD = HGRN ? HGRN_N : GLA_N, MTW = 2, VB = DV / 32, NTC = VB / 2, NU = BATCH * H * NCH;
    const int lane = tid & 63, wave = tid >> 6, g = lane >> 4, l15 = lane & 15, d = tid & 127, rg = tid >> 7;
    const int vb = wave % VB, th = wave / VB, v0 = vb * 32, vrow = v0 + 8 * (l15 >> 2) + (l15 & 3);
    u32x4 rla[2], rq[2], rk[2], rv[DV / 64];
    int u = bid;
    if (u < NU) { const int b = u / (H * NCH), h = (u / NCH) % H, n = u % NCH; const bf16* base = proj + (size_t)(b * T + n * CH) * LD;
        load_raw128(base, LD, 1024 + h * 128, tid, rla); load_raw128(base, LD, h * 128, tid, rq); if (!HGRN) load_raw128(base, LD, 512 + h * 128, tid, rk); load_raw_v<DV>(base, LD, (HGRN ? 3072 : 2560) + h * DV, tid, rv); }
    for (; u < NU; u += G) {
        const int b = u / (H * NCH), h = (u / NCH) % H, n = u % NCH;
        bf16* base = proj + (size_t)(b * T + n * CH) * LD;
        const int vcol = (HGRN ? 3072 : 2560) + h * DV, gcol = (HGRN ? 2048 : 1536) + h * DV;
        store_raw128(lds, L_LA, tid, rla); store_raw128(lds, L_QS, tid, rq); if (!HGRN) store_raw128(lds, L_KS, tid, rk); store_raw_v<DV>(lds, tid, rv);
        __syncthreads();
        bf16x8 sfr[4][MTW];
#pragma unroll
        for (int kk = 0; kk < 4; ++kk)
#pragma unroll
            for (int mt = 0; mt < MTW; ++mt) sfr[kk][mt] = *(const bf16x8*)(GS + ((size_t)u * DV + vrow + 4 * mt) * 128 + kk * 32 + 8 * g);
        { const int un = u + G; if (un < NU) { const int b2 = un / (H * NCH), h2 = (un / NCH) % H, n2 = un % NCH; const bf16* nb = proj + (size_t)(b2 * T + n2 * CH) * LD;
            load_raw128(nb, LD, 1024 + h2 * 128, tid, rla); load_raw128(nb, LD, h2 * 128, tid, rq); if (!HGRN) load_raw128(nb, LD, 512 + h2 * 128, tid, rk); load_raw_v<DV>(nb, LD, (HGRN ? 3072 : 2560) + h2 * DV, tid, rv); } }
        float bb[16], kv[16], blast;
        cumsum_local(lds, d, rg, bb);
        if (HGRN) {
#pragma unroll
            for (int i = 0; i < 16; ++i) kv[i] = 1.0f - __expf(bb[i]);
        } else { unsigned r[16]; ds_read16_s272(lds + L_KS + (rg * 16) * QS_STR + d * 2, r);
#pragma unroll
            for (int i = 0; i < 16; ++i) kv[i] = __uint_as_float(r[i] << 16); }
        cumsum_scan(lds, d, rg, bb);
        transpose_v<DV>(lds, tid);
        __syncthreads();
        cumsum_finish(lds, d, rg, bb, blast);
        { unsigned rq_[16]; ds_read16_s272(lds + L_QS + (rg * 16) * QS_STR + d * 2, rq_);
#pragma unroll
          for (int i = 0; i < 16; ++i) { const int s = rg * 16 + i; LAS bf16* qa = (LAS bf16*)(lds + L_QS + s * QS_STR + d * 2); LAS bf16* ka = (LAS bf16*)(lds + L_KS + s * QS_STR + d * 2);
              const float q = __uint_as_float(rq_[i] << 16); *qa = (bf16)f2bf(q * __expf(bb[i])); *ka = (bf16)f2bf(kv[i] * __expf(-bb[i])); } }
        __syncthreads();
        { const int tt = wave >> 1;
#pragma unroll
          for (int si = 0; si < 2; ++si) { const int st = (wave & 1) * 2 + si; f32x4 c = (f32x4){0.f, 0.f, 0.f, 0.f};
              bf16x8 afr[4], bfr[4];
#pragma unroll
              for (int kk = 0; kk < 4; ++kk) { afr[kk] = *(const LAS bf16x8*)(lds + L_KS + (st * 16 + l15) * QS_STR + (kk * 32 + 8 * g) * 2);
                  bfr[kk] = *(const LAS bf16x8*)(lds + L_QS + (tt * 16 + l15) * QS_STR + (kk * 32 + 8 * g) * 2); }
#pragma unroll
              for (int kk = 0; kk < 4; ++kk) c = MFMA16(afr[kk], bfr[kk], c);
              const int t = tt * 16 + l15, s0 = st * 16 + 4 * g;
              u32x2 w; w.x = pk2(s0 <= t ? c[0] : 0.f, s0 + 1 <= t ? c[1] : 0.f); w.y = pk2(s0 + 2 <= t ? c[2] : 0.f, s0 + 3 <= t ? c[3] : 0.f);
              *(LAS u32x2*)(lds + L_AT + t * KT_STR + s0 * 2) = w; } }
        u32x4 gt[NTC];
#pragma unroll
        for (int nt = 0; nt < NTC; ++nt) gt[nt] = *(const u32x4*)(base + (size_t)((th * NTC + nt) * 16 + l15) * LD + gcol + v0 + 8 * g);
        __syncthreads();
        f32x4 acc[MTW][NTC];
#pragma unroll
        for (int mt = 0; mt < MTW; ++mt)
#pragma unroll
            for (int nt = 0; nt < NTC; ++nt) acc[mt][nt] = (f32x4){0.f, 0.f, 0.f, 0.f};
#pragma unroll
        for (int kp = 0; kp < 2; ++kp) {
            bf16x8 bfr[2][NTC];
#pragma unroll
            for (int k2 = 0; k2 < 2; ++k2)
#pragma unroll
                for (int nt = 0; nt < NTC; ++nt) bfr[k2][nt] = *(const LAS bf16x8*)(lds + L_QS + ((th * NTC + nt) * 16 + l15) * QS_STR + ((kp * 2 + k2) * 32 + 8 * g) * 2);
#pragma unroll
            for (int k2 = 0; k2 < 2; ++k2)
#pragma unroll
                for (int nt = 0; nt < NTC; ++nt)
#pragma unroll
                    for (int mt = 0; mt < MTW; ++mt) acc[mt][nt] = MFMA16(sfr[kp * 2 + k2][mt], bfr[k2][nt], acc[mt][nt]);
        }
        {
            bf16x8 afr[2][MTW], bfr[2][NTC];
#pragma unroll
            for (int kk = 0; kk < 2; ++kk) {
#pragma unroll
                for (int mt = 0; mt < MTW; ++mt) afr[kk][mt] = *(const LAS bf16x8*)(lds + L_VT + (vrow + 4 * mt) * KT_STR + (kk * 32 + 8 * g) * 2);
#pragma unroll
                for (int nt = 0; nt < NTC; ++nt) bfr[kk][nt] = *(const LAS bf16x8*)(lds + L_AT + ((th * NTC + nt) * 16 + l15) * KT_STR + (kk * 32 + 8 * g) * 2); }
#pragma unroll
            for (int kk = 0; kk < 2; ++kk)
#pragma unroll
                for (int nt = 0; nt < NTC; ++nt)
#pragma unroll
                    for (int mt = 0; mt < MTW; ++mt) acc[mt][nt] = MFMA16(afr[kk][mt], bfr[kk][nt], acc[mt][nt]);
        }
        LAS float* red = (LAS float*)(lds + L_RED);
        { float pp[NTC];
#pragma unroll
          for (int nt = 0; nt < NTC; ++nt) { float p = 0.f;
#pragma unroll
              for (int mt = 0; mt < MTW; ++mt) p += (acc[mt][nt][0] * acc[mt][nt][0] + acc[mt][nt][1] * acc[mt][nt][1]) + (acc[mt][nt][2] * acc[mt][nt][2] + acc[mt][nt][3] * acc[mt][nt][3]);
              pp[nt] = p; }
          if constexpr (NTC == 4) { pg8::shx_add4(pp, 16, lane); pg8::shx_add4(pp, 32, lane); } else { pg8::shx_add2(pp, 16, lane); pg8::shx_add2(pp, 32, lane); }
          if (g == 0) {
#pragma unroll
              for (int nt = 0; nt < NTC; ++nt) red[vb * 64 + (th * NTC + nt) * 16 + l15] = pp[nt]; } }
        __syncthreads();
        float rsum[NTC];
#pragma unroll
        for (int np = 0; np < NTC / 2; ++np) { float r16[16]; ds_read16_red(lds + L_RED + ((th * NTC + 2 * np) * 16 + l15) * 4, r16);
#pragma unroll
            for (int q = 0; q < 2; ++q) { float s = 0.f;
#pragma unroll
                for (int w = 0; w < VB; ++w) s += r16[q * 8 + w];
                rsum[2 * np + q] = s; } }
#pragma unroll
        for (int nt = 0; nt < NTC; ++nt) { const int t = (th * NTC + nt) * 16 + l15; const float s = rsum[nt];
            const float rstd = rsqrtf(s * (1.0f / DV) + EPS);
            bf16* rowp = base + (size_t)t * LD; const u32x4 gg = gt[nt];
            u32x4 w; w.x = pk2(acc[0][nt][0] * rstd * __uint_as_float(gg.x << 16), acc[0][nt][1] * rstd * __uint_as_float(gg.x & 0xffff0000u));
            w.y = pk2(acc[0][nt][2] * rstd * __uint_as_float(gg.y << 16), acc[0][nt][3] * rstd * __uint_as_float(gg.y & 0xffff0000u));
            w.z = pk2(acc[1][nt][0] * rstd * __uint_as_float(gg.z << 16), acc[1][nt][1] * rstd * __uint_as_float(gg.z & 0xffff0000u));
            w.w = pk2(acc[1][nt][2] * rstd * __uint_as_float(gg.w << 16), acc[1][nt][3] * rstd * __uint_as_float(gg.w & 0xffff0000u));
            if (!DRY || w.x == 0x12345678u) *(u32x4*)(rowp + vcol + v0 + 8 * g) = w; }
    }
    __syncthreads();
}
constexpr int KL_STR = 272, VL_STR = 528, L_KL = 0, L_VL = 256 * KL_STR;
static_assert(L_VL + 128 * VL_STR <= LDS_BYTES, "xattn LDS map");
template <bool DRY = false>
__device__ __forceinline__ void xattn(LAS unsigned char* lds, bf16* proj, int LD, int xcol, const bf16* KM, const bf16* VMT, int G, int bid, const int tid) {
    const int lane = tid & 63, wave = tid >> 6, g = lane >> 4, l15 = lane & 15;
    for (int w = bid; w < 256; w += G) {
        const int pair = w >> 4, sub = w & 15, b = pair >> 2, h = pair & 3;
        __syncthreads();
#pragma unroll
        for (int i = 0; i < 8; ++i) { const int c = tid + i * NT, m = c >> 4, part = c & 15;
            *(LAS u32x4*)(lds + L_KL + m * KL_STR + part * 16) = *(const u32x4*)(KM + (size_t)(b * 256 + m) * 512 + h * 128 + part * 8); }
#pragma unroll
        for (int i = 0; i < 8; ++i) { const int c = tid + i * NT, dd = c >> 5, part = c & 31;
            *(LAS u32x4*)(lds + L_VL + dd * VL_STR + part * 16) = *(const u32x4*)(VMT + ((size_t)b * 512 + h * 128 + dd) * 256 + part * 8); }
        __syncthreads();
        bf16x8 qn[4];
        { const bf16* q0 = proj + (size_t)(b * T + (sub * 4) * 128 + wave * 16 + l15) * LD + xcol + h * 128;
#pragma unroll
          for (int kk = 0; kk < 4; ++kk) qn[kk] = *(const bf16x8*)(q0 + kk * 32 + 8 * g); }
        for (int tile = 0; tile < 4; ++tile) {
            const int r0 = b * T + (sub * 4 + tile) * 128 + wave * 16;
            bf16* qp = proj + (size_t)(r0 + l15) * LD + xcol + h * 128;
            bf16x8 qf[4];
#pragma unroll
            for (int kk = 0; kk < 4; ++kk) qf[kk] = qn[kk];
            if (tile < 3) {
#pragma unroll
                for (int kk = 0; kk < 4; ++kk) qn[kk] = *(const bf16x8*)(qp + (size_t)128 * LD + kk * 32 + 8 * g); }
            f32x4 sc[16];
#pragma unroll
            for (int mp = 0; mp < 8; ++mp) {
                bf16x8 afr[2][4];
#pragma unroll
                for (int m2 = 0; m2 < 2; ++m2)
#pragma unroll
                    for (int kk = 0; kk < 4; ++kk) afr[m2][kk] = *(const LAS bf16x8*)(lds + L_KL + ((mp * 2 + m2) * 16 + l15) * KL_STR + (kk * 32 + 8 * g) * 2);
#pragma unroll
                for (int m2 = 0; m2 < 2; ++m2) { f32x4 c = (f32x4){0.f, 0.f, 0.f, 0.f};
#pragma unroll
                    for (int kk = 0; kk < 4; ++kk) c = MFMA16(afr[m2][kk], qf[kk], c);
                    sc[mp * 2 + m2] = c; } }
            float mx = -1e30f;
#pragma unroll
            for (int mt = 0; mt < 16; ++mt) mx = fmaxf(mx, fmaxf(fmaxf(sc[mt][0], sc[mt][1]), fmaxf(sc[mt][2], sc[mt][3])));
            mx = fmaxf(mx, pg8::shx(mx, 16, lane)); mx = fmaxf(mx, pg8::shx(mx, 32, lane));
            float sum = 0.f;
#pragma unroll
            for (int mt = 0; mt < 16; ++mt) {
#pragma unroll
                for (int j = 0; j < 4; ++j) { const float p = __expf(sc[mt][j] - mx); sc[mt][j] = p; sum += p; } }
            sum += pg8::shx(sum, 16, lane); sum += pg8::shx(sum, 32, lane);
            const float inv = 1.0f / sum;
            f32x4 oa[8];
#pragma unroll
            for (int dt = 0; dt < 8; ++dt) oa[dt] = (f32x4){0.f, 0.f, 0.f, 0.f};
#pragma unroll
            for (int kb = 0; kb < 8; ++kb) {
                union { bf16x8 v; unsigned u[4]; } pb;
                pb.u[0] = pk2(sc[2 * kb][0], sc[2 * kb][1]); pb.u[1] = pk2(sc[2 * kb][2], sc[2 * kb][3]); pb.u[2] = pk2(sc[2 * kb + 1][0], sc[2 * kb + 1][1]); pb.u[3] = pk2(sc[2 * kb + 1][2], sc[2 * kb + 1][3]);
                union { bf16x8 v; u32x2 h[2]; } pa[8];
#pragma unroll
                for (int dt = 0; dt < 8; ++dt) { const LAS unsigned char* vp = lds + L_VL + ((dt >> 1) * 32 + 8 * (l15 >> 2) + 4 * (dt & 1) + (l15 & 3)) * VL_STR + (kb * 32 + 4 * g) * 2;
                    pa[dt].h[0] = *(const LAS u32x2*)vp; pa[dt].h[1] = *(const LAS u32x2*)(vp + 32); }
#pragma unroll
                for (int dt = 0; dt < 8; ++dt) oa[dt] = MFMA16(pa[dt].v, pb.v, oa[dt]);
            }
#pragma unroll
            for (int P = 0; P < 4; ++P) { u32x4 o; o.x = pk2(oa[2 * P][0] * inv, oa[2 * P][1] * inv); o.y = pk2(oa[2 * P][2] * inv, oa[2 * P][3] * inv);
                o.z = pk2(oa[2 * P + 1][0] * inv, oa[2 * P + 1][1] * inv); o.w = pk2(oa[2 * P + 1][2] * inv, oa[2 * P + 1][3] * inv); if (!DRY || o.x == 0x12345678u) *(u32x4*)(qp + P * 32 + 8 * g) = o; }
        }
    }
    __syncthreads();
}
__device__ __forceinline__ void final_norm(float* out, const bf16* XB, const float* SS, const float* gain, int gw, int ngw, int lane) {
    f32x4 gv[4];
#pragma unroll
    for (int j = 0; j < 4; ++j) gv[j] = ((const f32x4*)gain)[lane + 64 * j];
    for (int m = gw; m < M; m += 2 * ngw) {
        const int m1 = (m + ngw < M) ? m + ngw : m; const bool two = (m1 != m);
        float sv[2]; sv[0] = lane < 16 ? SS[(size_t)lane * M + m] : 0.f; sv[1] = lane < 16 ? SS[(size_t)lane * M + m1] : 0.f;
        const u32x2* xr0 = (const u32x2*)(XB + (size_t)m * D) + lane; const u32x2* xr1 = (const u32x2*)(XB + (size_t)m1 * D) + lane;
        u32x2 xa[4], xb_[4];
#pragma unroll
        for (int j = 0; j < 4; ++j) { xa[j] = xr0[64 * j]; xb_[j] = xr1[64 * j]; }
#pragma unroll
        for (int o = 1; o < 64; o <<= 1) pg8::shx_add2(sv, o, lane);
        const float rstd0 = rsqrtf(sv[0] * (1.0f / D) + EPS), rstd1 = rsqrtf(sv[1] * (1.0f / D) + EPS);
        f32x4* or0 = (f32x4*)(out + (size_t)m * D) + lane; f32x4* or1 = (f32x4*)(out + (size_t)m1 * D) + lane;
#pragma unroll
        for (int j = 0; j < 4; ++j) { const u32x2 xw = xa[j]; f32x4 v = (f32x4){__uint_as_float(xw.x << 16), __uint_as_float(xw.x & 0xffff0000u), __uint_as_float(xw.y << 16), __uint_as_float(xw.y & 0xffff0000u)};
            or0[64 * j] = v * rstd0 * gv[j]; }
        if (two) {
#pragma unroll
            for (int j = 0; j < 4; ++j) { const u32x2 xw = xb_[j]; f32x4 v = (f32x4){__uint_as_float(xw.x << 16), __uint_as_float(xw.x & 0xffff0000u), __uint_as_float(xw.y << 16), __uint_as_float(xw.y & 0xffff0000u)};
                or1[64 * j] = v * rstd1 * gv[j]; } }
    }
}

struct Args { Ptrs P; int ph_lo, ph_hi; };
constexpr int N_PHASES = 2 + 7 * DEPTH;
__global__ void __launch_bounds__(NT, 2) fwd_kernel(Args a) {
    extern __shared__ __attribute__((aligned(16))) unsigned char lds_raw[];
#if ONE_LAUNCH
    cg::grid_group grid = cg::this_grid();
    { volatile LAS unsigned* st = (volatile LAS unsigned*)((LAS unsigned char*)lds_raw + LDS_BARST); int t0_ = threadIdx.x; if (t0_ == 0) { st[0] = 0u; st[1] = 0u; } __syncthreads();
      (void)xcd_barrier_post((unsigned*)(a.P.ws + WS_CTL), st, t0_); }
#define SEAM() do { XcdBarrier xb_; xb_.bar = (unsigned*)(ws + WS_CTL); xb_.x = xb_xcc_id(); xb_.st = (volatile LAS unsigned*)(lds + LDS_BARST); xcd_barrier(xb_, tid); if (ph == 0) grid.sync(); } while (0)
#else
#define SEAM() do {} while (0)
#endif
    const int ph_lo = a.ph_lo, ph_hi = a.ph_hi;
    const int wave0 = __builtin_amdgcn_readfirstlane(threadIdx.x >> 6);
    for (int ph = ph_lo; ph < ph_hi; ++ph) {
        const __attribute__((address_space(4))) Args* ap = (const __attribute__((address_space(4))) Args*)__builtin_amdgcn_kernarg_segment_ptr();
        asm volatile("" : "+s"(ap));
        int zero_ = 0; asm volatile("" : "+v"(zero_));
        int tid = wave0 * 64 + (int)__builtin_amdgcn_mbcnt_hi(~0u, __builtin_amdgcn_mbcnt_lo(~0u, (unsigned)zero_)); asm volatile("" : "+v"(tid));
        LAS unsigned char* lds = (LAS unsigned char*)lds_raw;
        const int lane = tid & 63, wave = __builtin_amdgcn_readfirstlane(tid >> 6);
        int G = gridDim.x, bid = blockIdx.x; asm volatile("" : "+s"(G), "+s"(bid));
        const int gw = bid * NWAVES + wave, ngw = G * NWAVES;
        unsigned char* ws = ap->P.ws;
        float* SS = (float*)(ws + WS_SS); bf16* XB = (bf16*)ap->P.out; bf16* GS = (bf16*)(ws + WS_XB); bf16* X2 = (bf16*)(ws + WS_XB); bf16* PROJ = (bf16*)(ws + WS_PROJ);
        int ngemm = 0;
        int L = 0, sp = 0; bool hg = false;
        if (ph == 0) { prologue(&ap->P, lds, gw, ngw, wave, lane); }
        else if (ph == N_PHASES - 1) { final_norm(ap->P.out, X2, SS, ap->P.final_norm, gw, ngw, lane); }
        else {
            L = (ph - 1) / 7; sp = (ph - 1) % 7; hg = (L & 1);
            const int LD = hg ? HGRN_N : GLA_N;
            if (sp == 0) ngemm = (L == 0) ? 2 : 1;
            else if (sp == 1) {
                float* DEC = (float*)(ws + WS_DEC);
#if EXP == 3
                if (hg) pass_a<128, true>(lds, PROJ, GS, DEC, G, bid, tid); else pass_a<256, false>(lds, PROJ, GS, DEC, G, bid, tid);
#endif
                if (hg) pass_a<128, true>(lds, PROJ, GS, DEC, G, bid, tid); else pass_a<256, false>(lds, PROJ, GS, DEC, G, bid, tid);
#if EXP == 5
                xattn<true>(lds, PROJ, LD, hg ? 4096 : 3584, (const bf16*)(ws + WS_KM) + (size_t)L * 1024 * 512, (const bf16*)(ws + WS_VMT) + (size_t)L * 4 * 512 * 256, G, bid, tid);
#endif
#if EXP == 6
                if (L + 1 < DEPTH) { convert_layer(&ap->P, L + 1, lds, gw, ngw, wave, lane); } __syncthreads();
#endif
                xattn(lds, PROJ, LD, hg ? 4096 : 3584, (const bf16*)(ws + WS_KM) + (size_t)L * 1024 * 512, (const bf16*)(ws + WS_VMT) + (size_t)L * 4 * 512 * 256, G, bid, tid);
                if (L + 1 < DEPTH) { convert_layer(&ap->P, L + 1, lds, gw, ngw, wave, lane); }
            } else if (sp == 2) {
                const float* DEC = (const float*)(ws + WS_DEC);
#if EXP == 3
                if (hg) pass_b<128, true, true>(GS, DEC, G, bid, tid); else pass_b<256, false, true>(GS, DEC, G, bid, tid);
#endif
                if (hg) pass_b<128, true>(GS, DEC, G, bid, tid); else pass_b<256, false>(GS, DEC, G, bid, tid);
            } else if (sp == 3) {
#if EXP == 4
                if (hg) pass_c<128, true, true>(lds, PROJ, GS, G, bid, tid); else pass_c<256, false, true>(lds, PROJ, GS, G, bid, tid);
#endif
                if (hg) pass_c<128, true>(lds, PROJ, GS, G, bid, tid); else pass_c<256, false>(lds, PROJ, GS, G, bid, tid);
            } else ngemm = 1;
            if (EXP == 2 && (sp == 0 || sp == 5)) ngemm += 8;
        }
        for (int rep = 0; rep < (ngemm & 7) * (ngemm >= 8 ? 2 : 1); ++rep) {
            unsigned char* wb = ws + WS_WT + (size_t)(L & 1) * WT_BUF;
            const int LD = hg ? HGRN_N : GLA_N;
            pg8::Gemm g; pg8::EpiAll E; E.hgrn = hg ? 1 : 0; E.M = M; E.aux = nullptr; E.xin = nullptr; E.xout = nullptr;
            if (sp == 0 && (ngemm & 7) == 2 && (rep & 7) == 0 && rep < 8) {
                g.A = (const bf16*)(ws + WS_MEMB); g.Bt = (const bf16*)(ws + WS_WKV); g.M = MROWS; g.N = 4096; g.K = D; g.lda = D; g.perm = 0;
                E.kind = 3; E.ldc = 0; E.O = (bf16*)(ws + WS_KM); E.ss = (const float*)(ws + WS_SSM); E.xout = (float*)(ws + WS_VMT);
            } else if (sp == 0) {
                g.A = XB; g.Bt = (const bf16*)(wb + WT_IN); g.M = M; g.N = LD; g.K = D; g.lda = D; g.perm = 1;
                E.kind = 0; E.ldc = LD; E.O = PROJ; E.ss = SS; E.aux = hg ? (const float*)(ws + WS_LB) + (size_t)L * 1024 : ap->P.gla_b_gate + (size_t)(L >> 1) * 512;
            } else if (sp == 4) {
                g.A = PROJ + (hg ? 3072 : 2560); g.Bt = (const bf16*)(wb + WT_OUT); g.M = M; g.N = D; g.K = KOUT; g.lda = LD; g.perm = 1;
                E.kind = 2; E.ldc = D; E.O = XB; E.ss = SS; E.xin = (L == 0 && ph_hi < 0) ? ap->P.x : nullptr; E.xout = (float*)XB;
            } else if (sp == 5) {
                g.A = XB; g.Bt = (const bf16*)(wb + WT_UP); g.M = M; g.N = FF; g.K = D; g.lda = D; g.perm = 1;
                E.kind = 1; E.ldc = FF; E.O = PROJ; E.ss = SS;
            } else {
                g.A = PROJ; g.Bt = (const bf16*)(wb + WT_DOWN); g.M = M; g.N = D; g.K = FF; g.lda = FF; g.perm = 1;
                E.kind = 2; E.ldc = D; E.O = XB; E.ss = SS; E.xout = (float*)((L == DEPTH - 1) ? X2 : XB);
            }
#if EXP == 9
            if (E.kind == 2) { pg8::Gemm g2 = g; g2.perm = 1; pg8::EpiAll E2 = E; E2.kind = 1; E2.ldc = D; E2.O = GS; E2.ss = SS; E2.xin = nullptr;
                pg8::StaticOrder S2; S2.init(g2.M, g2.N, G, bid); pg8::gemm_phase<pg8::EpiAll, pg8::StaticOrder, true, true>(lds, g2, S2, E2, tid); }
#endif
            pg8::StaticOrder S; S.init(g.M, g.N, G, bid, (sp == 6) ? REV_DOWN : 0);
#if SKEW_TICKS > 0
            if (E.kind <= 1) {
                const unsigned long long t0_ = __builtin_amdgcn_s_memrealtime(); const unsigned long long dl_ = (unsigned long long)((bid & 7) * SKEW_TICKS);
                while (__builtin_amdgcn_s_memrealtime() - t0_ < dl_) __builtin_amdgcn_s_sleep(8);
            }
#endif
            pg8::gemm_phase<pg8::EpiAll, pg8::StaticOrder, true, true>(lds, g, S, E, tid);
        }
        if (ph + 1 < ph_hi) { SEAM(); }
#if EXP == 7
        if (ph + 1 < ph_hi) { SEAM(); }
#endif
    }
}

extern "C" void kernel_launch(void* const* d_in, const int* in_sizes, int n_in, void* d_out, int out_size, void* d_ws, size_t ws_size, hipStream_t stream) {
    static int grid = 0;
    if (grid == 0) {
        if (n_in != 17 || out_size != M * D || ws_size < WS_END) { fprintf(stderr, "kernel_launch: unexpected shapes (n_in %d out %d ws %zu)\n", n_in, out_size, ws_size); grid = -1; return; }
        int dev = 0, cus = 0, per_cu = 0;
        hipGetDevice(&dev); hipDeviceGetAttribute(&cus, hipDeviceAttributeMultiprocessorCount, dev);
        if (hipFuncSetAttribute((const void*)fwd_kernel, hipFuncAttributeMaxDynamicSharedMemorySize, LDS_BYTES) != hipSuccess) { fprintf(stderr, "kernel_launch: hipFuncSetAttribute failed\n"); grid = -1; return; }
        if (hipOccupancyMaxActiveBlocksPerMultiprocessor(&per_cu, (const void*)fwd_kernel, NT, LDS_BYTES) != hipSuccess || per_cu < 1) { fprintf(stderr, "kernel_launch: occupancy query says %d\n", per_cu); per_cu = 1; }
        (void)hipGetLastError();
        grid = cus * per_cu;
        if (grid > 256) grid = 256;
        grid = (grid / 16) * 16;
        fprintf(stderr, "kernel_launch: grid %d (cus %d per_cu %d)\n", grid, cus, per_cu);
    }
    if (grid <= 0) return;
#if ONE_LAUNCH
    if (hipMemsetAsync((char*)d_ws + WS_CTL, 0, CTL_BYTES, stream) != hipSuccess) { fprintf(stderr, "kernel_launch: memset failed\n"); return; }
#endif
    Args a{};
    const float** pp = (const float**)&a.P;
    for (int i = 0; i < 17; ++i) pp[i] = (const float*)d_in[i];
    a.P.out = (float*)d_out; a.P.ws = (unsigned char*)d_ws;
#if ONE_LAUNCH
    a.ph_lo = 0; a.ph_hi = N_PHASES;
    void* args[] = {&a};
    hipError_t e = hipLaunchCooperativeKernel((const void*)fwd_kernel, dim3(grid), dim3(NT), args, LDS_BYTES, stream);
    if (e != hipSuccess) fprintf(stderr, "kernel_launch: cooperative launch failed: %s (grid %d)\n", hipGetErrorString(e), grid);
#else
    for (int ph = 0; ph < N_PHASES; ++ph) { a.ph_lo = ph; a.ph_hi = ph + 1; hipLaunchKernelGGL(fwd_kernel, dim3(grid), dim3(NT), LDS_BYTES, stream, a); }
#endif
}
```

```cpp
#include <hip/hip_runtime.h>
#include <hip/hip_cooperative_groups.h>
#include <cstdio>
#include <cstdint>
namespace cg = cooperative_groups;

#ifndef EXP
#define EXP 0
#endif
#ifndef SKEW_TICKS
#define SKEW_TICKS 0
#endif
#ifndef REV_DOWN
#define REV_DOWN 0
#endif
#ifndef ONE_LAUNCH
#define ONE_LAUNCH 1
#endif

namespace pg8 {
#define PG8_LAS __attribute__((address_space(3)))
typedef unsigned short bf16_t;
typedef short bf16x8 __attribute__((ext_vector_type(8)));
typedef float f32x4 __attribute__((ext_vector_type(4)));
typedef unsigned u32x4 __attribute__((ext_vector_type(4)));
typedef unsigned u32x2 __attribute__((ext_vector_type(2)));
constexpr int BM = 256, BK = 64, HALF = 128, HTB = HALF * BK * 2, STAGE_BYTES = 8 * HTB, NXCD = 8, WGM = 8;

__host__ __device__ __forceinline__ int lds_byte(int r, int c) { const int st = (r >> 4) * 2 + (c >> 5), rr = r & 15, cc = c & 31, ob = rr * 64 + cc * 2; return st * 1024 + (ob ^ (((ob >> 9) & 1) << 5)); }
__host__ __device__ __forceinline__ void stage_rc(int b, int& R, int& C) { const int st = b / 1024, sb = b % 1024, swz = sb ^ (((sb >> 9) & 1) << 5); R = (st >> 1) * 16 + swz / 64; C = (st & 1) * 32 + (swz % 64) / 2; }
__host__ __device__ __forceinline__ int perm32(int rho) { const int n = rho >> 4, i = rho & 15; return 8 * (i >> 2) + 4 * n + (i & 3); }

struct Unit { int pm, pn; };
struct Gemm { const bf16_t* A; const bf16_t* Bt; int M, N, K, lda, perm; };

struct StaticOrder {
    int nM, nN, nwg, G, c, rev;
    __host__ __device__ void init(int M, int N, int G_, int c_, int rev_ = 0) { nM = M / BM; nN = N / BM; nwg = nM * nN; G = G_; c = c_; rev = rev_; }
    __host__ __device__ bool next(int i, Unit& u) const {
        const long L = (long)i * G + c; if (L >= nwg) return false;
        int wgid = (int)L; { const int q = nwg / NXCD, r = nwg % NXCD, xcd = wgid % NXCD, off = wgid / NXCD; wgid = (xcd < r ? xcd * (q + 1) : r * (q + 1) + (xcd - r) * q) + off; }
        const int nig = WGM * nN, gid = wgid / nig, fm = gid * WGM, gsz = (nM - fm) < WGM ? (nM - fm) : WGM;
        u.pm = fm + ((wgid % nig) % gsz); u.pn = (wgid % nig) / gsz; if (rev) u.pm = nM - 1 - u.pm; return true;
    }
    __device__ __forceinline__ void a_ready(const Unit&) const {}
    __device__ __forceinline__ void done(const Unit&) const {}
};

__device__ __forceinline__ float shx(float v, int mask, int lane) { return __int_as_float(__builtin_amdgcn_ds_bpermute((lane ^ mask) << 2, __float_as_int(v))); }
__device__ __forceinline__ void shx_add2(float (&v)[2], int mask, int lane) {
    const int a = (lane ^ mask) << 2; float r[2];
    asm volatile("ds_bpermute_b32 %0, %2, %3\n\tds_bpermute_b32 %1, %2, %4\n\ts_waitcnt lgkmcnt(0)"
        : "=&v"(r[0]), "=&v"(r[1]) : "v"(a), "v"(v[0]), "v"(v[1]));
#pragma unroll
    for (int i = 0; i < 2; ++i) v[i] += r[i];
}
__device__ __forceinline__ void shx_add4(float (&v)[4], int mask, int lane) {
    const int a = (lane ^ mask) << 2; float r[4];
    asm volatile("ds_bpermute_b32 %0, %4, %5\n\tds_bpermute_b32 %1, %4, %6\n\tds_bpermute_b32 %2, %4, %7\n\tds_bpermute_b32 %3, %4, %8\n\ts_waitcnt lgkmcnt(0)"
        : "=&v"(r[0]), "=&v"(r[1]), "=&v"(r[2]), "=&v"(r[3]) : "v"(a), "v"(v[0]), "v"(v[1]), "v"(v[2]), "v"(v[3]));
#pragma unroll
    for (int i = 0; i < 4; ++i) v[i] += r[i];
}
__device__ __forceinline__ void shx_add8(float (&v)[8], int mask, int lane) {
    const int a = (lane ^ mask) << 2; float r[8];
    asm volatile("ds_bpermute_b32 %0, %8, %9\n\tds_bpermute_b32 %1, %8, %10\n\tds_bpermute_b32 %2, %8, %11\n\tds_bpermute_b32 %3, %8, %12\n\tds_bpermute_b32 %4, %8, %13\n\tds_bpermute_b32 %5, %8, %14\n\tds_bpermute_b32 %6, %8, %15\n\tds_bpermute_b32 %7, %8, %16\n\ts_waitcnt lgkmcnt(0)"
        : "=&v"(r[0]), "=&v"(r[1]), "=&v"(r[2]), "=&v"(r[3]), "=&v"(r[4]), "=&v"(r[5]), "=&v"(r[6]), "=&v"(r[7]) : "v"(a), "v"(v[0]), "v"(v[1]), "v"(v[2]), "v"(v[3]), "v"(v[4]), "v"(v[5]), "v"(v[6]), "v"(v[7]));
#pragma unroll
    for (int i = 0; i < 8; ++i) v[i] += r[i];
}
typedef float f32x2_t __attribute__((ext_vector_type(2)));
typedef __bf16 bf16x2_t __attribute__((ext_vector_type(2)));
__device__ __forceinline__ unsigned cvt_pk_native(float lo, float hi) { const f32x2_t f = {lo, hi}; const bf16x2_t b = __builtin_convertvector(f, bf16x2_t); return __builtin_bit_cast(unsigned, b); }
__device__ __forceinline__ unsigned cvt_pk_bf16(float lo, float hi) { unsigned r; asm volatile("v_cvt_pk_bf16_f32 %0, %1, %2" : "=v"(r) : "v"(lo), "v"(hi)); return r; }

__device__ __forceinline__ float fsigmoid(float v) { return __builtin_amdgcn_rcpf(1.0f + __expf(-v)); }
__device__ __forceinline__ float fsilu(float v) { return v * fsigmoid(v); }
__device__ __forceinline__ float row_rstd(const float* ss, int M, int row, int fq, int lane) {
    const float* p = ss + (size_t)(4 * fq) * M + row;
    float s = (p[0] + p[M]) + (p[2 * (size_t)M] + p[3 * (size_t)M]);
    s += shx(s, 16, lane); s += shx(s, 32, lane);
    return rsqrtf(s * (1.0f / 1024.0f) + 1e-6f);
}
template <int MODE> __device__ __forceinline__ float proj_act(float v, float a) {
    if (MODE == 1) return fsilu(v);
    if (MODE == 2) { const float z = v + a; const float ls = fminf(z, 0.f) - __logf(1.0f + __expf(-fabsf(z))); return ls * 0.0625f; }
    if (MODE == 3) { const float sg = fsigmoid(v); return __logf(a + (1.0f - a) * sg); }
    if (MODE == 4) return fsilu(v) * 0.08838834764831845f;
    if (MODE == 5) { const float r = fmaxf(v, 0.f); return r * r; }
    return v;
}
struct EpiAll {
    static constexpr bool AFTER_DRAIN = false;
    int kind, ldc, hgrn, M;
    bf16_t* O;
    const float* ss;
    const float* aux;
    const float* xin;
    float* xout;
    template <int MODE> __device__ __forceinline__ void body_proj(const f32x4 (&acc)[2][2][4][2], const Unit& u, int wr, int wc, int fr, int fq) const {
        const int row0 = u.pm * BM + wr * 64 + fr, col0 = u.pn * BM + wc * 32 + 8 * fq;
        f32x4 av[2][2];
#pragma unroll
        for (int bj = 0; bj < 2; ++bj)
#pragma unroll
            for (int n = 0; n < 2; ++n) av[bj][n] = (MODE == 2 || MODE == 3) ? *(const f32x4*)(aux + (col0 - 1024) + bj * HALF + 4 * n) : (f32x4){0.f, 0.f, 0.f, 0.f};
        float ps[2][4];
#pragma unroll
        for (int ai = 0; ai < 2; ++ai)
#pragma unroll
            for (int m = 0; m < 4; ++m) { const float* p = ss + (size_t)(4 * fq) * M + (row0 + ai * HALF + m * 16); ps[ai][m] = (p[0] + p[M]) + (p[2 * (size_t)M] + p[3 * (size_t)M]); }
        float rs[2][4];
        { float pv[8];
#pragma unroll
          for (int i = 0; i < 8; ++i) pv[i] = ps[i >> 2][i & 3];
          shx_add8(pv, 16, fq * 16 + fr); shx_add8(pv, 32, fq * 16 + fr);
#pragma unroll
          for (int i = 0; i < 8; ++i) rs[i >> 2][i & 3] = rsqrtf(pv[i] * (1.0f / 1024.0f) + 1e-6f); }
#pragma unroll
        for (int ai = 0; ai < 2; ++ai)
#pragma unroll
            for (int m = 0; m < 4; ++m) { const int row = row0 + ai * HALF + m * 16; const float rstd = rs[ai][m]; bf16_t* rowp = O + (size_t)row * ldc + col0;
#pragma unroll
                for (int bj = 0; bj < 2; ++bj) { f32x4 v0 = acc[ai][bj][m][0] * rstd, v1 = acc[ai][bj][m][1] * rstd;
#pragma unroll
                    for (int j = 0; j < 4; ++j) { v0[j] = proj_act<MODE>(v0[j], av[bj][0][j]); v1[j] = proj_act<MODE>(v1[j], av[bj][1][j]); }
                    u32x4 w; w.x = cvt_pk_bf16(v0[0], v0[1]); w.y = cvt_pk_bf16(v0[2], v0[3]); w.z = cvt_pk_bf16(v1[0], v1[1]); w.w = cvt_pk_bf16(v1[2], v1[3]);
                    *(u32x4*)(rowp + bj * HALF) = w; } }
    }
    template <bool F32IN> __device__ __forceinline__ void body_res(const f32x4 (&acc)[2][2][4][2], const Unit& u, int wr, int wc, int fr, int fq) const {
        const int row0 = u.pm * BM + wr * 64 + fr, col0 = u.pn * BM + wc * 32 + 8 * fq; float* ssw = (float*)ss; bf16_t* XO = (bf16_t*)xout;
#pragma unroll
        for (int ai = 0; ai < 2; ++ai) {
            u32x4 xi[4][2];
            if (!F32IN) {
#pragma unroll
                for (int m = 0; m < 4; ++m) { const size_t off = (size_t)(row0 + ai * HALF + m * 16) * 1024 + col0;
#pragma unroll
                    for (int bj = 0; bj < 2; ++bj) xi[m][bj] = *(const u32x4*)(O + off + bj * HALF); } }
            float sv[4];
#pragma unroll
            for (int m = 0; m < 4; ++m) { const int row = row0 + ai * HALF + m * 16; const size_t off = (size_t)row * 1024 + col0; float s = 0.f;
#pragma unroll
                for (int bj = 0; bj < 2; ++bj) { f32x4 o0, o1;
                    if (F32IN) { o0 = *(const f32x4*)(xin + off + bj * HALF); o1 = *(const f32x4*)(xin + off + bj * HALF + 4); }
                    else { const u32x4 xw = xi[m][bj]; o0 = (f32x4){__uint_as_float(xw.x << 16), __uint_as_float(xw.x & 0xffff0000u), __uint_as_float(xw.y << 16), __uint_as_float(xw.y & 0xffff0000u)};
                        o1 = (f32x4){__uint_as_float(xw.z << 16), __uint_as_float(xw.z & 0xffff0000u), __uint_as_float(xw.w << 16), __uint_as_float(xw.w & 0xffff0000u)}; }
                    o0 = o0 + acc[ai][bj][m][0]; o1 = o1 + acc[ai][bj][m][1];
                    u32x4 w; w.x = cvt_pk_bf16(o0[0], o0[1]); w.y = cvt_pk_bf16(o0[2], o0[3]); w.z = cvt_pk_bf16(o1[0], o1[1]); w.w = cvt_pk_bf16(o1[2], o1[3]);
                    *(u32x4*)(XO + off + bj * HALF) = w;
#pragma unroll
                    for (int q = 0; q < 4; ++q) { const unsigned wq = q == 0 ? w.x : (q == 1 ? w.y : (q == 2 ? w.z : w.w)); const float r0 = __uint_as_float(wq << 16), r1 = __uint_as_float(wq & 0xffff0000u); s += r0 * r0 + r1 * r1; } }
                sv[m] = s; }
            shx_add4(sv, 16, fq * 16 + fr); shx_add4(sv, 32, fq * 16 + fr);
            if (fq == 0) {
#pragma unroll
                for (int m = 0; m < 4; ++m) ssw[(size_t)(u.pn * 4 + wc) * M + row0 + ai * HALF + m * 16] = sv[m]; }
        }
    }
    __device__ __forceinline__ void body_kv(const f32x4 (&acc)[2][2][4][2], const Unit& u, int wr, int wc, int fr, int fq) const {
        const int row0 = u.pm * BM + wr * 64 + fr, layer = u.pn >> 2, cl0 = (u.pn & 3) * BM + wc * 32 + 4 * fq; bf16_t* VMT = (bf16_t*)xout;
        float rsv[2][4];
#pragma unroll
        for (int ai = 0; ai < 2; ++ai)
#pragma unroll
            for (int m = 0; m < 4; ++m) rsv[ai][m] = ss[row0 + ai * HALF + m * 16];
#pragma unroll
        for (int ai = 0; ai < 2; ++ai)
#pragma unroll
            for (int m = 0; m < 4; ++m) { const int row = row0 + ai * HALF + m * 16; const float rstd = rsqrtf(rsv[ai][m] * (1.0f / 1024.0f) + 1e-6f);
#pragma unroll
                for (int bj = 0; bj < 2; ++bj)
#pragma unroll
                    for (int n = 0; n < 2; ++n) { const f32x4 o = acc[ai][bj][m][n] * rstd; const int cl = cl0 + bj * HALF + n * 16;
                        if (cl < 512) { u32x2 w; w.x = cvt_pk_bf16(o[0], o[1]); w.y = cvt_pk_bf16(o[2], o[3]); *(u32x2*)(O + ((size_t)layer * 1024 + row) * 512 + cl) = w; }
                        else { const unsigned lo = cvt_pk_bf16(o[0], o[1]), hi = cvt_pk_bf16(o[2], o[3]); bf16_t* d = VMT + ((size_t)(layer * 4 + (row >> 8)) * 512 + (cl - 512)) * 256 + (row & 255);
                            d[0] = (bf16_t)(lo & 0xffff); d[256] = (bf16_t)(lo >> 16); d[512] = (bf16_t)(hi & 0xffff); d[768] = (bf16_t)(hi >> 16); } } }
    }
    __device__ __forceinline__ void operator()(const f32x4 (&acc)[2][2][4][2], const Unit& u, int wr, int wc, int fr, int fq) const {
        if (kind == 0) {
            int mode;
            if (!hgrn) mode = (u.pn >= 4 && u.pn < 6) ? 2 : ((u.pn >= 6 && u.pn < 10) ? 1 : 0);
            else mode = u.pn < 4 ? 4 : (u.pn < 8 ? 3 : (u.pn < 12 ? 1 : 0));
            if (mode == 0) body_proj<0>(acc, u, wr, wc, fr, fq); else if (mode == 1) body_proj<1>(acc, u, wr, wc, fr, fq); else if (mode == 2) body_proj<2>(acc, u, wr, wc, fr, fq);
            else if (mode == 3) body_proj<3>(acc, u, wr, wc, fr, fq); else body_proj<4>(acc, u, wr, wc, fr, fq);
        } else if (kind == 1) body_proj<5>(acc, u, wr, wc, fr, fq);
        else if (kind == 2) { if (xin) body_res<true>(acc, u, wr, wc, fr, fq); else body_res<false>(acc, u, wr, wc, fr, fq); }
        else body_kv(acc, u, wr, wc, fr, fq);
    }
};

template <class Epi, class Sched, bool ALIGN_EPI = false, bool SP2 = false>
__device__ __forceinline__ void gemm_phase(PG8_LAS unsigned char* lds, const Gemm g, const Sched& S, const Epi& E, const int tid) {
    const int wid = __builtin_amdgcn_readfirstlane(tid >> 6), lane = tid & 63, wr = wid >> 2, wc = wid & 3, fr = lane & 15, fq = lane >> 4;
    const int K = g.K, nt = K / BK;
    unsigned voffA[2], voffB[2];
#pragma unroll
    for (int i = 0; i < 2; ++i) { int R, C; stage_rc(tid * 16 + i * 8192, R, C); const int Rb = g.perm ? ((R & ~31) + perm32(R & 31)) : R;
        voffA[i] = (unsigned)(R * g.lda + C) * 2u; voffB[i] = (unsigned)(Rb * K + C) * 2u; }
    const size_t kstep = (size_t)(BK * 2);
    const size_t hstepA = (size_t)HALF * g.lda * 2, hstepB = (size_t)HALF * K * 2;
    const size_t tstepA = 2 * hstepA, tstepB = 2 * hstepB;
    const unsigned ldsw = (unsigned)wid * 1024u;
    const int aoff = lds_byte(wr * 64 + fr, fq * 8), boff = lds_byte(wc * 32 + fr, fq * 8);
#define PG8_SA(b, h) (((b) * 2 + (h)) * HTB)
#define PG8_SB(b, h) ((4 + (b) * 2 + (h)) * HTB)
#define PG8_STAGE(bufoff, gbase, voff) do { _Pragma("unroll") for (int _i = 0; _i < 2; ++_i) \
        __builtin_amdgcn_global_load_lds((const unsigned*)((const char*)(gbase) + (voff)[_i]), (PG8_LAS unsigned*)(lds + (bufoff) + ldsw + _i * 8192), 16, 0, 0); } while (0)
#define PG8_LDA(dst, b, h) do { _Pragma("unroll") for (int m = 0; m < 4; ++m) _Pragma("unroll") for (int k = 0; k < 2; ++k) dst[m][k] = *(const PG8_LAS bf16x8*)(lds + PG8_SA(b, h) + aoff + m * 2048 + k * 1024); } while (0)
#define PG8_LDB(dst, b, h) do { _Pragma("unroll") for (int n = 0; n < 2; ++n) _Pragma("unroll") for (int k = 0; k < 2; ++k) dst[n][k] = *(const PG8_LAS bf16x8*)(lds + PG8_SB(b, h) + boff + n * 2048 + k * 1024); } while (0)
#define PG8_MMA(ai, bj, At, Bt) do { __builtin_amdgcn_s_setprio(1); _Pragma("unroll") for (int m = 0; m < 4; ++m) _Pragma("unroll") for (int n = 0; n < 2; ++n) _Pragma("unroll") for (int k = 0; k < 2; ++k) \
        acc[ai][bj][m][n] = __builtin_amdgcn_mfma_f32_16x16x32_bf16(Bt[n][k], At[m][k], acc[ai][bj][m][n], 0, 0, 0); __builtin_amdgcn_s_setprio(0); } while (0)
#define PG8_WAIT_V(n) asm volatile("s_waitcnt vmcnt(" #n ")" ::: "memory")
#define PG8_WAIT_L(n) asm volatile("s_waitcnt lgkmcnt(" #n ")" ::: "memory")
#define PG8_BAR __builtin_amdgcn_s_barrier()
#define PG8_SCHED __builtin_amdgcn_sched_barrier(0)
    Unit cur, nxt; int ui = 0;
    if (!S.next(0, cur)) return;
    f32x4 acc[2][2][4][2];
#pragma unroll
    for (int a = 0; a < 2; ++a)
#pragma unroll
        for (int b = 0; b < 2; ++b)
#pragma unroll
            for (int m = 0; m < 4; ++m)
#pragma unroll
                for (int n = 0; n < 2; ++n) acc[a][b][m][n] = (f32x4){0.f, 0.f, 0.f, 0.f};
    bf16x8 At[4][2], B0[2][2], B1[2][2];
    const char* cA = (const char*)g.A + (size_t)cur.pm * tstepA; const char* cB = (const char*)g.Bt + (size_t)cur.pn * tstepB;
    S.a_ready(cur);
    if constexpr (SP2) {
        PG8_STAGE(PG8_SB(0, 0), cB, voffB); PG8_STAGE(PG8_SB(0, 1), cB + hstepB, voffB); PG8_STAGE(PG8_SA(0, 0), cA, voffA); PG8_STAGE(PG8_SA(0, 1), cA + hstepA, voffA);
        if (wr == 1) PG8_BAR;
        PG8_WAIT_V(2); PG8_BAR;
        PG8_STAGE(PG8_SB(1, 0), cB + kstep, voffB); PG8_STAGE(PG8_SA(1, 0), cA + kstep, voffA); PG8_STAGE(PG8_SB(1, 1), cB + hstepB + kstep, voffB);
        PG8_WAIT_V(6); PG8_BAR;
    } else {
        PG8_STAGE(PG8_SB(0, 0), cB, voffB); PG8_STAGE(PG8_SA(0, 0), cA, voffA); PG8_STAGE(PG8_SB(0, 1), cB + hstepB, voffB); PG8_STAGE(PG8_SA(0, 1), cA + hstepA, voffA);
        if (wr == 1) PG8_BAR;
        PG8_WAIT_V(4); PG8_BAR;
        PG8_STAGE(PG8_SB(1, 0), cB + kstep, voffB); PG8_STAGE(PG8_SA(1, 0), cA + kstep, voffA); PG8_STAGE(PG8_SB(1, 1), cB + hstepB + kstep, voffB);
        PG8_WAIT_V(6); PG8_BAR;
    }
    for (;;) {
        const bool has_next = S.next(ui + 1, nxt);
        const char* nA = has_next ? (const char*)g.A + (size_t)nxt.pm * tstepA : cA; const char* nB = has_next ? (const char*)g.Bt + (size_t)nxt.pn * tstepB : cB;
        for (int t = 0; t < nt; t += 2) {
            const bool last = (t == nt - 2);
            const char* a1 = cA + (size_t)(t + 1) * kstep;
            const char* a2 = last ? nA : cA + (size_t)(t + 2) * kstep; const char* b2 = last ? nB : cB + (size_t)(t + 2) * kstep;
            const char* a3 = a2 + kstep; const char* b3 = b2 + kstep;
            if (last && has_next) S.a_ready(nxt);
            if constexpr (SP2) {
            PG8_LDB(B0, 0, 0); PG8_LDB(B1, 0, 1); PG8_SCHED; PG8_LDA(At, 0, 0); PG8_STAGE(PG8_SA(1, 1), a1 + hstepA, voffA);
            PG8_WAIT_V(8); PG8_WAIT_L(0); PG8_BAR; PG8_MMA(0, 0, At, B0); PG8_MMA(0, 1, At, B1); PG8_BAR; PG8_SCHED;
            PG8_LDA(At, 0, 1); PG8_STAGE(PG8_SB(0, 0), b2, voffB); PG8_STAGE(PG8_SB(0, 1), b2 + hstepB, voffB); PG8_STAGE(PG8_SA(0, 0), a2, voffA);
            PG8_WAIT_V(8); PG8_WAIT_L(0); PG8_BAR; PG8_MMA(1, 0, At, B0); PG8_MMA(1, 1, At, B1); PG8_BAR; PG8_SCHED;
            PG8_LDB(B0, 1, 0); PG8_LDB(B1, 1, 1); PG8_SCHED; PG8_LDA(At, 1, 0); PG8_STAGE(PG8_SA(0, 1), a2 + hstepA, voffA);
            PG8_WAIT_V(8); PG8_WAIT_L(0); PG8_BAR; PG8_MMA(0, 0, At, B0); PG8_MMA(0, 1, At, B1); PG8_BAR; PG8_SCHED;
            PG8_LDA(At, 1, 1); PG8_STAGE(PG8_SB(1, 0), b3, voffB); PG8_STAGE(PG8_SB(1, 1), b3 + hstepB, voffB); PG8_STAGE(PG8_SA(1, 0), a3, voffA);
            PG8_WAIT_V(8); PG8_WAIT_L(0); PG8_BAR; PG8_MMA(1, 0, At, B0); PG8_MMA(1, 1, At, B1); PG8_BAR; PG8_SCHED;
            } else {
            PG8_LDB(B0, 0, 0); PG8_SCHED; PG8_LDA(At, 0, 0); PG8_STAGE(PG8_SA(1, 1), a1 + hstepA, voffA);
            PG8_WAIT_L(8); PG8_BAR; PG8_WAIT_L(0); PG8_MMA(0, 0, At, B0); PG8_BAR; PG8_SCHED;
            PG8_LDB(B1, 0, 1); PG8_STAGE(PG8_SB(0, 0), b2, voffB);
            PG8_BAR; PG8_WAIT_L(0); PG8_MMA(0, 1, At, B1); PG8_BAR;
            PG8_LDA(At, 0, 1); PG8_STAGE(PG8_SA(0, 0), a2, voffA);
            PG8_BAR; PG8_WAIT_L(0); PG8_MMA(1, 0, At, B0); PG8_BAR; PG8_SCHED;
            PG8_STAGE(PG8_SB(0, 1), b2 + hstepB, voffB);
            PG8_WAIT_V(6); PG8_BAR; PG8_MMA(1, 1, At, B1); PG8_BAR;
            PG8_LDB(B0, 1, 0); PG8_SCHED; PG8_LDA(At, 1, 0); PG8_STAGE(PG8_SA(0, 1), a2 + hstepA, voffA);
            PG8_WAIT_L(8); PG8_BAR; PG8_WAIT_L(0); PG8_MMA(0, 0, At, B0); PG8_BAR; PG8_SCHED;
            PG8_LDB(B1, 1, 1); PG8_STAGE(PG8_SB(1, 0), b3, voffB);
            PG8_BAR; PG8_WAIT_L(0); PG8_MMA(0, 1, At, B1); PG8_BAR;
            PG8_LDA(At, 1, 1); PG8_STAGE(PG8_SA(1, 0), a3, voffA);
            PG8_BAR; PG8_WAIT_L(0); PG8_MMA(1, 0, At, B0); PG8_BAR; PG8_SCHED;
            PG8_STAGE(PG8_SB(1, 1), b3 + hstepB, voffB);
            PG8_WAIT_V(6); PG8_BAR; PG8_MMA(1, 1, At, B1); PG8_BAR;
            }
        }
        if constexpr (ALIGN_EPI) { if (wr == 0) PG8_BAR; }
        if constexpr (!Epi::AFTER_DRAIN) { E(acc, cur, wr, wc, fr, fq); S.done(cur); }
        if (!has_next) break;
#pragma unroll
        for (int a = 0; a < 2; ++a)
#pragma unroll
            for (int b = 0; b < 2; ++b)
#pragma unroll
                for (int m = 0; m < 4; ++m)
#pragma unroll
                    for (int n = 0; n < 2; ++n) acc[a][b][m][n] = (f32x4){0.f, 0.f, 0.f, 0.f};
        cur = nxt; cA = nA; cB = nB; ++ui;
        if constexpr (ALIGN_EPI) { if (wr == 1) PG8_BAR; }
    }
    PG8_WAIT_V(0);
    if constexpr (!ALIGN_EPI) { if (wr == 0) PG8_BAR; }
    PG8_BAR;
    if constexpr (Epi::AFTER_DRAIN) { E.fused(acc, cur, wr, wc, fr, fq, lds, wid, lane); S.done(cur); }
#undef PG8_SA
#undef PG8_SB
#undef PG8_STAGE
#undef PG8_LDA
#undef PG8_LDB
#undef PG8_MMA
#undef PG8_WAIT_V
#undef PG8_WAIT_L
#undef PG8_BAR
#undef PG8_SCHED
}
}

constexpr int NWAVES = 8, NT = 512;
constexpr int D = 1024, BATCH = 4, T = 8192, M = BATCH * T, DEPTH = 4, MEM = 256, MROWS = BATCH * MEM;
constexpr int DK = 128, CH = 64, NCH = T / CH;
constexpr int GLA_N = 4096, HGRN_N = 4608, FF = 4096, KOUT = 1536;
constexpr float EPS = 1e-6f;
constexpr size_t MiB = 1u << 20;
constexpr size_t WS_SS = 0;
constexpr size_t WS_DEC = 2 * MiB;
constexpr size_t WS_MEMB = 4 * MiB;
constexpr size_t WS_SSM = 6 * MiB;
constexpr size_t WS_LB = 6 * MiB + 65536;
constexpr size_t WS_KM = 8 * MiB;
constexpr size_t WS_VMT = 12 * MiB;
constexpr size_t WS_WKV = 16 * MiB;
constexpr size_t WS_WT = 24 * MiB, WT_BUF = 30 * MiB;
constexpr size_t WT_IN = 0, WT_OUT = 10 * MiB, WT_UP = 14 * MiB, WT_DOWN = 22 * MiB;
constexpr size_t WS_PROJ = 84 * MiB;
constexpr size_t WS_XB = 372 * MiB;
constexpr size_t WS_END = 500 * MiB;
constexpr int LDS_BYTES = 147456;

#define LAS __attribute__((address_space(3)))
typedef unsigned short bf16;
typedef float f32x4 __attribute__((ext_vector_type(4)));
typedef short bf16x8 __attribute__((ext_vector_type(8)));
typedef short bf16x4 __attribute__((ext_vector_type(4)));
typedef unsigned u32x4 __attribute__((ext_vector_type(4)));
typedef unsigned u32x2 __attribute__((ext_vector_type(2)));
__device__ __forceinline__ float bf2f(bf16 b) { return __uint_as_float(((unsigned)b) << 16); }
__device__ __forceinline__ unsigned f2bf(float f) { unsigned u = __float_as_uint(f); return (u + 0x7fffu + ((u >> 16) & 1u)) >> 16; }
__device__ __forceinline__ unsigned pk2(float lo, float hi) { return pg8::cvt_pk_bf16(lo, hi); }
__device__ __forceinline__ float wave_sum(float v, int lane) {
#pragma unroll
    for (int o = 1; o < 64; o <<= 1) v += pg8::shx(v, o, lane);
    return v;
}
#define MFMA16(a, b, c) __builtin_amdgcn_mfma_f32_16x16x32_bf16((a), (b), (c), 0, 0, 0)

constexpr size_t WS_CTL = 7 * MiB, CTL_BYTES = 16384;
constexpr int LDS_BARST = LDS_BYTES - 64;
#define XB_TMO      128
#define XB_XCNT(j)  (256  + 64 * (j))
#define XB_XSUB(j)  (1280 + 64 * (j))
#define XB_XGEN(j)  (2304 + 64 * (j))
#define XB_TOP      3328
#define XB_TOPGEN   3392
#define XCD_BAR_WORDS 3456
#define XB_SPIN_CAP (1u << 18)

__device__ __forceinline__ unsigned xb_ld(unsigned* p)              { return __hip_atomic_load(p, __ATOMIC_RELAXED, __HIP_MEMORY_SCOPE_AGENT); }
__device__ __forceinline__ unsigned xb_add(unsigned* p, unsigned v) { return __hip_atomic_fetch_add(p, v, __ATOMIC_RELAXED, __HIP_MEMORY_SCOPE_AGENT); }
__device__ __forceinline__ unsigned xb_xcc_id() { return (unsigned)__builtin_amdgcn_s_getreg((3 << 11) | 20) & 0xFu; }
#define XB_SPIN(cond, bar) do { unsigned _sp = 0; while (cond) { __builtin_amdgcn_s_sleep(1); \
    if ((++_sp & 255u) == 0u) { if (xb_ld(&(bar)[XB_TMO])) break; if (_sp > XB_SPIN_CAP) { atomicAdd(&(bar)[XB_TMO], 1u); break; } } } } while (0)

struct XcdBarrier {
    unsigned* bar; unsigned x;
    volatile LAS unsigned* st;
};

__device__ __forceinline__ XcdBarrier xcd_barrier_post(unsigned* bar, volatile LAS unsigned* st, int tid) {
    XcdBarrier b; b.bar = bar; b.x = xb_xcc_id(); b.st = st;
    if (tid == 0) (void)xb_add(&bar[XB_XCNT(b.x)], 1u);
    return b;
}
__device__ __forceinline__ void xcd_barrier_complete(unsigned* bar, unsigned x, unsigned& nloc, unsigned& nx) {
    const unsigned G = gridDim.x * gridDim.y * gridDim.z;
    unsigned sum, cnt, mine, sp = 0u;
    for (;;) {
        sum = 0u; cnt = 0u; mine = 0u;
#pragma unroll
        for (unsigned j = 0; j < 16; ++j) { const unsigned c = xb_ld(&bar[XB_XCNT(j)]); sum += c; cnt += (c > 0u) ? 1u : 0u; mine = (j == x) ? c : mine; }
        if (sum == G) break;
        __builtin_amdgcn_s_sleep(1);
        if ((++sp & 255u) == 0u) { if (xb_ld(&bar[XB_TMO])) break; if (sp > XB_SPIN_CAP) { atomicAdd(&bar[XB_TMO], 1u); break; } }
    }
    nloc = mine > 0u ? mine : 1u; nx = cnt > 0u ? cnt : 1u;
}

__device__ __forceinline__ void xcd_barrier(const XcdBarrier& b, int tid) {
    asm volatile("s_waitcnt vmcnt(0)" ::: "memory");
    __syncthreads();
    if (tid == 0) {
        unsigned* bar = b.bar;
        __builtin_amdgcn_s_waitcnt(0);
        unsigned nloc = b.st[0], nx = b.st[1];
        if (nloc == 0u) { xcd_barrier_complete(bar, b.x, nloc, nx); b.st[0] = nloc; b.st[1] = nx; }
        const unsigned old = xb_add(&bar[XB_XSUB(b.x)], 1u);
        const unsigned gen = old / nloc;
        if (old + 1u == (gen + 1u) * nloc) {
            __builtin_amdgcn_fence(__ATOMIC_RELEASE, "agent");
            asm volatile("s_waitcnt vmcnt(0)" ::: "memory");
            const unsigned og = xb_add(&bar[XB_TOP], 1u);
            const unsigned tg = og / nx;
            if (og + 1u == (tg + 1u) * nx) xb_add(&bar[XB_TOPGEN], 1u);
            else XB_SPIN(xb_ld(&bar[XB_TOPGEN]) == tg, bar);
            __builtin_amdgcn_fence(__ATOMIC_ACQUIRE, "agent");
            xb_add(&bar[XB_XGEN(b.x)], 1u);
            asm volatile("s_waitcnt vmcnt(0)" ::: "memory");
        } else {
            XB_SPIN(xb_ld(&bar[XB_XGEN(b.x)]) == gen, bar);
            __builtin_amdgcn_fence(__ATOMIC_ACQUIRE, "agent");
            asm volatile("s_waitcnt vmcnt(0)" ::: "memory");
        }
    }
    __syncthreads();
}

__device__ __forceinline__ void transpose_item(const float* W, int ldw, int K, int sc, bf16* WT, int dr, const float* gain, int gmask, int glimit, float scale, LAS float* scr, int item, int nblk, int lane) {
    const int kb = item / nblk, nb = item % nblk, k0 = 64 * kb, n0 = 32 * nb;
    float wv[32], gg[32];
#pragma unroll
    for (int i = 0; i < 32; ++i) { const int kk = 2 * i + (lane >> 5); const int k = k0 + kk; wv[i] = W[(size_t)k * ldw + sc + n0 + (lane & 31)]; gg[i] = (gain && k < glimit) ? gain[k & gmask] : 1.0f; }
#pragma unroll
    for (int i = 0; i < 32; ++i) { const int kk = 2 * i + (lane >> 5); scr[kk * 33 + (lane & 31)] = wv[i] * (gg[i] * scale); }
    asm volatile("s_waitcnt lgkmcnt(0)" ::: "memory");
    const int c = lane & 7;
#pragma unroll
    for (int j = 0; j < 4; ++j) { const int n = (lane >> 3) + 8 * j; const LAS float* s = scr + (8 * c) * 33 + n;
        u32x4 o; o.x = pk2(s[0 * 33], s[1 * 33]); o.y = pk2(s[2 * 33], s[3 * 33]); o.z = pk2(s[4 * 33], s[5 * 33]); o.w = pk2(s[6 * 33], s[7 * 33]);
        *(u32x4*)(WT + (size_t)(dr + n0 + n) * K + k0 + 8 * c) = o; }
    asm volatile("s_waitcnt lgkmcnt(0)" ::: "memory");
}
struct Ptrs {
    const float *x, *mem, *norm_mix, *norm_mem, *w_kv, *w_out, *norm_mlp, *w_up, *w_down, *gla_w_in, *gla_w_gate2, *gla_b_gate, *gla_out_gain, *hgrn_w_in, *hgrn_lb, *hgrn_out_gain, *final_norm;
    float* out; unsigned char* ws;
};
#define SEG(Wp, ldw, K, sc, ncols, WTp, dr, gain, gmask, glimit, scale) { const int nblk_ = (ncols) / 32, nit_ = ((K) / 64) * nblk_; \
    if (r < nit_) { transpose_item(Wp, ldw, K, sc, WTp, dr, gain, gmask, glimit, scale, scr, r, nblk_, lane); continue; } r -= nit_; }
template <class PT> __device__ __forceinline__ void convert_layer(PT Pp, int L, LAS unsigned char* lds, int gw, int ngw, int wave, int lane) {
    LAS float* scr = (LAS float*)(lds + wave * 16384);
    unsigned char* wb = Pp->ws + WS_WT + (size_t)(L & 1) * WT_BUF;
    bf16* Win = (bf16*)(wb + WT_IN); bf16* Wout = (bf16*)(wb + WT_OUT); bf16* Wup = (bf16*)(wb + WT_UP); bf16* Wdn = (bf16*)(wb + WT_DOWN);
    const int j = L >> 1; const bool hg = (L & 1);
    const float* gmix = Pp->norm_mix + (size_t)L * D; const float* gmlp = Pp->norm_mlp + (size_t)L * D;
    const float* wo = Pp->w_out + (size_t)L * KOUT * D; const float* wu = Pp->w_up + (size_t)L * D * FF; const float* wd = Pp->w_down + (size_t)L * FF * D;
    const float QS = 0.08838834764831845f;
    if (!hg) {
        const float* wi = Pp->gla_w_in + (size_t)j * D * 3600; const float* og = Pp->gla_out_gain + (size_t)j * 256;
        const int total = 16 * (16 + 16 + 32 + 32 + 16) + 24 * 32 + 16 * 128 + 64 * 32 + 128;
        for (int it = gw; it < total; it += ngw) { int r = it;
            SEG(wi, 3600, D, 0, 512, Win, 0, gmix, 1023, D, QS)
            SEG(wi, 3600, D, 512, 512, Win, 512, gmix, 1023, D, 1.f)
            SEG(wi, 3600, D, 1024, 1024, Win, 2560, gmix, 1023, D, 1.f)
            SEG(wi, 3600, D, 2064, 1024, Win, 1536, gmix, 1023, D, 1.f)
            SEG(wi, 3600, D, 3088, 512, Win, 3584, gmix, 1023, D, QS)
            SEG(wo, D, KOUT, 0, 1024, Wout, 0, og, 255, 1024, 1.f)
            SEG(wu, FF, D, 0, 4096, Wup, 0, gmlp, 1023, D, 1.f)
            SEG(wd, D, FF, 0, 1024, Wdn, 0, (const float*)nullptr, 0, 0, 1.f)
            { const int kb = r >> 3, cb = r & 7, k = kb * 64 + lane; const float* g2 = Pp->gla_w_gate2 + (size_t)j * 16 * 512 + cb * 64;
              const f32x4* wr4 = (const f32x4*)(wi + (size_t)k * 3600 + 2048); const f32x4 w0 = wr4[0], w1 = wr4[1], w2 = wr4[2], w3 = wr4[3]; const float gk = gmix[k];
              for (int c = 0; c < 64; ++c) { float s = 0.f;
#pragma unroll
                  for (int q = 0; q < 4; ++q) { s += w0[q] * g2[q * 512 + c]; s += w1[q] * g2[(4 + q) * 512 + c]; s += w2[q] * g2[(8 + q) * 512 + c]; s += w3[q] * g2[(12 + q) * 512 + c]; }
                  Win[(size_t)(1024 + cb * 64 + c) * D + k] = (bf16)f2bf(s * gk); } }
        }
    } else {
        const float* wi = Pp->hgrn_w_in + (size_t)j * D * 4608; const float* og = Pp->hgrn_out_gain + (size_t)j * 128;
        const int total = 16 * (32 + 32 + 32 + 32 + 16) + 24 * 32 + 16 * 128 + 64 * 32;
        for (int it = gw; it < total; it += ngw) { int r = it;
            SEG(wi, 4608, D, 0, 1024, Win, 0, gmix, 1023, D, 1.f)
            SEG(wi, 4608, D, 1024, 1024, Win, 1024, gmix, 1023, D, 1.f)
            SEG(wi, 4608, D, 2048, 1024, Win, 3072, gmix, 1023, D, 1.f)
            SEG(wi, 4608, D, 3072, 1024, Win, 2048, gmix, 1023, D, 1.f)
            SEG(wi, 4608, D, 4096, 512, Win, 4096, gmix, 1023, D, QS)
            SEG(wo, D, KOUT, 0, 1024, Wout, 0, og, 127, 1024, 1.f)
            SEG(wu, FF, D, 0, 4096, Wup, 0, gmlp, 1023, D, 1.f)
            { const int nblk_ = 32; transpose_item(wd, D, FF, 0, Wdn, 0, (const float*)nullptr, 0, 0, 1.f, scr, r, nblk_, lane); }
        }
    }
}
template <class PT> __device__ __forceinline__ void prologue(PT Pp, LAS unsigned char* lds, int gw, int ngw, int wave, int lane) {
    convert_layer(Pp, 0, lds, gw, ngw, wave, lane);
    { LAS float* scr = (LAS float*)(lds + wave * 16384); bf16* Wkv = (bf16*)(Pp->ws + WS_WKV);
      const int per = 16 * 32, total = 4 * per;
      for (int it = gw; it < total; it += ngw) { const int L = it / per, r = it % per;
          transpose_item(Pp->w_kv + (size_t)L * D * 1024, 1024, D, 0, Wkv + (size_t)L * 1024 * D, 0, Pp->norm_mem + (size_t)L * D, 1023, D, 1.f, scr, r, 32, lane); } }
    { float* LB = (float*)(Pp->ws + WS_LB);
      for (int c = gw * 64 + lane; c < 1024; c += ngw * 64) { const float v0 = Pp->hgrn_lb[c], v1 = Pp->hgrn_lb[1024 + c], v2 = Pp->hgrn_lb[2048 + c], v3 = Pp->hgrn_lb[3072 + c];
          const float mx = fmaxf(fmaxf(v0, v1), fmaxf(v2, v3)); const float e0 = expf(v0 - mx), e1 = expf(v1 - mx), e2 = expf(v2 - mx), e3 = expf(v3 - mx); const float inv = 1.0f / (e0 + e1 + e2 + e3);
          LB[c] = 0.f; LB[1024 + c] = e1 * inv; LB[2048 + c] = (e1 + e2) * inv; LB[3072 + c] = (e1 + e2 + e3) * inv; } }
    bf16* XB = (bf16*)Pp->out; float* SS = (float*)(Pp->ws + WS_SS);     bf16* MB = (bf16*)(Pp->ws + WS_MEMB); float* SSM = (float*)(Pp->ws + WS_SSM);
    for (int m = gw; m < M + MROWS; m += 2 * ngw) {
        const int m1 = (m + ngw < M + MROWS) ? m + ngw : m; const bool two = (m1 != m);
        const bool ism0 = m >= M, ism1 = m1 >= M; const int row0 = ism0 ? m - M : m, row1 = ism1 ? m1 - M : m1;
        const f32x4* xr0 = (const f32x4*)((ism0 ? Pp->mem : Pp->x) + (size_t)row0 * D) + lane; const f32x4* xr1 = (const f32x4*)((ism1 ? Pp->mem : Pp->x) + (size_t)row1 * D) + lane;
        f32x4 va[4], vb[4];
#pragma unroll
        for (int j = 0; j < 4; ++j) { va[j] = xr0[64 * j]; vb[j] = xr1[64 * j]; }
        unsigned long long* o80 = (unsigned long long*)((ism0 ? MB : XB) + (size_t)row0 * D) + lane; unsigned long long* o81 = (unsigned long long*)((ism1 ? MB : XB) + (size_t)row1 * D) + lane;
        float sv[2] = {0.f, 0.f};
#pragma unroll
        for (int j = 0; j < 4; ++j) { const f32x4 v = va[j]; sv[0] += (v.x * v.x + v.y * v.y) + (v.z * v.z + v.w * v.w); o80[64 * j] = (unsigned long long)pk2(v.x, v.y) | ((unsigned long long)pk2(v.z, v.w) << 32); }
        if (two) {
#pragma unroll
            for (int j = 0; j < 4; ++j) { const f32x4 v = vb[j]; sv[1] += (v.x * v.x + v.y * v.y) + (v.z * v.z + v.w * v.w); o81[64 * j] = (unsigned long long)pk2(v.x, v.y) | ((unsigned long long)pk2(v.z, v.w) << 32); } }
#pragma unroll
        for (int o = 1; o < 64; o <<= 1) pg8::shx_add2(sv, o, lane);
        if (ism0) { if (lane == 0) SSM[row0] = sv[0]; } else if (lane < 16) SS[(size_t)lane * M + row0] = lane == 0 ? sv[0] : 0.f;
        if (two) { if (ism1) { if (lane == 0) SSM[row1] = sv[1]; } else if (lane < 16) SS[(size_t)lane * M + row1] = lane == 0 ? sv[1] : 0.f; }
    }
}
constexpr int KT_STR = 144;
constexpr int QS_STR = 272;
constexpr int VS_STR = 528;
constexpr int L_TOT = 0;
constexpr int L_LA = 2048;
constexpr int L_QS = L_LA + 64 * QS_STR;
constexpr int L_KS = L_QS + 64 * QS_STR;
constexpr int L_VS = L_KS + 64 * QS_STR;
constexpr int L_VT = L_VS + 64 * VS_STR;
constexpr int L_KT = L_VT + 256 * KT_STR;
constexpr int L_AT = L_KT;
constexpr int L_RED = L_KT + 128 * KT_STR;
static_assert(L_RED + 2048 <= LDS_BYTES - 64, "mixer LDS map");

__device__ __forceinline__ void ds_read16_s272(const LAS unsigned char* p, unsigned (&r)[16]) {
    const unsigned a = (unsigned)(__SIZE_TYPE__)p;
    asm volatile("ds_read_u16 %0, %16 offset:0\n\tds_read_u16 %1, %16 offset:272\n\tds_read_u16 %2, %16 offset:544\n\tds_read_u16 %3, %16 offset:816\n\tds_read_u16 %4, %16 offset:1088\n\tds_read_u16 %5, %16 offset:1360\n\tds_read_u16 %6, %16 offset:1632\n\tds_read_u16 %7, %16 offset:1904\n\tds_read_u16 %8, %16 offset:2176\n\tds_read_u16 %9, %16 offset:2448\n\tds_read_u16 %10, %16 offset:2720\n\tds_read_u16 %11, %16 offset:2992\n\tds_read_u16 %12, %16 offset:3264\n\tds_read_u16 %13, %16 offset:3536\n\tds_read_u16 %14, %16 offset:3808\n\tds_read_u16 %15, %16 offset:4080\n\ts_waitcnt lgkmcnt(0)"
        : "=&v"(r[0]), "=&v"(r[1]), "=&v"(r[2]), "=&v"(r[3]), "=&v"(r[4]), "=&v"(r[5]), "=&v"(r[6]), "=&v"(r[7]), "=&v"(r[8]), "=&v"(r[9]), "=&v"(r[10]), "=&v"(r[11]), "=&v"(r[12]), "=&v"(r[13]), "=&v"(r[14]), "=&v"(r[15]) : "v"(a) : "memory");
}
__device__ __forceinline__ void ds_read16_s528(const LAS unsigned char* p, unsigned (&r)[16]) {
    const unsigned a = (unsigned)(__SIZE_TYPE__)p;
    asm volatile("ds_read_u16 %0, %16 offset:0\n\tds_read_u16 %1, %16 offset:528\n\tds_read_u16 %2, %16 offset:1056\n\tds_read_u16 %3, %16 offset:1584\n\tds_read_u16 %4, %16 offset:2112\n\tds_read_u16 %5, %16 offset:2640\n\tds_read_u16 %6, %16 offset:3168\n\tds_read_u16 %7, %16 offset:3696\n\tds_read_u16 %8, %16 offset:4224\n\tds_read_u16 %9, %16 offset:4752\n\tds_read_u16 %10, %16 offset:5280\n\tds_read_u16 %11, %16 offset:5808\n\tds_read_u16 %12, %16 offset:6336\n\tds_read_u16 %13, %16 offset:6864\n\tds_read_u16 %14, %16 offset:7392\n\tds_read_u16 %15, %16 offset:7920\n\ts_waitcnt lgkmcnt(0)"
        : "=&v"(r[0]), "=&v"(r[1]), "=&v"(r[2]), "=&v"(r[3]), "=&v"(r[4]), "=&v"(r[5]), "=&v"(r[6]), "=&v"(r[7]), "=&v"(r[8]), "=&v"(r[9]), "=&v"(r[10]), "=&v"(r[11]), "=&v"(r[12]), "=&v"(r[13]), "=&v"(r[14]), "=&v"(r[15]) : "v"(a) : "memory");
}
__device__ __forceinline__ void ds_read16_red(const LAS unsigned char* p, float (&r)[16]) {
    const unsigned a = (unsigned)(__SIZE_TYPE__)p;
    asm volatile("ds_read_b32 %0, %16 offset:0\n\tds_read_b32 %1, %16 offset:256\n\tds_read_b32 %2, %16 offset:512\n\tds_read_b32 %3, %16 offset:768\n\tds_read_b32 %4, %16 offset:1024\n\tds_read_b32 %5, %16 offset:1280\n\tds_read_b32 %6, %16 offset:1536\n\tds_read_b32 %7, %16 offset:1792\n\tds_read_b32 %8, %16 offset:64\n\tds_read_b32 %9, %16 offset:320\n\tds_read_b32 %10, %16 offset:576\n\tds_read_b32 %11, %16 offset:832\n\tds_read_b32 %12, %16 offset:1088\n\tds_read_b32 %13, %16 offset:1344\n\tds_read_b32 %14, %16 offset:1600\n\tds_read_b32 %15, %16 offset:1856\n\ts_waitcnt lgkmcnt(0)"
        : "=&v"(r[0]), "=&v"(r[1]), "=&v"(r[2]), "=&v"(r[3]), "=&v"(r[4]), "=&v"(r[5]), "=&v"(r[6]), "=&v"(r[7]), "=&v"(r[8]), "=&v"(r[9]), "=&v"(r[10]), "=&v"(r[11]), "=&v"(r[12]), "=&v"(r[13]), "=&v"(r[14]), "=&v"(r[15]) : "v"(a) : "memory");
}
template <int DV>
__device__ __forceinline__ void load_raw_v(const bf16* base, int ld, int vcol, int tid, u32x4 (&rv)[DV / 64]) {
#pragma unroll
    for (int i = 0; i < DV / 64; ++i) { const int c = tid + i * NT, row = c / (DV / 8), part = c % (DV / 8); rv[i] = *(const u32x4*)(base + (size_t)row * ld + vcol + part * 8); }
}
template <int DV>
__device__ __forceinline__ void store_raw_v(LAS unsigned char* lds, int tid, const u32x4 (&rv)[DV / 64]) {
#pragma unroll
    for (int i = 0; i < DV / 64; ++i) { const int c = tid + i * NT, row = c / (DV / 8), part = c % (DV / 8); *(LAS u32x4*)(lds + L_VS + row * VS_STR + part * 16) = rv[i]; }
}
__device__ __forceinline__ void load_raw128(const bf16* base, int ld, int col, int tid, u32x4 (&r)[2]) {
#pragma unroll
    for (int i = 0; i < 2; ++i) { const int c = tid + i * NT; r[i] = *(const u32x4*)(base + (size_t)(c >> 4) * ld + col + (c & 15) * 8); }
}
__device__ __forceinline__ void store_raw128(LAS unsigned char* lds, int off, int tid, const u32x4 (&r)[2]) {
#pragma unroll
    for (int i = 0; i < 2; ++i) { const int c = tid + i * NT; *(LAS u32x4*)(lds + off + (c >> 4) * QS_STR + (c & 15) * 16) = r[i]; }
}
template <int DV>
__device__ __forceinline__ void transpose_v(LAS unsigned char* lds, int tid) {
    constexpr int RPT = DV / 8;
    const int v = tid % DV, part = tid / DV;
    unsigned w[RPT / 2];
#pragma unroll
    for (int h = 0; h < RPT / 16; ++h) { unsigned r[16]; ds_read16_s528(lds + L_VS + (part * RPT + 16 * h) * VS_STR + v * 2, r);
#pragma unroll
        for (int i = 0; i < 8; ++i) w[8 * h + i] = r[2 * i] | (r[2 * i + 1] << 16); }
    LAS u32x4* dst = (LAS u32x4*)(lds + L_VT + v * KT_STR + part * RPT * 2);
#pragma unroll
    for (int i = 0; i < RPT / 8; ++i) dst[i] = (u32x4){w[4 * i], w[4 * i + 1], w[4 * i + 2], w[4 * i + 3]};
}
__device__ __forceinline__ void cumsum_local(LAS unsigned char* lds, int d, int rg, float (&bb)[16]) {
    unsigned r[16]; ds_read16_s272(lds + L_LA + (rg * 16) * QS_STR + d * 2, r);
#pragma unroll
    for (int i = 0; i < 16; ++i) bb[i] = __uint_as_float(r[i] << 16);
}
__device__ __forceinline__ void cumsum_scan(LAS unsigned char* lds, int d, int rg, float (&bb)[16]) {
#pragma unroll
    for (int i = 1; i < 16; ++i) bb[i] += bb[i - 1];
    ((LAS float*)(lds + L_TOT))[rg * 128 + d] = bb[15];
}
__device__ __forceinline__ void cumsum_finish(LAS unsigned char* lds, int d, int rg, float (&bb)[16], float& blast) {
    const LAS float* tot = (const LAS float*)(lds + L_TOT);
    const float t0 = tot[d], t1 = tot[128 + d], t2 = tot[256 + d], t3 = tot[384 + d];
    const float off = rg == 0 ? 0.f : (rg == 1 ? t0 : (rg == 2 ? t0 + t1 : t0 + t1 + t2));
    blast = (t0 + t1) + (t2 + t3);
#pragma unroll
    for (int i = 0; i < 16; ++i) bb[i] += off;
}
template <int DV, bool HGRN>
__device__ __forceinline__ void pass_a(LAS unsigned char* lds, const bf16* proj, bf16* GS, float* DEC, int G, int bid, const int tid) {
    constexpr int H = HGRN ? 8 : 4, LD = HGRN ? HGRN_N : GLA_N, NTW = DV / 128, NU = BATCH * H * NCH;
    const int lane = tid & 63, wave = tid >> 6, g = lane >> 4, l15 = lane & 15, d = tid & 127, rg = tid >> 7;
    u32x4 rla[2], rk[2], rv[DV / 64];
    int u = bid;
    if (u < NU) { const int b = u / (H * NCH), h = (u / NCH) % H, n = u % NCH; const bf16* base = proj + (size_t)(b * T + n * CH) * LD;
        load_raw128(base, LD, 1024 + h * 128, tid, rla); if (!HGRN) load_raw128(base, LD, 512 + h * 128, tid, rk); load_raw_v<DV>(base, LD, (HGRN ? 3072 : 2560) + h * DV, tid, rv); }
    for (; u < NU; u += G) {
        store_raw128(lds, L_LA, tid, rla); if (!HGRN) store_raw128(lds, L_KS, tid, rk); store_raw_v<DV>(lds, tid, rv);
        __syncthreads();
        { const int un = u + G; if (un < NU) { const int b = un / (H * NCH), h = (un / NCH) % H, n = un % NCH; const bf16* base = proj + (size_t)(b * T + n * CH) * LD;
            load_raw128(base, LD, 1024 + h * 128, tid, rla); if (!HGRN) load_raw128(base, LD, 512 + h * 128, tid, rk); load_raw_v<DV>(base, LD, (HGRN ? 3072 : 2560) + h * DV, tid, rv); } }
        float bb[16], kv[16], blast;
        cumsum_local(lds, d, rg, bb);
        if (HGRN) {
#pragma unroll
            for (int i = 0; i < 16; ++i) kv[i] = 1.0f - __expf(bb[i]);
        } else { unsigned r[16]; ds_read16_s272(lds + L_KS + (rg * 16) * QS_STR + d * 2, r);
#pragma unroll
            for (int i = 0; i < 16; ++i) kv[i] = __uint_as_float(r[i] << 16); }
        cumsum_scan(lds, d, rg, bb);
        transpose_v<DV>(lds, tid);
        __syncthreads();
        cumsum_finish(lds, d, rg, bb, blast);
        { unsigned w[8];
#pragma unroll
          for (int i = 0; i < 8; ++i) w[i] = pk2(kv[2 * i] * __expf(-bb[2 * i]), kv[2 * i + 1] * __expf(-bb[2 * i + 1]));
          LAS u32x4* dst = (LAS u32x4*)(lds + L_KT + d * KT_STR + rg * 32);
          dst[0] = (u32x4){w[0], w[1], w[2], w[3]}; dst[1] = (u32x4){w[4], w[5], w[6], w[7]}; }
        if (rg == 0) DEC[(size_t)u * 128 + d] = __expf(blast);
        __syncthreads();
        f32x4 acc[8][NTW];
#pragma unroll
        for (int mt = 0; mt < 8; ++mt)
#pragma unroll
            for (int nt = 0; nt < NTW; ++nt) acc[mt][nt] = (f32x4){0.f, 0.f, 0.f, 0.f};
#pragma unroll
        for (int kk = 0; kk < 2; ++kk) {
            bf16x8 bfr[NTW], afr[8];
#pragma unroll
            for (int nt = 0; nt < NTW; ++nt) bfr[nt] = *(const LAS bf16x8*)(lds + L_VT + ((wave * NTW + nt) * 16 + l15) * KT_STR + (kk * 32 + 8 * g) * 2);
#pragma unroll
            for (int mt = 0; mt < 8; ++mt) afr[mt] = *(const LAS bf16x8*)(lds + L_KT + ((mt >> 1) * 32 + 8 * (l15 >> 2) + 4 * (mt & 1) + (l15 & 3)) * KT_STR + (kk * 32 + 8 * g) * 2);
#pragma unroll
            for (int mt = 0; mt < 8; ++mt)
#pragma unroll
                for (int nt = 0; nt < NTW; ++nt) acc[mt][nt] = MFMA16(afr[mt], bfr[nt], acc[mt][nt]);
        }
#pragma unroll
        for (int mt = 0; mt < 8; ++mt)
#pragma unroll
            for (int nt = 0; nt < NTW; ++nt) asm volatile("s_nop 7\n\ts_nop 7" : "+v"(acc[mt][nt]));
#pragma unroll
        for (int nt = 0; nt < NTW; ++nt) { bf16* gp = GS + ((size_t)u * DV + (wave * NTW + nt) * 16 + l15) * 128 + 8 * g;
#pragma unroll
            for (int P = 0; P < 4; ++P) { u32x4 w; w.x = pk2(acc[2 * P][nt][0], acc[2 * P][nt][1]); w.y = pk2(acc[2 * P][nt][2], acc[2 * P][nt][3]);
                w.z = pk2(acc[2 * P + 1][nt][0], acc[2 * P + 1][nt][1]); w.w = pk2(acc[2 * P + 1][nt][2], acc[2 * P + 1][nt][3]); *(u32x4*)(gp + P * 32) = w; } }
    }
    __syncthreads();
}
template <int DV, bool HGRN, bool DRY = false>
__device__ __forceinline__ void pass_b(bf16* GS, const float* DEC, int G, int bid, const int tid) {
    constexpr int H = HGRN ? 8 : 4, E = DV * 128, E4 = E / 4;
    const int nthreads = G * NT;
    for (int i = bid * NT + tid; i < BATCH * H * E4; i += nthreads) {
        const int bh = i / E4, e = (i % E4) * 4, d = e & 127;
        float S0 = 0.f, S1 = 0.f, S2 = 0.f, S3 = 0.f;
        u32x2* gp = (u32x2*)(GS + (size_t)bh * NCH * E + e); const f32x4* dp = (const f32x4*)(DEC + (size_t)bh * NCH * 128 + d);
        for (int n0 = 0; n0 < NCH; n0 += 8) {
            u32x2 gv[8]; f32x4 dv[8];
#pragma unroll
            for (int q = 0; q < 8; ++q) { gv[q] = gp[(size_t)(n0 + q) * (E / 4)]; dv[q] = dp[(size_t)(n0 + q) * 32]; }
#pragma unroll
            for (int q = 0; q < 8; ++q) {
                u32x2 o; o.x = pk2(S0, S1); o.y = pk2(S2, S3); if (!DRY || o.x == 0x12345678u) gp[(size_t)(n0 + q) * (E / 4)] = o;
                S0 = dv[q].x * (S0 + __uint_as_float(gv[q].x << 16)); S1 = dv[q].y * (S1 + __uint_as_float(gv[q].x & 0xffff0000u));
                S2 = dv[q].z * (S2 + __uint_as_float(gv[q].y << 16)); S3 = dv[q].w * (S3 + __uint_as_float(gv[q].y & 0xffff0000u)); }
        }
    }
}
template <int DV, bool HGRN, bool DRY = false>
__device__ __forceinline__ void pass_c(LAS unsigned char* lds, bf16* proj, const bf16* GS, int G, int bid, const int tid) {
    constexpr int H = HGRN ? 8 : 4, LD = HGRN ? HGRN_N : GLA_N, MTW = 2, VB = DV / 32, NTC = VB / 2, NU = BATCH * H * NCH;
    const int lane = tid & 63, wave = tid >> 6, g = lane >> 4, l15 = lane & 15, d = tid & 127, rg = tid >> 7;
    const int vb = wave % VB, th = wave / VB, v0 = vb * 32, vrow = v0 + 8 * (l15 >> 2) + (l15 & 3);
    u32x4 rla[2], rq[2], rk[2], rv[DV / 64];
    int u = bid;
    if (u < NU) { const int b = u / (H * NCH), h = (u / NCH) % H, n = u % NCH; const bf16* base = proj + (size_t)(b * T + n * CH) * LD;
        load_raw128(base, LD, 1024 + h * 128, tid, rla); load_raw128(base, LD, h * 128, tid, rq); if (!HGRN) load_raw128(base, LD, 512 + h * 128, tid, rk); load_raw_v<DV>(base, LD, (HGRN ? 3072 : 2560) + h * DV, tid, rv); }
    for (; u < NU; u += G) {
        const int b = u / (H * NCH), h = (u / NCH) % H, n = u % NCH;
        bf16* base = proj + (size_t)(b * T + n * CH) * LD;
        const int vcol = (HGRN ? 3072 : 2560) + h * DV, gcol = (HGRN ? 2048 : 1536) + h * DV;
        store_raw128(lds, L_LA, tid, rla); store_raw128(lds, L_QS, tid, rq); if (!HGRN) store_raw128(lds, L_KS, tid, rk); store_raw_v<DV>(lds, tid, rv);
        __syncthreads();
        bf16x8 sfr[4][MTW];
#pragma unroll
        for (int kk = 0; kk < 4; ++kk)
#pragma unroll
            for (int mt = 0; mt < MTW; ++mt) sfr[kk][mt] = *(const bf16x8*)(GS + ((size_t)u * DV + vrow + 4 * mt) * 128 + kk * 32 + 8 * g);
        { const int un = u + G; if (un < NU) { const int b2 = un / (H * NCH), h2 = (un / NCH) % H, n2 = un % NCH; const bf16* nb = proj + (size_t)(b2 * T + n2 * CH) * LD;
            load_raw128(nb, LD, 1024 + h2 * 128, tid, rla); load_raw128(nb, LD, h2 * 128, tid, rq); if (!HGRN) load_raw128(nb, LD, 512 + h2 * 128, tid, rk); load_raw_v<DV>(nb, LD, (HGRN ? 3072 : 2560) + h2 * DV, tid, rv); } }
        float bb[16], kv[16], blast;
        cumsum_local(lds, d, rg, bb);
        if (HGRN) {
#pragma unroll
            for (int i = 0; i < 16; ++i) kv[i] = 1.0f - __expf(bb[i]);
        } else { unsigned r[16]; ds_read16_s272(lds + L_KS + (rg * 16) * QS_STR + d * 2, r);
#pragma unroll
            for (int i = 0; i < 16; ++i) kv[i] = __uint_as_float(r[i] << 16); }
        cumsum_scan(lds, d, rg, bb);
        transpose_v<DV>(lds, tid);
        __syncthreads();
        cumsum_finish(lds, d, rg, bb, blast);
        { unsigned rq_[16]; ds_read16_s272(lds + L_QS + (rg * 16) * QS_STR + d * 2, rq_);
#pragma unroll
          for (int i = 0; i < 16; ++i) { const int s = rg * 16 + i; LAS bf16* qa = (LAS bf16*)(lds + L_QS + s * QS_STR + d * 2); LAS bf16* ka = (LAS bf16*)(lds + L_KS + s * QS_STR + d * 2);
              const float q = __uint_as_float(rq_[i] << 16); *qa = (bf16)f2bf(q * __expf(bb[i])); *ka = (bf16)f2bf(kv[i] * __expf(-bb[i])); } }
        __syncthreads();
        { const int tt = wave >> 1;
#pragma unroll
          for (int si = 0; si < 2; ++si) { const int st = (wave & 1) * 2 + si; f32x4 c = (f32x4){0.f, 0.f, 0.f, 0.f};
              bf16x8 afr[4], bfr[4];
#pragma unroll
              for (int kk = 0; kk < 4; ++kk) { afr[kk] = *(const LAS bf16x8*)(lds + L_KS + (st * 16 + l15) * QS_STR + (kk * 32 + 8 * g) * 2);
                  bfr[kk] = *(const LAS bf16x8*)(lds + L_QS + (tt * 16 + l15) * QS_STR + (kk * 32 + 8 * g) * 2); }
#pragma unroll
              for (int kk = 0; kk < 4; ++kk) c = MFMA16(afr[kk], bfr[kk], c);
              const int t = tt * 16 + l15, s0 = st * 16 + 4 * g;
              u32x2 w; w.x = pk2(s0 <= t ? c[0] : 0.f, s0 + 1 <= t ? c[1] : 0.f); w.y = pk2(s0 + 2 <= t ? c[2] : 0.f, s0 + 3 <= t ? c[3] : 0.f);
              *(LAS u32x2*)(lds + L_AT + t * KT_STR + s0 * 2) = w; } }
        u32x4 gt[NTC];
#pragma unroll
        for (int nt = 0; nt < NTC; ++nt) gt[nt] = *(const u32x4*)(base + (size_t)((th * NTC + nt) * 16 + l15) * LD + gcol + v0 + 8 * g);
        __syncthreads();
        f32x4 acc[MTW][NTC];
#pragma unroll
        for (int mt = 0; mt < MTW; ++mt)
#pragma unroll
            for (int nt = 0; nt < NTC; ++nt) acc[mt][nt] = (f32x4){0.f, 0.f, 0.f, 0.f};
#pragma unroll
        for (int kp = 0; kp < 2; ++kp) {
            bf16x8 bfr[2][NTC];
#pragma unroll
            for (int k2 = 0; k2 < 2; ++k2)
#pragma unroll
                for (int nt = 0; nt < NTC; ++nt) bfr[k2][nt] = *(const LAS bf16x8*)(lds + L_QS + ((th * NTC + nt) * 16 + l15) * QS_STR + ((kp * 2 + k2) * 32 + 8 * g) * 2);
#pragma unroll
            for (int k2 = 0; k2 < 2; ++k2)
#pragma unroll
                for (int nt = 0; nt < NTC; ++nt)
#pragma unroll
                    for (int mt = 0; mt < MTW; ++mt) acc[mt][nt] = MFMA16(sfr[kp * 2 + k2][mt], bfr[k2][nt], acc[mt][nt]);
        }
        {
            bf16x8 afr[2][MTW], bfr[2][NTC];
#pragma unroll
            for (int kk = 0; kk < 2; ++kk) {
#pragma unroll
                for (int mt = 0; mt < MTW; ++mt) afr[kk][mt] = *(const LAS bf16x8*)(lds + L_VT + (vrow + 4 * mt) * KT_STR + (kk * 32 + 8 * g) * 2);
#pragma unroll
                for (int nt = 0; nt < NTC; ++nt) bfr[kk][nt] = *(const LAS bf16x8*)(lds + L_AT + ((th * NTC + nt) * 16 + l15) * KT_STR + (kk * 32 + 8 * g) * 2); }
#pragma unroll
            for (int kk = 0; kk < 2; ++kk)
#pragma unroll
                for (int nt = 0; nt < NTC; ++nt)
#pragma unroll
                    for (int mt = 0; mt < MTW; ++mt) acc[mt][nt] = MFMA16(afr[kk][mt], bfr[kk][nt], acc[mt][nt]);
        }
        LAS float* red = (LAS float*)(lds + L_RED);
        { float pp[NTC];
#pragma unroll
          for (int nt = 0; nt < NTC; ++nt) { float p = 0.f;
#pragma unroll
              for (int mt = 0; mt < MTW; ++mt) p += (acc[mt][nt][0] * acc[mt][nt][0] + acc[mt][nt][1] * acc[mt][nt][1]) + (acc[mt][nt][2] * acc[mt][nt][2] + acc[mt][nt][3] * acc[mt][nt][3]);
              pp[nt] = p; }
          if constexpr (NTC == 4) { pg8::shx_add4(pp, 16, lane); pg8::shx_add4(pp, 32, lane); } else { pg8::shx_add2(pp, 16, lane); pg8::shx_add2(pp, 32, lane); }
          if (g == 0) {
#pragma unroll
              for (int nt = 0; nt < NTC; ++nt) red[vb * 64 + (th * NTC + nt) * 16 + l15] = pp[nt]; } }
        __syncthreads();
        float rsum[NTC];
#pragma unroll
        for (int np = 0; np < NTC / 2; ++np) { float r16[16]; ds_read16_red(lds + L_RED + ((th * NTC + 2 * np) * 16 + l15) * 4, r16);
#pragma unroll
            for (int q = 0; q < 2; ++q) { float s = 0.f;
#pragma unroll
                for (int w = 0; w < VB; ++w) s += r16[q * 8 + w];
                rsum[2 * np + q] = s; } }
#pragma unroll
        for (int nt = 0; nt < NTC; ++nt) { const int t = (th * NTC + nt) * 16 + l15; const float s = rsum[nt];
            const float rstd = rsqrtf(s * (1.0f / DV) + EPS);
            bf16* rowp = base + (size_t)t * LD; const u32x4 gg = gt[nt];
            u32x4 w; w.x = pk2(acc[0][nt][0] * rstd * __uint_as_float(gg.x << 16), acc[0][nt][1] * rstd * __uint_as_float(gg.x & 0xffff0000u));
            w.y = pk2(acc[0][nt][2] * rstd * __uint_as_float(gg.y << 16), acc[0][nt][3] * rstd * __uint_as_float(gg.y & 0xffff0000u));
            w.z = pk2(acc[1][nt][0] * rstd * __uint_as_float(gg.z << 16), acc[1][nt][1] * rstd * __uint_as_float(gg.z & 0xffff0000u));
            w.w = pk2(acc[1][nt][2] * rstd * __uint_as_float(gg.w << 16), acc[1][nt][3] * rstd * __uint_as_float(gg.w & 0xffff0000u));
            if (!DRY || w.x == 0x12345678u) *(u32x4*)(rowp + vcol + v0 + 8 * g) = w; }
    }
    __syncthreads();
}
constexpr int KL_STR = 272, VL_STR = 528, L_KL = 0, L_VL = 256 * KL_STR;
static_assert(L_VL + 128 * VL_STR <= LDS_BYTES, "xattn LDS map");
template <bool DRY = false>
__device__ __forceinline__ void xattn(LAS unsigned char* lds, bf16* proj, int LD, int xcol, const bf16* KM, const bf16* VMT, int G, int bid, const int tid) {
    const int lane = tid & 63, wave = tid >> 6, g = lane >> 4, l15 = lane & 15;
    for (int w = bid; w < 256; w += G) {
        const int pair = w >> 4, sub = w & 15, b = pair >> 2, h = pair & 3;
        __syncthreads();
        { u32x4 kr[8], vr[8];
#pragma unroll
          for (int i = 0; i < 8; ++i) { const int c = tid + i * NT; kr[i] = *(const u32x4*)(KM + (size_t)(b * 256 + (c >> 4)) * 512 + h * 128 + (c & 15) * 8);
              vr[i] = *(const u32x4*)(VMT + ((size_t)b * 512 + h * 128 + (c >> 5)) * 256 + (c & 31) * 8); }
#pragma unroll
          for (int i = 0; i < 8; ++i) { const int c = tid + i * NT; *(LAS u32x4*)(lds + L_KL + (c >> 4) * KL_STR + (c & 15) * 16) = kr[i];
              *(LAS u32x4*)(lds + L_VL + (c >> 5) * VL_STR + (c & 31) * 16) = vr[i]; } }
        __syncthreads();
        bf16x8 qn[4];
        { const bf16* q0 = proj + (size_t)(b * T + (sub * 4) * 128 + wave * 16 + l15) * LD + xcol + h * 128;
#pragma unroll
          for (int kk = 0; kk < 4; ++kk) qn[kk] = *(const bf16x8*)(q0 + kk * 32 + 8 * g); }
        for (int tile = 0; tile < 4; ++tile) {
            const int r0 = b * T + (sub * 4 + tile) * 128 + wave * 16;
            bf16* qp = proj + (size_t)(r0 + l15) * LD + xcol + h * 128;
            bf16x8 qf[4];
#pragma unroll
            for (int kk = 0; kk < 4; ++kk) qf[kk] = qn[kk];
            if (tile < 3) {
#pragma unroll
                for (int kk = 0; kk < 4; ++kk) qn[kk] = *(const bf16x8*)(qp + (size_t)128 * LD + kk * 32 + 8 * g); }
            f32x4 sc[16];
#pragma unroll
            for (int mp = 0; mp < 8; ++mp) {
                bf16x8 afr[2][4];
#pragma unroll
                for (int m2 = 0; m2 < 2; ++m2)
#pragma unroll
                    for (int kk = 0; kk < 4; ++kk) afr[m2][kk] = *(const LAS bf16x8*)(lds + L_KL + ((mp * 2 + m2) * 16 + l15) * KL_STR + (kk * 32 + 8 * g) * 2);
#pragma unroll
                for (int m2 = 0; m2 < 2; ++m2) { f32x4 c = (f32x4){0.f, 0.f, 0.f, 0.f};
#pragma unroll
                    for (int kk = 0; kk < 4; ++kk) c = MFMA16(afr[m2][kk], qf[kk], c);
                    sc[mp * 2 + m2] = c; } }
            float mx = -1e30f;
#pragma unroll
            for (int mt = 0; mt < 16; ++mt) mx = fmaxf(mx, fmaxf(fmaxf(sc[mt][0], sc[mt][1]), fmaxf(sc[mt][2], sc[mt][3])));
            mx = fmaxf(mx, pg8::shx(mx, 16, lane)); mx = fmaxf(mx, pg8::shx(mx, 32, lane));
            float sum = 0.f;
#pragma unroll
            for (int mt = 0; mt < 16; ++mt) {
#pragma unroll
                for (int j = 0; j < 4; ++j) { const float p = __expf(sc[mt][j] - mx); sc[mt][j] = p; sum += p; } }
            sum += pg8::shx(sum, 16, lane); sum += pg8::shx(sum, 32, lane);
            const float inv = 1.0f / sum;
            f32x4 oa[8];
#pragma unroll
            for (int dt = 0; dt < 8; ++dt) oa[dt] = (f32x4){0.f, 0.f, 0.f, 0.f};
#pragma unroll
            for (int kb = 0; kb < 8; ++kb) {
                union { bf16x8 v; unsigned u[4]; } pb;
                pb.u[0] = pk2(sc[2 * kb][0], sc[2 * kb][1]); pb.u[1] = pk2(sc[2 * kb][2], sc[2 * kb][3]); pb.u[2] = pk2(sc[2 * kb + 1][0], sc[2 * kb + 1][1]); pb.u[3] = pk2(sc[2 * kb + 1][2], sc[2 * kb + 1][3]);
                union { bf16x8 v; u32x2 h[2]; } pa[8];
#pragma unroll
                for (int dt = 0; dt < 8; ++dt) { const LAS unsigned char* vp = lds + L_VL + ((dt >> 1) * 32 + 8 * (l15 >> 2) + 4 * (dt & 1) + (l15 & 3)) * VL_STR + (kb * 32 + 4 * g) * 2;
                    pa[dt].h[0] = *(const LAS u32x2*)vp; pa[dt].h[1] = *(const LAS u32x2*)(vp + 32); }
#pragma unroll
                for (int dt = 0; dt < 8; ++dt) oa[dt] = MFMA16(pa[dt].v, pb.v, oa[dt]);
            }
#pragma unroll
            for (int P = 0; P < 4; ++P) { u32x4 o; o.x = pk2(oa[2 * P][0] * inv, oa[2 * P][1] * inv); o.y = pk2(oa[2 * P][2] * inv, oa[2 * P][3] * inv);
                o.z = pk2(oa[2 * P + 1][0] * inv, oa[2 * P + 1][1] * inv); o.w = pk2(oa[2 * P + 1][2] * inv, oa[2 * P + 1][3] * inv); if (!DRY || o.x == 0x12345678u) *(u32x4*)(qp + P * 32 + 8 * g) = o; }
        }
    }
    __syncthreads();
}
__device__ __forceinline__ void final_norm(float* out, const bf16* XB, const float* SS, const float* gain, int gw, int ngw, int lane) {
    f32x4 gv[4];
#pragma unroll
    for (int j = 0; j < 4; ++j) gv[j] = ((const f32x4*)gain)[lane + 64 * j];
    for (int m = gw; m < M; m += 2 * ngw) {
        const int m1 = (m + ngw < M) ? m + ngw : m; const bool two = (m1 != m);
        float sv[2]; sv[0] = lane < 16 ? SS[(size_t)lane * M + m] : 0.f; sv[1] = lane < 16 ? SS[(size_t)lane * M + m1] : 0.f;
        const u32x2* xr0 = (const u32x2*)(XB + (size_t)m * D) + lane; const u32x2* xr1 = (const u32x2*)(XB + (size_t)m1 * D) + lane;
        u32x2 xa[4], xb_[4];
#pragma unroll
        for (int j = 0; j < 4; ++j) { xa[j] = xr0[64 * j]; xb_[j] = xr1[64 * j]; }
#pragma unroll
        for (int o = 1; o < 64; o <<= 1) pg8::shx_add2(sv, o, lane);
        const float rstd0 = rsqrtf(sv[0] * (1.0f / D) + EPS), rstd1 = rsqrtf(sv[1] * (1.0f / D) + EPS);
        f32x4* or0 = (f32x4*)(out + (size_t)m * D) + lane; f32x4* or1 = (f32x4*)(out + (size_t)m1 * D) + lane;
#pragma unroll
        for (int j = 0; j < 4; ++j) { const u32x2 xw = xa[j]; f32x4 v = (f32x4){__uint_as_float(xw.x << 16), __uint_as_float(xw.x & 0xffff0000u), __uint_as_float(xw.y << 16), __uint_as_float(xw.y & 0xffff0000u)};
            or0[64 * j] = v * rstd0 * gv[j]; }
        if (two) {
#pragma unroll
            for (int j = 0; j < 4; ++j) { const u32x2 xw = xb_[j]; f32x4 v = (f32x4){__uint_as_float(xw.x << 16), __uint_as_float(xw.x & 0xffff0000u), __uint_as_float(xw.y << 16), __uint_as_float(xw.y & 0xffff0000u)};
                or1[64 * j] = v * rstd1 * gv[j]; } }
    }
}

struct Args { Ptrs P; int ph_lo, ph_hi; };
constexpr int N_PHASES = 2 + 7 * DEPTH;
__global__ void __launch_bounds__(NT, 2) fwd_kernel(Args a) {
    extern __shared__ __attribute__((aligned(16))) unsigned char lds_raw[];
#if ONE_LAUNCH
    cg::grid_group grid = cg::this_grid();
    { volatile LAS unsigned* st = (volatile LAS unsigned*)((LAS unsigned char*)lds_raw + LDS_BARST); int t0_ = threadIdx.x; if (t0_ == 0) { st[0] = 0u; st[1] = 0u; } __syncthreads();
      (void)xcd_barrier_post((unsigned*)(a.P.ws + WS_CTL), st, t0_); }
#define SEAM() do { XcdBarrier xb_; xb_.bar = (unsigned*)(ws + WS_CTL); xb_.x = xb_xcc_id(); xb_.st = (volatile LAS unsigned*)(lds + LDS_BARST); xcd_barrier(xb_, tid); if (ph == 0) grid.sync(); } while (0)
#else
#define SEAM() do {} while (0)
#endif
    const int ph_lo = a.ph_lo, ph_hi = a.ph_hi;
    const int wave0 = __builtin_amdgcn_readfirstlane(threadIdx.x >> 6);
    for (int ph = ph_lo; ph < ph_hi; ++ph) {
        const __attribute__((address_space(4))) Args* ap = (const __attribute__((address_space(4))) Args*)__builtin_amdgcn_kernarg_segment_ptr();
        asm volatile("" : "+s"(ap));
        int zero_ = 0; asm volatile("" : "+v"(zero_));
        int tid = wave0 * 64 + (int)__builtin_amdgcn_mbcnt_hi(~0u, __builtin_amdgcn_mbcnt_lo(~0u, (unsigned)zero_)); asm volatile("" : "+v"(tid));
        LAS unsigned char* lds = (LAS unsigned char*)lds_raw;
        const int lane = tid & 63, wave = __builtin_amdgcn_readfirstlane(tid >> 6);
        int G = gridDim.x, bid = blockIdx.x; asm volatile("" : "+s"(G), "+s"(bid));
        const int gw = bid * NWAVES + wave, ngw = G * NWAVES;
        unsigned char* ws = ap->P.ws;
        float* SS = (float*)(ws + WS_SS); bf16* XB = (bf16*)ap->P.out; bf16* GS = (bf16*)(ws + WS_XB); bf16* X2 = (bf16*)(ws + WS_XB); bf16* PROJ = (bf16*)(ws + WS_PROJ);
        int ngemm = 0;
        int L = 0, sp = 0; bool hg = false;
        if (ph == 0) { prologue(&ap->P, lds, gw, ngw, wave, lane); }
        else if (ph == N_PHASES - 1) { final_norm(ap->P.out, X2, SS, ap->P.final_norm, gw, ngw, lane); }
        else {
            L = (ph - 1) / 7; sp = (ph - 1) % 7; hg = (L & 1);
            const int LD = hg ? HGRN_N : GLA_N;
            if (sp == 0) ngemm = (L == 0) ? 2 : 1;
            else if (sp == 1) {
                float* DEC = (float*)(ws + WS_DEC);
#if EXP == 3
                if (hg) pass_a<128, true>(lds, PROJ, GS, DEC, G, bid, tid); else pass_a<256, false>(lds, PROJ, GS, DEC, G, bid, tid);
#endif
                if (hg) pass_a<128, true>(lds, PROJ, GS, DEC, G, bid, tid); else pass_a<256, false>(lds, PROJ, GS, DEC, G, bid, tid);
#if EXP == 5
                xattn<true>(lds, PROJ, LD, hg ? 4096 : 3584, (const bf16*)(ws + WS_KM) + (size_t)L * 1024 * 512, (const bf16*)(ws + WS_VMT) + (size_t)L * 4 * 512 * 256, G, bid, tid);
#endif
#if EXP == 6
                if (L + 1 < DEPTH) { convert_layer(&ap->P, L + 1, lds, gw, ngw, wave, lane); } __syncthreads();
#endif
                xattn(lds, PROJ, LD, hg ? 4096 : 3584, (const bf16*)(ws + WS_KM) + (size_t)L * 1024 * 512, (const bf16*)(ws + WS_VMT) + (size_t)L * 4 * 512 * 256, G, bid, tid);
                if (L + 1 < DEPTH) { convert_layer(&ap->P, L + 1, lds, gw, ngw, wave, lane); }
            } else if (sp == 2) {
                const float* DEC = (const float*)(ws + WS_DEC);
#if EXP == 3
                if (hg) pass_b<128, true, true>(GS, DEC, G, bid, tid); else pass_b<256, false, true>(GS, DEC, G, bid, tid);
#endif
                if (hg) pass_b<128, true>(GS, DEC, G, bid, tid); else pass_b<256, false>(GS, DEC, G, bid, tid);
            } else if (sp == 3) {
#if EXP == 4
                if (hg) pass_c<128, true, true>(lds, PROJ, GS, G, bid, tid); else pass_c<256, false, true>(lds, PROJ, GS, G, bid, tid);
#endif
                if (hg) pass_c<128, true>(lds, PROJ, GS, G, bid, tid); else pass_c<256, false>(lds, PROJ, GS, G, bid, tid);
            } else ngemm = 1;
            if (EXP == 2 && (sp == 0 || sp == 5)) ngemm += 8;
        }
        for (int rep = 0; rep < (ngemm & 7) * (ngemm >= 8 ? 2 : 1); ++rep) {
            unsigned char* wb = ws + WS_WT + (size_t)(L & 1) * WT_BUF;
            const int LD = hg ? HGRN_N : GLA_N;
            pg8::Gemm g; pg8::EpiAll E; E.hgrn = hg ? 1 : 0; E.M = M; E.aux = nullptr; E.xin = nullptr; E.xout = nullptr;
            if (sp == 0 && (ngemm & 7) == 2 && (rep & 7) == 0 && rep < 8) {
                g.A = (const bf16*)(ws + WS_MEMB); g.Bt = (const bf16*)(ws + WS_WKV); g.M = MROWS; g.N = 4096; g.K = D; g.lda = D; g.perm = 0;
                E.kind = 3; E.ldc = 0; E.O = (bf16*)(ws + WS_KM); E.ss = (const float*)(ws + WS_SSM); E.xout = (float*)(ws + WS_VMT);
            } else if (sp == 0) {
                g.A = XB; g.Bt = (const bf16*)(wb + WT_IN); g.M = M; g.N = LD; g.K = D; g.lda = D; g.perm = 1;
                E.kind = 0; E.ldc = LD; E.O = PROJ; E.ss = SS; E.aux = hg ? (const float*)(ws + WS_LB) + (size_t)L * 1024 : ap->P.gla_b_gate + (size_t)(L >> 1) * 512;
            } else if (sp == 4) {
                g.A = PROJ + (hg ? 3072 : 2560); g.Bt = (const bf16*)(wb + WT_OUT); g.M = M; g.N = D; g.K = KOUT; g.lda = LD; g.perm = 1;
                E.kind = 2; E.ldc = D; E.O = XB; E.ss = SS; E.xin = (L == 0 && ph_hi < 0) ? ap->P.x : nullptr; E.xout = (float*)XB;
            } else if (sp == 5) {
                g.A = XB; g.Bt = (const bf16*)(wb + WT_UP); g.M = M; g.N = FF; g.K = D; g.lda = D; g.perm = 1;
                E.kind = 1; E.ldc = FF; E.O = PROJ; E.ss = SS;
            } else {
                g.A = PROJ; g.Bt = (const bf16*)(wb + WT_DOWN); g.M = M; g.N = D; g.K = FF; g.lda = FF; g.perm = 1;
                E.kind = 2; E.ldc = D; E.O = XB; E.ss = SS; E.xout = (float*)((L == DEPTH - 1) ? X2 : XB);
            }
#if EXP == 9
            if (E.kind == 2) { pg8::Gemm g2 = g; g2.perm = 1; pg8::EpiAll E2 = E; E2.kind = 1; E2.ldc = D; E2.O = GS; E2.ss = SS; E2.xin = nullptr;
                pg8::StaticOrder S2; S2.init(g2.M, g2.N, G, bid); pg8::gemm_phase<pg8::EpiAll, pg8::StaticOrder, true, true>(lds, g2, S2, E2, tid); }
#endif
            pg8::StaticOrder S; S.init(g.M, g.N, G, bid, (sp == 6) ? REV_DOWN : 0);
#if SKEW_TICKS > 0
            if (E.kind <= 1) {
                const unsigned long long t0_ = __builtin_amdgcn_s_memrealtime(); const unsigned long long dl_ = (unsigned long long)((bid & 7) * SKEW_TICKS);
                while (__builtin_amdgcn_s_memrealtime() - t0_ < dl_) __builtin_amdgcn_s_sleep(8);
            }
#endif
            pg8::gemm_phase<pg8::EpiAll, pg8::StaticOrder, true, true>(lds, g, S, E, tid);
        }
        if (ph + 1 < ph_hi) { SEAM(); }
#if EXP == 7
        if (ph + 1 < ph_hi) { SEAM(); }
#endif
    }
}

extern "C" void kernel_launch(void* const* d_in, const int* in_sizes, int n_in, void* d_out, int out_size, void* d_ws, size_t ws_size, hipStream_t stream) {
    static int grid = 0;
    if (grid == 0) {
        if (n_in != 17 || out_size != M * D || ws_size < WS_END) { fprintf(stderr, "kernel_launch: unexpected shapes (n_in %d out %d ws %zu)\n", n_in, out_size, ws_size); grid = -1; return; }
        int dev = 0, cus = 0, per_cu = 0;
        hipGetDevice(&dev); hipDeviceGetAttribute(&cus, hipDeviceAttributeMultiprocessorCount, dev);
        if (hipFuncSetAttribute((const void*)fwd_kernel, hipFuncAttributeMaxDynamicSharedMemorySize, LDS_BYTES) != hipSuccess) { fprintf(stderr, "kernel_launch: hipFuncSetAttribute failed\n"); grid = -1; return; }
        if (hipOccupancyMaxActiveBlocksPerMultiprocessor(&per_cu, (const void*)fwd_kernel, NT, LDS_BYTES) != hipSuccess || per_cu < 1) { fprintf(stderr, "kernel_launch: occupancy query says %d\n", per_cu); per_cu = 1; }
        (void)hipGetLastError();
        grid = cus * per_cu;
        if (grid > 256) grid = 256;
        grid = (grid / 16) * 16;
        fprintf(stderr, "kernel_launch: grid %d (cus %d per_cu %d)\n", grid, cus, per_cu);
    }
    if (grid <= 0) return;
#if ONE_LAUNCH
    if (hipMemsetAsync((char*)d_ws + WS_CTL, 0, CTL_BYTES, stream) != hipSuccess) { fprintf(stderr, "kernel_launch: memset failed\n"); return; }
#endif
    Args a{};
    const float** pp = (const float**)&a.P;
    for (int i = 0; i < 17; ++i) pp[i] = (const float*)d_in[i];
    a.P.out = (float*)d_out; a.P.ws = (unsigned char*)d_ws;
#if ONE_LAUNCH
    a.ph_lo = 0; a.ph_hi = N_PHASES;
    void* args[] = {&a};
    hipError_t e = hipLaunchCooperativeKernel((const void*)fwd_kernel, dim3(grid), dim3(NT), args, LDS_BYTES, stream);
    if (e != hipSuccess) fprintf(stderr, "kernel_launch: cooperative launch failed: %s (grid %d)\n", hipGetErrorString(e), grid);
#else
    for (int ph = 0; ph < N_PHASES; ++ph) { a.ph_lo = ph; a.ph_hi = ph + 1; hipLaunchKernelGGL(fwd_kernel, dim3(grid), dim3(NT), LDS_BYTES, stream, a); }
#endif
}
```
